# Optimizing an MI355X kernel written in HIP

```python
import math
import jax
import jax.numpy as jnp
from jax import lax
import numpy as np

D_MODEL = 1024
BATCH = 8
SEQ = 2048
DEPTH = 1

S5_WIDTH = D_MODEL // 2
S5_GROUP = 16
S5_GROUPS = S5_WIDTH // S5_GROUP
S5_STATE = 64
DT_MIN = 1e-3
DT_MAX = 1e-1

GLA_HEADS = 4
GLA_DK = D_MODEL // 16
GLA_DV = D_MODEL // 8
GLA_KEY = GLA_HEADS * GLA_DK
GLA_VAL = GLA_HEADS * GLA_DV
GLA_GATE_RANK = 16
GLA_GATE_TAU = 16.0
GLA_CHUNK = 64

N_EXPERTS = 256
TOP_K = 8
N_GROUPS = 8
TOPK_GROUPS = 4
EXPERT_FF = D_MODEL // 4
SHARED_FF = D_MODEL // 4
ROUTE_SCALE = 2.5
MOE_BLOCK = 128

EPS = 1e-6
IN_SPLITS = (S5_WIDTH, GLA_KEY, GLA_KEY, GLA_VAL, GLA_GATE_RANK, GLA_VAL, D_MODEL, D_MODEL)
IN_WIDTH = sum(IN_SPLITS)
IN_OFFSETS = [int(o) for o in np.cumsum(IN_SPLITS)[:-1]]

kernel_name = 'hybrid_s5_gla_moe_block'


def rmsnorm(x, g):
    xf = x.astype(jnp.float32)
    r = lax.rsqrt(jnp.mean(xf * xf, axis=-1, keepdims=True) + EPS)
    return (xf * r).astype(x.dtype) * g


def _cmul(ar, ai, br, bi):
    return ar * br - ai * bi, ar * bi + ai * br


def _affine_combine(left, right):
    a1r, a1i, b1r, b1i = left
    a2r, a2i, b2r, b2i = right
    ar, ai = _cmul(a2r, a2i, a1r, a1i)
    br, bi = _cmul(a2r, a2i, b1r, b1i)
    return ar, ai, br + b2r, bi + b2i


def s5_branch(u, lam_re, lam_im, log_dt, b_re, b_im, c_re, c_im, d_skip, w_glu, b_glu):
    bsz, seq, _ = u.shape
    f32 = jnp.float32
    ug = u.reshape(bsz, seq, S5_GROUPS, S5_GROUP).astype(f32)
    lr = lam_re.astype(f32)
    li = lam_im.astype(f32)
    dt = jnp.exp(log_dt.astype(f32))[:, None]
    mag = jnp.exp(lr * dt)
    abar_re = mag * jnp.cos(li * dt)
    abar_im = mag * jnp.sin(li * dt)
    den = lr * lr + li * li
    num_re = abar_re - 1.0
    coef_re = (num_re * lr + abar_im * li) / den
    coef_im = (abar_im * lr - num_re * li) / den
    bbar_re, bbar_im = _cmul(coef_re[..., None], coef_im[..., None], b_re.astype(f32), b_im.astype(f32))
    bu_re = jnp.einsum('blgh,gph->blgp', ug, bbar_re)
    bu_im = jnp.einsum('blgh,gph->blgp', ug, bbar_im)
    a_re = jnp.broadcast_to(abar_re, (1, seq) + abar_re.shape)
    a_im = jnp.broadcast_to(abar_im, (1, seq) + abar_im.shape)
    _, _, s_re, s_im = lax.associative_scan(_affine_combine, (a_re, a_im, bu_re, bu_im), axis=1)
    y = (jnp.einsum('blgp,ghp->blgh', s_re, c_re.astype(f32))
         - jnp.einsum('blgp,ghp->blgh', s_im, c_im.astype(f32))
         + d_skip.astype(f32) * ug)
    y = jax.nn.gelu(y.reshape(bsz, seq, S5_WIDTH)).astype(u.dtype)
    return y * jax.nn.sigmoid(y @ w_glu + b_glu)


def gla_chunk_scan(q, k, v, log_a):
    f32 = jnp.float32
    q, k, v, log_a = (t.astype(f32) for t in (q, k, v, log_a))
    bsz, nh, seq, dk = q.shape
    dv = v.shape[-1]
    nck = seq // GLA_CHUNK

    def to_chunks(t):
        return jnp.moveaxis(t.reshape(bsz, nh, nck, GLA_CHUNK, t.shape[-1]), 2, 0)

    qc, kc, vc, gc = (to_chunks(t) for t in (q, k, v, log_a))
    bc = jnp.cumsum(gc, axis=3)
    causal = jnp.tril(jnp.ones((GLA_CHUNK, GLA_CHUNK), dtype=bool))[:, :, None]

    def step(state, inp):
        qi, ki, vi, bi = inp
        b_last = bi[:, :, -1:, :]
        o_inter = jnp.einsum('bhcd,bhde->bhce', qi * jnp.exp(bi), state)
        rel = bi[:, :, :, None, :] - bi[:, :, None, :, :]
        decay = jnp.exp(jnp.where(causal, rel, -jnp.inf))
        scores = jnp.einsum('bhid,bhjd,bhijd->bhij', qi, ki, decay)
        out = o_inter + jnp.einsum('bhij,bhje->bhie', scores, vi)
        state = (jnp.exp(b_last[:, :, 0, :])[..., None] * state
                 + jnp.einsum('bhjd,bhje->bhde', ki * jnp.exp(b_last - bi), vi))
        return state, out

    s0 = jnp.zeros((bsz, nh, dk, dv), f32)
    _, oc = lax.scan(step, s0, (qc, kc, vc, bc))
    return jnp.moveaxis(oc, 0, 2).reshape(bsz, nh, seq, dv)


def gla_branch(q, k, v, gk_low, r, w_gk2, b_gk2, norm_g):
    bsz, seq, _ = q.shape

    def heads(t, dh):
        return t.reshape(bsz, seq, GLA_HEADS, dh).transpose(0, 2, 1, 3)

    log_a = jax.nn.log_sigmoid((gk_low @ w_gk2 + b_gk2).astype(jnp.float32)) / GLA_GATE_TAU
    o = gla_chunk_scan(heads(q, GLA_DK) * (GLA_DK ** -0.5), heads(k, GLA_DK),
                       heads(v, GLA_DV), heads(log_a, GLA_DK))
    o = rmsnorm(o.astype(q.dtype), norm_g)
    o = o.transpose(0, 2, 1, 3).reshape(bsz, seq, GLA_VAL)
    return o * jax.nn.silu(r)


def moe_ffn(h, w_router, router_bias, w_gate, w_up, w_down, ws_gate, ws_up, ws_down):
    bsz, seq, d = h.shape
    t = bsz * seq
    hf = h.reshape(t, d)
    scores = jax.nn.sigmoid((hf @ w_router).astype(jnp.float32))
    biased = scores + router_bias.astype(jnp.float32)
    grp = biased.reshape(t, N_GROUPS, N_EXPERTS // N_GROUPS)
    grp_score = lax.top_k(grp, 2)[0].sum(-1)
    _, grp_idx = lax.top_k(grp_score, TOPK_GROUPS)
    grp_mask = jnp.any(grp_idx[:, :, None] == jnp.arange(N_GROUPS)[None, None, :], axis=1)
    exp_mask = jnp.repeat(grp_mask, N_EXPERTS // N_GROUPS, axis=1)
    _, idx = lax.top_k(jnp.where(exp_mask, biased, -jnp.inf), TOP_K)
    wts = jnp.take_along_axis(scores, idx, axis=1)
    wts = wts / jnp.sum(wts, axis=-1, keepdims=True) * ROUTE_SCALE

    n_assign = t * TOP_K
    e_flat = idx.reshape(-1)
    tok_flat = jnp.repeat(jnp.arange(t, dtype=jnp.int32), TOP_K)
    w_flat = wts.reshape(-1)
    order = jnp.argsort(e_flat)
    e_s, tok_s, w_s = e_flat[order], tok_flat[order], w_flat[order]
    counts = jnp.bincount(e_flat, length=N_EXPERTS)
    padded = (counts + MOE_BLOCK - 1) // MOE_BLOCK * MOE_BLOCK
    pad_end = jnp.cumsum(padded)
    pad_start = pad_end - padded
    start = jnp.cumsum(counts) - counts
    dest = pad_start[e_s] + (jnp.arange(n_assign, dtype=jnp.int32) - start[e_s])
    n_slots = -(-(n_assign + N_EXPERTS * (MOE_BLOCK - 1)) // MOE_BLOCK) * MOE_BLOCK
    n_blocks = n_slots // MOE_BLOCK
    slot_tok = jnp.full((n_slots,), t, jnp.int32).at[dest].set(tok_s)
    slot_w = jnp.zeros((n_slots,), jnp.float32).at[dest].set(w_s)
    block_exp = jnp.minimum(
        jnp.searchsorted(pad_end, jnp.arange(n_blocks, dtype=jnp.int32) * MOE_BLOCK, side='right'),
        N_EXPERTS - 1)
    h_pad = jnp.concatenate([hf, jnp.zeros((1, d), hf.dtype)], axis=0)

    def block_step(acc, blk):
        toks, bw, e = blk
        xb = h_pad[toks]
        yb = (jax.nn.silu(xb @ w_gate[e]) * (xb @ w_up[e])) @ w_down[e]
        return acc.at[toks].add(yb * bw[:, None].astype(yb.dtype)), None

    acc0 = jnp.zeros((t + 1, d), hf.dtype)
    routed, _ = lax.scan(block_step, acc0, (slot_tok.reshape(n_blocks, MOE_BLOCK),
                                            slot_w.reshape(n_blocks, MOE_BLOCK), block_exp))
    shared = (jax.nn.silu(hf @ ws_gate) * (hf @ ws_up)) @ ws_down
    return (routed[:t] + shared).reshape(bsz, seq, d)


def setup_inputs(seed: int = 0) -> dict:
    key = jax.random.key(seed)
    ks = iter(jax.random.split(key, 40))
    f32 = jnp.float32

    def nrm(shape, scale):
        return scale * jax.random.normal(next(ks), shape, f32)

    L = DEPTH
    n_idx = jnp.arange(S5_STATE, dtype=f32)
    inp = {}
    inp['x'] = nrm((BATCH, SEQ, D_MODEL), 1.0)
    inp['c'] = nrm((BATCH, D_MODEL), 1.0)
    inp['ada_w'] = nrm((L, D_MODEL, 6 * D_MODEL), 0.5 * D_MODEL ** -0.5)
    inp['ada_b'] = nrm((L, 6 * D_MODEL), 0.02)
    inp['norm1_g'] = 1.0 + nrm((L, D_MODEL), 0.05)
    inp['w_in'] = nrm((L, D_MODEL, IN_WIDTH), D_MODEL ** -0.5)
    inp['s5_lam_re'] = -0.5 + nrm((L, S5_GROUPS, S5_STATE), 0.01)
    inp['s5_lam_im'] = jnp.pi * n_idx + nrm((L, S5_GROUPS, S5_STATE), 0.01)
    inp['s5_log_dt'] = jax.random.uniform(next(ks), (L, S5_GROUPS), f32,
                                          math.log(DT_MIN), math.log(DT_MAX))
    inp['s5_b_re'] = nrm((L, S5_GROUPS, S5_STATE, S5_GROUP), (2 * S5_GROUP) ** -0.5)
    inp['s5_b_im'] = nrm((L, S5_GROUPS, S5_STATE, S5_GROUP), (2 * S5_GROUP) ** -0.5)
    inp['s5_c_re'] = nrm((L, S5_GROUPS, S5_GROUP, S5_STATE), (2 * S5_STATE) ** -0.5)
    inp['s5_c_im'] = nrm((L, S5_GROUPS, S5_GROUP, S5_STATE), (2 * S5_STATE) ** -0.5)
    inp['s5_d'] = nrm((L, S5_GROUPS, S5_GROUP), 1.0)
    inp['s5_w_glu'] = nrm((L, S5_WIDTH, S5_WIDTH), S5_WIDTH ** -0.5)
    inp['s5_b_glu'] = nrm((L, S5_WIDTH), 0.02)
    inp['w_proj_a'] = nrm((L, S5_WIDTH, D_MODEL), S5_WIDTH ** -0.5)
    inp['gla_w_gk2'] = nrm((L, GLA_GATE_RANK, GLA_KEY), GLA_GATE_RANK ** -0.5)
    inp['gla_b_gk2'] = nrm((L, GLA_KEY), 0.1)
    inp['gla_norm_g'] = 1.0 + nrm((L, GLA_DV), 0.05)
    inp['w_proj_b'] = nrm((L, GLA_VAL, D_MODEL), GLA_VAL ** -0.5)
    inp['w_out'] = nrm((L, D_MODEL, D_MODEL), D_MODEL ** -0.5)
    inp['norm2_g'] = 1.0 + nrm((L, D_MODEL), 0.05)
    inp['router_w'] = nrm((L, D_MODEL, N_EXPERTS), D_MODEL ** -0.5)
    inp['router_bias'] = nrm((L, N_EXPERTS), 0.01)
    inp['exp_w_gate'] = nrm((L, N_EXPERTS, D_MODEL, EXPERT_FF), D_MODEL ** -0.5)
    inp['exp_w_up'] = nrm((L, N_EXPERTS, D_MODEL, EXPERT_FF), D_MODEL ** -0.5)
    inp['exp_w_down'] = nrm((L, N_EXPERTS, EXPERT_FF, D_MODEL), EXPERT_FF ** -0.5)
    inp['sh_w_gate'] = nrm((L, D_MODEL, SHARED_FF), D_MODEL ** -0.5)
    inp['sh_w_up'] = nrm((L, D_MODEL, SHARED_FF), D_MODEL ** -0.5)
    inp['sh_w_down'] = nrm((L, SHARED_FF, D_MODEL), SHARED_FF ** -0.5)
    inp['final_g'] = 1.0 + nrm((D_MODEL,), 0.05)
    return inp


def reference(x, c, ada_w, ada_b, norm1_g, w_in, s5_lam_re, s5_lam_im, s5_log_dt, s5_b_re, s5_b_im,
              s5_c_re, s5_c_im, s5_d, s5_w_glu, s5_b_glu, w_proj_a, gla_w_gk2, gla_b_gk2, gla_norm_g,
              w_proj_b, w_out, norm2_g, router_w, router_bias, exp_w_gate, exp_w_up, exp_w_down,
              sh_w_gate, sh_w_up, sh_w_down, final_g):
    for l in range(DEPTH):
        mod = jax.nn.silu(c) @ ada_w[l] + ada_b[l]
        sh1, sc1, g1, sh2, sc2, g2 = jnp.split(mod[:, None, :], 6, axis=-1)
        h = rmsnorm(x, norm1_g[l]) * (1.0 + sc1) + sh1
        u_s5, q, k, v, gk_low, r, gate_a, gate_b = jnp.split(h @ w_in[l], IN_OFFSETS, axis=-1)
        y_a = s5_branch(u_s5, s5_lam_re[l], s5_lam_im[l], s5_log_dt[l], s5_b_re[l], s5_b_im[l],
                        s5_c_re[l], s5_c_im[l], s5_d[l], s5_w_glu[l], s5_b_glu[l])
        y_b = gla_branch(q, k, v, gk_low, r, gla_w_gk2[l], gla_b_gk2[l], gla_norm_g[l])
        mixed = (jax.nn.sigmoid(gate_a) * (y_a @ w_proj_a[l])
                 + jax.nn.sigmoid(gate_b) * (y_b @ w_proj_b[l]))
        x = x + g1 * (mixed @ w_out[l])
        h = rmsnorm(x, norm2_g[l]) * (1.0 + sc2) + sh2
        x = x + g2 * moe_ffn(h, router_w[l], router_bias[l], exp_w_gate[l], exp_w_up[l],
                             exp_w_down[l], sh_w_gate[l], sh_w_up[l], sh_w_down[l])
    return rmsnorm(x, final_g)
```

```cpp
#include <hip/hip_runtime.h>
#include <hip/hip_cooperative_groups.h>
namespace cg = cooperative_groups;
#include <cstdint>
#include <cstdio>

typedef unsigned short bf16_t;
typedef short s16x8 __attribute__((ext_vector_type(8)));
typedef short s16x4 __attribute__((ext_vector_type(4)));
typedef float f32x4 __attribute__((ext_vector_type(4)));
typedef unsigned u32x4 __attribute__((ext_vector_type(4)));
typedef unsigned u32x2 __attribute__((ext_vector_type(2)));
#define LAS __attribute__((address_space(3)))
typedef LAS unsigned char* lds_ptr;

constexpr int D = 1024, NB = 8, SEQ = 2048, T = NB * SEQ;
constexpr int S5W = 512, S5G = 32, S5H = 16, S5P = 64;
constexpr int GH = 4, GDK = 64, GDV = 128, GKEY = 256, GVAL = 512, GRANK = 16;
constexpr int NE = 256, TOPK = 8, NGRP = 8, EFF = 256, SFF = 256;
constexpr int INW = 4112, LDP = 4096;
constexpr int OFF_U = 0, OFF_Q = 512, OFF_K = 768, OFF_V = 1024, OFF_R = 1536, OFF_GA = 2048, OFF_GB = 3072;
constexpr int WIN_GK = 1536;
constexpr int NSLOT = 163584, NBLK128 = NSLOT / 128;
constexpr int NTHR = 512;
constexpr int USE_MFMA = 127;
constexpr int USE_NEW = 7;
constexpr int REP_PHASE = -1;
constexpr int MOE_REP_GU = 1, MOE_REP_DN = 1;

__device__ __forceinline__ float bf2f(bf16_t v) { return __uint_as_float(((unsigned)v) << 16); }
__device__ __forceinline__ bf16_t f2bf(float f) { return __builtin_bit_cast(unsigned short, (__bf16)f); }
typedef float f32x2 __attribute__((ext_vector_type(2)));
typedef __bf16 bf16x2_t __attribute__((ext_vector_type(2)));
__device__ __forceinline__ unsigned cvtpk(float lo, float hi) { const f32x2 v = {lo, hi}; return __builtin_bit_cast(unsigned, __builtin_convertvector(v, bf16x2_t)); }
__device__ __forceinline__ float sigmoidf_(float x) { return __builtin_amdgcn_rcpf(1.f + __expf(-x)); }
__device__ __forceinline__ float siluf_(float x) { return x * __builtin_amdgcn_rcpf(1.f + __expf(-x)); }
__device__ __forceinline__ float geluf_(float x) { const float u = 0.7978845608028654f * (x + 0.044715f * x * x * x); return x * __builtin_amdgcn_rcpf(1.f + __expf(-2.f * u)); }
__device__ __forceinline__ float logsigmoidf_(float x) { return fminf(x, 0.f) - __logf(1.f + __expf(-fabsf(x))); }

__device__ __forceinline__ int ltid() { int t = threadIdx.x; asm volatile("" : "+v"(t)); return t; }

struct P {
  const float *x, *c, *ada_w, *ada_b, *norm1_g, *w_in, *lam_re, *lam_im, *log_dt, *b_re, *b_im, *c_re, *c_im, *s5_d, *w_glu, *b_glu, *w_proj_a,
      *w_gk2, *b_gk2, *gla_norm_g, *w_proj_b, *w_out, *norm2_g, *router_w, *router_bias, *ew_gate, *ew_up, *ew_down, *sw_gate, *sw_up, *sw_down, *final_g;
  float* out;
  float* mod;
  bf16_t* wb_in;
  bf16_t* wb_glu;
  bf16_t* wb_pa;
  bf16_t* wb_pb;
  bf16_t* wb_out;
  bf16_t* wb_rs;
  bf16_t* wb_sd;
  bf16_t* h1;
  float* gkl;
  bf16_t* proj;
  float* abar;
  float* bbar;
  bf16_t* yA;
  float* oraw;
  bf16_t* yB;
  bf16_t* zA;
  bf16_t* mixed;
  float* x1;
  bf16_t* h2;
  float* logits;
  int* tk_idx;
  float* tk_w;
  int* tk_rank;
  int* slot_of;
  int* counts;
  int* pad_start;
  int* blk_exp;
  int* slot_tok;
  bf16_t* Y;
  bf16_t* shH;
  bf16_t* S;
  bf16_t* bbarT;
  bf16_t* cmT;
  float* apow64;
  float* s5E;
  float* s5Sin;
  float* glaKV;
  float* glaDec;
  bf16_t* glaSin;
  bf16_t* wgkT;
  int* moe_list;
  int* moe_cnt;
  int* moe_ctr;
  bf16_t* Hbuf;
  unsigned* bar;
};

constexpr int G_ASZ = 128 * 64, G_BSZ = 32 * 512, G_STAGE = G_ASZ + G_BSZ;

__device__ __forceinline__ int a_off(int r, int c) { return r * 64 + ((c ^ ((0x78 >> (((r >> 2) & 3) * 2)) & 3)) << 4); }
__device__ __forceinline__ int b_off(int k, int ch) { return k * 512 + ((ch ^ ((k & 3) | (((k >> 3) & 1) << 2))) << 5); }
__device__ __forceinline__ s16x4 tr_read(lds_ptr p) { return __builtin_bit_cast(s16x4, __builtin_amdgcn_ds_read_tr16_b64_v4i16((LAS s16x4*)p)); }

struct ALoadDense { const bf16_t* A; long lda; __device__ __forceinline__ const bf16_t* rowptr(int r) const { return A + (size_t)r * lda; } };
struct ALoadGatherLds { const bf16_t* A; LAS int* tk; __device__ __forceinline__ const bf16_t* rowptr(int r) const { int t = tk[r]; t = t < 0 ? 0 : t; return A + (size_t)t * D; } };
struct BLoadBf { const bf16_t* Bm; long ldb;
  __device__ __forceinline__ u32x4 load(int kg, int c8) const { return *(const u32x4*)(Bm + (size_t)kg * ldb + c8 * 8); } };
struct BLoadF32 { const float* Bm; long ldb;
  __device__ __forceinline__ u32x4 load(int kg, int c8) const { const float* q = Bm + (size_t)kg * ldb + c8 * 8; const f32x4 a = *(const f32x4*)q, b = *(const f32x4*)(q + 4);
    u32x4 r; r.x = cvtpk(a[0], a[1]); r.y = cvtpk(a[2], a[3]); r.z = cvtpk(b[0], b[1]); r.w = cvtpk(b[2], b[3]); return r; } };
struct BLoadGU { const float* Wg; const float* Wu; long ldb; int h0;
  __device__ __forceinline__ u32x4 load(int kg, int c8) const { const int col = c8 * 8, w = col >> 6, xx = col & 63; const float* base = (xx < 32) ? Wg : Wu;
    const float* q = base + (size_t)kg * ldb + h0 + 32 * w + (xx & 31); const f32x4 a = *(const f32x4*)q, b = *(const f32x4*)(q + 4);
    u32x4 r; r.x = cvtpk(a[0], a[1]); r.y = cvtpk(a[2], a[3]); r.z = cvtpk(b[0], b[1]); r.w = cvtpk(b[2], b[3]); return r; } };

template <bool A_RES, class AL, class BL>
__device__ __forceinline__ void gemm_mainloop(f32x4 (&acc)[4][4], const AL& al, const BL& bl, int nk, lds_ptr stage, lds_ptr resA) {
  const int tid = ltid(), lane = tid & 63, wid = tid >> 6, wm = wid >> 2, wn = wid & 3, fr = lane & 15, fq = lane >> 4;
  const int ar = tid >> 2, ac = tid & 3;
  const int p0 = tid, p1 = tid + 512;
  const int bk0 = p0 >> 5, bc0 = p0 & 31, bk1 = p1 >> 5, bc1 = p1 & 31;
  const bf16_t* aptr = nullptr;
  if (!A_RES) aptr = al.rowptr(ar) + ac * 8;
  const int a_st = a_off(ar, ac);
  const int b_st0 = b_off(bk0, bc0 >> 1) + (bc0 & 1) * 16, b_st1 = b_off(bk1, bc1 >> 1) + (bc1 & 1) * 16;
  int a_rd[4];
#pragma unroll
  for (int mt = 0; mt < 4; ++mt) a_rd[mt] = a_off(wm * 64 + mt * 16 + fr, fq);
  int b_rd[4][2];
#pragma unroll
  for (int nt = 0; nt < 4; ++nt) {
    b_rd[nt][0] = b_off(8 * fq + (fr >> 2), wn * 4 + nt) + (fr & 3) * 8;
    b_rd[nt][1] = b_off(8 * fq + 4 + (fr >> 2), wn * 4 + nt) + (fr & 3) * 8;
  }
#pragma unroll
  for (int mt = 0; mt < 4; ++mt)
#pragma unroll
    for (int nt = 0; nt < 4; ++nt) acc[mt][nt] = (f32x4){0.f, 0.f, 0.f, 0.f};
  u32x4 areg = {0, 0, 0, 0}, breg0, breg1;
  if (!A_RES) areg = *(const u32x4*)aptr;
  breg0 = bl.load(bk0, bc0); breg1 = bl.load(bk1, bc1);
  __syncthreads();
  if (!A_RES) *(LAS u32x4*)(stage + a_st) = areg;
  *(LAS u32x4*)(stage + G_ASZ + b_st0) = breg0;
  *(LAS u32x4*)(stage + G_ASZ + b_st1) = breg1;
  __syncthreads();
  for (int kt = 0; kt < nk; ++kt) {
    const lds_ptr cur = stage + (kt & 1) * G_STAGE, nxt = stage + ((kt + 1) & 1) * G_STAGE;
    const bool more = kt + 1 < nk;
    if (more) {
      if (!A_RES) areg = *(const u32x4*)(aptr + (kt + 1) * 32);
      breg0 = bl.load((kt + 1) * 32 + bk0, bc0); breg1 = bl.load((kt + 1) * 32 + bk1, bc1);
    }
    s16x8 af[4], bfr[4];
    const lds_ptr abase = A_RES ? (resA + kt * G_ASZ) : cur;
#pragma unroll
    for (int mt = 0; mt < 4; ++mt) af[mt] = *(LAS s16x8*)(abase + a_rd[mt]);
#pragma unroll
    for (int nt = 0; nt < 4; ++nt) {
      const s16x4 lo = tr_read(cur + G_ASZ + b_rd[nt][0]), hi = tr_read(cur + G_ASZ + b_rd[nt][1]);
      bfr[nt] = __builtin_shufflevector(lo, hi, 0, 1, 2, 3, 4, 5, 6, 7);
    }
#pragma unroll
    for (int mt = 0; mt < 4; ++mt)
#pragma unroll
      for (int nt = 0; nt < 4; ++nt) acc[mt][nt] = __builtin_amdgcn_mfma_f32_16x16x32_bf16(bfr[nt], af[mt], acc[mt][nt], 0, 0, 0);
    if (more) {
      if (!A_RES) *(LAS u32x4*)(nxt + a_st) = areg;
      *(LAS u32x4*)(nxt + G_ASZ + b_st0) = breg0;
      *(LAS u32x4*)(nxt + G_ASZ + b_st1) = breg1;
    }
    __syncthreads();
  }
}


struct BRaw { f32x4 v[4]; };
struct BLoadF32R { const float* Bm; long ldb;
  __device__ __forceinline__ void load(BRaw& r, int kbase, int tid) const {
    const float* q = Bm + (size_t)(kbase + (tid >> 6)) * ldb + (tid & 63) * 4;
#pragma unroll
    for (int i = 0; i < 4; ++i) r.v[i] = *(const f32x4*)(q + (size_t)(8 * i) * ldb); } };
struct BLoadGUR { const float* Wg; long du; long ldb; int h0;
  __device__ __forceinline__ void load(BRaw& r, int kbase, int tid) const {
    const int col = (tid & 63) * 4, w = col >> 6, xx = col & 63;
    const float* q = Wg + ((xx < 32) ? 0l : du) + (size_t)(kbase + (tid >> 6)) * ldb + h0 + 32 * w + (xx & 31);
#pragma unroll
    for (int i = 0; i < 4; ++i) r.v[i] = *(const f32x4*)(q + (size_t)(8 * i) * ldb); } };
__device__ __forceinline__ u32x4 cvt8(const f32x4& a, const f32x4& b) { u32x4 r; r.x = cvtpk(a[0], a[1]); r.y = cvtpk(a[2], a[3]); r.z = cvtpk(b[0], b[1]); r.w = cvtpk(b[2], b[3]); return r; }

template <bool A_RES, class AL, class BL>
__device__ __forceinline__ void gemm_mainloop_r3(f32x4 (&acc)[4][4], const AL& al, const BL& bl, int nk, lds_ptr stage, lds_ptr resA) {
  const int tid = ltid(), lane = tid & 63, wid = tid >> 6, wm = wid >> 2, wn = wid & 3, fr = lane & 15, fq = lane >> 4;
  const int ar = tid >> 2, ac = tid & 3;
  const bf16_t* aptr = nullptr;
  if (!A_RES) aptr = al.rowptr(ar) + ac * 8;
  const int a_st = a_off(ar, ac);
  int b_st[4];
#pragma unroll
  for (int i = 0; i < 4; ++i) b_st[i] = G_ASZ + b_off((tid >> 6) + 8 * i, (tid & 63) >> 2) + (tid & 3) * 8;
  int a_rd[4];
#pragma unroll
  for (int mt = 0; mt < 4; ++mt) a_rd[mt] = a_off(wm * 64 + mt * 16 + fr, fq);
  int b_rd[4][2];
#pragma unroll
  for (int nt = 0; nt < 4; ++nt) {
    b_rd[nt][0] = G_ASZ + b_off(8 * fq + (fr >> 2), wn * 4 + nt) + (fr & 3) * 8;
    b_rd[nt][1] = G_ASZ + b_off(8 * fq + 4 + (fr >> 2), wn * 4 + nt) + (fr & 3) * 8;
  }
#pragma unroll
  for (int mt = 0; mt < 4; ++mt)
#pragma unroll
    for (int nt = 0; nt < 4; ++nt) acc[mt][nt] = (f32x4){0.f, 0.f, 0.f, 0.f};
  u32x4 ra0 = {0, 0, 0, 0}, ra1 = {0, 0, 0, 0}, ra2 = {0, 0, 0, 0};
  BRaw rb0, rb1, rb2;
#define R3_LOAD(RA, RB, kt_) do { if (!A_RES) RA = *(const u32x4*)(aptr + (size_t)(kt_) * 32); bl.load(RB, (kt_) * 32, tid); } while (0)
#define R3_STORE(RA, RB, st_) do { const lds_ptr s_ = stage + (st_) * G_STAGE; if (!A_RES) *(LAS u32x4*)(s_ + a_st) = RA; \
    _Pragma("unroll") for (int i_ = 0; i_ < 4; ++i_) { u32x2 o_; o_.x = cvtpk(RB.v[i_][0], RB.v[i_][1]); o_.y = cvtpk(RB.v[i_][2], RB.v[i_][3]); *(LAS u32x2*)(s_ + b_st[i_]) = o_; } } while (0)
#define R3_COMPUTE(kt_) do { const lds_ptr cur = stage + ((kt_) & 1) * G_STAGE; const lds_ptr abase = A_RES ? (resA + (kt_) * G_ASZ) : cur; \
    s16x8 af[4], bfr[4]; \
    _Pragma("unroll") for (int mt = 0; mt < 4; ++mt) af[mt] = *(LAS s16x8*)(abase + a_rd[mt]); \
    _Pragma("unroll") for (int nt = 0; nt < 4; ++nt) { const s16x4 lo = tr_read(cur + b_rd[nt][0]), hi = tr_read(cur + b_rd[nt][1]); bfr[nt] = __builtin_shufflevector(lo, hi, 0, 1, 2, 3, 4, 5, 6, 7); } \
    _Pragma("unroll") for (int mt = 0; mt < 4; ++mt) _Pragma("unroll") for (int nt = 0; nt < 4; ++nt) acc[mt][nt] = __builtin_amdgcn_mfma_f32_16x16x32_bf16(bfr[nt], af[mt], acc[mt][nt], 0, 0, 0); } while (0)
#define R3_BODY_U(kt_, RAN, RBN, RAW, RBW) do { const int kl_ = ((kt_) + 3 < nk) ? (kt_) + 3 : nk - 1; R3_LOAD(RAN, RBN, kl_); __builtin_amdgcn_sched_barrier(0); R3_COMPUTE(kt_); __builtin_amdgcn_sched_barrier(0); R3_STORE(RAW, RBW, ((kt_) + 1) & 1); __syncthreads(); } while (0)
#define R3_BODY_T(kt_, RAW, RBW) do { R3_COMPUTE(kt_); if ((kt_) + 1 < nk) R3_STORE(RAW, RBW, ((kt_) + 1) & 1); __syncthreads(); } while (0)
  R3_LOAD(ra0, rb0, 0);
  R3_LOAD(ra1, rb1, 1);
  R3_LOAD(ra2, rb2, 2);
  __syncthreads();
  R3_STORE(ra0, rb0, 0);
  __syncthreads();
  int kt = 0;
  for (; kt + 3 <= nk; kt += 3) {
    R3_BODY_U(kt, ra0, rb0, ra1, rb1);
    R3_BODY_U(kt + 1, ra1, rb1, ra2, rb2);
    R3_BODY_U(kt + 2, ra2, rb2, ra0, rb0);
  }
  if (kt < nk) { R3_BODY_T(kt, ra1, rb1); if (kt + 1 < nk) R3_BODY_T(kt + 1, ra2, rb2); }
#undef R3_BODY_U
#undef R3_BODY_T
#undef R3_LOAD
#undef R3_STORE
#undef R3_COMPUTE
}

constexpr int G_NST = 4;
#define WAIT_VM(n) asm volatile("s_waitcnt vmcnt(" #n ")" ::: "memory")
template <class AL>
__device__ __forceinline__ void gemm_mainloop_glds(f32x4 (&acc)[4][4], const AL& al, const bf16_t* __restrict__ Bm, long ldb, int nk, lds_ptr ring) {
  const int tid = ltid(), lane = tid & 63, wid = tid >> 6, wm = wid >> 2, wn = wid & 3, fr = lane & 15, fq = lane >> 4;
  const int ar = tid >> 2;
  const bf16_t* aptr = al.rowptr(ar) + (((tid & 3) ^ ((0x78 >> (((ar >> 2) & 3) * 2)) & 3)) << 3);
  const int bk = tid >> 5, pc = tid & 31;
  const int bcol = ((((pc >> 1) ^ ((bk & 3) | (((bk >> 3) & 1) << 2))) << 4) | ((pc & 1) << 3));
  const bf16_t* bptr0 = Bm + (size_t)bk * ldb + bcol;
  const bf16_t* bptr1 = bptr0 + (size_t)16 * ldb;
  const size_t bstep = (size_t)32 * ldb;
  int a_rd[4];
#pragma unroll
  for (int mt = 0; mt < 4; ++mt) a_rd[mt] = a_off(wm * 64 + mt * 16 + fr, fq);
  int b_rd[4][2];
#pragma unroll
  for (int nt = 0; nt < 4; ++nt) {
    b_rd[nt][0] = G_ASZ + b_off(8 * fq + (fr >> 2), wn * 4 + nt) + (fr & 3) * 8;
    b_rd[nt][1] = G_ASZ + b_off(8 * fq + 4 + (fr >> 2), wn * 4 + nt) + (fr & 3) * 8;
  }
#pragma unroll
  for (int mt = 0; mt < 4; ++mt)
#pragma unroll
    for (int nt = 0; nt < 4; ++nt) acc[mt][nt] = (f32x4){0.f, 0.f, 0.f, 0.f};
  const lds_ptr dstl = ring + tid * 16;
#define GLDS_ISSUE(kt_) do { const lds_ptr d_ = dstl + ((kt_) & (G_NST - 1)) * G_STAGE; \
    __builtin_amdgcn_global_load_lds((const unsigned*)(aptr + (size_t)(kt_) * 32), (LAS unsigned*)(d_), 16, 0, 0); \
    __builtin_amdgcn_global_load_lds((const unsigned*)(bptr0 + (size_t)(kt_) * bstep), (LAS unsigned*)(d_ + G_ASZ), 16, 0, 0); \
    __builtin_amdgcn_global_load_lds((const unsigned*)(bptr1 + (size_t)(kt_) * bstep), (LAS unsigned*)(d_ + G_ASZ + 8192), 16, 0, 0); } while (0)
  __syncthreads();
  GLDS_ISSUE(0);
  if (nk > 1) GLDS_ISSUE(1);
  if (nk > 2) GLDS_ISSUE(2);
  for (int kt = 0; kt < nk; ++kt) {
    if (kt + 2 < nk) WAIT_VM(6); else if (kt + 1 < nk) WAIT_VM(3); else WAIT_VM(0);
    __builtin_amdgcn_s_barrier();
    if (kt + 3 < nk) GLDS_ISSUE(kt + 3);
    const lds_ptr cur = ring + (kt & (G_NST - 1)) * G_STAGE;
    s16x8 af[4], bfr[4];
#pragma unroll
    for (int mt = 0; mt < 4; ++mt) af[mt] = *(LAS s16x8*)(cur + a_rd[mt]);
#pragma unroll
    for (int nt = 0; nt < 4; ++nt) {
      const s16x4 lo = tr_read(cur + b_rd[nt][0]), hi = tr_read(cur + b_rd[nt][1]);
      bfr[nt] = __builtin_shufflevector(lo, hi, 0, 1, 2, 3, 4, 5, 6, 7);
    }
#pragma unroll
    for (int mt = 0; mt < 4; ++mt)
#pragma unroll
      for (int nt = 0; nt < 4; ++nt) acc[mt][nt] = __builtin_amdgcn_mfma_f32_16x16x32_bf16(bfr[nt], af[mt], acc[mt][nt], 0, 0, 0);
  }
#undef GLDS_ISSUE
}


constexpr int G2_STAGE = 2 * G_ASZ + G_BSZ;
__device__ __forceinline__ void gemm_mainloop_glds256(f32x4 (&acc)[8][4], const bf16_t* __restrict__ A, long lda, const bf16_t* __restrict__ Bm, long ldb, int nk, lds_ptr ring) {
  const int tid = ltid(), lane = tid & 63, wid = tid >> 6, wm = wid >> 2, wn = wid & 3, fr = lane & 15, fq = lane >> 4;
  const int ar = tid >> 2;
  const bf16_t* aptr0 = A + (size_t)ar * lda + (((tid & 3) ^ ((0x78 >> (((ar >> 2) & 3) * 2)) & 3)) << 3);
  const bf16_t* aptr1 = aptr0 + (size_t)128 * lda;
  const int bk = tid >> 5, pc = tid & 31;
  const int bcol = ((((pc >> 1) ^ ((bk & 3) | (((bk >> 3) & 1) << 2))) << 4) | ((pc & 1) << 3));
  const bf16_t* bptr0 = Bm + (size_t)bk * ldb + bcol;
  const bf16_t* bptr1 = bptr0 + (size_t)16 * ldb;
  const size_t bstep = (size_t)32 * ldb;
  int a_rd[8];
#pragma unroll
  for (int mt = 0; mt < 8; ++mt) a_rd[mt] = wm * G_ASZ + a_off(mt * 16 + fr, fq);
  int b_rd[4][2];
#pragma unroll
  for (int nt = 0; nt < 4; ++nt) {
    b_rd[nt][0] = 2 * G_ASZ + b_off(8 * fq + (fr >> 2), wn * 4 + nt) + (fr & 3) * 8;
    b_rd[nt][1] = 2 * G_ASZ + b_off(8 * fq + 4 + (fr >> 2), wn * 4 + nt) + (fr & 3) * 8;
  }
#pragma unroll
  for (int mt = 0; mt < 8; ++mt)
#pragma unroll
    for (int nt = 0; nt < 4; ++nt) acc[mt][nt] = (f32x4){0.f, 0.f, 0.f, 0.f};
  const lds_ptr dstl = ring + tid * 16;
#define GLDS2_ISSUE(kt_) do { const lds_ptr d_ = dstl + ((kt_) & (G_NST - 1)) * G2_STAGE; \
    __builtin_amdgcn_global_load_lds((const unsigned*)(aptr0 + (size_t)(kt_) * 32), (LAS unsigned*)(d_), 16, 0, 0); \
    __builtin_amdgcn_global_load_lds((const unsigned*)(aptr1 + (size_t)(kt_) * 32), (LAS unsigned*)(d_ + G_ASZ), 16, 0, 0); \
    __builtin_amdgcn_global_load_lds((const unsigned*)(bptr0 + (size_t)(kt_) * bstep), (LAS unsigned*)(d_ + 2 * G_ASZ), 16, 0, 0); \
    __builtin_amdgcn_global_load_lds((const unsigned*)(bptr1 + (size_t)(kt_) * bstep), (LAS unsigned*)(d_ + 2 * G_ASZ + 8192), 16, 0, 0); } while (0)
  __syncthreads();
  GLDS2_ISSUE(0);
  if (nk > 1) GLDS2_ISSUE(1);
  if (nk > 2) GLDS2_ISSUE(2);
  for (int kt = 0; kt < nk; ++kt) {
    if (kt + 2 < nk) WAIT_VM(8); else if (kt + 1 < nk) WAIT_VM(4); else WAIT_VM(0);
    __builtin_amdgcn_s_barrier();
    if (kt + 3 < nk) GLDS2_ISSUE(kt + 3);
    const lds_ptr cur = ring + (kt & (G_NST - 1)) * G2_STAGE;
    s16x8 bfr[4];
#pragma unroll
    for (int nt = 0; nt < 4; ++nt) {
      const s16x4 lo = tr_read(cur + b_rd[nt][0]), hi = tr_read(cur + b_rd[nt][1]);
      bfr[nt] = __builtin_shufflevector(lo, hi, 0, 1, 2, 3, 4, 5, 6, 7);
    }
#pragma unroll
    for (int h = 0; h < 2; ++h) {
      s16x8 af[4];
#pragma unroll
      for (int mt = 0; mt < 4; ++mt) af[mt] = *(LAS s16x8*)(cur + a_rd[h * 4 + mt]);
#pragma unroll
      for (int mt = 0; mt < 4; ++mt)
#pragma unroll
        for (int nt = 0; nt < 4; ++nt) acc[h * 4 + mt][nt] = __builtin_amdgcn_mfma_f32_16x16x32_bf16(bfr[nt], af[mt], acc[h * 4 + mt][nt], 0, 0, 0);
    }
  }
#undef GLDS2_ISSUE
}

__device__ __forceinline__ void tile_map(int round, int bid, int nb, int nMt, int nNt, int& mt, int& nt, bool& valid) {
  if (nb == 256 && (nNt & 3) == 0 && (nMt & 7) == 0) {
    const int xcd = bid & 7, j = bid >> 3, q = round * 8 + xcd, rn = nNt >> 2;
    const int rect_m = q / rn, rect_n = q % rn;
    mt = rect_m * 8 + (j & 7); nt = rect_n * 4 + (j >> 3); valid = mt < nMt;
  } else {
    const int per = (nb + 7) / 8, xcd = bid & 7, j = bid >> 3;
    const int idx = round * nb + xcd * per + j;
    mt = idx / nNt; nt = idx % nNt; valid = (j < per) && (idx < nMt * nNt) && (xcd * per + j < nb);
  }
}

__device__ __forceinline__ void cvt_copy(const float* __restrict__ src, long lds_, bf16_t* __restrict__ dst, long ldd, int rows, int cols, int gtid, int gsz) {
  const int c4 = cols >> 2;
  for (long i = gtid; i < (long)rows * c4; i += gsz) {
    const int r = (int)(i / c4), c = (int)(i % c4) * 4;
    const f32x4 v = *(const f32x4*)(src + (size_t)r * lds_ + c);
    u32x2 o; o.x = cvtpk(v[0], v[1]); o.y = cvtpk(v[2], v[3]);
    *(u32x2*)(dst + (size_t)r * ldd + c) = o;
  }
}
__device__ __forceinline__ void phase_prep(const P& p, int bid, int nb, lds_ptr smem) {
  const int gtid = bid * NTHR + ltid(), gsz = nb * NTHR;
  cvt_copy(p.w_in, INW, p.wb_in, LDP, D, WIN_GK, gtid, gsz);
  cvt_copy(p.w_in + WIN_GK + 16, INW, p.wb_in + WIN_GK, LDP, D, LDP - WIN_GK, gtid, gsz);
  cvt_copy(p.w_glu, S5W, p.wb_glu, S5W, S5W, S5W, gtid, gsz);
  cvt_copy(p.w_proj_a, D, p.wb_pa, D, S5W, D, gtid, gsz);
  cvt_copy(p.w_proj_b, D, p.wb_pb, D, GVAL, D, gtid, gsz);
  cvt_copy(p.w_out, D, p.wb_out, D, D, D, gtid, gsz);
  cvt_copy(p.router_w, NE, p.wb_rs, 768, D, NE, gtid, gsz);
  cvt_copy(p.sw_down, D, p.wb_sd, D, SFF, D, gtid, gsz);
  for (long i = gtid; i < (long)D * 512; i += gsz) {
    const int k = (int)(i >> 9), cc = (int)(i & 511), w = cc >> 6, xx = cc & 63;
    const int hcol = 32 * w + (xx & 31);
    const float v = (xx < 32) ? p.sw_gate[(size_t)k * SFF + hcol] : p.sw_up[(size_t)k * SFF + hcol];
    p.wb_rs[(size_t)k * 768 + 256 + cc] = f2bf(v);
  }
  for (int i = gtid; i < 16 * D; i += gsz) { const int n = i >> 10, k = i & 1023; p.wgkT[i] = f2bf(p.w_in[(size_t)k * INW + WIN_GK + n]); }
  for (int i = gtid; i < NSLOT; i += gsz) p.slot_tok[i] = -1;
  if (gtid < 256) p.counts[gtid] = 0;
  if (gtid < 16) p.moe_ctr[gtid] = 0;
  if (ltid() < 8 && bid * 8 + ltid() < S5G * S5P) {
    const int i = bid * 8 + ltid(), g = i / S5P;
    const double lr = p.lam_re[i], li = p.lam_im[i], dt = (double)__expf(p.log_dt[g]);
    const double TWO_PI = 6.283185307179586476925286766559;
    double ang = li * dt; ang -= TWO_PI * floor(ang / TWO_PI);
    const double mag = (double)__expf((float)(lr * dt));
    const double are = mag * (double)cosf((float)ang), aim = mag * (double)sinf((float)ang);
    const double den = lr * lr + li * li, nre = are - 1.0;
    const double cre = (nre * lr + aim * li) / den, cim = (aim * lr - nre * li) / den;
    p.abar[i * 2] = (float)are; p.abar[i * 2 + 1] = (float)aim;
    for (int h = 0; h < S5H; ++h) {
      const double br = p.b_re[i * S5H + h], bi = p.b_im[i * S5H + h];
      p.bbar[(i * S5H + h) * 2] = (float)(cre * br - cim * bi);
      p.bbar[(i * S5H + h) * 2 + 1] = (float)(cre * bi + cim * br);
      const int pq = i & 63;
      p.bbarT[(size_t)(g * 128 + pq) * 16 + h] = f2bf((float)(cre * br - cim * bi));
      p.bbarT[(size_t)(g * 128 + 64 + pq) * 16 + h] = f2bf((float)(cre * bi + cim * br));
    }
    double a64 = 64.0 * li * dt; a64 -= TWO_PI * floor(a64 / TWO_PI);
    const double m64 = (double)__expf((float)(64.0 * lr * dt));
    p.apow64[i * 2] = (float)(m64 * (double)cosf((float)a64)); p.apow64[i * 2 + 1] = (float)(m64 * (double)sinf((float)a64));
  }
  for (int i = gtid; i < S5G * S5H * 128; i += gsz) {
    const int pp = i & 127, ho = (i >> 7) & 15, g = i >> 11;
    p.cmT[i] = f2bf(pp < 64 ? p.c_re[(g * 16 + ho) * 64 + pp] : -p.c_im[(g * 16 + ho) * 64 + pp - 64]);
  }
  LAS float* red = (LAS float*)smem;
  LAS float* sc = (LAS float*)(smem + 16384);
  if (bid < 192) {
    __syncthreads();
    for (int i = ltid(); i < 8 * D; i += NTHR) sc[i] = siluf_(p.c[i]);
    __syncthreads();
  }
  for (int item = bid; item < 192; item += nb) {
    const int cl = ltid() & 31, kg = ltid() >> 5, col = item * 32 + cl;
    float acc[8];
#pragma unroll
    for (int b = 0; b < 8; ++b) acc[b] = 0.f;
    const float* wp = p.ada_w + (size_t)(kg * 64) * 6144 + col;
#pragma unroll 1
    for (int k0 = 0; k0 < 64; k0 += 16) {
      float w[16];
#pragma unroll
      for (int q = 0; q < 16; ++q) w[q] = wp[(size_t)(k0 + q) * 6144];
#pragma unroll
      for (int q = 0; q < 16; ++q)
#pragma unroll
        for (int b = 0; b < 8; ++b) acc[b] += sc[b * D + kg * 64 + k0 + q] * w[q];
    }
    __syncthreads();
#pragma unroll
    for (int b = 0; b < 8; ++b) red[(kg * 8 + b) * 32 + cl] = acc[b];
    __syncthreads();
    if (ltid() < 256) {
      const int b = ltid() >> 5, c2 = ltid() & 31;
      float sum = p.ada_b[item * 32 + c2];
      for (int q = 0; q < 16; ++q) sum += red[(q * 8 + b) * 32 + c2];
      p.mod[b * 6144 + item * 32 + c2] = sum;
    }
  }
}

template <bool WITH_GK>
__device__ __forceinline__ void phase_norm(const P& p, const float* __restrict__ xin, const float* __restrict__ g, int sh_off, int sc_off, bf16_t* __restrict__ outp, int bid, int nb, lds_ptr smem) {
  const int lane = ltid() & 63, wid = ltid() >> 6;
  const int stride = nb * 8;
  int row = bid * 8 + wid;
  f32x4 nx[4];
  if (row < T) {
#pragma unroll
    for (int i = 0; i < 4; ++i) nx[i] = *(const f32x4*)(xin + (size_t)row * D + lane * 4 + 256 * i);
  }
  f32x4 gv[4];
#pragma unroll
  for (int i = 0; i < 4; ++i) gv[i] = *(const f32x4*)(g + lane * 4 + 256 * i);
  for (; row < T; row += stride) {
    const int b = row / SEQ;
    f32x4 v[4];
#pragma unroll
    for (int i = 0; i < 4; ++i) v[i] = nx[i];
    const int rn = row + stride;
    if (rn < T) {
#pragma unroll
      for (int i = 0; i < 4; ++i) nx[i] = *(const f32x4*)(xin + (size_t)rn * D + lane * 4 + 256 * i);
    }
    float ss = 0.f;
#pragma unroll
    for (int i = 0; i < 4; ++i) ss += v[i][0] * v[i][0] + v[i][1] * v[i][1] + v[i][2] * v[i][2] + v[i][3] * v[i][3];
#pragma unroll
    for (int o = 32; o > 0; o >>= 1) ss += __shfl_xor(ss, o);
    const float r = rsqrtf(ss * (1.f / D) + 1e-6f);
#pragma unroll
    for (int i = 0; i < 4; ++i) {
      const int c0 = lane * 4 + 256 * i;
      const f32x4 scv = *(const f32x4*)(p.mod + b * 6144 + sc_off + c0), shv = *(const f32x4*)(p.mod + b * 6144 + sh_off + c0);
      float y[4];
#pragma unroll
      for (int j = 0; j < 4; ++j) y[j] = (v[i][j] * r) * gv[i][j] * (1.f + scv[j]) + shv[j];
      u32x2 o; o.x = cvtpk(y[0], y[1]); o.y = cvtpk(y[2], y[3]);
      *(u32x2*)(outp + (size_t)row * D + c0) = o;
    }
  }
}

struct EpiStoreBf {
  bf16_t* O; long ld;
  template <int MT> __device__ __forceinline__ void operator()(const f32x4 (&acc)[MT][4], int mbase, int nbase, int fr, int fq) const {
    bf16_t* rowp = O + (size_t)(mbase + fr) * ld + nbase + fq * 4;
#pragma unroll
    for (int mt = 0; mt < MT; ++mt) {
#pragma unroll
      for (int nt = 0; nt < 4; ++nt) { const f32x4 v = acc[mt][nt]; u32x2 o; o.x = cvtpk(v[0], v[1]); o.y = cvtpk(v[2], v[3]);
        *(u32x2*)(rowp + nt * 16) = o; }
      rowp += 16 * ld;
      __builtin_amdgcn_sched_barrier(0); }
  }
};
__device__ __forceinline__ f32x4 ld_bf4(const bf16_t* q) { const u32x2 w = *(const u32x2*)q; f32x4 r; r[0] = __uint_as_float(w.x << 16); r[1] = __uint_as_float(w.x & 0xffff0000u); r[2] = __uint_as_float(w.y << 16); r[3] = __uint_as_float(w.y & 0xffff0000u); return r; }
struct EpiGlu {
  const bf16_t* yA; const float* b; bf16_t* z;
  template <int MT> __device__ __forceinline__ void operator()(const f32x4 (&acc)[MT][4], int mbase, int nbase, int fr, int fq) const {
#pragma unroll
    for (int mt = 0; mt < MT; ++mt) {
#pragma unroll
      for (int nt = 0; nt < 4; ++nt) { const int row = mbase + mt * 16 + fr, col = nbase + nt * 16 + fq * 4; const f32x4 v = acc[mt][nt];
        const f32x4 y = ld_bf4(yA + (size_t)row * S5W + col); const f32x4 bb = *(const f32x4*)(b + col);
        u32x2 o; o.x = cvtpk(y[0] * sigmoidf_(v[0] + bb[0]), y[1] * sigmoidf_(v[1] + bb[1])); o.y = cvtpk(y[2] * sigmoidf_(v[2] + bb[2]), y[3] * sigmoidf_(v[3] + bb[3]));
        *(u32x2*)(z + (size_t)row * S5W + col) = o; }
      __builtin_amdgcn_sched_barrier(0); }
  }
};
struct EpiOut {
  const float* x; const float* mod; float* x1;
  template <int MT> __device__ __forceinline__ void operator()(const f32x4 (&acc)[MT][4], int mbase, int nbase, int fr, int fq) const {
#pragma unroll
    for (int mt = 0; mt < MT; ++mt) {
#pragma unroll
      for (int nt = 0; nt < 4; ++nt) { const int row = mbase + mt * 16 + fr, col = nbase + nt * 16 + fq * 4, b = row / SEQ; const f32x4 v = acc[mt][nt];
        const f32x4 xv = *(const f32x4*)(x + (size_t)row * D + col), gg = *(const f32x4*)(mod + b * 6144 + 2 * D + col);
        f32x4 o; o[0] = xv[0] + gg[0] * v[0]; o[1] = xv[1] + gg[1] * v[1]; o[2] = xv[2] + gg[2] * v[2]; o[3] = xv[3] + gg[3] * v[3];
        *(f32x4*)(x1 + (size_t)row * D + col) = o; }
      __builtin_amdgcn_sched_barrier(0); }
  }
};

template <class Epi>
__device__ __forceinline__ void phase_gemm_dense(const bf16_t* A, long lda, const bf16_t* Bm, long ldb, int M, int N, int K, const Epi& epi, int bid, int nb, lds_ptr smem) {
  const int nMt = M / 128, nNt = N / 256, ntiles = nMt * nNt, rounds = (ntiles + nb - 1) / nb;
  const int lane = ltid() & 63, wid = ltid() >> 6, wm = wid >> 2, wn = wid & 3, fr = lane & 15, fq = lane >> 4;
  for (int r = 0; r < rounds; ++r) {
    int mt, nt; bool valid; tile_map(r, bid, nb, nMt, nNt, mt, nt, valid);
    if (!valid) continue;
    f32x4 acc[4][4];
    ALoadDense al{A + (size_t)mt * 128 * lda, lda};
    gemm_mainloop_glds(acc, al, Bm + nt * 256, ldb, K / 32, smem);
    epi.template operator()<4>(acc, mt * 128 + wm * 64, nt * 256 + wn * 64, fr, fq);
  }
}


template <class Epi>
__device__ __forceinline__ void phase_gemm_dense256(const bf16_t* A, long lda, const bf16_t* Bm, long ldb, int M, int N, int K, const Epi& epi, int bid, int nb, lds_ptr smem) {
  const int nMt = M / 256, nNt = N / 256, ntiles = nMt * nNt, rounds = (ntiles + nb - 1) / nb;
  const int lane = ltid() & 63, wid = ltid() >> 6, wm = wid >> 2, wn = wid & 3, fr = lane & 15, fq = lane >> 4;
  for (int r = 0; r < rounds; ++r) {
    int mt, nt; bool valid; tile_map(r, bid, nb, nMt, nNt, mt, nt, valid);
    if (!valid) continue;
    f32x4 acc[8][4];
    gemm_mainloop_glds256(acc, A + (size_t)mt * 256 * lda, lda, Bm + nt * 256, ldb, K / 32, smem);
    epi.template operator()<8>(acc, mt * 256 + wm * 128, nt * 256 + wn * 64, fr, fq);
  }
}

__device__ __forceinline__ void gk_rows(const P& p, int bid, int nb) {
  const int lane = ltid() & 63, wid = ltid() >> 6, fr = lane & 15, fq = lane >> 4;
  if (wid >= 4) return;
  for (int r0 = (bid * 4 + wid) * 16; r0 < T; r0 += nb * 64) {
    const bf16_t* ap = p.h1 + (size_t)(r0 + fr) * D + fq * 8;
    const bf16_t* bp = p.wgkT + (size_t)fr * D + fq * 8;
    f32x4 acc = {0.f, 0.f, 0.f, 0.f};
#pragma unroll 1
    for (int k0 = 0; k0 < 32; k0 += 8) {
      s16x8 a[8], b[8];
#pragma unroll
      for (int q = 0; q < 8; ++q) { a[q] = *(const s16x8*)(ap + (k0 + q) * 32); b[q] = *(const s16x8*)(bp + (k0 + q) * 32); }
#pragma unroll
      for (int q = 0; q < 8; ++q) acc = __builtin_amdgcn_mfma_f32_16x16x32_bf16(a[q], b[q], acc, 0, 0, 0);
    }
#pragma unroll
    for (int j = 0; j < 4; ++j) p.gkl[(size_t)(r0 + 4 * fq + j) * 16 + fr] = acc[j];
  }
}

__device__ __forceinline__ void phase_gemm_mixed(const P& p, int bid, int nb, lds_ptr smem) {
  const int nMt = T / 128, nNt = D / 256, ntiles = nMt * nNt, rounds = (ntiles + nb - 1) / nb;
  const int lane = ltid() & 63, wid = ltid() >> 6, wm = wid >> 2, wn = wid & 3, fr = lane & 15, fq = lane >> 4;
  for (int r = 0; r < rounds; ++r) {
    int mt, nt; bool valid; tile_map(r, bid, nb, nMt, nNt, mt, nt, valid);
    if (!valid) continue;
    const int mbase = mt * 128 + wm * 64, nbase = nt * 256 + wn * 64;
    const bf16_t* gp = p.proj + (size_t)(mbase + fr) * LDP + nbase + fq * 4;
    u32x2 gte[4][4], pk[4][4];
#pragma unroll
    for (int i = 0; i < 4; ++i)
#pragma unroll
      for (int j = 0; j < 4; ++j) gte[i][j] = *(const u32x2*)(gp + (size_t)(i * 16) * LDP + OFF_GA + j * 16);
    f32x4 acc[4][4];
    { ALoadDense al{p.zA + (size_t)mt * 128 * S5W, S5W}; gemm_mainloop_glds(acc, al, p.wb_pa + nt * 256, D, S5W / 32, smem); }
#pragma unroll
    for (int i = 0; i < 4; ++i)
#pragma unroll
      for (int j = 0; j < 4; ++j) {
        const float g0 = __uint_as_float(gte[i][j].x << 16), g1 = __uint_as_float(gte[i][j].x & 0xffff0000u), g2 = __uint_as_float(gte[i][j].y << 16), g3 = __uint_as_float(gte[i][j].y & 0xffff0000u);
        pk[i][j].x = cvtpk(acc[i][j][0] * sigmoidf_(g0), acc[i][j][1] * sigmoidf_(g1)); pk[i][j].y = cvtpk(acc[i][j][2] * sigmoidf_(g2), acc[i][j][3] * sigmoidf_(g3)); }
#pragma unroll
    for (int i = 0; i < 4; ++i)
#pragma unroll
      for (int j = 0; j < 4; ++j) gte[i][j] = *(const u32x2*)(gp + (size_t)(i * 16) * LDP + OFF_GB + j * 16);
    { ALoadDense al{p.yB + (size_t)mt * 128 * GVAL, GVAL}; gemm_mainloop_glds(acc, al, p.wb_pb + nt * 256, D, GVAL / 32, smem); }
    bf16_t* op = p.mixed + (size_t)(mbase + fr) * D + nbase + fq * 4;
#pragma unroll
    for (int i = 0; i < 4; ++i)
#pragma unroll
      for (int j = 0; j < 4; ++j) {
        const float g0 = __uint_as_float(gte[i][j].x << 16), g1 = __uint_as_float(gte[i][j].x & 0xffff0000u), g2 = __uint_as_float(gte[i][j].y << 16), g3 = __uint_as_float(gte[i][j].y & 0xffff0000u);
        const float a0 = __uint_as_float(pk[i][j].x << 16), a1 = __uint_as_float(pk[i][j].x & 0xffff0000u), a2 = __uint_as_float(pk[i][j].y << 16), a3 = __uint_as_float(pk[i][j].y & 0xffff0000u);
        u32x2 o; o.x = cvtpk(a0 + sigmoidf_(g0) * acc[i][j][0], a1 + sigmoidf_(g1) * acc[i][j][1]); o.y = cvtpk(a2 + sigmoidf_(g2) * acc[i][j][2], a3 + sigmoidf_(g3) * acc[i][j][3]);
        *(u32x2*)(op + (size_t)(i * 16) * D + j * 16) = o; }
  }
}

__device__ __forceinline__ void phase_gemm_rs(const P& p, int bid, int nb, lds_ptr smem) {
  const int nMt = T / 256, nNt = 3, ntiles = nMt * nNt, rounds = (ntiles + nb - 1) / nb;
  const int lane = ltid() & 63, wid = ltid() >> 6, wm = wid >> 2, wn = wid & 3, fr = lane & 15, fq = lane >> 4;
  for (int r = 0; r < rounds; ++r) {
    int mt, nt; bool valid; tile_map(r, bid, nb, nMt, nNt, mt, nt, valid);
    if (!valid) continue;
    f32x4 acc[8][4];
    gemm_mainloop_glds256(acc, p.h2 + (size_t)mt * 256 * D, D, p.wb_rs + nt * 256, 768, D / 32, smem);
    const int mbase = mt * 256 + wm * 128;
    if (nt == 0) {
#pragma unroll
      for (int i = 0; i < 8; ++i) {
#pragma unroll
        for (int j = 0; j < 4; ++j) *(f32x4*)(p.logits + (size_t)(mbase + i * 16 + fr) * NE + wn * 64 + j * 16 + fq * 4) = acc[i][j];
        __builtin_amdgcn_sched_barrier(0); }
    } else {
      const int h0 = (nt - 1) * 128 + wn * 32;
#pragma unroll
      for (int i = 0; i < 8; ++i) {
#pragma unroll
        for (int j = 0; j < 2; ++j) { const f32x4 gv = acc[i][j], uv = acc[i][j + 2];
          u32x2 o; o.x = cvtpk(siluf_(gv[0]) * uv[0], siluf_(gv[1]) * uv[1]); o.y = cvtpk(siluf_(gv[2]) * uv[2], siluf_(gv[3]) * uv[3]);
          *(u32x2*)(p.shH + (size_t)(mbase + i * 16 + fr) * SFF + h0 + j * 16 + fq * 4) = o; }
        __builtin_amdgcn_sched_barrier(0); }
    }
  }
}

constexpr int MOE_H_OFF = 2 * G_STAGE;
constexpr int MOE_TOK_OFF = MOE_H_OFF + 65536;
constexpr int SMEM_BYTES = 132096;
__device__ __forceinline__ void phase_moe(const P& p, int bid, int nb, lds_ptr smem) {
  const int lane = ltid() & 63, wid = ltid() >> 6, wm = wid >> 2, wn = wid & 3, fr = lane & 15, fq = lane >> 4;
  LAS int* toks = (LAS int*)(smem + MOE_TOK_OFF);
  const lds_ptr Hs = smem + MOE_H_OFF;
  LAS int* qi = (LAS int*)(smem + MOE_TOK_OFF + 512);
  for (int sx = 0; sx < 8; ++sx) {
   const int x = (bid + sx) & 7;
   const int cnt = p.moe_cnt[x];
   for (;;) {
    __syncthreads();
    if (ltid() == 0) qi[0] = atomicAdd(&p.moe_ctr[x], 1);
    __syncthreads();
    const int qidx = qi[0];
    if (qidx >= cnt) break;
    const int blk = p.moe_list[x * NBLK128 + qidx];
    const int e = p.blk_exp[blk];
    if (ltid() < 128) toks[ltid()] = p.slot_tok[blk * 128 + ltid()];
    __syncthreads();
    const float* Wg = p.ew_gate + (size_t)e * D * EFF; const float* Wu = p.ew_up + (size_t)e * D * EFF; const float* Wd = p.ew_down + (size_t)e * EFF * D;
    for (int hp2 = 0; hp2 < 2 * MOE_REP_GU; ++hp2) { const int hp = hp2 & 1;
      f32x4 acc[4][4];
      ALoadGatherLds al2{p.h2, toks};
      BLoadGUR bl{Wg, (long)(Wu - Wg), EFF, hp * 128};
      gemm_mainloop_r3<false>(acc, al2, bl, D / 32, smem, smem);
#pragma unroll
      for (int i = 0; i < 4; ++i)
#pragma unroll
        for (int j = 0; j < 2; ++j) { const f32x4 gv = acc[i][j], uv = acc[i][j + 2]; const int row = wm * 64 + i * 16 + fr, hc = hp * 128 + wn * 32 + j * 16 + fq * 4;
          u32x2 o; o.x = cvtpk(siluf_(gv[0]) * uv[0], siluf_(gv[1]) * uv[1]); o.y = cvtpk(siluf_(gv[2]) * uv[2], siluf_(gv[3]) * uv[3]);
          *(LAS u32x2*)(Hs + (hc >> 5) * G_ASZ + a_off(row, (hc & 31) >> 3) + (hc & 7) * 2) = o; }
    }
    for (int np2 = 0; np2 < 4 * MOE_REP_DN; ++np2) { const int np = np2 & 3;
      f32x4 acc[4][4];
      ALoadDense al{nullptr, 0};
      BLoadF32R bl{Wd + np * 256, D};
      gemm_mainloop_r3<true>(acc, al, bl, EFF / 32, smem, Hs);
#pragma unroll
      for (int i = 0; i < 4; ++i) {
        const int rl = wm * 64 + i * 16 + fr;
        if (toks[rl] >= 0) {
#pragma unroll
          for (int j = 0; j < 4; ++j) { const f32x4 v = acc[i][j]; u32x2 o; o.x = cvtpk(v[0], v[1]); o.y = cvtpk(v[2], v[3]);
            *(u32x2*)(p.Y + (size_t)(blk * 128 + rl) * D + np * 256 + wn * 64 + j * 16 + fq * 4) = o; }
        }
      }
    }
   }
  }
}

struct BStreamGU { const float* Wg; long du; int hp0;
  __device__ __forceinline__ void load(BRaw& r, int s, int tid) const {
    const int hp = hp0 + (s >> 5), kbase = (s & 31) * 32;
    const int col = (tid & 63) * 4, w = col >> 6, xx = col & 63;
    const float* q = Wg + ((xx < 32) ? 0l : du) + (size_t)(kbase + (tid >> 6)) * EFF + hp * 128 + 32 * w + (xx & 31);
#pragma unroll
    for (int i = 0; i < 4; ++i) r.v[i] = *(const f32x4*)(q + (size_t)(8 * i) * EFF); } };
struct BStreamDown { const float* Wd; int np0;
  __device__ __forceinline__ void load(BRaw& r, int s, int tid) const {
    const int np = np0 + (s >> 3), kbase = (s & 7) * 32;
    const float* q = Wd + (size_t)(kbase + (tid >> 6)) * D + np * 256 + (tid & 63) * 4;
#pragma unroll
    for (int i = 0; i < 4; ++i) r.v[i] = *(const f32x4*)(q + (size_t)(8 * i) * D); } };
constexpr int PV_STAGE = 2 * G_ASZ + G_BSZ;
template <int SEG, int NSEG, class AL, class BL, class SE>
__device__ __forceinline__ void gemm_stream_pair(const AL& al, const BL& bl, lds_ptr stage, const SE& segend, bool has2) {
  constexpr int NS = SEG * NSEG;
  const int tid = ltid(), lane = tid & 63, wid = tid >> 6, wm = wid >> 2, wn = wid & 3, fr = lane & 15, fq = lane >> 4;
  const int ar = tid >> 2, ac = tid & 3;
  const bf16_t* aptr0 = al.rowptr(0, ar) + ac * 8;
  const bf16_t* aptr1 = al.rowptr(1, ar) + ac * 8;
  const int a_st = a_off(ar, ac);
  int b_st[4];
#pragma unroll
  for (int i = 0; i < 4; ++i) b_st[i] = 2 * G_ASZ + b_off((tid >> 6) + 8 * i, (tid & 63) >> 2) + (tid & 3) * 8;
  int a_rd[4];
#pragma unroll
  for (int mt = 0; mt < 4; ++mt) a_rd[mt] = a_off(wm * 64 + mt * 16 + fr, fq);
  int b_rd[4][2];
#pragma unroll
  for (int nt = 0; nt < 4; ++nt) {
    b_rd[nt][0] = 2 * G_ASZ + b_off(8 * fq + (fr >> 2), wn * 4 + nt) + (fr & 3) * 8;
    b_rd[nt][1] = 2 * G_ASZ + b_off(8 * fq + 4 + (fr >> 2), wn * 4 + nt) + (fr & 3) * 8;
  }
  f32x4 acc[2][4][4];
#pragma unroll
  for (int h = 0; h < 2; ++h)
#pragma unroll
    for (int mt = 0; mt < 4; ++mt)
#pragma unroll
      for (int nt = 0; nt < 4; ++nt) acc[h][mt][nt] = (f32x4){0.f, 0.f, 0.f, 0.f};
  u32x4 xa0, xb0, xa1, xb1;
  BRaw rb0, rb1;
#define P2_LOAD(XA, XB, RB, s_) do { XA = *(const u32x4*)(aptr0 + (size_t)((s_) % SEG) * 32); XB = *(const u32x4*)(aptr1 + (size_t)((s_) % SEG) * 32); bl.load(RB, (s_), tid); } while (0)
#define P2_STORE(XA, XB, RB, st_) do { const lds_ptr q_ = stage + (st_) * PV_STAGE; *(LAS u32x4*)(q_ + a_st) = XA; *(LAS u32x4*)(q_ + G_ASZ + a_st) = XB; \
    _Pragma("unroll") for (int i_ = 0; i_ < 4; ++i_) { u32x2 o_; o_.x = cvtpk(RB.v[i_][0], RB.v[i_][1]); o_.y = cvtpk(RB.v[i_][2], RB.v[i_][3]); *(LAS u32x2*)(q_ + b_st[i_]) = o_; } } while (0)
#define P2_COMPUTE(s_) do { const lds_ptr cur = stage + ((s_) & 1) * PV_STAGE; s16x8 bfr[4]; \
    _Pragma("unroll") for (int nt = 0; nt < 4; ++nt) { const s16x4 lo = tr_read(cur + b_rd[nt][0]), hi = tr_read(cur + b_rd[nt][1]); bfr[nt] = __builtin_shufflevector(lo, hi, 0, 1, 2, 3, 4, 5, 6, 7); } \
    _Pragma("unroll") for (int h = 0; h < 2; ++h) if (h == 0 || has2) { s16x8 af[4]; \
      _Pragma("unroll") for (int mt = 0; mt < 4; ++mt) af[mt] = *(LAS s16x8*)(cur + h * G_ASZ + a_rd[mt]); \
      _Pragma("unroll") for (int mt = 0; mt < 4; ++mt) _Pragma("unroll") for (int nt = 0; nt < 4; ++nt) acc[h][mt][nt] = __builtin_amdgcn_mfma_f32_16x16x32_bf16(bfr[nt], af[mt], acc[h][mt][nt], 0, 0, 0); } } while (0)
#define P2_SEGEND(s_) do { if (((s_) % SEG) == SEG - 1) { segend((s_) / SEG, acc); \
    _Pragma("unroll") for (int h = 0; h < 2; ++h) _Pragma("unroll") for (int mt = 0; mt < 4; ++mt) _Pragma("unroll") for (int nt = 0; nt < 4; ++nt) acc[h][mt][nt] = (f32x4){0.f, 0.f, 0.f, 0.f}; } } while (0)
#define P2_BODY(s_, XAN, XBN, RBN, XAW, XBW, RBW) do { const int sl_ = ((s_) + 2 < NS) ? (s_) + 2 : NS - 1; P2_LOAD(XAN, XBN, RBN, sl_); __builtin_amdgcn_sched_barrier(0); \
    P2_COMPUTE(s_); __builtin_amdgcn_sched_barrier(0); P2_SEGEND(s_); P2_STORE(XAW, XBW, RBW, ((s_) + 1) & 1); __syncthreads(); } while (0)
  P2_LOAD(xa0, xb0, rb0, 0);
  P2_LOAD(xa1, xb1, rb1, 1);
  __syncthreads();
  P2_STORE(xa0, xb0, rb0, 0);
  __syncthreads();
  for (int s = 0; s < NS; s += 2) {
    P2_BODY(s, xa0, xb0, rb0, xa1, xb1, rb1);
    P2_BODY(s + 1, xa1, xb1, rb1, xa0, xb0, rb0);
  }
#undef P2_LOAD
#undef P2_STORE
#undef P2_COMPUTE
#undef P2_SEGEND
#undef P2_BODY
}
struct APairGather { const bf16_t* A; LAS int* tk; __device__ __forceinline__ const bf16_t* rowptr(int h, int r) const { int t = tk[h * 128 + r]; t = t < 0 ? 0 : t; return A + (size_t)t * D; } };
struct APairDense { const bf16_t* A0; const bf16_t* A1; __device__ __forceinline__ const bf16_t* rowptr(int h, int r) const { return (h ? A1 : A0) + (size_t)r * EFF; } };

constexpr int PV_TOK = 2 * PV_STAGE;
constexpr int PV_Q = PV_TOK + 1024;
template <int STG>
__device__ __forceinline__ void phase_moe_pair(const P& p, int bid, int nb, lds_ptr smem) {
  LAS int* toks = (LAS int*)(smem + PV_TOK);
  LAS int* qi = (LAS int*)(smem + PV_Q);
  for (int sx = 0; sx < 8; ++sx) {
   const int x = ((int)((unsigned)__builtin_amdgcn_s_getreg((3 << 11) | 20) & 7u) + sx) & 7;
   const int cnt = 2 * p.moe_cnt[x];
   for (;;) {
    __syncthreads();
    if (ltid() == 0) qi[0] = atomicAdd(&p.moe_ctr[(STG - 1) * 8 + x], 1);
    __syncthreads();
    const int qidx = qi[0];
    if (qidx >= cnt) break;
    const int blk = p.moe_list[x * NBLK128 + (qidx >> 1)], sub = qidx & 1;
    const int e = p.blk_exp[blk];
    const bool has2 = (blk + 1 < NBLK128) && (p.blk_exp[blk + 1] == e);
    const int blk2 = has2 ? blk + 1 : blk;
    { const int t = ltid(); if (t < 256) toks[t] = (t < 128) ? p.slot_tok[blk * 128 + t] : (has2 ? p.slot_tok[blk2 * 128 + (t - 128)] : -1); }
    __syncthreads();
    const int lane = ltid() & 63, wid = ltid() >> 6, wm = wid >> 2, wn = wid & 3, fr = lane & 15, fq = lane >> 4;
    if (STG == 1) {
      const float* Wg = p.ew_gate + (size_t)e * D * EFF; const float* Wu = p.ew_up + (size_t)e * D * EFF;
      APairGather al{p.h2, toks};
      BStreamGU bl{Wg, (long)(Wu - Wg), sub};
      auto segH = [&](int hseg, const f32x4 (&acc)[2][4][4]) { const int hp = sub + hseg;
#pragma unroll
        for (int h = 0; h < 2; ++h) {
          if (h == 1 && !has2) continue;
          const int sb = (h ? blk2 : blk) * 128;
#pragma unroll
          for (int i = 0; i < 4; ++i)
#pragma unroll
            for (int j = 0; j < 2; ++j) { const f32x4 gv = acc[h][i][j], uv = acc[h][i][j + 2]; const int row = wm * 64 + i * 16 + fr, hc = hp * 128 + wn * 32 + j * 16 + fq * 4;
              u32x2 o; o.x = cvtpk(siluf_(gv[0]) * uv[0], siluf_(gv[1]) * uv[1]); o.y = cvtpk(siluf_(gv[2]) * uv[2], siluf_(gv[3]) * uv[3]);
              *(u32x2*)(p.Hbuf + (size_t)(sb + row) * EFF + hc) = o; }
        }
      };
      gemm_stream_pair<32, 1>(al, bl, smem, segH, has2);
    } else {
      const float* Wd = p.ew_down + (size_t)e * EFF * D;
      APairDense al{p.Hbuf + (size_t)blk * 128 * EFF, p.Hbuf + (size_t)blk2 * 128 * EFF};
      BStreamDown bl{Wd, 2 * sub};
      auto segY = [&](int nseg, const f32x4 (&acc)[2][4][4]) { const int np = 2 * sub + nseg;
#pragma unroll
        for (int h = 0; h < 2; ++h) {
          if (h == 1 && !has2) continue;
          const int sb = (h ? blk2 : blk) * 128;
#pragma unroll
          for (int i = 0; i < 4; ++i) {
            const int rl = wm * 64 + i * 16 + fr;
            if (toks[h * 128 + rl] >= 0) {
#pragma unroll
              for (int j = 0; j < 4; ++j) { const f32x4 v = acc[h][i][j]; u32x2 o; o.x = cvtpk(v[0], v[1]); o.y = cvtpk(v[2], v[3]);
                *(u32x2*)(p.Y + (size_t)(sb + rl) * D + np * 256 + wn * 64 + j * 16 + fq * 4) = o; }
            }
          }
        }
      };
      gemm_stream_pair<8, 2>(al, bl, smem, segY, has2);
    }
   }
  }
}

__device__ __forceinline__ void wave_sync() { __syncthreads(); }
constexpr int S5_BU_STRIDE = 132;
constexpr int S5_S_STRIDE = 272;
constexpr int S5_WAVE_LDS = 16 * S5_BU_STRIDE * 4 + 16 * S5_S_STRIDE;
template <bool FINAL>
__device__ __forceinline__ void s5_item(const P& p, int b, int c, int g, lds_ptr wl) {
  const int lane = ltid() & 63, fr = lane & 15, fq = lane >> 4;
  LAS float* bu = (LAS float*)wl;
  const lds_ptr Sb = wl + 16 * S5_BU_STRIDE * 4;
  const size_t t0 = (size_t)b * SEQ + (size_t)c * 64;
  const s16x8 zero8 = {0, 0, 0, 0, 0, 0, 0, 0};
  s16x8 bfr[8];
#pragma unroll
  for (int nt = 0; nt < 8; ++nt) { const s16x8 x = *(const s16x8*)(p.bbarT + ((size_t)(g * 128 + nt * 16 + fr) * 16 + (fq & 1) * 8)); bfr[nt] = (fq < 2) ? x : zero8; }
  const float are = p.abar[(g * 64 + lane) * 2], aim = p.abar[(g * 64 + lane) * 2 + 1];
  const size_t sidx = (((size_t)b * 32 + c) * S5G + g) * 64 + lane;
  float sre = 0.f, sim = 0.f;
  s16x8 cfr[4];
  f32x4 dsk = {0.f, 0.f, 0.f, 0.f};
  if (FINAL) {
    sre = p.s5Sin[sidx * 2]; sim = p.s5Sin[sidx * 2 + 1];
#pragma unroll
    for (int ks = 0; ks < 4; ++ks) cfr[ks] = *(const s16x8*)(p.cmT + ((size_t)(g * 16 + fr) * 128 + ks * 32 + fq * 8));
    dsk = *(const f32x4*)(p.s5_d + g * 16 + fq * 4);
  }
  for (int mt = 0; mt < 4; ++mt) {
    const bf16_t* urow = p.proj + (t0 + mt * 16 + fr) * LDP + OFF_U + g * 16;
    const s16x8 ux = *(const s16x8*)(urow + (fq & 1) * 8);
    const s16x8 ufr = (fq < 2) ? ux : zero8;
#pragma unroll
    for (int nt = 0; nt < 8; ++nt) {
      const f32x4 z = {0.f, 0.f, 0.f, 0.f};
      const f32x4 acc = __builtin_amdgcn_mfma_f32_16x16x32_bf16(ufr, bfr[nt], z, 0, 0, 0);
#pragma unroll
      for (int j = 0; j < 4; ++j) bu[(4 * fq + j) * S5_BU_STRIDE + nt * 16 + fr] = acc[j];
    }
    wave_sync();
#pragma unroll
    for (int l = 0; l < 16; ++l) {
      const float br = bu[l * S5_BU_STRIDE + lane], bi = bu[l * S5_BU_STRIDE + 64 + lane];
      const float nr = are * sre - aim * sim + br, ni = are * sim + aim * sre + bi;
      sre = nr; sim = ni;
      if (FINAL) {
        *(LAS bf16_t*)(Sb + l * S5_S_STRIDE + lane * 2) = f2bf(sre);
        *(LAS bf16_t*)(Sb + l * S5_S_STRIDE + (64 + lane) * 2) = f2bf(sim);
      }
    }
    wave_sync();
    if (FINAL) {
      f32x4 y = {0.f, 0.f, 0.f, 0.f};
#pragma unroll
      for (int ks = 0; ks < 4; ++ks) {
        const s16x8 sfr = *(LAS s16x8*)(Sb + fr * S5_S_STRIDE + (ks * 32 + fq * 8) * 2);
        y = __builtin_amdgcn_mfma_f32_16x16x32_bf16(cfr[ks], sfr, y, 0, 0, 0);
      }
      const f32x4 u4 = ld_bf4(urow + fq * 4);
      u32x2 o; o.x = cvtpk(geluf_(y[0] + dsk[0] * u4[0]), geluf_(y[1] + dsk[1] * u4[1])); o.y = cvtpk(geluf_(y[2] + dsk[2] * u4[2]), geluf_(y[3] + dsk[3] * u4[3]));
      *(u32x2*)(p.yA + (t0 + mt * 16 + fr) * S5W + g * 16 + fq * 4) = o;
      wave_sync();
    }
  }
  if (!FINAL) { p.s5E[sidx * 2] = sre; p.s5E[sidx * 2 + 1] = sim; }
}
template <bool FINAL>
__device__ __forceinline__ void s5_block_item(const P& p, int item, lds_ptr smem) {
  const int wid = ltid() >> 6;
  const int go = item & 3, c = (item >> 2) & 31, b = item >> 7;
  s5_item<FINAL>(p, b, c, go * 8 + wid, smem + wid * S5_WAVE_LDS);
}

constexpr int GL_QD = 0, GL_KE = 8192, GL_V = 16384, GL_SIN = 32768, GL_GL = 49152, GL_W2 = 53248, GL_TOT = 57344, GL_B2 = 58368, GL_ITEM = 58624;
__device__ __forceinline__ int rowrd_off(int r, int c) { return r * 128 + ((c ^ ((r >> 1) & 7)) << 4); }
__device__ __forceinline__ int tr128_off(int r, int ch) { return r * 128 + ((ch ^ (((r >> 1) & 1) | (((r >> 3) & 1) << 1))) << 5); }
__device__ __forceinline__ int tr256_off(int r, int ch) { return r * 256 + ((ch ^ ((r & 3) | (((r >> 3) & 1) << 2))) << 5); }

__device__ __forceinline__ void gla_front(const P& p, int b, int h, int c, lds_ptr il, int t, float (&bl)[16], float& blast) {
  LAS float* gl = (LAS float*)(il + GL_GL); LAS float* w2 = (LAS float*)(il + GL_W2); LAS float* tot = (LAS float*)(il + GL_TOT); LAS float* b2 = (LAS float*)(il + GL_B2);
  const size_t t0 = (size_t)b * SEQ + (size_t)c * 64;
  __syncthreads();
  *(LAS f32x4*)(gl + t * 4) = *(const f32x4*)(p.gkl + t0 * 16 + t * 4);
#pragma unroll
  for (int q = 0; q < 4; ++q) { const int i = t + 256 * q; w2[i] = p.w_gk2[(i >> 6) * GKEY + h * 64 + (i & 63)]; }
  if (t < 64) b2[t] = p.b_gk2[h * 64 + t];
  __syncthreads();
  const int d = t & 63, part = t >> 6;
  float wv[16];
#pragma unroll
  for (int r = 0; r < 16; ++r) wv[r] = w2[r * 64 + d];
  const float bias = b2[d];
  float run = 0.f;
#pragma unroll
  for (int ii = 0; ii < 16; ++ii) {
    const int i = part * 16 + ii;
    float gk = bias;
#pragma unroll
    for (int q = 0; q < 4; ++q) { const f32x4 gv = *(LAS f32x4*)(gl + i * 16 + q * 4); gk += gv[0] * wv[q * 4] + gv[1] * wv[q * 4 + 1] + gv[2] * wv[q * 4 + 2] + gv[3] * wv[q * 4 + 3]; }
    run += logsigmoidf_(gk) * (1.f / 16.f);
    bl[ii] = run;
  }
  tot[part * 64 + d] = run;
  __syncthreads();
  float offs = 0.f, all = 0.f;
#pragma unroll
  for (int q = 0; q < 4; ++q) { const float v = tot[q * 64 + d]; all += v; offs += (q < part) ? v : 0.f; }
#pragma unroll
  for (int ii = 0; ii < 16; ++ii) bl[ii] += offs;
  blast = all;
}

__device__ __forceinline__ void gla_pass1(const P& p, int item, lds_ptr smem) {
  const int half = ltid() >> 8, t = ltid() & 255, lane = t & 63, w = t >> 6, fr = lane & 15, fq = lane >> 4;
  const int it = item * 2 + half, c = it & 31, h = (it >> 5) & 3, b = it >> 7;
  const lds_ptr il = smem + half * GL_ITEM;
  const size_t t0 = (size_t)b * SEQ + (size_t)c * 64;
  float bl[16], blast;
  gla_front(p, b, h, c, il, t, bl, blast);
  {
    const int d = t & 63, part = t >> 6;
#pragma unroll
    for (int ii = 0; ii < 16; ++ii) {
      const int i = part * 16 + ii;
      const float kv = bf2f(p.proj[(t0 + i) * LDP + OFF_K + h * 64 + d]);
      *(LAS bf16_t*)(il + GL_KE + tr128_off(i, d >> 4) + (d & 15) * 2) = f2bf(kv * __expf(blast - bl[ii]));
    }
    if (part == 0) p.glaDec[(size_t)it * 64 + d] = __expf(blast);
#pragma unroll
    for (int q = 0; q < 4; ++q) { const int pc = t + 256 * q, r = pc >> 4, c8 = pc & 15;
      *(LAS u32x4*)(il + GL_V + tr256_off(r, c8 >> 1) + (c8 & 1) * 16) = *(const u32x4*)(p.proj + (t0 + r) * LDP + OFF_V + h * 128 + c8 * 8); }
  }
  __syncthreads();
  f32x4 acc[8];
#pragma unroll
  for (int et = 0; et < 8; ++et) acc[et] = (f32x4){0.f, 0.f, 0.f, 0.f};
#pragma unroll
  for (int ks = 0; ks < 2; ++ks) {
    const int r0 = 32 * ks + 8 * fq + (fr >> 2);
    const s16x4 klo = tr_read(il + GL_KE + tr128_off(r0, w) + (fr & 3) * 8), khi = tr_read(il + GL_KE + tr128_off(r0 + 4, w) + (fr & 3) * 8);
    const s16x8 kf = __builtin_shufflevector(klo, khi, 0, 1, 2, 3, 4, 5, 6, 7);
#pragma unroll
    for (int et = 0; et < 8; ++et) {
      const s16x4 vlo = tr_read(il + GL_V + tr256_off(r0, et) + (fr & 3) * 8), vhi = tr_read(il + GL_V + tr256_off(r0 + 4, et) + (fr & 3) * 8);
      const s16x8 vf = __builtin_shufflevector(vlo, vhi, 0, 1, 2, 3, 4, 5, 6, 7);
      acc[et] = __builtin_amdgcn_mfma_f32_16x16x32_bf16(vf, kf, acc[et], 0, 0, 0);
    }
  }
#pragma unroll
  for (int et = 0; et < 8; ++et) *(f32x4*)(p.glaKV + ((size_t)it * 64 + 16 * w + fr) * 128 + et * 16 + fq * 4) = acc[et];
}

__device__ __forceinline__ void gla_pass2(const P& p, int item, lds_ptr smem) {
  const int half = ltid() >> 8, t = ltid() & 255, lane = t & 63, w = t >> 6, fr = lane & 15, fq = lane >> 4;
  const int it = item * 2 + half, c = it & 31, h = (it >> 5) & 3, b = it >> 7;
  const lds_ptr il = smem + half * GL_ITEM;
  const size_t t0 = (size_t)b * SEQ + (size_t)c * 64;
  float bl[16], blast;
  gla_front(p, b, h, c, il, t, bl, blast);
  {
    const int d = t & 63, part = t >> 6;
#pragma unroll
    for (int ii = 0; ii < 16; ++ii) {
      const int i = part * 16 + ii;
      const float qv = bf2f(p.proj[(t0 + i) * LDP + OFF_Q + h * 64 + d]) * 0.125f, kv = bf2f(p.proj[(t0 + i) * LDP + OFF_K + h * 64 + d]);
      const int o = rowrd_off(i, d >> 3) + (d & 7) * 2;
      *(LAS bf16_t*)(il + GL_QD + o) = f2bf(qv * __expf(bl[ii]));
      *(LAS bf16_t*)(il + GL_KE + o) = f2bf(kv * __expf(-bl[ii]));
    }
#pragma unroll
    for (int q = 0; q < 4; ++q) { const int pc = t + 256 * q, r = pc >> 4, c8 = pc & 15;
      *(LAS u32x4*)(il + GL_V + tr256_off(r, c8 >> 1) + (c8 & 1) * 16) = *(const u32x4*)(p.proj + (t0 + r) * LDP + OFF_V + h * 128 + c8 * 8);
      *(LAS u32x4*)(il + GL_SIN + tr256_off(r, c8 >> 1) + (c8 & 1) * 16) = *(const u32x4*)(p.glaSin + ((size_t)it * 64 + r) * 128 + c8 * 8); }
  }
  __syncthreads();
  s16x8 qf[2];
#pragma unroll
  for (int ks = 0; ks < 2; ++ks) qf[ks] = *(LAS s16x8*)(il + GL_QD + rowrd_off(16 * w + fr, ks * 4 + fq));
  f32x4 st[4];
#pragma unroll
  for (int jt = 0; jt < 4; ++jt) {
    st[jt] = (f32x4){0.f, 0.f, 0.f, 0.f};
    if (jt <= w) {
#pragma unroll
      for (int ks = 0; ks < 2; ++ks) {
        const s16x8 kf = *(LAS s16x8*)(il + GL_KE + rowrd_off(16 * jt + fr, ks * 4 + fq));
        st[jt] = __builtin_amdgcn_mfma_f32_16x16x32_bf16(kf, qf[ks], st[jt], 0, 0, 0);
      }
      if (jt == w) {
#pragma unroll
        for (int r = 0; r < 4; ++r) st[jt][r] = (4 * fq + r <= fr) ? st[jt][r] : 0.f;
      }
    }
  }
  f32x4 acc[8];
#pragma unroll
  for (int et = 0; et < 8; ++et) acc[et] = (f32x4){0.f, 0.f, 0.f, 0.f};
#pragma unroll
  for (int u = 0; u < 2; ++u) {
    if (2 * u <= w) {
      u32x4 pk; pk.x = cvtpk(st[2 * u][0], st[2 * u][1]); pk.y = cvtpk(st[2 * u][2], st[2 * u][3]); pk.z = cvtpk(st[2 * u + 1][0], st[2 * u + 1][1]); pk.w = cvtpk(st[2 * u + 1][2], st[2 * u + 1][3]);
      const s16x8 pf = __builtin_bit_cast(s16x8, pk);
      const int r0 = 32 * u + 4 * fq + (fr >> 2);
#pragma unroll
      for (int et = 0; et < 8; ++et) {
        const s16x4 vlo = tr_read(il + GL_V + tr256_off(r0, et) + (fr & 3) * 8), vhi = tr_read(il + GL_V + tr256_off(r0 + 16, et) + (fr & 3) * 8);
        const s16x8 vf = __builtin_shufflevector(vlo, vhi, 0, 1, 2, 3, 4, 5, 6, 7);
        acc[et] = __builtin_amdgcn_mfma_f32_16x16x32_bf16(vf, pf, acc[et], 0, 0, 0);
      }
    }
  }
#pragma unroll
  for (int ks = 0; ks < 2; ++ks) {
    const int r0 = 32 * ks + 8 * fq + (fr >> 2);
#pragma unroll
    for (int et = 0; et < 8; ++et) {
      const s16x4 slo = tr_read(il + GL_SIN + tr256_off(r0, et) + (fr & 3) * 8), shi = tr_read(il + GL_SIN + tr256_off(r0 + 4, et) + (fr & 3) * 8);
      const s16x8 sf = __builtin_shufflevector(slo, shi, 0, 1, 2, 3, 4, 5, 6, 7);
      acc[et] = __builtin_amdgcn_mfma_f32_16x16x32_bf16(sf, qf[ks], acc[et], 0, 0, 0);
    }
  }
  float ss = 0.f;
#pragma unroll
  for (int et = 0; et < 8; ++et) ss += acc[et][0] * acc[et][0] + acc[et][1] * acc[et][1] + acc[et][2] * acc[et][2] + acc[et][3] * acc[et][3];
  ss += __shfl_xor(ss, 16); ss += __shfl_xor(ss, 32);
  const float rn = rsqrtf(ss * (1.f / 128.f) + 1e-6f);
  const size_t trow = t0 + 16 * w + fr;
#pragma unroll
  for (int et = 0; et < 8; ++et) {
    const int e = et * 16 + fq * 4;
    const f32x4 ng = *(const f32x4*)(p.gla_norm_g + e), rg = ld_bf4(p.proj + trow * LDP + OFF_R + h * 128 + e);
    u32x2 o; o.x = cvtpk(acc[et][0] * rn * ng[0] * siluf_(rg[0]), acc[et][1] * rn * ng[1] * siluf_(rg[1])); o.y = cvtpk(acc[et][2] * rn * ng[2] * siluf_(rg[2]), acc[et][3] * rn * ng[3] * siluf_(rg[3]));
    *(u32x2*)(p.yB + trow * GVAL + h * 128 + e) = o;
  }
}

__device__ __forceinline__ void phase_mix_local(const P& p, int bid, int nb, lds_ptr smem, int which) {
  for (int idx = bid; idx < 1024 + 512; idx += nb) {
    if (idx < 1024) { if (which & 1) { __syncthreads(); s5_block_item<false>(p, idx, smem); } }
    else if (which & 2) gla_pass1(p, idx - 1024, smem);
  }
}
__device__ __forceinline__ void phase_mix_carry(const P& p, int bid, int nb, int which) {
  const int gtid = bid * NTHR + ltid(), gsz = nb * NTHR;
  if (which & 1) for (int i = gtid; i < NB * S5G * S5P; i += gsz) {
    const int pq = i & 63, g = (i >> 6) & 31, b = i >> 11;
    const float are = p.apow64[(g * 64 + pq) * 2], aim = p.apow64[(g * 64 + pq) * 2 + 1];
    float sre = 0.f, sim = 0.f;
    for (int c = 0; c < 32; ++c) {
      const size_t sidx = (((size_t)b * 32 + c) * S5G + g) * 64 + pq;
      p.s5Sin[sidx * 2] = sre; p.s5Sin[sidx * 2 + 1] = sim;
      const float er = p.s5E[sidx * 2], ei = p.s5E[sidx * 2 + 1];
      const float nr = are * sre - aim * sim + er, ni = are * sim + aim * sre + ei;
      sre = nr; sim = ni;
    }
  }
  if (which & 2) for (int i = gtid; i < NB * GH * 64 * 128; i += gsz) {
    const int e = i & 127, d = (i >> 7) & 63, bh = i >> 13;
    float S = 0.f;
#pragma unroll 8
    for (int c = 0; c < 32; ++c) {
      const size_t it = (size_t)bh * 32 + c;
      p.glaSin[(it * 64 + d) * 128 + e] = f2bf(S);
      S = p.glaDec[it * 64 + d] * S + p.glaKV[(it * 64 + d) * 128 + e];
    }
  }
}
__device__ __forceinline__ void phase_mix_final(const P& p, int bid, int nb, lds_ptr smem, int which) {
  for (int idx = bid; idx < 1024 + 512; idx += nb) {
    if (idx < 1024) { if (which & 1) { __syncthreads(); s5_block_item<true>(p, idx, smem); } }
    else if (which & 2) gla_pass2(p, idx - 1024, smem);
  }
}

__device__ __forceinline__ void phase_route(const P& p, int bid, int nb) {
  const int lane = ltid() & 63, wid = ltid() >> 6;
  const f32x4 bias = *(const f32x4*)(p.router_bias + lane * 4);
  for (int t = bid * 8 + wid; t < T; t += nb * 8) {
    const f32x4 lg = *(const f32x4*)(p.logits + (size_t)t * NE + lane * 4);
    float sc[4], v[4];
#pragma unroll
    for (int j = 0; j < 4; ++j) { sc[j] = sigmoidf_(lg[j]); v[j] = sc[j] + bias[j]; }
    float m1 = fmaxf(v[0], v[1]), m2 = fminf(v[0], v[1]);
#pragma unroll
    for (int j = 2; j < 4; ++j) { const float nm1 = fmaxf(m1, v[j]); m2 = fmaxf(fminf(m1, v[j]), m2); m1 = nm1; }
#pragma unroll
    for (int o = 1; o < 8; o <<= 1) { const float o1 = __shfl_xor(m1, o), o2 = __shfl_xor(m2, o); const float nm1 = fmaxf(m1, o1); m2 = fmaxf(fminf(m1, o1), fmaxf(m2, o2)); m1 = nm1; }
    const float gs = m1 + m2;
    const int grp = lane >> 3;
    int rank = 0;
#pragma unroll
    for (int g2 = 0; g2 < 8; ++g2) { const float og = __shfl(gs, g2 * 8); rank += (og > gs || (og == gs && g2 < grp)) ? 1 : 0; }
    const bool gsel = rank < 4;
#pragma unroll
    for (int j = 0; j < 4; ++j) v[j] = gsel ? v[j] : -INFINITY;
    int my_e = 0; float my_s = 0.f, wsum = 0.f;
#pragma unroll 1
    for (int r = 0; r < 8; ++r) {
      float bv = v[0]; int bi = 0;
#pragma unroll
      for (int j = 1; j < 4; ++j) if (v[j] > bv) { bv = v[j]; bi = j; }
      int be = lane * 4 + bi;
#pragma unroll
      for (int o = 1; o < 64; o <<= 1) { const float ov = __shfl_xor(bv, o); const int oe = __shfl_xor(be, o); if (ov > bv || (ov == bv && oe < be)) { bv = ov; be = oe; } }
      const int ol = be >> 2, oj = be & 3;
      float s_own = 0.f;
#pragma unroll
      for (int j = 0; j < 4; ++j) if (lane == ol && oj == j) { s_own = sc[j]; v[j] = -INFINITY; }
      const float s_w = __shfl(s_own, ol);
      wsum += s_w;
      if (lane == r) { my_e = be; my_s = s_w; }
    }
    if (lane < 8) {
      p.tk_idx[t * 8 + lane] = my_e;
      p.tk_w[t * 8 + lane] = my_s / wsum * 2.5f;
      p.tk_rank[t * 8 + lane] = atomicAdd(&p.counts[my_e], 1);
    }
  }
}
__device__ __forceinline__ void phase_scatter(const P& p, int bid, int nb, lds_ptr smem) {
  LAS int* st = (LAS int*)smem;
  __syncthreads();
  if (ltid() < 256) st[ltid() + 1] = (p.counts[ltid()] + 127) / 128 * 128;
  if (ltid() == 0) st[0] = 0;
  __syncthreads();
  if (ltid() == 0) { int s = 0; for (int i = 1; i <= 256; ++i) { s += st[i]; st[i] = s; } }
  __syncthreads();
  if (bid == 0) {
    if (ltid() < 256) { const int e = ltid(); for (int b = st[e] / 128; b < st[e + 1] / 128; ++b) p.blk_exp[b] = e; }
    for (int b = st[256] / 128 + ltid(); b < NBLK128; b += NTHR) p.blk_exp[b] = -1;
    if (ltid() < 8) {
      const int x = ltid(); int pos = 0;
      for (int e = x; e < NE; e += 8) for (int b = st[e] / 128; b < st[e + 1] / 128; b += 2) p.moe_list[x * NBLK128 + pos++] = b;
      p.moe_cnt[x] = pos;
    }
  }
  for (int i = bid * NTHR + ltid(); i < T * 8; i += nb * NTHR) {
    const int e = p.tk_idx[i], pos = st[e] + p.tk_rank[i];
    p.slot_tok[pos] = i >> 3;
    p.slot_of[i] = pos;
  }
}

__global__ void __launch_bounds__(64) k_s5_naive(P p) {
  __shared__ float sre[64], sim[64], cre[16][64], cim[16][64], us[16];
  const int b = blockIdx.x / S5G, g = blockIdx.x % S5G, lane = threadIdx.x;
  const float are = p.abar[(g * 64 + lane) * 2], aim = p.abar[(g * 64 + lane) * 2 + 1];
  float bre[16], bim[16];
  for (int h = 0; h < 16; ++h) { bre[h] = p.bbar[((g * 64 + lane) * 16 + h) * 2]; bim[h] = p.bbar[((g * 64 + lane) * 16 + h) * 2 + 1]; }
  for (int i = lane; i < 1024; i += 64) { cre[i >> 6][i & 63] = p.c_re[g * 1024 + i]; cim[i >> 6][i & 63] = p.c_im[g * 1024 + i]; }
  const float dsk = lane < 16 ? p.s5_d[g * 16 + lane] : 0.f;
  float s_re = 0.f, s_im = 0.f;
  __syncthreads();
  for (int l = 0; l < SEQ; ++l) {
    const size_t t = (size_t)b * SEQ + l;
    if (lane < 16) us[lane] = bf2f(p.proj[t * LDP + OFF_U + g * 16 + lane]);
    __syncthreads();
    float bur = 0.f, bui = 0.f;
    for (int h = 0; h < 16; ++h) { bur += us[h] * bre[h]; bui += us[h] * bim[h]; }
    const float nr = are * s_re - aim * s_im + bur, ni = are * s_im + aim * s_re + bui;
    s_re = nr; s_im = ni;
    sre[lane] = s_re; sim[lane] = s_im;
    __syncthreads();
    if (lane < 16) {
      float y = dsk * us[lane];
      for (int q = 0; q < 64; ++q) y += sre[q] * cre[lane][q] - sim[q] * cim[lane][q];
      p.yA[t * S5W + g * 16 + lane] = f2bf(geluf_(y));
    }
    __syncthreads();
  }
}

__global__ void __launch_bounds__(128) k_gla_naive(P p) {
  __shared__ float qs[32][64], ks[32][64], as[32][64], gl[32][16], w2[16][64], b2[64];
  const int b = blockIdx.x / GH, h = blockIdx.x % GH, tid = threadIdx.x;
  for (int i = tid; i < 16 * 64; i += 128) w2[i >> 6][i & 63] = p.w_gk2[(i >> 6) * GKEY + h * 64 + (i & 63)];
  if (tid < 64) b2[tid] = p.b_gk2[h * 64 + tid];
  float S[64];
  for (int d = 0; d < 64; ++d) S[d] = 0.f;
  for (int l0 = 0; l0 < SEQ; l0 += 32) {
    __syncthreads();
    for (int i = tid; i < 32 * 64; i += 128) {
      const size_t t = (size_t)b * SEQ + l0 + (i >> 6);
      qs[i >> 6][i & 63] = bf2f(p.proj[t * LDP + OFF_Q + h * 64 + (i & 63)]) * 0.125f;
      ks[i >> 6][i & 63] = bf2f(p.proj[t * LDP + OFF_K + h * 64 + (i & 63)]);
    }
    for (int i = tid; i < 32 * 16; i += 128) { const size_t t = (size_t)b * SEQ + l0 + (i >> 4); gl[i >> 4][i & 15] = p.gkl[t * 16 + (i & 15)]; }
    __syncthreads();
    for (int i = tid; i < 32 * 64; i += 128) {
      const int s = i >> 6, d = i & 63;
      float gk = b2[d];
      for (int r = 0; r < 16; ++r) gk += gl[s][r] * w2[r][d];
      as[s][d] = __expf(logsigmoidf_(gk) * (1.f / 16.f));
    }
    __syncthreads();
    for (int s = 0; s < 32; ++s) {
      const size_t t = (size_t)b * SEQ + l0 + s;
      const float v = bf2f(p.proj[t * LDP + OFF_V + h * 128 + tid]);
      float o = 0.f;
      for (int d = 0; d < 64; ++d) { S[d] = as[s][d] * S[d] + ks[s][d] * v; o += qs[s][d] * S[d]; }
      p.oraw[t * GVAL + h * 128 + tid] = o;
    }
  }
}
__global__ void __launch_bounds__(256) k_gla_post(P p) {
  const int idx = blockIdx.x * 4 + (threadIdx.x >> 6), lane = threadIdx.x & 63;
  const int t = idx / GH, h = idx % GH;
  const float o0 = p.oraw[(size_t)t * GVAL + h * 128 + lane], o1 = p.oraw[(size_t)t * GVAL + h * 128 + 64 + lane];
  float ss = o0 * o0 + o1 * o1;
  for (int o = 32; o > 0; o >>= 1) ss += __shfl_xor(ss, o);
  const float r = rsqrtf(ss * (1.f / 128.f) + 1e-6f);
  const float r0 = bf2f(p.proj[(size_t)t * LDP + OFF_R + h * 128 + lane]), r1 = bf2f(p.proj[(size_t)t * LDP + OFF_R + h * 128 + 64 + lane]);
  p.yB[(size_t)t * GVAL + h * 128 + lane] = f2bf(o0 * r * p.gla_norm_g[lane] * siluf_(r0));
  p.yB[(size_t)t * GVAL + h * 128 + 64 + lane] = f2bf(o1 * r * p.gla_norm_g[64 + lane] * siluf_(r1));
}

__global__ void __launch_bounds__(64) k_route(P p) {
  const int t = blockIdx.x * 64 + threadIdx.x;
  const float* lg = p.logits + (size_t)t * NE;
  float gs[8];
#pragma unroll
  for (int g = 0; g < 8; ++g) {
    float m1 = -INFINITY, m2 = -INFINITY;
    for (int j = 0; j < 32; ++j) { const float v = sigmoidf_(lg[g * 32 + j]) + p.router_bias[g * 32 + j]; if (v > m1) { m2 = m1; m1 = v; } else if (v > m2) m2 = v; }
    gs[g] = m1 + m2;
  }
  unsigned gmask = 0;
#pragma unroll
  for (int r = 0; r < 4; ++r) { int best = -1; float bv = -INFINITY;
#pragma unroll
    for (int g = 0; g < 8; ++g) if (!((gmask >> g) & 1u) && gs[g] > bv) { bv = gs[g]; best = g; }
    gmask |= 1u << best; }
  int sel[8]; float sw[8]; float wsum = 0.f;
#pragma unroll
  for (int r = 0; r < 8; ++r) {
    int best = -1; float bv = -INFINITY;
    for (int e = 0; e < NE; ++e) {
      if (!((gmask >> (e >> 5)) & 1u)) continue;
      bool taken = false;
#pragma unroll
      for (int q = 0; q < 8; ++q) taken |= (q < r) && (sel[q] == e);
      if (taken) continue;
      const float v = sigmoidf_(lg[e]) + p.router_bias[e];
      if (v > bv) { bv = v; best = e; }
    }
    best = best < 0 ? r : best;
    sel[r] = best; sw[r] = sigmoidf_(lg[best]); wsum += sw[r];
  }
#pragma unroll
  for (int r = 0; r < 8; ++r) {
    p.tk_idx[t * 8 + r] = sel[r];
    p.tk_w[t * 8 + r] = sw[r] / wsum * 2.5f;
    p.tk_rank[t * 8 + r] = atomicAdd(&p.counts[sel[r]], 1);
  }
}
__global__ void __launch_bounds__(256) k_offsets(P p) {
  __shared__ int pad[256], st[257];
  const int e = threadIdx.x;
  pad[e] = (p.counts[e] + 127) / 128 * 128;
  __syncthreads();
  if (e == 0) { int s = 0; for (int i = 0; i < 256; ++i) { st[i] = s; s += pad[i]; } st[256] = s; }
  __syncthreads();
  p.pad_start[e] = st[e];
  if (e == 0) p.pad_start[256] = st[256];
  for (int b = st[e] / 128; b < st[e + 1] / 128; ++b) p.blk_exp[b] = e;
  for (int b = st[256] / 128 + e; b < NBLK128; b += 256) p.blk_exp[b] = -1;
}
__global__ void __launch_bounds__(256) k_scatter(P p) {
  const int i = blockIdx.x * 256 + threadIdx.x;
  const int e = p.tk_idx[i], pos = p.pad_start[e] + p.tk_rank[i];
  p.slot_tok[pos] = i >> 3;
  p.slot_of[i] = pos;
}

__device__ __forceinline__ void phase_combine(const P& p, int bid, int nb) {
  const int lane = ltid() & 63, wid = ltid() >> 6;
  for (int t = bid * 8 + wid; t < T; t += nb * 8) {
    const int b = t / SEQ;
    int so[8]; float w[8];
#pragma unroll
    for (int k = 0; k < 8; ++k) { so[k] = p.slot_of[t * 8 + k]; w[k] = p.tk_w[t * 8 + k]; }
    float v[16], ss = 0.f;
#pragma unroll
    for (int i = 0; i < 4; ++i) {
      const int c0 = lane * 4 + 256 * i;
      f32x4 m = ld_bf4(p.S + (size_t)t * D + c0);
#pragma unroll
      for (int k = 0; k < 8; ++k) { const f32x4 y = ld_bf4(p.Y + (size_t)so[k] * D + c0); m[0] += w[k] * y[0]; m[1] += w[k] * y[1]; m[2] += w[k] * y[2]; m[3] += w[k] * y[3]; }
      const f32x4 xv = *(const f32x4*)(p.x1 + (size_t)t * D + c0), gg = *(const f32x4*)(p.mod + b * 6144 + 5 * D + c0);
#pragma unroll
      for (int j = 0; j < 4; ++j) { v[i * 4 + j] = xv[j] + gg[j] * m[j]; ss += v[i * 4 + j] * v[i * 4 + j]; }
    }
#pragma unroll
    for (int o = 32; o > 0; o >>= 1) ss += __shfl_xor(ss, o);
    const float r = rsqrtf(ss * (1.f / D) + 1e-6f);
#pragma unroll
    for (int i = 0; i < 4; ++i) {
      const int c0 = lane * 4 + 256 * i; const f32x4 fg = *(const f32x4*)(p.final_g + c0);
      f32x4 o; o[0] = v[i * 4] * r * fg[0]; o[1] = v[i * 4 + 1] * r * fg[1]; o[2] = v[i * 4 + 2] * r * fg[2]; o[3] = v[i * 4 + 3] * r * fg[3];
      *(f32x4*)(p.out + (size_t)t * D + c0) = o;
    }
  }
}


template <class Epi>
__global__ void __launch_bounds__(256) k_gemm_naive(const bf16_t* __restrict__ A, int lda, const float* __restrict__ Bm, int ldb, int M, int N, int K, Epi epi) {
  __shared__ float As[16][68];
  __shared__ float Bs[16][68];
  const int tx = threadIdx.x & 15, ty = threadIdx.x >> 4;
  const int row0 = blockIdx.y * 64, col0 = blockIdx.x * 64;
  float acc[4][4];
  for (int i = 0; i < 4; ++i) for (int j = 0; j < 4; ++j) acc[i][j] = 0.f;
  for (int k0 = 0; k0 < K; k0 += 16) {
    { const int r = threadIdx.x >> 2, k4 = (threadIdx.x & 3) * 4;
      const bf16_t* ap = A + (size_t)(row0 + r) * lda + k0 + k4;
      for (int j = 0; j < 4; ++j) As[k4 + j][r] = bf2f(ap[j]); }
    { const int k = threadIdx.x >> 4, c4 = (threadIdx.x & 15) * 4;
      for (int j = 0; j < 4; ++j) { const int cc = col0 + c4 + j; Bs[k][c4 + j] = cc < N ? Bm[(size_t)(k0 + k) * ldb + cc] : 0.f; } }
    __syncthreads();
    for (int k = 0; k < 16; ++k) {
      float a[4], b[4];
      for (int i = 0; i < 4; ++i) a[i] = As[k][ty * 4 + i];
      for (int j = 0; j < 4; ++j) b[j] = Bs[k][tx * 4 + j];
      for (int i = 0; i < 4; ++i) for (int j = 0; j < 4; ++j) acc[i][j] += a[i] * b[j];
    }
    __syncthreads();
  }
  for (int i = 0; i < 4; ++i) for (int j = 0; j < 4; ++j) { const int r = row0 + ty * 4 + i, cc = col0 + tx * 4 + j; if (cc < N) epi(r, cc, acc[i][j]); }
}
struct NEpiProj { bf16_t* o; __device__ void operator()(int r, int c, float v) const { if (c >= WIN_GK && c < WIN_GK + 16) return; const int cc = c < WIN_GK ? c : c - 16; o[(size_t)r * LDP + cc] = f2bf(v); } };
struct NEpiGlu { const bf16_t* yA; const float* b; bf16_t* z; __device__ void operator()(int r, int c, float v) const { const float y = bf2f(yA[(size_t)r * S5W + c]); z[(size_t)r * S5W + c] = f2bf(y * sigmoidf_(v + b[c])); } };
struct NEpiPA { const bf16_t* proj; float* t; __device__ void operator()(int r, int c, float v) const { t[(size_t)r * D + c] = sigmoidf_(bf2f(proj[(size_t)r * LDP + OFF_GA + c])) * v; } };
struct NEpiPB { const bf16_t* proj; const float* t; bf16_t* m; __device__ void operator()(int r, int c, float v) const { m[(size_t)r * D + c] = f2bf(t[(size_t)r * D + c] + sigmoidf_(bf2f(proj[(size_t)r * LDP + OFF_GB + c])) * v); } };
struct NEpiOut { const float* x; const float* mod; float* x1; __device__ void operator()(int r, int c, float v) const { const int b = r / SEQ; x1[(size_t)r * D + c] = x[(size_t)r * D + c] + mod[b * 6144 + 2 * D + c] * v; } };
struct NEpiF32 { float* o; long ld; __device__ void operator()(int r, int c, float v) const { o[(size_t)r * ld + c] = v; } };
struct NEpiShUp { const float* g; bf16_t* h; __device__ void operator()(int r, int c, float v) const { h[(size_t)r * SFF + c] = f2bf(siluf_(g[(size_t)r * SFF + c]) * v); } };
struct NEpiBf { bf16_t* o; long ld; __device__ void operator()(int r, int c, float v) const { o[(size_t)r * ld + c] = f2bf(v); } };
__global__ void __launch_bounds__(256) k_moe_naive(P p) {
  __shared__ float xs[16][1024];
  __shared__ float hs[16][256];
  __shared__ int toks[16];
  const int s0 = blockIdx.x * 16, e = p.blk_exp[s0 / 128], tid = threadIdx.x;
  if (e < 0) return;
  if (tid < 16) toks[tid] = p.slot_tok[s0 + tid];
  __syncthreads();
  bool any = false;
  for (int s = 0; s < 16; ++s) any |= toks[s] >= 0;
  if (!any) return;
  for (int i = tid; i < 16 * 1024; i += 256) { const int s = i >> 10, d = i & 1023; xs[s][d] = toks[s] >= 0 ? bf2f(p.h2[(size_t)toks[s] * D + d]) : 0.f; }
  __syncthreads();
  {
    float ag[16], au[16];
    for (int s = 0; s < 16; ++s) { ag[s] = 0.f; au[s] = 0.f; }
    const float* wg = p.ew_gate + (size_t)e * D * EFF + tid;
    const float* wu = p.ew_up + (size_t)e * D * EFF + tid;
    for (int d = 0; d < D; ++d) {
      const float g = wg[(size_t)d * EFF], u = wu[(size_t)d * EFF];
      for (int s = 0; s < 16; ++s) { const float xv = xs[s][d]; ag[s] += xv * g; au[s] += xv * u; }
    }
    for (int s = 0; s < 16; ++s) hs[s][tid] = bf2f(f2bf(siluf_(ag[s]) * au[s]));
  }
  __syncthreads();
  for (int nb = 0; nb < 4; ++nb) {
    float acc[16];
    for (int s = 0; s < 16; ++s) acc[s] = 0.f;
    const float* wd = p.ew_down + (size_t)e * EFF * D + nb * 256 + tid;
    for (int j = 0; j < EFF; ++j) { const float w = wd[(size_t)j * D]; for (int s = 0; s < 16; ++s) acc[s] += hs[s][j] * w; }
    for (int s = 0; s < 16; ++s) if (toks[s] >= 0) p.Y[(size_t)(s0 + s) * D + nb * 256 + tid] = f2bf(acc[s]);
  }
}

#define SMEM_DECL __shared__ __attribute__((aligned(16))) unsigned char smem_raw[SMEM_BYTES]; const lds_ptr smem = (lds_ptr)smem_raw;
__global__ void __launch_bounds__(NTHR) k_prep(P p) { SMEM_DECL phase_prep(p, blockIdx.x, gridDim.x, smem); }
__global__ void __launch_bounds__(NTHR) k_norm1(P p) { SMEM_DECL phase_norm<true>(p, p.x, p.norm1_g, 0, D, p.h1, blockIdx.x, gridDim.x, smem); }
__global__ void __launch_bounds__(NTHR) k_proj(P p) { SMEM_DECL phase_gemm_dense(p.h1, D, p.wb_in, LDP, T, LDP, D, EpiStoreBf{p.proj, LDP}, blockIdx.x, gridDim.x, smem); }
__global__ void __launch_bounds__(NTHR) k_glu(P p) { SMEM_DECL phase_gemm_dense(p.yA, S5W, p.wb_glu, S5W, T, S5W, S5W, EpiGlu{p.yA, p.b_glu, p.zA}, blockIdx.x, gridDim.x, smem); }
__global__ void __launch_bounds__(NTHR) k_mixed(P p) { SMEM_DECL phase_gemm_mixed(p, blockIdx.x, gridDim.x, smem); }
__global__ void __launch_bounds__(NTHR) k_out(P p) { SMEM_DECL phase_gemm_dense(p.mixed, D, p.wb_out, D, T, D, D, EpiOut{p.x, p.mod, p.x1}, blockIdx.x, gridDim.x, smem); }
__global__ void __launch_bounds__(NTHR) k_norm2(P p) { SMEM_DECL phase_norm<false>(p, p.x1, p.norm2_g, 3 * D, 4 * D, p.h2, blockIdx.x, gridDim.x, smem); }
__global__ void __launch_bounds__(NTHR) k_rs(P p) { SMEM_DECL phase_gemm_rs(p, blockIdx.x, gridDim.x, smem); }
__global__ void __launch_bounds__(NTHR) k_moe(P p) { SMEM_DECL phase_moe(p, blockIdx.x, gridDim.x, smem); }
__global__ void __launch_bounds__(NTHR) k_shdown(P p) { SMEM_DECL phase_gemm_dense(p.shH, SFF, p.wb_sd, D, T, D, SFF, EpiStoreBf{p.S, D}, blockIdx.x, gridDim.x, smem); }
__global__ void __launch_bounds__(NTHR) k_combine(P p) { phase_combine(p, blockIdx.x, gridDim.x); }
__global__ void __launch_bounds__(NTHR) k_mix_local(P p, int which) { SMEM_DECL phase_mix_local(p, blockIdx.x, gridDim.x, smem, which); }
__global__ void __launch_bounds__(NTHR) k_mix_carry(P p, int which) { phase_mix_carry(p, blockIdx.x, gridDim.x, which); }
__global__ void __launch_bounds__(NTHR) k_mix_final(P p, int which) { SMEM_DECL phase_mix_final(p, blockIdx.x, gridDim.x, smem, which); }
__global__ void __launch_bounds__(NTHR) k_route2(P p) { phase_route(p, blockIdx.x, gridDim.x); }
__global__ void __launch_bounds__(NTHR) k_scatter2(P p) { SMEM_DECL phase_scatter(p, blockIdx.x, gridDim.x, smem); }


#define XB_TMO      128
#define XB_XCNT(j)  (256  + 64 * (j))
#define XB_XSUB(j)  (1280 + 64 * (j))
#define XB_XGEN(j)  (2304 + 64 * (j))
#define XB_TOP      3328
#define XB_TOPGEN   3392
#define XCD_BAR_WORDS 3456
#define XB_SPIN_CAP (1u << 18)
__device__ __forceinline__ unsigned xb_ld(unsigned* q)              { return __hip_atomic_load(q, __ATOMIC_RELAXED, __HIP_MEMORY_SCOPE_AGENT); }
__device__ __forceinline__ unsigned xb_add(unsigned* q, unsigned v) { return __hip_atomic_fetch_add(q, v, __ATOMIC_RELAXED, __HIP_MEMORY_SCOPE_AGENT); }
__device__ __forceinline__ unsigned xb_xcc_id() { return (unsigned)__builtin_amdgcn_s_getreg((3 << 11) | 20) & 0xFu; }
#define XB_SPIN(cond, bar) do { unsigned _sp = 0; while (cond) { __builtin_amdgcn_s_sleep(1); \
    if ((++_sp & 255u) == 0u) { if (xb_ld(&(bar)[XB_TMO])) break; if (_sp > XB_SPIN_CAP) { atomicAdd(&(bar)[XB_TMO], 1u); break; } } } } while (0)
struct XcdBarrier { unsigned* bar; unsigned x; volatile LAS unsigned* st; };
__device__ __forceinline__ XcdBarrier xcd_barrier_post(unsigned* bar, volatile LAS unsigned* st) {
  XcdBarrier b; b.bar = bar; b.x = xb_xcc_id(); b.st = st;
  if (threadIdx.x == 0) (void)xb_add(&bar[XB_XCNT(b.x)], 1u);
  return b;
}
__device__ __forceinline__ void xcd_barrier_complete(unsigned* bar, unsigned x, unsigned& nloc, unsigned& nx) {
  const unsigned G = gridDim.x * gridDim.y * gridDim.z;
  unsigned sum, cnt, mine, sp = 0u;
  for (;;) {
    sum = 0u; cnt = 0u; mine = 0u;
#pragma unroll
    for (unsigned j = 0; j < 16; ++j) { const unsigned c = xb_ld(&bar[XB_XCNT(j)]); sum += c; cnt += (c > 0u) ? 1u : 0u; mine = (j == x) ? c : mine; }
    if (sum == G) break;
    __builtin_amdgcn_s_sleep(1);
    if ((++sp & 255u) == 0u) { if (xb_ld(&bar[XB_TMO])) break; if (sp > XB_SPIN_CAP) { atomicAdd(&bar[XB_TMO], 1u); break; } }
  }
  nloc = mine > 0u ? mine : 1u; nx = cnt > 0u ? cnt : 1u;
}
__device__ __forceinline__ void xcd_barrier(const XcdBarrier& b) {
  asm volatile("s_waitcnt vmcnt(0)" ::: "memory");
  __syncthreads();
  if (threadIdx.x == 0) {
    unsigned* bar = b.bar;
    __builtin_amdgcn_s_waitcnt(0);
    unsigned nloc = b.st[0], nx = b.st[1];
    if (nloc == 0u) { xcd_barrier_complete(bar, b.x, nloc, nx); b.st[0] = nloc; b.st[1] = nx; }
    const unsigned old = xb_add(&bar[XB_XSUB(b.x)], 1u);
    const unsigned gen = old / nloc;
    if (old + 1u == (gen + 1u) * nloc) {
      __builtin_amdgcn_fence(__ATOMIC_RELEASE, "agent");
      asm volatile("s_waitcnt vmcnt(0)" ::: "memory");
      const unsigned og = xb_add(&bar[XB_TOP], 1u);
      const unsigned tg = og / nx;
      if (og + 1u == (tg + 1u) * nx) xb_add(&bar[XB_TOPGEN], 1u);
      else XB_SPIN(xb_ld(&bar[XB_TOPGEN]) == tg, bar);
      __builtin_amdgcn_fence(__ATOMIC_ACQUIRE, "agent");
      xb_add(&bar[XB_XGEN(b.x)], 1u);
      asm volatile("s_waitcnt vmcnt(0)" ::: "memory");
    } else {
      XB_SPIN(xb_ld(&bar[XB_XGEN(b.x)]) == gen, bar);
      __builtin_amdgcn_fence(__ATOMIC_ACQUIRE, "agent");
      asm volatile("s_waitcnt vmcnt(0)" ::: "memory");
    }
  }
  __syncthreads();
}

__global__ void __launch_bounds__(NTHR) k_fused(P p) {
  SMEM_DECL
  const int bid = blockIdx.x, nb = gridDim.x;
  volatile LAS unsigned* xbw = (volatile LAS unsigned*)(smem + SMEM_BYTES - 16);
  if (threadIdx.x == 0) { xbw[0] = 0u; xbw[1] = 0u; }
  __syncthreads();
  const XcdBarrier xb = xcd_barrier_post(p.bar, xbw);
#define GSYNC() xcd_barrier(xb)
#define RUN(k, ...) do { __VA_ARGS__; if (REP_PHASE == (k)) { __VA_ARGS__; } } while (0)
  RUN(0, phase_prep(p, bid, nb, smem));                                                                   GSYNC();
  RUN(1, phase_norm<false>(p, p.x, p.norm1_g, 0, D, p.h1, bid, nb, smem));                                 GSYNC();
  RUN(2, phase_gemm_dense256(p.h1, D, p.wb_in, LDP, T, LDP, D, EpiStoreBf{p.proj, LDP}, bid, nb, smem); gk_rows(p, bid, nb));     GSYNC();
  RUN(3, phase_mix_local(p, bid, nb, smem, 3));                                                           GSYNC();
  RUN(4, phase_mix_carry(p, bid, nb, 3));                                                                 GSYNC();
  RUN(5, phase_mix_final(p, bid, nb, smem, 3));                                                           GSYNC();
  RUN(6, phase_gemm_dense(p.yA, S5W, p.wb_glu, S5W, T, S5W, S5W, EpiGlu{p.yA, p.b_glu, p.zA}, bid, nb, smem));   GSYNC();
  RUN(7, phase_gemm_mixed(p, bid, nb, smem));                                                             GSYNC();
  RUN(8, phase_gemm_dense256(p.mixed, D, p.wb_out, D, T, D, D, EpiOut{p.x, p.mod, p.x1}, bid, nb, smem));    GSYNC();
  RUN(9, phase_norm<false>(p, p.x1, p.norm2_g, 3 * D, 4 * D, p.h2, bid, nb, smem));                       GSYNC();
  RUN(10, phase_gemm_rs(p, bid, nb, smem));                                                               GSYNC();
  phase_route(p, bid, nb);                                                                                GSYNC();
  RUN(12, phase_scatter(p, bid, nb, smem));                                                               GSYNC();
  phase_moe_pair<1>(p, bid, nb, smem);                                                                    GSYNC();
  phase_moe_pair<2>(p, bid, nb, smem);
  RUN(14, phase_gemm_dense256(p.shH, SFF, p.wb_sd, D, T, D, SFF, EpiStoreBf{p.S, D}, bid, nb, smem));        GSYNC();
  RUN(15, phase_combine(p, bid, nb));
}

static inline size_t al256(size_t v) { return (v + 255) & ~(size_t)255; }

extern "C" void kernel_launch(void* const* d_in, const int* in_sizes, int n_in, void* d_out, int out_size, void* d_ws, size_t ws_size, hipStream_t stream) {
  P p{};
  const float** pin = (const float**)&p;
  for (int i = 0; i < 32; ++i) pin[i] = (const float*)d_in[i];
  p.out = (float*)d_out;
  char* w = (char*)d_ws; size_t off = 0;
  auto take = [&](size_t bytes) { char* r = w + off; off = al256(off + bytes); return (void*)r; };
  p.mod = (float*)take(8 * 6144 * 4);
  p.wb_in = (bf16_t*)take((size_t)D * LDP * 2);
  p.wb_glu = (bf16_t*)take((size_t)S5W * S5W * 2);
  p.wb_pa = (bf16_t*)take((size_t)S5W * D * 2);
  p.wb_pb = (bf16_t*)take((size_t)GVAL * D * 2);
  p.wb_out = (bf16_t*)take((size_t)D * D * 2);
  p.wb_rs = (bf16_t*)take((size_t)D * 768 * 2);
  p.wb_sd = (bf16_t*)take((size_t)SFF * D * 2);
  p.h1 = (bf16_t*)take((size_t)T * D * 2);
  p.gkl = (float*)take((size_t)T * 16 * 4);
  p.proj = (bf16_t*)take((size_t)T * LDP * 2);
  p.abar = (float*)take(S5G * S5P * 2 * 4);
  p.bbar = (float*)take(S5G * S5P * S5H * 2 * 4);
  p.yA = (bf16_t*)take((size_t)T * S5W * 2);
  p.oraw = (float*)take((size_t)T * GVAL * 4);
  p.yB = (bf16_t*)take((size_t)T * GVAL * 2);
  p.zA = (bf16_t*)take((size_t)T * S5W * 2);
  p.mixed = (bf16_t*)take((size_t)T * D * 2);
  p.x1 = (float*)take((size_t)T * D * 4);
  p.h2 = (bf16_t*)take((size_t)T * D * 2);
  p.logits = (float*)take((size_t)T * NE * 4);
  p.tk_idx = (int*)take((size_t)T * 8 * 4);
  p.tk_w = (float*)take((size_t)T * 8 * 4);
  p.tk_rank = (int*)take((size_t)T * 8 * 4);
  p.slot_of = (int*)take((size_t)T * 8 * 4);
  p.counts = (int*)take(256 * 4);
  p.pad_start = (int*)take(257 * 4);
  p.blk_exp = (int*)take(NBLK128 * 4);
  p.slot_tok = (int*)take((size_t)NSLOT * 4);
  p.Y = (bf16_t*)take((size_t)NSLOT * D * 2);
  p.shH = (bf16_t*)take((size_t)T * SFF * 2);
  p.S = (bf16_t*)take((size_t)T * D * 2);
  p.bbarT = (bf16_t*)take((size_t)S5G * 128 * 16 * 2);
  p.cmT = (bf16_t*)take((size_t)S5G * 16 * 128 * 2);
  p.apow64 = (float*)take(S5G * S5P * 2 * 4);
  p.s5E = (float*)take((size_t)NB * 32 * S5G * 64 * 2 * 4);
  p.s5Sin = (float*)take((size_t)NB * 32 * S5G * 64 * 2 * 4);
  p.glaKV = (float*)take((size_t)1024 * 64 * 128 * 4);
  p.glaDec = (float*)take((size_t)1024 * 64 * 4);
  p.glaSin = (bf16_t*)take((size_t)1024 * 64 * 128 * 2);
  p.wgkT = (bf16_t*)take((size_t)16 * D * 2);
  p.moe_list = (int*)take((size_t)8 * NBLK128 * 4);
  p.moe_cnt = (int*)take(64);
  p.moe_ctr = (int*)take(64);
  p.Hbuf = (bf16_t*)take((size_t)NSLOT * EFF * 2);
  p.bar = (unsigned*)take(XCD_BAR_WORDS * 4);
  if (off > ws_size) { fprintf(stderr, "workspace too small: need %zu have %zu\n", off, ws_size); return; }

  static int grid_blocks = 0;
  if (!grid_blocks) {
    int dev = 0, cus = 0, per_cu = 0;
    (void)hipGetDevice(&dev);
    (void)hipDeviceGetAttribute(&cus, hipDeviceAttributeMultiprocessorCount, dev);
    (void)hipOccupancyMaxActiveBlocksPerMultiprocessor(&per_cu, k_fused, NTHR, 0);
    grid_blocks = (per_cu >= 1) ? cus : 0;
    grid_blocks &= ~7;
    if (grid_blocks <= 0) { fprintf(stderr, "occupancy query says the fused kernel does not fit (per_cu=%d cus=%d)\n", per_cu, cus); grid_blocks = 0; return; }
  }
  (void)hipMemsetAsync(p.bar, 0, XCD_BAR_WORDS * 4, stream);
  void* args[] = {&p};
  hipError_t e = hipLaunchCooperativeKernel((const void*)k_fused, dim3(grid_blocks), dim3(NTHR), args, 0, stream);
  if (e != hipSuccess) fprintf(stderr, "cooperative launch failed: %s (grid %d)\n", hipGetErrorString(e), grid_blocks);
}
```

```cpp
#include <hip/hip_runtime.h>
#include <hip/hip_cooperative_groups.h>
namespace cg = cooperative_groups;
#include <cstdint>
#include <cstdio>

typedef unsigned short bf16_t;
typedef short s16x8 __attribute__((ext_vector_type(8)));
typedef short s16x4 __attribute__((ext_vector_type(4)));
typedef float f32x4 __attribute__((ext_vector_type(4)));
typedef unsigned u32x4 __attribute__((ext_vector_type(4)));
typedef unsigned u32x2 __attribute__((ext_vector_type(2)));
#define LAS __attribute__((address_space(3)))
typedef LAS unsigned char* lds_ptr;

constexpr int D = 1024, NB = 8, SEQ = 2048, T = NB * SEQ;
constexpr int S5W = 512, S5G = 32, S5H = 16, S5P = 64;
constexpr int GH = 4, GDK = 64, GDV = 128, GKEY = 256, GVAL = 512, GRANK = 16;
constexpr int NE = 256, TOPK = 8, NGRP = 8, EFF = 256, SFF = 256;
constexpr int INW = 4112, LDP = 4096;
constexpr int OFF_U = 0, OFF_Q = 512, OFF_K = 768, OFF_V = 1024, OFF_R = 1536, OFF_GA = 2048, OFF_GB = 3072;
constexpr int WIN_GK = 1536;
constexpr int NSLOT = 163584, NBLK128 = NSLOT / 128;
constexpr int NTHR = 512;
constexpr int USE_MFMA = 127;
constexpr int USE_NEW = 7;
constexpr int REP_PHASE = -1;
constexpr int MOE_REP_GU = 1, MOE_REP_DN = 1;

__device__ __forceinline__ float bf2f(bf16_t v) { return __uint_as_float(((unsigned)v) << 16); }
__device__ __forceinline__ bf16_t f2bf(float f) { return __builtin_bit_cast(unsigned short, (__bf16)f); }
typedef float f32x2 __attribute__((ext_vector_type(2)));
typedef __bf16 bf16x2_t __attribute__((ext_vector_type(2)));
__device__ __forceinline__ unsigned cvtpk(float lo, float hi) { const f32x2 v = {lo, hi}; return __builtin_bit_cast(unsigned, __builtin_convertvector(v, bf16x2_t)); }
__device__ __forceinline__ float sigmoidf_(float x) { return __builtin_amdgcn_rcpf(1.f + __expf(-x)); }
__device__ __forceinline__ float siluf_(float x) { return x * __builtin_amdgcn_rcpf(1.f + __expf(-x)); }
__device__ __forceinline__ float geluf_(float x) { const float u = 0.7978845608028654f * (x + 0.044715f * x * x * x); return x * __builtin_amdgcn_rcpf(1.f + __expf(-2.f * u)); }
__device__ __forceinline__ float logsigmoidf_(float x) { return fminf(x, 0.f) - __logf(1.f + __expf(-fabsf(x))); }

struct P;
typedef const __attribute__((address_space(4))) P& PR;

__device__ __forceinline__ int ltid() { int t = threadIdx.x; asm volatile("" : "+v"(t)); return t; }

struct P {
  const float *x, *c, *ada_w, *ada_b, *norm1_g, *w_in, *lam_re, *lam_im, *log_dt, *b_re, *b_im, *c_re, *c_im, *s5_d, *w_glu, *b_glu, *w_proj_a,
      *w_gk2, *b_gk2, *gla_norm_g, *w_proj_b, *w_out, *norm2_g, *router_w, *router_bias, *ew_gate, *ew_up, *ew_down, *sw_gate, *sw_up, *sw_down, *final_g;
  float* out;
  float* mod;
  bf16_t* wb_in;
  bf16_t* wb_glu;
  bf16_t* wb_pa;
  bf16_t* wb_pb;
  bf16_t* wb_out;
  bf16_t* wb_rs;
  bf16_t* wb_sd;
  bf16_t* h1;
  float* gkl;
  bf16_t* proj;
  float* abar;
  float* bbar;
  bf16_t* yA;
  float* oraw;
  bf16_t* yB;
  bf16_t* zA;
  bf16_t* mixed;
  float* x1;
  bf16_t* h2;
  float* logits;
  int* tk_idx;
  float* tk_w;
  int* tk_rank;
  int* slot_of;
  int* counts;
  int* pad_start;
  int* blk_exp;
  int* slot_tok;
  bf16_t* Y;
  bf16_t* shH;
  bf16_t* S;
  bf16_t* bbarT;
  bf16_t* cmT;
  float* apow64;
  float* s5E;
  float* s5Sin;
  float* glaKV;
  float* glaDec;
  bf16_t* glaSin;
  bf16_t* wgkT;
  int* moe_list;
  int* moe_cnt;
  int* moe_ctr;
  bf16_t* Hbuf;
  unsigned* bar;
};

constexpr int G_ASZ = 128 * 64, G_BSZ = 32 * 512, G_STAGE = G_ASZ + G_BSZ;

__device__ __forceinline__ int a_off(int r, int c) { return r * 64 + ((c ^ ((0x78 >> (((r >> 2) & 3) * 2)) & 3)) << 4); }
__device__ __forceinline__ int b_off(int k, int ch) { return k * 512 + ((ch ^ ((k & 3) | (((k >> 3) & 1) << 2))) << 5); }
__device__ __forceinline__ s16x4 tr_read(lds_ptr p) { return __builtin_bit_cast(s16x4, __builtin_amdgcn_ds_read_tr16_b64_v4i16((LAS s16x4*)p)); }

struct ALoadDense { const bf16_t* A; long lda; __device__ __forceinline__ const bf16_t* rowptr(int r) const { return A + (size_t)r * lda; } };
struct ALoadGatherLds { const bf16_t* A; LAS int* tk; __device__ __forceinline__ const bf16_t* rowptr(int r) const { int t = tk[r]; t = t < 0 ? 0 : t; return A + (size_t)t * D; } };
struct BLoadBf { const bf16_t* Bm; long ldb;
  __device__ __forceinline__ u32x4 load(int kg, int c8) const { return *(const u32x4*)(Bm + (size_t)kg * ldb + c8 * 8); } };
struct BLoadF32 { const float* Bm; long ldb;
  __device__ __forceinline__ u32x4 load(int kg, int c8) const { const float* q = Bm + (size_t)kg * ldb + c8 * 8; const f32x4 a = *(const f32x4*)q, b = *(const f32x4*)(q + 4);
    u32x4 r; r.x = cvtpk(a[0], a[1]); r.y = cvtpk(a[2], a[3]); r.z = cvtpk(b[0], b[1]); r.w = cvtpk(b[2], b[3]); return r; } };
struct BLoadGU { const float* Wg; const float* Wu; long ldb; int h0;
  __device__ __forceinline__ u32x4 load(int kg, int c8) const { const int col = c8 * 8, w = col >> 6, xx = col & 63; const float* base = (xx < 32) ? Wg : Wu;
    const float* q = base + (size_t)kg * ldb + h0 + 32 * w + (xx & 31); const f32x4 a = *(const f32x4*)q, b = *(const f32x4*)(q + 4);
    u32x4 r; r.x = cvtpk(a[0], a[1]); r.y = cvtpk(a[2], a[3]); r.z = cvtpk(b[0], b[1]); r.w = cvtpk(b[2], b[3]); return r; } };

template <bool A_RES, class AL, class BL>
__device__ __forceinline__ void gemm_mainloop(f32x4 (&acc)[4][4], const AL& al, const BL& bl, int nk, lds_ptr stage, lds_ptr resA) {
  const int tid = ltid(), lane = tid & 63, wid = tid >> 6, wm = wid >> 2, wn = wid & 3, fr = lane & 15, fq = lane >> 4;
  const int ar = tid >> 2, ac = tid & 3;
  const int p0 = tid, p1 = tid + 512;
  const int bk0 = p0 >> 5, bc0 = p0 & 31, bk1 = p1 >> 5, bc1 = p1 & 31;
  const bf16_t* aptr = nullptr;
  if (!A_RES) aptr = al.rowptr(ar) + ac * 8;
  const int a_st = a_off(ar, ac);
  const int b_st0 = b_off(bk0, bc0 >> 1) + (bc0 & 1) * 16, b_st1 = b_off(bk1, bc1 >> 1) + (bc1 & 1) * 16;
  int a_rd[4];
#pragma unroll
  for (int mt = 0; mt < 4; ++mt) a_rd[mt] = a_off(wm * 64 + mt * 16 + fr, fq);
  int b_rd[4][2];
#pragma unroll
  for (int nt = 0; nt < 4; ++nt) {
    b_rd[nt][0] = b_off(8 * fq + (fr >> 2), wn * 4 + nt) + (fr & 3) * 8;
    b_rd[nt][1] = b_off(8 * fq + 4 + (fr >> 2), wn * 4 + nt) + (fr & 3) * 8;
  }
#pragma unroll
  for (int mt = 0; mt < 4; ++mt)
#pragma unroll
    for (int nt = 0; nt < 4; ++nt) acc[mt][nt] = (f32x4){0.f, 0.f, 0.f, 0.f};
  u32x4 areg = {0, 0, 0, 0}, breg0, breg1;
  if (!A_RES) areg = *(const u32x4*)aptr;
  breg0 = bl.load(bk0, bc0); breg1 = bl.load(bk1, bc1);
  __syncthreads();
  if (!A_RES) *(LAS u32x4*)(stage + a_st) = areg;
  *(LAS u32x4*)(stage + G_ASZ + b_st0) = breg0;
  *(LAS u32x4*)(stage + G_ASZ + b_st1) = breg1;
  __syncthreads();
  for (int kt = 0; kt < nk; ++kt) {
    const lds_ptr cur = stage + (kt & 1) * G_STAGE, nxt = stage + ((kt + 1) & 1) * G_STAGE;
    const bool more = kt + 1 < nk;
    if (more) {
      if (!A_RES) areg = *(const u32x4*)(aptr + (kt + 1) * 32);
      breg0 = bl.load((kt + 1) * 32 + bk0, bc0); breg1 = bl.load((kt + 1) * 32 + bk1, bc1);
    }
    s16x8 af[4], bfr[4];
    const lds_ptr abase = A_RES ? (resA + kt * G_ASZ) : cur;
#pragma unroll
    for (int mt = 0; mt < 4; ++mt) af[mt] = *(LAS s16x8*)(abase + a_rd[mt]);
#pragma unroll
    for (int nt = 0; nt < 4; ++nt) {
      const s16x4 lo = tr_read(cur + G_ASZ + b_rd[nt][0]), hi = tr_read(cur + G_ASZ + b_rd[nt][1]);
      bfr[nt] = __builtin_shufflevector(lo, hi, 0, 1, 2, 3, 4, 5, 6, 7);
    }
#pragma unroll
    for (int mt = 0; mt < 4; ++mt)
#pragma unroll
      for (int nt = 0; nt < 4; ++nt) acc[mt][nt] = __builtin_amdgcn_mfma_f32_16x16x32_bf16(bfr[nt], af[mt], acc[mt][nt], 0, 0, 0);
    if (more) {
      if (!A_RES) *(LAS u32x4*)(nxt + a_st) = areg;
      *(LAS u32x4*)(nxt + G_ASZ + b_st0) = breg0;
      *(LAS u32x4*)(nxt + G_ASZ + b_st1) = breg1;
    }
    __syncthreads();
  }
}


struct BRaw { f32x4 v[4]; };
struct BLoadF32R { const float* Bm; long ldb;
  __device__ __forceinline__ void load(BRaw& r, int kbase, int tid) const {
    const float* q = Bm + (size_t)(kbase + (tid >> 6)) * ldb + (tid & 63) * 4;
#pragma unroll
    for (int i = 0; i < 4; ++i) r.v[i] = *(const f32x4*)(q + (size_t)(8 * i) * ldb); } };
struct BLoadGUR { const float* Wg; long du; long ldb; int h0;
  __device__ __forceinline__ void load(BRaw& r, int kbase, int tid) const {
    const int col = (tid & 63) * 4, w = col >> 6, xx = col & 63;
    const float* q = Wg + ((xx < 32) ? 0l : du) + (size_t)(kbase + (tid >> 6)) * ldb + h0 + 32 * w + (xx & 31);
#pragma unroll
    for (int i = 0; i < 4; ++i) r.v[i] = *(const f32x4*)(q + (size_t)(8 * i) * ldb); } };
__device__ __forceinline__ u32x4 cvt8(const f32x4& a, const f32x4& b) { u32x4 r; r.x = cvtpk(a[0], a[1]); r.y = cvtpk(a[2], a[3]); r.z = cvtpk(b[0], b[1]); r.w = cvtpk(b[2], b[3]); return r; }

template <bool A_RES, class AL, class BL>
__device__ __forceinline__ void gemm_mainloop_r3(f32x4 (&acc)[4][4], const AL& al, const BL& bl, int nk, lds_ptr stage, lds_ptr resA) {
  const int tid = ltid(), lane = tid & 63, wid = tid >> 6, wm = wid >> 2, wn = wid & 3, fr = lane & 15, fq = lane >> 4;
  const int ar = tid >> 2, ac = tid & 3;
  const bf16_t* aptr = nullptr;
  if (!A_RES) aptr = al.rowptr(ar) + ac * 8;
  const int a_st = a_off(ar, ac);
  int b_st[4];
#pragma unroll
  for (int i = 0; i < 4; ++i) b_st[i] = G_ASZ + b_off((tid >> 6) + 8 * i, (tid & 63) >> 2) + (tid & 3) * 8;
  int a_rd[4];
#pragma unroll
  for (int mt = 0; mt < 4; ++mt) a_rd[mt] = a_off(wm * 64 + mt * 16 + fr, fq);
  int b_rd[4][2];
#pragma unroll
  for (int nt = 0; nt < 4; ++nt) {
    b_rd[nt][0] = G_ASZ + b_off(8 * fq + (fr >> 2), wn * 4 + nt) + (fr & 3) * 8;
    b_rd[nt][1] = G_ASZ + b_off(8 * fq + 4 + (fr >> 2), wn * 4 + nt) + (fr & 3) * 8;
  }
#pragma unroll
  for (int mt = 0; mt < 4; ++mt)
#pragma unroll
    for (int nt = 0; nt < 4; ++nt) acc[mt][nt] = (f32x4){0.f, 0.f, 0.f, 0.f};
  u32x4 ra0 = {0, 0, 0, 0}, ra1 = {0, 0, 0, 0}, ra2 = {0, 0, 0, 0};
  BRaw rb0, rb1, rb2;
#define R3_LOAD(RA, RB, kt_) do { if (!A_RES) RA = *(const u32x4*)(aptr + (size_t)(kt_) * 32); bl.load(RB, (kt_) * 32, tid); } while (0)
#define R3_STORE(RA, RB, st_) do { const lds_ptr s_ = stage + (st_) * G_STAGE; if (!A_RES) *(LAS u32x4*)(s_ + a_st) = RA; \
    _Pragma("unroll") for (int i_ = 0; i_ < 4; ++i_) { u32x2 o_; o_.x = cvtpk(RB.v[i_][0], RB.v[i_][1]); o_.y = cvtpk(RB.v[i_][2], RB.v[i_][3]); *(LAS u32x2*)(s_ + b_st[i_]) = o_; } } while (0)
#define R3_COMPUTE(kt_) do { const lds_ptr cur = stage + ((kt_) & 1) * G_STAGE; const lds_ptr abase = A_RES ? (resA + (kt_) * G_ASZ) : cur; \
    s16x8 af[4], bfr[4]; \
    _Pragma("unroll") for (int mt = 0; mt < 4; ++mt) af[mt] = *(LAS s16x8*)(abase + a_rd[mt]); \
    _Pragma("unroll") for (int nt = 0; nt < 4; ++nt) { const s16x4 lo = tr_read(cur + b_rd[nt][0]), hi = tr_read(cur + b_rd[nt][1]); bfr[nt] = __builtin_shufflevector(lo, hi, 0, 1, 2, 3, 4, 5, 6, 7); } \
    _Pragma("unroll") for (int mt = 0; mt < 4; ++mt) _Pragma("unroll") for (int nt = 0; nt < 4; ++nt) acc[mt][nt] = __builtin_amdgcn_mfma_f32_16x16x32_bf16(bfr[nt], af[mt], acc[mt][nt], 0, 0, 0); } while (0)
#define R3_BODY_U(kt_, RAN, RBN, RAW, RBW) do { const int kl_ = ((kt_) + 3 < nk) ? (kt_) + 3 : nk - 1; R3_LOAD(RAN, RBN, kl_); __builtin_amdgcn_sched_barrier(0); R3_COMPUTE(kt_); __builtin_amdgcn_sched_barrier(0); R3_STORE(RAW, RBW, ((kt_) + 1) & 1); __syncthreads(); } while (0)
#define R3_BODY_T(kt_, RAW, RBW) do { R3_COMPUTE(kt_); if ((kt_) + 1 < nk) R3_STORE(RAW, RBW, ((kt_) + 1) & 1); __syncthreads(); } while (0)
  R3_LOAD(ra0, rb0, 0);
  R3_LOAD(ra1, rb1, 1);
  R3_LOAD(ra2, rb2, 2);
  __syncthreads();
  R3_STORE(ra0, rb0, 0);
  __syncthreads();
  int kt = 0;
  for (; kt + 3 <= nk; kt += 3) {
    R3_BODY_U(kt, ra0, rb0, ra1, rb1);
    R3_BODY_U(kt + 1, ra1, rb1, ra2, rb2);
    R3_BODY_U(kt + 2, ra2, rb2, ra0, rb0);
  }
  if (kt < nk) { R3_BODY_T(kt, ra1, rb1); if (kt + 1 < nk) R3_BODY_T(kt + 1, ra2, rb2); }
#undef R3_BODY_U
#undef R3_BODY_T
#undef R3_LOAD
#undef R3_STORE
#undef R3_COMPUTE
}

constexpr int G_NST = 4;
#define WAIT_VM(n) asm volatile("s_waitcnt vmcnt(" #n ")" ::: "memory")
template <class AL>
__device__ __forceinline__ void gemm_mainloop_glds(f32x4 (&acc)[4][4], const AL& al, const bf16_t* __restrict__ Bm, long ldb, int nk, lds_ptr ring) {
  const int tid = ltid(), lane = tid & 63, wid = tid >> 6, wm = wid >> 2, wn = wid & 3, fr = lane & 15, fq = lane >> 4;
  const int ar = tid >> 2;
  const bf16_t* aptr = al.rowptr(ar) + (((tid & 3) ^ ((0x78 >> (((ar >> 2) & 3) * 2)) & 3)) << 3);
  const int bk = tid >> 5, pc = tid & 31;
  const int bcol = ((((pc >> 1) ^ ((bk & 3) | (((bk >> 3) & 1) << 2))) << 4) | ((pc & 1) << 3));
  const bf16_t* bptr0 = Bm + (size_t)bk * ldb + bcol;
  const bf16_t* bptr1 = bptr0 + (size_t)16 * ldb;
  const size_t bstep = (size_t)32 * ldb;
  int a_rd[4];
#pragma unroll
  for (int mt = 0; mt < 4; ++mt) a_rd[mt] = a_off(wm * 64 + mt * 16 + fr, fq);
  int b_rd[4][2];
#pragma unroll
  for (int nt = 0; nt < 4; ++nt) {
    b_rd[nt][0] = G_ASZ + b_off(8 * fq + (fr >> 2), wn * 4 + nt) + (fr & 3) * 8;
    b_rd[nt][1] = G_ASZ + b_off(8 * fq + 4 + (fr >> 2), wn * 4 + nt) + (fr & 3) * 8;
  }
#pragma unroll
  for (int mt = 0; mt < 4; ++mt)
#pragma unroll
    for (int nt = 0; nt < 4; ++nt) acc[mt][nt] = (f32x4){0.f, 0.f, 0.f, 0.f};
  const lds_ptr dstl = ring + tid * 16;
#define GLDS_ISSUE(kt_) do { const lds_ptr d_ = dstl + ((kt_) & (G_NST - 1)) * G_STAGE; \
    __builtin_amdgcn_global_load_lds((const unsigned*)(aptr + (size_t)(kt_) * 32), (LAS unsigned*)(d_), 16, 0, 0); \
    __builtin_amdgcn_global_load_lds((const unsigned*)(bptr0 + (size_t)(kt_) * bstep), (LAS unsigned*)(d_ + G_ASZ), 16, 0, 0); \
    __builtin_amdgcn_global_load_lds((const unsigned*)(bptr1 + (size_t)(kt_) * bstep), (LAS unsigned*)(d_ + G_ASZ + 8192), 16, 0, 0); } while (0)
  __syncthreads();
  GLDS_ISSUE(0);
  if (nk > 1) GLDS_ISSUE(1);
  if (nk > 2) GLDS_ISSUE(2);
  for (int kt = 0; kt < nk; ++kt) {
    if (kt + 2 < nk) WAIT_VM(6); else if (kt + 1 < nk) WAIT_VM(3); else WAIT_VM(0);
    __builtin_amdgcn_s_barrier();
    if (kt + 3 < nk) GLDS_ISSUE(kt + 3);
    const lds_ptr cur = ring + (kt & (G_NST - 1)) * G_STAGE;
    s16x8 af[4], bfr[4];
#pragma unroll
    for (int mt = 0; mt < 4; ++mt) af[mt] = *(LAS s16x8*)(cur + a_rd[mt]);
#pragma unroll
    for (int nt = 0; nt < 4; ++nt) {
      const s16x4 lo = tr_read(cur + b_rd[nt][0]), hi = tr_read(cur + b_rd[nt][1]);
      bfr[nt] = __builtin_shufflevector(lo, hi, 0, 1, 2, 3, 4, 5, 6, 7);
    }
#pragma unroll
    for (int mt = 0; mt < 4; ++mt)
#pragma unroll
      for (int nt = 0; nt < 4; ++nt) acc[mt][nt] = __builtin_amdgcn_mfma_f32_16x16x32_bf16(bfr[nt], af[mt], acc[mt][nt], 0, 0, 0);
  }
#undef GLDS_ISSUE
}


constexpr int G2_STAGE = 2 * G_ASZ + G_BSZ;
__device__ __forceinline__ void gemm_mainloop_glds256(f32x4 (&acc)[8][4], const bf16_t* __restrict__ A, long lda, const bf16_t* __restrict__ Bm, long ldb, int nk, lds_ptr ring) {
  const int tid = ltid(), lane = tid & 63, wid = tid >> 6, wm = wid >> 2, wn = wid & 3, fr = lane & 15, fq = lane >> 4;
  const int ar = tid >> 2;
  const bf16_t* aptr0 = A + (size_t)ar * lda + (((tid & 3) ^ ((0x78 >> (((ar >> 2) & 3) * 2)) & 3)) << 3);
  const bf16_t* aptr1 = aptr0 + (size_t)128 * lda;
  const int bk = tid >> 5, pc = tid & 31;
  const int bcol = ((((pc >> 1) ^ ((bk & 3) | (((bk >> 3) & 1) << 2))) << 4) | ((pc & 1) << 3));
  const bf16_t* bptr0 = Bm + (size_t)bk * ldb + bcol;
  const bf16_t* bptr1 = bptr0 + (size_t)16 * ldb;
  const size_t bstep = (size_t)32 * ldb;
  int a_rd[8];
#pragma unroll
  for (int mt = 0; mt < 8; ++mt) a_rd[mt] = wm * G_ASZ + a_off(mt * 16 + fr, fq);
  int b_rd[4][2];
#pragma unroll
  for (int nt = 0; nt < 4; ++nt) {
    b_rd[nt][0] = 2 * G_ASZ + b_off(8 * fq + (fr >> 2), wn * 4 + nt) + (fr & 3) * 8;
    b_rd[nt][1] = 2 * G_ASZ + b_off(8 * fq + 4 + (fr >> 2), wn * 4 + nt) + (fr & 3) * 8;
  }
#pragma unroll
  for (int mt = 0; mt < 8; ++mt)
#pragma unroll
    for (int nt = 0; nt < 4; ++nt) acc[mt][nt] = (f32x4){0.f, 0.f, 0.f, 0.f};
  const lds_ptr dstl = ring + tid * 16;
#define GLDS2_ISSUE(kt_) do { const lds_ptr d_ = dstl + ((kt_) & (G_NST - 1)) * G2_STAGE; \
    __builtin_amdgcn_global_load_lds((const unsigned*)(aptr0 + (size_t)(kt_) * 32), (LAS unsigned*)(d_), 16, 0, 0); \
    __builtin_amdgcn_global_load_lds((const unsigned*)(aptr1 + (size_t)(kt_) * 32), (LAS unsigned*)(d_ + G_ASZ), 16, 0, 0); \
    __builtin_amdgcn_global_load_lds((const unsigned*)(bptr0 + (size_t)(kt_) * bstep), (LAS unsigned*)(d_ + 2 * G_ASZ), 16, 0, 0); \
    __builtin_amdgcn_global_load_lds((const unsigned*)(bptr1 + (size_t)(kt_) * bstep), (LAS unsigned*)(d_ + 2 * G_ASZ + 8192), 16, 0, 0); } while (0)
  __syncthreads();
  GLDS2_ISSUE(0);
  if (nk > 1) GLDS2_ISSUE(1);
  if (nk > 2) GLDS2_ISSUE(2);
  for (int kt = 0; kt < nk; ++kt) {
    if (kt + 2 < nk) WAIT_VM(8); else if (kt + 1 < nk) WAIT_VM(4); else WAIT_VM(0);
    __builtin_amdgcn_s_barrier();
    if (kt + 3 < nk) GLDS2_ISSUE(kt + 3);
    const lds_ptr cur = ring + (kt & (G_NST - 1)) * G2_STAGE;
    s16x8 bfr[4];
#pragma unroll
    for (int nt = 0; nt < 4; ++nt) {
      const s16x4 lo = tr_read(cur + b_rd[nt][0]), hi = tr_read(cur + b_rd[nt][1]);
      bfr[nt] = __builtin_shufflevector(lo, hi, 0, 1, 2, 3, 4, 5, 6, 7);
    }
#pragma unroll
    for (int h = 0; h < 2; ++h) {
      s16x8 af[4];
#pragma unroll
      for (int mt = 0; mt < 4; ++mt) af[mt] = *(LAS s16x8*)(cur + a_rd[h * 4 + mt]);
#pragma unroll
      for (int mt = 0; mt < 4; ++mt)
#pragma unroll
        for (int nt = 0; nt < 4; ++nt) acc[h * 4 + mt][nt] = __builtin_amdgcn_mfma_f32_16x16x32_bf16(bfr[nt], af[mt], acc[h * 4 + mt][nt], 0, 0, 0);
    }
  }
#undef GLDS2_ISSUE
}

__device__ __forceinline__ void tile_map(int round, int bid, int nb, int nMt, int nNt, int& mt, int& nt, bool& valid) {
  if (nb == 256 && (nNt & 3) == 0 && (nMt & 7) == 0) {
    const int xcd = bid & 7, j = bid >> 3, q = round * 8 + xcd, rn = nNt >> 2;
    const int rect_m = q / rn, rect_n = q % rn;
    mt = rect_m * 8 + (j & 7); nt = rect_n * 4 + (j >> 3); valid = mt < nMt;
  } else {
    const int per = (nb + 7) / 8, xcd = bid & 7, j = bid >> 3;
    const int idx = round * nb + xcd * per + j;
    mt = idx / nNt; nt = idx % nNt; valid = (j < per) && (idx < nMt * nNt) && (xcd * per + j < nb);
  }
}

__device__ __forceinline__ void cvt_copy(const float* __restrict__ src, long lds_, bf16_t* __restrict__ dst, long ldd, int rows, int cols, int gtid, int gsz) {
  const int c4 = cols >> 2;
  for (long i = gtid; i < (long)rows * c4; i += gsz) {
    const int r = (int)(i / c4), c = (int)(i % c4) * 4;
    const f32x4 v = *(const f32x4*)(src + (size_t)r * lds_ + c);
    u32x2 o; o.x = cvtpk(v[0], v[1]); o.y = cvtpk(v[2], v[3]);
    *(u32x2*)(dst + (size_t)r * ldd + c) = o;
  }
}
__device__ __forceinline__ void phase_prep(PR p, int bid, int nb, lds_ptr smem) {
  const int gtid = bid * NTHR + ltid(), gsz = nb * NTHR;
  cvt_copy(p.w_in, INW, p.wb_in, LDP, D, WIN_GK, gtid, gsz);
  cvt_copy(p.w_in + WIN_GK + 16, INW, p.wb_in + WIN_GK, LDP, D, LDP - WIN_GK, gtid, gsz);
  cvt_copy(p.w_glu, S5W, p.wb_glu, S5W, S5W, S5W, gtid, gsz);
  cvt_copy(p.w_proj_a, D, p.wb_pa, D, S5W, D, gtid, gsz);
  cvt_copy(p.w_proj_b, D, p.wb_pb, D, GVAL, D, gtid, gsz);
  cvt_copy(p.w_out, D, p.wb_out, D, D, D, gtid, gsz);
  cvt_copy(p.router_w, NE, p.wb_rs, 768, D, NE, gtid, gsz);
  cvt_copy(p.sw_down, D, p.wb_sd, D, SFF, D, gtid, gsz);
  for (long i = gtid; i < (long)D * 512; i += gsz) {
    const int k = (int)(i >> 9), cc = (int)(i & 511), w = cc >> 6, xx = cc & 63;
    const int hcol = 32 * w + (xx & 31);
    const float v = (xx < 32) ? p.sw_gate[(size_t)k * SFF + hcol] : p.sw_up[(size_t)k * SFF + hcol];
    p.wb_rs[(size_t)k * 768 + 256 + cc] = f2bf(v);
  }
  for (int i = gtid; i < 16 * D; i += gsz) { const int n = i >> 10, k = i & 1023; p.wgkT[i] = f2bf(p.w_in[(size_t)k * INW + WIN_GK + n]); }
  for (int i = gtid; i < NSLOT; i += gsz) p.slot_tok[i] = -1;
  if (gtid < 256) p.counts[gtid] = 0;
  if (gtid < 16) p.moe_ctr[gtid] = 0;
  if (ltid() < 8 && bid * 8 + ltid() < S5G * S5P) {
    const int i = bid * 8 + ltid(), g = i / S5P;
    const double lr = p.lam_re[i], li = p.lam_im[i], dt = (double)__expf(p.log_dt[g]);
    const double TWO_PI = 6.283185307179586476925286766559;
    double ang = li * dt; ang -= TWO_PI * floor(ang / TWO_PI);
    const double mag = (double)__expf((float)(lr * dt));
    const double are = mag * (double)cosf((float)ang), aim = mag * (double)sinf((float)ang);
    const double den = lr * lr + li * li, nre = are - 1.0;
    const double cre = (nre * lr + aim * li) / den, cim = (aim * lr - nre * li) / den;
    p.abar[i * 2] = (float)are; p.abar[i * 2 + 1] = (float)aim;
    for (int h = 0; h < S5H; ++h) {
      const double br = p.b_re[i * S5H + h], bi = p.b_im[i * S5H + h];
      p.bbar[(i * S5H + h) * 2] = (float)(cre * br - cim * bi);
      p.bbar[(i * S5H + h) * 2 + 1] = (float)(cre * bi + cim * br);
      const int pq = i & 63;
      p.bbarT[(size_t)(g * 128 + pq) * 16 + h] = f2bf((float)(cre * br - cim * bi));
      p.bbarT[(size_t)(g * 128 + 64 + pq) * 16 + h] = f2bf((float)(cre * bi + cim * br));
    }
    double a64 = 64.0 * li * dt; a64 -= TWO_PI * floor(a64 / TWO_PI);
    const double m64 = (double)__expf((float)(64.0 * lr * dt));
    p.apow64[i * 2] = (float)(m64 * (double)cosf((float)a64)); p.apow64[i * 2 + 1] = (float)(m64 * (double)sinf((float)a64));
  }
  for (int i = gtid; i < S5G * S5H * 128; i += gsz) {
    const int pp = i & 127, ho = (i >> 7) & 15, g = i >> 11;
    p.cmT[i] = f2bf(pp < 64 ? p.c_re[(g * 16 + ho) * 64 + pp] : -p.c_im[(g * 16 + ho) * 64 + pp - 64]);
  }
  LAS float* red = (LAS float*)smem;
  LAS float* sc = (LAS float*)(smem + 16384);
  if (bid < 192) {
    __syncthreads();
    for (int i = ltid(); i < 8 * D; i += NTHR) sc[i] = siluf_(p.c[i]);
    __syncthreads();
  }
  for (int item = bid; item < 192; item += nb) {
    const int cl = ltid() & 31, kg = ltid() >> 5, col = item * 32 + cl;
    float acc[8];
#pragma unroll
    for (int b = 0; b < 8; ++b) acc[b] = 0.f;
    const float* wp = p.ada_w + (size_t)(kg * 64) * 6144 + col;
#pragma unroll 1
    for (int k0 = 0; k0 < 64; k0 += 16) {
      float w[16];
#pragma unroll
      for (int q = 0; q < 16; ++q) w[q] = wp[(size_t)(k0 + q) * 6144];
#pragma unroll
      for (int q = 0; q < 16; ++q)
#pragma unroll
        for (int b = 0; b < 8; ++b) acc[b] += sc[b * D + kg * 64 + k0 + q] * w[q];
    }
    __syncthreads();
#pragma unroll
    for (int b = 0; b < 8; ++b) red[(kg * 8 + b) * 32 + cl] = acc[b];
    __syncthreads();
    if (ltid() < 256) {
      const int b = ltid() >> 5, c2 = ltid() & 31;
      float sum = p.ada_b[item * 32 + c2];
      for (int q = 0; q < 16; ++q) sum += red[(q * 8 + b) * 32 + c2];
      p.mod[b * 6144 + item * 32 + c2] = sum;
    }
  }
}

template <bool WITH_GK>
__device__ __forceinline__ void phase_norm(PR p, const float* __restrict__ xin, const float* __restrict__ g, int sh_off, int sc_off, bf16_t* __restrict__ outp, int bid, int nb, lds_ptr smem) {
  const int lane = ltid() & 63, wid = ltid() >> 6;
  const int stride = nb * 8;
  int row = bid * 8 + wid;
  f32x4 nx[4];
  if (row < T) {
#pragma unroll
    for (int i = 0; i < 4; ++i) nx[i] = *(const f32x4*)(xin + (size_t)row * D + lane * 4 + 256 * i);
  }
  f32x4 gv[4];
#pragma unroll
  for (int i = 0; i < 4; ++i) gv[i] = *(const f32x4*)(g + lane * 4 + 256 * i);
  for (; row < T; row += stride) {
    const int b = row / SEQ;
    f32x4 v[4];
#pragma unroll
    for (int i = 0; i < 4; ++i) v[i] = nx[i];
    const int rn = row + stride;
    if (rn < T) {
#pragma unroll
      for (int i = 0; i < 4; ++i) nx[i] = *(const f32x4*)(xin + (size_t)rn * D + lane * 4 + 256 * i);
    }
    float ss = 0.f;
#pragma unroll
    for (int i = 0; i < 4; ++i) ss += v[i][0] * v[i][0] + v[i][1] * v[i][1] + v[i][2] * v[i][2] + v[i][3] * v[i][3];
#pragma unroll
    for (int o = 32; o > 0; o >>= 1) ss += __shfl_xor(ss, o);
    const float r = rsqrtf(ss * (1.f / D) + 1e-6f);
#pragma unroll
    for (int i = 0; i < 4; ++i) {
      const int c0 = lane * 4 + 256 * i;
      const f32x4 scv = *(const f32x4*)(p.mod + b * 6144 + sc_off + c0), shv = *(const f32x4*)(p.mod + b * 6144 + sh_off + c0);
      float y[4];
#pragma unroll
      for (int j = 0; j < 4; ++j) y[j] = (v[i][j] * r) * gv[i][j] * (1.f + scv[j]) + shv[j];
      u32x2 o; o.x = cvtpk(y[0], y[1]); o.y = cvtpk(y[2], y[3]);
      *(u32x2*)(outp + (size_t)row * D + c0) = o;
    }
  }
}

struct EpiStoreBf {
  bf16_t* O; long ld;
  template <int MT> __device__ __forceinline__ void operator()(const f32x4 (&acc)[MT][4], int mbase, int nbase, int fr, int fq) const {
    bf16_t* rowp = O + (size_t)(mbase + fr) * ld + nbase + fq * 4;
#pragma unroll
    for (int mt = 0; mt < MT; ++mt) {
#pragma unroll
      for (int nt = 0; nt < 4; ++nt) { const f32x4 v = acc[mt][nt]; u32x2 o; o.x = cvtpk(v[0], v[1]); o.y = cvtpk(v[2], v[3]);
        *(u32x2*)(rowp + nt * 16) = o; }
      rowp += 16 * ld;
      __builtin_amdgcn_sched_barrier(0); }
  }
};
__device__ __forceinline__ f32x4 ld_bf4(const bf16_t* q) { const u32x2 w = *(const u32x2*)q; f32x4 r; r[0] = __uint_as_float(w.x << 16); r[1] = __uint_as_float(w.x & 0xffff0000u); r[2] = __uint_as_float(w.y << 16); r[3] = __uint_as_float(w.y & 0xffff0000u); return r; }
struct EpiGlu {
  const bf16_t* yA; const float* b; bf16_t* z;
  template <int MT> __device__ __forceinline__ void operator()(const f32x4 (&acc)[MT][4], int mbase, int nbase, int fr, int fq) const {
#pragma unroll
    for (int mt = 0; mt < MT; ++mt) {
#pragma unroll
      for (int nt = 0; nt < 4; ++nt) { const int row = mbase + mt * 16 + fr, col = nbase + nt * 16 + fq * 4; const f32x4 v = acc[mt][nt];
        const f32x4 y = ld_bf4(yA + (size_t)row * S5W + col); const f32x4 bb = *(const f32x4*)(b + col);
        u32x2 o; o.x = cvtpk(y[0] * sigmoidf_(v[0] + bb[0]), y[1] * sigmoidf_(v[1] + bb[1])); o.y = cvtpk(y[2] * sigmoidf_(v[2] + bb[2]), y[3] * sigmoidf_(v[3] + bb[3]));
        *(u32x2*)(z + (size_t)row * S5W + col) = o; }
      __builtin_amdgcn_sched_barrier(0); }
  }
};
struct EpiOut {
  const float* x; const float* mod; float* x1;
  template <int MT> __device__ __forceinline__ void operator()(const f32x4 (&acc)[MT][4], int mbase, int nbase, int fr, int fq) const {
#pragma unroll
    for (int mt = 0; mt < MT; ++mt) {
#pragma unroll
      for (int nt = 0; nt < 4; ++nt) { const int row = mbase + mt * 16 + fr, col = nbase + nt * 16 + fq * 4, b = row / SEQ; const f32x4 v = acc[mt][nt];
        const f32x4 xv = *(const f32x4*)(x + (size_t)row * D + col), gg = *(const f32x4*)(mod + b * 6144 + 2 * D + col);
        f32x4 o; o[0] = xv[0] + gg[0] * v[0]; o[1] = xv[1] + gg[1] * v[1]; o[2] = xv[2] + gg[2] * v[2]; o[3] = xv[3] + gg[3] * v[3];
        *(f32x4*)(x1 + (size_t)row * D + col) = o; }
      __builtin_amdgcn_sched_barrier(0); }
  }
};

template <class Epi>
__device__ __forceinline__ void phase_gemm_dense(const bf16_t* A, long lda, const bf16_t* Bm, long ldb, int M, int N, int K, const Epi& epi, int bid, int nb, lds_ptr smem) {
  const int nMt = M / 128, nNt = N / 256, ntiles = nMt * nNt, rounds = (ntiles + nb - 1) / nb;
  const int lane = ltid() & 63, wid = ltid() >> 6, wm = wid >> 2, wn = wid & 3, fr = lane & 15, fq = lane >> 4;
  for (int r = 0; r < rounds; ++r) {
    int mt, nt; bool valid; tile_map(r, bid, nb, nMt, nNt, mt, nt, valid);
    if (!valid) continue;
    f32x4 acc[4][4];
    ALoadDense al{A + (size_t)mt * 128 * lda, lda};
    gemm_mainloop_glds(acc, al, Bm + nt * 256, ldb, K / 32, smem);
    epi.template operator()<4>(acc, mt * 128 + wm * 64, nt * 256 + wn * 64, fr, fq);
  }
}


template <class Epi>
__device__ __forceinline__ void phase_gemm_dense256(const bf16_t* A, long lda, const bf16_t* Bm, long ldb, int M, int N, int K, const Epi& epi, int bid, int nb, lds_ptr smem) {
  const int nMt = M / 256, nNt = N / 256, ntiles = nMt * nNt, rounds = (ntiles + nb - 1) / nb;
  const int lane = ltid() & 63, wid = ltid() >> 6, wm = wid >> 2, wn = wid & 3, fr = lane & 15, fq = lane >> 4;
  for (int r = 0; r < rounds; ++r) {
    int mt, nt; bool valid; tile_map(r, bid, nb, nMt, nNt, mt, nt, valid);
    if (!valid) continue;
    f32x4 acc[8][4];
    gemm_mainloop_glds256(acc, A + (size_t)mt * 256 * lda, lda, Bm + nt * 256, ldb, K / 32, smem);
    epi.template operator()<8>(acc, mt * 256 + wm * 128, nt * 256 + wn * 64, fr, fq);
  }
}

__device__ __forceinline__ void gk_rows(PR p, int bid, int nb) {
  const int lane = ltid() & 63, wid = ltid() >> 6, fr = lane & 15, fq = lane >> 4;
  if (wid >= 4) return;
  for (int r0 = (bid * 4 + wid) * 16; r0 < T; r0 += nb * 64) {
    const bf16_t* ap = p.h1 + (size_t)(r0 + fr) * D + fq * 8;
    const bf16_t* bp = p.wgkT + (size_t)fr * D + fq * 8;
    f32x4 acc = {0.f, 0.f, 0.f, 0.f};
#pragma unroll 1
    for (int k0 = 0; k0 < 32; k0 += 8) {
      s16x8 a[8], b[8];
#pragma unroll
      for (int q = 0; q < 8; ++q) { a[q] = *(const s16x8*)(ap + (k0 + q) * 32); b[q] = *(const s16x8*)(bp + (k0 + q) * 32); }
#pragma unroll
      for (int q = 0; q < 8; ++q) acc = __builtin_amdgcn_mfma_f32_16x16x32_bf16(a[q], b[q], acc, 0, 0, 0);
    }
#pragma unroll
    for (int j = 0; j < 4; ++j) p.gkl[(size_t)(r0 + 4 * fq + j) * 16 + fr] = acc[j];
  }
}

__device__ __forceinline__ void phase_gemm_mixed(PR p, int bid, int nb, lds_ptr smem) {
  const int nMt = T / 128, nNt = D / 256, ntiles = nMt * nNt, rounds = (ntiles + nb - 1) / nb;
  const int lane = ltid() & 63, wid = ltid() >> 6, wm = wid >> 2, wn = wid & 3, fr = lane & 15, fq = lane >> 4;
  for (int r = 0; r < rounds; ++r) {
    int mt, nt; bool valid; tile_map(r, bid, nb, nMt, nNt, mt, nt, valid);
    if (!valid) continue;
    const int mbase = mt * 128 + wm * 64, nbase = nt * 256 + wn * 64;
    const bf16_t* gp = p.proj + (size_t)(mbase + fr) * LDP + nbase + fq * 4;
    u32x2 gte[4][4], pk[4][4];
#pragma unroll
    for (int i = 0; i < 4; ++i)
#pragma unroll
      for (int j = 0; j < 4; ++j) gte[i][j] = *(const u32x2*)(gp + (size_t)(i * 16) * LDP + OFF_GA + j * 16);
    f32x4 acc[4][4];
    { ALoadDense al{p.zA + (size_t)mt * 128 * S5W, S5W}; gemm_mainloop_glds(acc, al, p.wb_pa + nt * 256, D, S5W / 32, smem); }
#pragma unroll
    for (int i = 0; i < 4; ++i)
#pragma unroll
      for (int j = 0; j < 4; ++j) {
        const float g0 = __uint_as_float(gte[i][j].x << 16), g1 = __uint_as_float(gte[i][j].x & 0xffff0000u), g2 = __uint_as_float(gte[i][j].y << 16), g3 = __uint_as_float(gte[i][j].y & 0xffff0000u);
        pk[i][j].x = cvtpk(acc[i][j][0] * sigmoidf_(g0), acc[i][j][1] * sigmoidf_(g1)); pk[i][j].y = cvtpk(acc[i][j][2] * sigmoidf_(g2), acc[i][j][3] * sigmoidf_(g3)); }
#pragma unroll
    for (int i = 0; i < 4; ++i)
#pragma unroll
      for (int j = 0; j < 4; ++j) gte[i][j] = *(const u32x2*)(gp + (size_t)(i * 16) * LDP + OFF_GB + j * 16);
    { ALoadDense al{p.yB + (size_t)mt * 128 * GVAL, GVAL}; gemm_mainloop_glds(acc, al, p.wb_pb + nt * 256, D, GVAL / 32, smem); }
    bf16_t* op = p.mixed + (size_t)(mbase + fr) * D + nbase + fq * 4;
#pragma unroll
    for (int i = 0; i < 4; ++i)
#pragma unroll
      for (int j = 0; j < 4; ++j) {
        const float g0 = __uint_as_float(gte[i][j].x << 16), g1 = __uint_as_float(gte[i][j].x & 0xffff0000u), g2 = __uint_as_float(gte[i][j].y << 16), g3 = __uint_as_float(gte[i][j].y & 0xffff0000u);
        const float a0 = __uint_as_float(pk[i][j].x << 16), a1 = __uint_as_float(pk[i][j].x & 0xffff0000u), a2 = __uint_as_float(pk[i][j].y << 16), a3 = __uint_as_float(pk[i][j].y & 0xffff0000u);
        u32x2 o; o.x = cvtpk(a0 + sigmoidf_(g0) * acc[i][j][0], a1 + sigmoidf_(g1) * acc[i][j][1]); o.y = cvtpk(a2 + sigmoidf_(g2) * acc[i][j][2], a3 + sigmoidf_(g3) * acc[i][j][3]);
        *(u32x2*)(op + (size_t)(i * 16) * D + j * 16) = o; }
  }
}

__device__ __forceinline__ void phase_gemm_rs(PR p, int bid, int nb, lds_ptr smem) {
  const int nMt = T / 256, nNt = 3, ntiles = nMt * nNt, rounds = (ntiles + nb - 1) / nb;
  const int lane = ltid() & 63, wid = ltid() >> 6, wm = wid >> 2, wn = wid & 3, fr = lane & 15, fq = lane >> 4;
  for (int r = 0; r < rounds; ++r) {
    int mt, nt; bool valid; tile_map(r, bid, nb, nMt, nNt, mt, nt, valid);
    if (!valid) continue;
    f32x4 acc[8][4];
    gemm_mainloop_glds256(acc, p.h2 + (size_t)mt * 256 * D, D, p.wb_rs + nt * 256, 768, D / 32, smem);
    const int mbase = mt * 256 + wm * 128;
    if (nt == 0) {
#pragma unroll
      for (int i = 0; i < 8; ++i) {
#pragma unroll
        for (int j = 0; j < 4; ++j) *(f32x4*)(p.logits + (size_t)(mbase + i * 16 + fr) * NE + wn * 64 + j * 16 + fq * 4) = acc[i][j];
        __builtin_amdgcn_sched_barrier(0); }
    } else {
      const int h0 = (nt - 1) * 128 + wn * 32;
#pragma unroll
      for (int i = 0; i < 8; ++i) {
#pragma unroll
        for (int j = 0; j < 2; ++j) { const f32x4 gv = acc[i][j], uv = acc[i][j + 2];
          u32x2 o; o.x = cvtpk(siluf_(gv[0]) * uv[0], siluf_(gv[1]) * uv[1]); o.y = cvtpk(siluf_(gv[2]) * uv[2], siluf_(gv[3]) * uv[3]);
          *(u32x2*)(p.shH + (size_t)(mbase + i * 16 + fr) * SFF + h0 + j * 16 + fq * 4) = o; }
        __builtin_amdgcn_sched_barrier(0); }
    }
  }
}

constexpr int MOE_H_OFF = 2 * G_STAGE;
constexpr int MOE_TOK_OFF = MOE_H_OFF + 65536;
constexpr int SMEM_BYTES = 132096;
__device__ __forceinline__ void phase_moe(PR p, int bid, int nb, lds_ptr smem) {
  const int lane = ltid() & 63, wid = ltid() >> 6, wm = wid >> 2, wn = wid & 3, fr = lane & 15, fq = lane >> 4;
  LAS int* toks = (LAS int*)(smem + MOE_TOK_OFF);
  const lds_ptr Hs = smem + MOE_H_OFF;
  LAS int* qi = (LAS int*)(smem + MOE_TOK_OFF + 512);
  for (int sx = 0; sx < 8; ++sx) {
   const int x = (bid + sx) & 7;
   const int cnt = p.moe_cnt[x];
   for (;;) {
    __syncthreads();
    if (ltid() == 0) qi[0] = atomicAdd(&p.moe_ctr[x], 1);
    __syncthreads();
    const int qidx = qi[0];
    if (qidx >= cnt) break;
    const int blk = p.moe_list[x * NBLK128 + qidx];
    const int e = p.blk_exp[blk];
    if (ltid() < 128) toks[ltid()] = p.slot_tok[blk * 128 + ltid()];
    __syncthreads();
    const float* Wg = p.ew_gate + (size_t)e * D * EFF; const float* Wu = p.ew_up + (size_t)e * D * EFF; const float* Wd = p.ew_down + (size_t)e * EFF * D;
    for (int hp2 = 0; hp2 < 2 * MOE_REP_GU; ++hp2) { const int hp = hp2 & 1;
      f32x4 acc[4][4];
      ALoadGatherLds al2{p.h2, toks};
      BLoadGUR bl{Wg, (long)(Wu - Wg), EFF, hp * 128};
      gemm_mainloop_r3<false>(acc, al2, bl, D / 32, smem, smem);
#pragma unroll
      for (int i = 0; i < 4; ++i)
#pragma unroll
        for (int j = 0; j < 2; ++j) { const f32x4 gv = acc[i][j], uv = acc[i][j + 2]; const int row = wm * 64 + i * 16 + fr, hc = hp * 128 + wn * 32 + j * 16 + fq * 4;
          u32x2 o; o.x = cvtpk(siluf_(gv[0]) * uv[0], siluf_(gv[1]) * uv[1]); o.y = cvtpk(siluf_(gv[2]) * uv[2], siluf_(gv[3]) * uv[3]);
          *(LAS u32x2*)(Hs + (hc >> 5) * G_ASZ + a_off(row, (hc & 31) >> 3) + (hc & 7) * 2) = o; }
    }
    for (int np2 = 0; np2 < 4 * MOE_REP_DN; ++np2) { const int np = np2 & 3;
      f32x4 acc[4][4];
      ALoadDense al{nullptr, 0};
      BLoadF32R bl{Wd + np * 256, D};
      gemm_mainloop_r3<true>(acc, al, bl, EFF / 32, smem, Hs);
#pragma unroll
      for (int i = 0; i < 4; ++i) {
        const int rl = wm * 64 + i * 16 + fr;
        if (toks[rl] >= 0) {
#pragma unroll
          for (int j = 0; j < 4; ++j) { const f32x4 v = acc[i][j]; u32x2 o; o.x = cvtpk(v[0], v[1]); o.y = cvtpk(v[2], v[3]);
            *(u32x2*)(p.Y + (size_t)(blk * 128 + rl) * D + np * 256 + wn * 64 + j * 16 + fq * 4) = o; }
        }
      }
    }
   }
  }
}

struct BStreamGU { const float* Wg; long du; int hp0;
  __device__ __forceinline__ void load(BRaw& r, int s, int tid) const {
    const int hp = hp0 + (s >> 5), kbase = (s & 31) * 32;
    const int col = (tid & 63) * 4, w = col >> 6, xx = col & 63;
    const float* q = Wg + ((xx < 32) ? 0l : du) + (size_t)(kbase + (tid >> 6)) * EFF + hp * 128 + 32 * w + (xx & 31);
#pragma unroll
    for (int i = 0; i < 4; ++i) r.v[i] = *(const f32x4*)(q + (size_t)(8 * i) * EFF); } };
struct BStreamDown { const float* Wd; int np0;
  __device__ __forceinline__ void load(BRaw& r, int s, int tid) const {
    const int np = np0 + (s >> 3), kbase = (s & 7) * 32;
    const float* q = Wd + (size_t)(kbase + (tid >> 6)) * D + np * 256 + (tid & 63) * 4;
#pragma unroll
    for (int i = 0; i < 4; ++i) r.v[i] = *(const f32x4*)(q + (size_t)(8 * i) * D); } };
constexpr int PV_STAGE = 2 * G_ASZ + G_BSZ;
template <int SEG, int NSEG, class AL, class BL, class SE>
__device__ __forceinline__ void gemm_stream_pair(const AL& al, const BL& bl, lds_ptr stage, const SE& segend, bool has2) {
  constexpr int NS = SEG * NSEG;
  const int tid = ltid(), lane = tid & 63, wid = tid >> 6, wm = wid >> 2, wn = wid & 3, fr = lane & 15, fq = lane >> 4;
  const int ar = tid >> 2, ac = tid & 3;
  const bf16_t* aptr0 = al.rowptr(0, ar) + ac * 8;
  const bf16_t* aptr1 = al.rowptr(1, ar) + ac * 8;
  const int a_st = a_off(ar, ac);
  int b_st[4];
#pragma unroll
  for (int i = 0; i < 4; ++i) b_st[i] = 2 * G_ASZ + b_off((tid >> 6) + 8 * i, (tid & 63) >> 2) + (tid & 3) * 8;
  int a_rd[4];
#pragma unroll
  for (int mt = 0; mt < 4; ++mt) a_rd[mt] = a_off(wm * 64 + mt * 16 + fr, fq);
  int b_rd[4][2];
#pragma unroll
  for (int nt = 0; nt < 4; ++nt) {
    b_rd[nt][0] = 2 * G_ASZ + b_off(8 * fq + (fr >> 2), wn * 4 + nt) + (fr & 3) * 8;
    b_rd[nt][1] = 2 * G_ASZ + b_off(8 * fq + 4 + (fr >> 2), wn * 4 + nt) + (fr & 3) * 8;
  }
  f32x4 acc[2][4][4];
#pragma unroll
  for (int h = 0; h < 2; ++h)
#pragma unroll
    for (int mt = 0; mt < 4; ++mt)
#pragma unroll
      for (int nt = 0; nt < 4; ++nt) acc[h][mt][nt] = (f32x4){0.f, 0.f, 0.f, 0.f};
  u32x4 xa0, xb0, xa1, xb1;
  BRaw rb0, rb1;
#define P2_LOAD(XA, XB, RB, s_) do { XA = *(const u32x4*)(aptr0 + (size_t)((s_) % SEG) * 32); XB = *(const u32x4*)(aptr1 + (size_t)((s_) % SEG) * 32); bl.load(RB, (s_), tid); } while (0)
#define P2_STORE(XA, XB, RB, st_) do { const lds_ptr q_ = stage + (st_) * PV_STAGE; *(LAS u32x4*)(q_ + a_st) = XA; *(LAS u32x4*)(q_ + G_ASZ + a_st) = XB; \
    _Pragma("unroll") for (int i_ = 0; i_ < 4; ++i_) { u32x2 o_; o_.x = cvtpk(RB.v[i_][0], RB.v[i_][1]); o_.y = cvtpk(RB.v[i_][2], RB.v[i_][3]); *(LAS u32x2*)(q_ + b_st[i_]) = o_; } } while (0)
#define P2_COMPUTE(s_) do { const lds_ptr cur = stage + ((s_) & 1) * PV_STAGE; s16x8 bfr[4]; \
    _Pragma("unroll") for (int nt = 0; nt < 4; ++nt) { const s16x4 lo = tr_read(cur + b_rd[nt][0]), hi = tr_read(cur + b_rd[nt][1]); bfr[nt] = __builtin_shufflevector(lo, hi, 0, 1, 2, 3, 4, 5, 6, 7); } \
    _Pragma("unroll") for (int h = 0; h < 2; ++h) if (h == 0 || has2) { s16x8 af[4]; \
      _Pragma("unroll") for (int mt = 0; mt < 4; ++mt) af[mt] = *(LAS s16x8*)(cur + h * G_ASZ + a_rd[mt]); \
      _Pragma("unroll") for (int mt = 0; mt < 4; ++mt) _Pragma("unroll") for (int nt = 0; nt < 4; ++nt) acc[h][mt][nt] = __builtin_amdgcn_mfma_f32_16x16x32_bf16(bfr[nt], af[mt], acc[h][mt][nt], 0, 0, 0); } } while (0)
#define P2_SEGEND(s_) do { if (((s_) % SEG) == SEG - 1) { segend((s_) / SEG, acc); \
    _Pragma("unroll") for (int h = 0; h < 2; ++h) _Pragma("unroll") for (int mt = 0; mt < 4; ++mt) _Pragma("unroll") for (int nt = 0; nt < 4; ++nt) acc[h][mt][nt] = (f32x4){0.f, 0.f, 0.f, 0.f}; } } while (0)
#define P2_BODY(s_, XAN, XBN, RBN, XAW, XBW, RBW) do { const int sl_ = ((s_) + 2 < NS) ? (s_) + 2 : NS - 1; P2_LOAD(XAN, XBN, RBN, sl_); __builtin_amdgcn_sched_barrier(0); \
    P2_COMPUTE(s_); __builtin_amdgcn_sched_barrier(0); P2_SEGEND(s_); P2_STORE(XAW, XBW, RBW, ((s_) + 1) & 1); __syncthreads(); } while (0)
  P2_LOAD(xa0, xb0, rb0, 0);
  P2_LOAD(xa1, xb1, rb1, 1);
  __syncthreads();
  P2_STORE(xa0, xb0, rb0, 0);
  __syncthreads();
  for (int s = 0; s < NS; s += 2) {
    P2_BODY(s, xa0, xb0, rb0, xa1, xb1, rb1);
    P2_BODY(s + 1, xa1, xb1, rb1, xa0, xb0, rb0);
  }
#undef P2_LOAD
#undef P2_STORE
#undef P2_COMPUTE
#undef P2_SEGEND
#undef P2_BODY
}
struct APairGather { const bf16_t* A; LAS int* tk; __device__ __forceinline__ const bf16_t* rowptr(int h, int r) const { int t = tk[h * 128 + r]; t = t < 0 ? 0 : t; return A + (size_t)t * D; } };
struct APairDense { const bf16_t* A0; const bf16_t* A1; __device__ __forceinline__ const bf16_t* rowptr(int h, int r) const { return (h ? A1 : A0) + (size_t)r * EFF; } };

constexpr int PV_TOK = 2 * PV_STAGE;
constexpr int PV_Q = PV_TOK + 1024;
template <int STG>
__device__ __forceinline__ void phase_moe_pair(PR p, int bid, int nb, lds_ptr smem) {
  LAS int* toks = (LAS int*)(smem + PV_TOK);
  LAS int* qi = (LAS int*)(smem + PV_Q);
  for (int sx = 0; sx < 8; ++sx) {
   const int x = ((int)((unsigned)__builtin_amdgcn_s_getreg((3 << 11) | 20) & 7u) + sx) & 7;
   const int cnt = 2 * p.moe_cnt[x];
   for (;;) {
    __syncthreads();
    if (ltid() == 0) qi[0] = atomicAdd(&p.moe_ctr[(STG - 1) * 8 + x], 1);
    __syncthreads();
    const int qidx = qi[0];
    if (qidx >= cnt) break;
    const int blk = p.moe_list[x * NBLK128 + (qidx >> 1)], sub = qidx & 1;
    const int e = p.blk_exp[blk];
    const bool has2 = (blk + 1 < NBLK128) && (p.blk_exp[blk + 1] == e);
    const int blk2 = has2 ? blk + 1 : blk;
    { const int t = ltid(); if (t < 256) toks[t] = (t < 128) ? p.slot_tok[blk * 128 + t] : (has2 ? p.slot_tok[blk2 * 128 + (t - 128)] : -1); }
    __syncthreads();
    const int lane = ltid() & 63, wid = ltid() >> 6, wm = wid >> 2, wn = wid & 3, fr = lane & 15, fq = lane >> 4;
    if (STG == 1) {
      const float* Wg = p.ew_gate + (size_t)e * D * EFF; const float* Wu = p.ew_up + (size_t)e * D * EFF;
      APairGather al{p.h2, toks};
      BStreamGU bl{Wg, (long)(Wu - Wg), sub};
      auto segH = [&](int hseg, const f32x4 (&acc)[2][4][4]) { const int hp = sub + hseg;
#pragma unroll
        for (int h = 0; h < 2; ++h) {
          if (h == 1 && !has2) continue;
          const int sb = (h ? blk2 : blk) * 128;
#pragma unroll
          for (int i = 0; i < 4; ++i)
#pragma unroll
            for (int j = 0; j < 2; ++j) { const f32x4 gv = acc[h][i][j], uv = acc[h][i][j + 2]; const int row = wm * 64 + i * 16 + fr, hc = hp * 128 + wn * 32 + j * 16 + fq * 4;
              u32x2 o; o.x = cvtpk(siluf_(gv[0]) * uv[0], siluf_(gv[1]) * uv[1]); o.y = cvtpk(siluf_(gv[2]) * uv[2], siluf_(gv[3]) * uv[3]);
              *(u32x2*)(p.Hbuf + (size_t)(sb + row) * EFF + hc) = o; }
        }
      };
      gemm_stream_pair<32, 1>(al, bl, smem, segH, has2);
    } else {
      const float* Wd = p.ew_down + (size_t)e * EFF * D;
      APairDense al{p.Hbuf + (size_t)blk * 128 * EFF, p.Hbuf + (size_t)blk2 * 128 * EFF};
      BStreamDown bl{Wd, 2 * sub};
      auto segY = [&](int nseg, const f32x4 (&acc)[2][4][4]) { const int np = 2 * sub + nseg;
#pragma unroll
        for (int h = 0; h < 2; ++h) {
          if (h == 1 && !has2) continue;
          const int sb = (h ? blk2 : blk) * 128;
#pragma unroll
          for (int i = 0; i < 4; ++i) {
            const int rl = wm * 64 + i * 16 + fr;
            if (toks[h * 128 + rl] >= 0) {
#pragma unroll
              for (int j = 0; j < 4; ++j) { const f32x4 v = acc[h][i][j]; u32x2 o; o.x = cvtpk(v[0], v[1]); o.y = cvtpk(v[2], v[3]);
                *(u32x2*)(p.Y + (size_t)(sb + rl) * D + np * 256 + wn * 64 + j * 16 + fq * 4) = o; }
            }
          }
        }
      };
      gemm_stream_pair<8, 2>(al, bl, smem, segY, has2);
    }
   }
  }
}

__device__ __forceinline__ void wave_sync() { __syncthreads(); }
constexpr int S5_BU_STRIDE = 132;
constexpr int S5_S_STRIDE = 272;
constexpr int S5_WAVE_LDS = 16 * S5_BU_STRIDE * 4 + 16 * S5_S_STRIDE;
template <bool FINAL>
__device__ __forceinline__ void s5_item(PR p, int b, int c, int g, lds_ptr wl) {
  const int lane = ltid() & 63, fr = lane & 15, fq = lane >> 4;
  LAS float* bu = (LAS float*)wl;
  const lds_ptr Sb = wl + 16 * S5_BU_STRIDE * 4;
  const size_t t0 = (size_t)b * SEQ + (size_t)c * 64;
  const s16x8 zero8 = {0, 0, 0, 0, 0, 0, 0, 0};
  s16x8 bfr[8];
#pragma unroll
  for (int nt = 0; nt < 8; ++nt) { const s16x8 x = *(const s16x8*)(p.bbarT + ((size_t)(g * 128 + nt * 16 + fr) * 16 + (fq & 1) * 8)); bfr[nt] = (fq < 2) ? x : zero8; }
  const float are = p.abar[(g * 64 + lane) * 2], aim = p.abar[(g * 64 + lane) * 2 + 1];
  const size_t sidx = (((size_t)b * 32 + c) * S5G + g) * 64 + lane;
  float sre = 0.f, sim = 0.f;
  s16x8 cfr[4];
  f32x4 dsk = {0.f, 0.f, 0.f, 0.f};
  if (FINAL) {
    sre = p.s5Sin[sidx * 2]; sim = p.s5Sin[sidx * 2 + 1];
#pragma unroll
    for (int ks = 0; ks < 4; ++ks) cfr[ks] = *(const s16x8*)(p.cmT + ((size_t)(g * 16 + fr) * 128 + ks * 32 + fq * 8));
    dsk = *(const f32x4*)(p.s5_d + g * 16 + fq * 4);
  }
  for (int mt = 0; mt < 4; ++mt) {
    const bf16_t* urow = p.proj + (t0 + mt * 16 + fr) * LDP + OFF_U + g * 16;
    const s16x8 ux = *(const s16x8*)(urow + (fq & 1) * 8);
    const s16x8 ufr = (fq < 2) ? ux : zero8;
#pragma unroll
    for (int nt = 0; nt < 8; ++nt) {
      const f32x4 z = {0.f, 0.f, 0.f, 0.f};
      const f32x4 acc = __builtin_amdgcn_mfma_f32_16x16x32_bf16(ufr, bfr[nt], z, 0, 0, 0);
#pragma unroll
      for (int j = 0; j < 4; ++j) bu[(4 * fq + j) * S5_BU_STRIDE + nt * 16 + fr] = acc[j];
    }
    wave_sync();
#pragma unroll
    for (int l = 0; l < 16; ++l) {
      const float br = bu[l * S5_BU_STRIDE + lane], bi = bu[l * S5_BU_STRIDE + 64 + lane];
      const float nr = are * sre - aim * sim + br, ni = are * sim + aim * sre + bi;
      sre = nr; sim = ni;
      if (FINAL) {
        *(LAS bf16_t*)(Sb + l * S5_S_STRIDE + lane * 2) = f2bf(sre);
        *(LAS bf16_t*)(Sb + l * S5_S_STRIDE + (64 + lane) * 2) = f2bf(sim);
      }
    }
    wave_sync();
    if (FINAL) {
      f32x4 y = {0.f, 0.f, 0.f, 0.f};
#pragma unroll
      for (int ks = 0; ks < 4; ++ks) {
        const s16x8 sfr = *(LAS s16x8*)(Sb + fr * S5_S_STRIDE + (ks * 32 + fq * 8) * 2);
        y = __builtin_amdgcn_mfma_f32_16x16x32_bf16(cfr[ks], sfr, y, 0, 0, 0);
      }
      const f32x4 u4 = ld_bf4(urow + fq * 4);
      u32x2 o; o.x = cvtpk(geluf_(y[0] + dsk[0] * u4[0]), geluf_(y[1] + dsk[1] * u4[1])); o.y = cvtpk(geluf_(y[2] + dsk[2] * u4[2]), geluf_(y[3] + dsk[3] * u4[3]));
      *(u32x2*)(p.yA + (t0 + mt * 16 + fr) * S5W + g * 16 + fq * 4) = o;
      wave_sync();
    }
  }
  if (!FINAL) { p.s5E[sidx * 2] = sre; p.s5E[sidx * 2 + 1] = sim; }
}
template <bool FINAL>
__device__ __forceinline__ void s5_block_item(PR p, int item, lds_ptr smem) {
  const int wid = ltid() >> 6;
  const int go = item & 3, c = (item >> 2) & 31, b = item >> 7;
  s5_item<FINAL>(p, b, c, go * 8 + wid, smem + wid * S5_WAVE_LDS);
}

constexpr int GL_QD = 0, GL_KE = 8192, GL_V = 16384, GL_SIN = 32768, GL_GL = 49152, GL_W2 = 53248, GL_TOT = 57344, GL_B2 = 58368, GL_ITEM = 58624;
__device__ __forceinline__ int rowrd_off(int r, int c) { return r * 128 + ((c ^ ((r >> 1) & 7)) << 4); }
__device__ __forceinline__ int tr128_off(int r, int ch) { return r * 128 + ((ch ^ (((r >> 1) & 1) | (((r >> 3) & 1) << 1))) << 5); }
__device__ __forceinline__ int tr256_off(int r, int ch) { return r * 256 + ((ch ^ ((r & 3) | (((r >> 3) & 1) << 2))) << 5); }

__device__ __forceinline__ void gla_front(PR p, int b, int h, int c, lds_ptr il, int t, float (&bl)[16], float& blast) {
  LAS float* gl = (LAS float*)(il + GL_GL); LAS float* w2 = (LAS float*)(il + GL_W2); LAS float* tot = (LAS float*)(il + GL_TOT); LAS float* b2 = (LAS float*)(il + GL_B2);
  const size_t t0 = (size_t)b * SEQ + (size_t)c * 64;
  __syncthreads();
  *(LAS f32x4*)(gl + t * 4) = *(const f32x4*)(p.gkl + t0 * 16 + t * 4);
#pragma unroll
  for (int q = 0; q < 4; ++q) { const int i = t + 256 * q; w2[i] = p.w_gk2[(i >> 6) * GKEY + h * 64 + (i & 63)]; }
  if (t < 64) b2[t] = p.b_gk2[h * 64 + t];
  __syncthreads();
  const int d = t & 63, part = t >> 6;
  float wv[16];
#pragma unroll
  for (int r = 0; r < 16; ++r) wv[r] = w2[r * 64 + d];
  const float bias = b2[d];
  float run = 0.f;
#pragma unroll
  for (int ii = 0; ii < 16; ++ii) {
    const int i = part * 16 + ii;
    float gk = bias;
#pragma unroll
    for (int q = 0; q < 4; ++q) { const f32x4 gv = *(LAS f32x4*)(gl + i * 16 + q * 4); gk += gv[0] * wv[q * 4] + gv[1] * wv[q * 4 + 1] + gv[2] * wv[q * 4 + 2] + gv[3] * wv[q * 4 + 3]; }
    run += logsigmoidf_(gk) * (1.f / 16.f);
    bl[ii] = run;
  }
  tot[part * 64 + d] = run;
  __syncthreads();
  float offs = 0.f, all = 0.f;
#pragma unroll
  for (int q = 0; q < 4; ++q) { const float v = tot[q * 64 + d]; all += v; offs += (q < part) ? v : 0.f; }
#pragma unroll
  for (int ii = 0; ii < 16; ++ii) bl[ii] += offs;
  blast = all;
}

__device__ __forceinline__ void gla_pass1(PR p, int item, lds_ptr smem) {
  const int half = ltid() >> 8, t = ltid() & 255, lane = t & 63, w = t >> 6, fr = lane & 15, fq = lane >> 4;
  const int it = item * 2 + half, c = it & 31, h = (it >> 5) & 3, b = it >> 7;
  const lds_ptr il = smem + half * GL_ITEM;
  const size_t t0 = (size_t)b * SEQ + (size_t)c * 64;
  float bl[16], blast;
  gla_front(p, b, h, c, il, t, bl, blast);
  {
    const int d = t & 63, part = t >> 6;
#pragma unroll
    for (int ii = 0; ii < 16; ++ii) {
      const int i = part * 16 + ii;
      const float kv = bf2f(p.proj[(t0 + i) * LDP + OFF_K + h * 64 + d]);
      *(LAS bf16_t*)(il + GL_KE + tr128_off(i, d >> 4) + (d & 15) * 2) = f2bf(kv * __expf(blast - bl[ii]));
    }
    if (part == 0) p.glaDec[(size_t)it * 64 + d] = __expf(blast);
#pragma unroll
    for (int q = 0; q < 4; ++q) { const int pc = t + 256 * q, r = pc >> 4, c8 = pc & 15;
      *(LAS u32x4*)(il + GL_V + tr256_off(r, c8 >> 1) + (c8 & 1) * 16) = *(const u32x4*)(p.proj + (t0 + r) * LDP + OFF_V + h * 128 + c8 * 8); }
  }
  __syncthreads();
  f32x4 acc[8];
#pragma unroll
  for (int et = 0; et < 8; ++et) acc[et] = (f32x4){0.f, 0.f, 0.f, 0.f};
#pragma unroll
  for (int ks = 0; ks < 2; ++ks) {
    const int r0 = 32 * ks + 8 * fq + (fr >> 2);
    const s16x4 klo = tr_read(il + GL_KE + tr128_off(r0, w) + (fr & 3) * 8), khi = tr_read(il + GL_KE + tr128_off(r0 + 4, w) + (fr & 3) * 8);
    const s16x8 kf = __builtin_shufflevector(klo, khi, 0, 1, 2, 3, 4, 5, 6, 7);
#pragma unroll
    for (int et = 0; et < 8; ++et) {
      const s16x4 vlo = tr_read(il + GL_V + tr256_off(r0, et) + (fr & 3) * 8), vhi = tr_read(il + GL_V + tr256_off(r0 + 4, et) + (fr & 3) * 8);
      const s16x8 vf = __builtin_shufflevector(vlo, vhi, 0, 1, 2, 3, 4, 5, 6, 7);
      acc[et] = __builtin_amdgcn_mfma_f32_16x16x32_bf16(vf, kf, acc[et], 0, 0, 0);
    }
  }
#pragma unroll
  for (int et = 0; et < 8; ++et) *(f32x4*)(p.glaKV + ((size_t)it * 64 + 16 * w + fr) * 128 + et * 16 + fq * 4) = acc[et];
}

__device__ __forceinline__ void gla_pass2(PR p, int item, lds_ptr smem) {
  const int half = ltid() >> 8, t = ltid() & 255, lane = t & 63, w = t >> 6, fr = lane & 15, fq = lane >> 4;
  const int it = item * 2 + half, c = it & 31, h = (it >> 5) & 3, b = it >> 7;
  const lds_ptr il = smem + half * GL_ITEM;
  const size_t t0 = (size_t)b * SEQ + (size_t)c * 64;
  float bl[16], blast;
  gla_front(p, b, h, c, il, t, bl, blast);
  {
    const int d = t & 63, part = t >> 6;
#pragma unroll
    for (int ii = 0; ii < 16; ++ii) {
      const int i = part * 16 + ii;
      const float qv = bf2f(p.proj[(t0 + i) * LDP + OFF_Q + h * 64 + d]) * 0.125f, kv = bf2f(p.proj[(t0 + i) * LDP + OFF_K + h * 64 + d]);
      const int o = rowrd_off(i, d >> 3) + (d & 7) * 2;
      *(LAS bf16_t*)(il + GL_QD + o) = f2bf(qv * __expf(bl[ii]));
      *(LAS bf16_t*)(il + GL_KE + o) = f2bf(kv * __expf(-bl[ii]));
    }
#pragma unroll
    for (int q = 0; q < 4; ++q) { const int pc = t + 256 * q, r = pc >> 4, c8 = pc & 15;
      *(LAS u32x4*)(il + GL_V + tr256_off(r, c8 >> 1) + (c8 & 1) * 16) = *(const u32x4*)(p.proj + (t0 + r) * LDP + OFF_V + h * 128 + c8 * 8);
      *(LAS u32x4*)(il + GL_SIN + tr256_off(r, c8 >> 1) + (c8 & 1) * 16) = *(const u32x4*)(p.glaSin + ((size_t)it * 64 + r) * 128 + c8 * 8); }
  }
  __syncthreads();
  s16x8 qf[2];
#pragma unroll
  for (int ks = 0; ks < 2; ++ks) qf[ks] = *(LAS s16x8*)(il + GL_QD + rowrd_off(16 * w + fr, ks * 4 + fq));
  f32x4 st[4];
#pragma unroll
  for (int jt = 0; jt < 4; ++jt) {
    st[jt] = (f32x4){0.f, 0.f, 0.f, 0.f};
    if (jt <= w) {
#pragma unroll
      for (int ks = 0; ks < 2; ++ks) {
        const s16x8 kf = *(LAS s16x8*)(il + GL_KE + rowrd_off(16 * jt + fr, ks * 4 + fq));
        st[jt] = __builtin_amdgcn_mfma_f32_16x16x32_bf16(kf, qf[ks], st[jt], 0, 0, 0);
      }
      if (jt == w) {
#pragma unroll
        for (int r = 0; r < 4; ++r) st[jt][r] = (4 * fq + r <= fr) ? st[jt][r] : 0.f;
      }
    }
  }
  f32x4 acc[8];
#pragma unroll
  for (int et = 0; et < 8; ++et) acc[et] = (f32x4){0.f, 0.f, 0.f, 0.f};
#pragma unroll
  for (int u = 0; u < 2; ++u) {
    if (2 * u <= w) {
      u32x4 pk; pk.x = cvtpk(st[2 * u][0], st[2 * u][1]); pk.y = cvtpk(st[2 * u][2], st[2 * u][3]); pk.z = cvtpk(st[2 * u + 1][0], st[2 * u + 1][1]); pk.w = cvtpk(st[2 * u + 1][2], st[2 * u + 1][3]);
      const s16x8 pf = __builtin_bit_cast(s16x8, pk);
      const int r0 = 32 * u + 4 * fq + (fr >> 2);
#pragma unroll
      for (int et = 0; et < 8; ++et) {
        const s16x4 vlo = tr_read(il + GL_V + tr256_off(r0, et) + (fr & 3) * 8), vhi = tr_read(il + GL_V + tr256_off(r0 + 16, et) + (fr & 3) * 8);
        const s16x8 vf = __builtin_shufflevector(vlo, vhi, 0, 1, 2, 3, 4, 5, 6, 7);
        acc[et] = __builtin_amdgcn_mfma_f32_16x16x32_bf16(vf, pf, acc[et], 0, 0, 0);
      }
    }
  }
#pragma unroll
  for (int ks = 0; ks < 2; ++ks) {
    const int r0 = 32 * ks + 8 * fq + (fr >> 2);
#pragma unroll
    for (int et = 0; et < 8; ++et) {
      const s16x4 slo = tr_read(il + GL_SIN + tr256_off(r0, et) + (fr & 3) * 8), shi = tr_read(il + GL_SIN + tr256_off(r0 + 4, et) + (fr & 3) * 8);
      const s16x8 sf = __builtin_shufflevector(slo, shi, 0, 1, 2, 3, 4, 5, 6, 7);
      acc[et] = __builtin_amdgcn_mfma_f32_16x16x32_bf16(sf, qf[ks], acc[et], 0, 0, 0);
    }
  }
  float ss = 0.f;
#pragma unroll
  for (int et = 0; et < 8; ++et) ss += acc[et][0] * acc[et][0] + acc[et][1] * acc[et][1] + acc[et][2] * acc[et][2] + acc[et][3] * acc[et][3];
  ss += __shfl_xor(ss, 16); ss += __shfl_xor(ss, 32);
  const float rn = rsqrtf(ss * (1.f / 128.f) + 1e-6f);
  const size_t trow = t0 + 16 * w + fr;
#pragma unroll
  for (int et = 0; et < 8; ++et) {
    const int e = et * 16 + fq * 4;
    const f32x4 ng = *(const f32x4*)(p.gla_norm_g + e), rg = ld_bf4(p.proj + trow * LDP + OFF_R + h * 128 + e);
    u32x2 o; o.x = cvtpk(acc[et][0] * rn * ng[0] * siluf_(rg[0]), acc[et][1] * rn * ng[1] * siluf_(rg[1])); o.y = cvtpk(acc[et][2] * rn * ng[2] * siluf_(rg[2]), acc[et][3] * rn * ng[3] * siluf_(rg[3]));
    *(u32x2*)(p.yB + trow * GVAL + h * 128 + e) = o;
  }
}

__device__ __forceinline__ void phase_mix_local(PR p, int bid, int nb, lds_ptr smem, int which) {
  for (int idx = bid; idx < 1024 + 512; idx += nb) {
    if (idx < 1024) { if (which & 1) { __syncthreads(); s5_block_item<false>(p, idx, smem); } }
    else if (which & 2) gla_pass1(p, idx - 1024, smem);
  }
}
__device__ __forceinline__ void phase_mix_carry(PR p, int bid, int nb, int which) {
  const int gtid = bid * NTHR + ltid(), gsz = nb * NTHR;
  if (which & 1) for (int i = gtid; i < NB * S5G * S5P; i += gsz) {
    const int pq = i & 63, g = (i >> 6) & 31, b = i >> 11;
    const float are = p.apow64[(g * 64 + pq) * 2], aim = p.apow64[(g * 64 + pq) * 2 + 1];
    float sre = 0.f, sim = 0.f;
    for (int c = 0; c < 32; ++c) {
      const size_t sidx = (((size_t)b * 32 + c) * S5G + g) * 64 + pq;
      p.s5Sin[sidx * 2] = sre; p.s5Sin[sidx * 2 + 1] = sim;
      const float er = p.s5E[sidx * 2], ei = p.s5E[sidx * 2 + 1];
      const float nr = are * sre - aim * sim + er, ni = are * sim + aim * sre + ei;
      sre = nr; sim = ni;
    }
  }
  if (which & 2) for (int i = gtid; i < NB * GH * 64 * 128; i += gsz) {
    const int e = i & 127, d = (i >> 7) & 63, bh = i >> 13;
    float S = 0.f;
#pragma unroll 8
    for (int c = 0; c < 32; ++c) {
      const size_t it = (size_t)bh * 32 + c;
      p.glaSin[(it * 64 + d) * 128 + e] = f2bf(S);
      S = p.glaDec[it * 64 + d] * S + p.glaKV[(it * 64 + d) * 128 + e];
    }
  }
}
__device__ __forceinline__ void phase_mix_final(PR p, int bid, int nb, lds_ptr smem, int which) {
  for (int idx = bid; idx < 1024 + 512; idx += nb) {
    if (idx < 1024) { if (which & 1) { __syncthreads(); s5_block_item<true>(p, idx, smem); } }
    else if (which & 2) gla_pass2(p, idx - 1024, smem);
  }
}

__device__ __forceinline__ void phase_route(PR p, int bid, int nb) {
  const int lane = ltid() & 63, wid = ltid() >> 6;
  const f32x4 bias = *(const f32x4*)(p.router_bias + lane * 4);
  for (int t = bid * 8 + wid; t < T; t += nb * 8) {
    const f32x4 lg = *(const f32x4*)(p.logits + (size_t)t * NE + lane * 4);
    float sc[4], v[4];
#pragma unroll
    for (int j = 0; j < 4; ++j) { sc[j] = sigmoidf_(lg[j]); v[j] = sc[j] + bias[j]; }
    float m1 = fmaxf(v[0], v[1]), m2 = fminf(v[0], v[1]);
#pragma unroll
    for (int j = 2; j < 4; ++j) { const float nm1 = fmaxf(m1, v[j]); m2 = fmaxf(fminf(m1, v[j]), m2); m1 = nm1; }
#pragma unroll
    for (int o = 1; o < 8; o <<= 1) { const float o1 = __shfl_xor(m1, o), o2 = __shfl_xor(m2, o); const float nm1 = fmaxf(m1, o1); m2 = fmaxf(fminf(m1, o1), fmaxf(m2, o2)); m1 = nm1; }
    const float gs = m1 + m2;
    const int grp = lane >> 3;
    int rank = 0;
#pragma unroll
    for (int g2 = 0; g2 < 8; ++g2) { const float og = __shfl(gs, g2 * 8); rank += (og > gs || (og == gs && g2 < grp)) ? 1 : 0; }
    const bool gsel = rank < 4;
#pragma unroll
    for (int j = 0; j < 4; ++j) v[j] = gsel ? v[j] : -INFINITY;
    int my_e = 0; float my_s = 0.f, wsum = 0.f;
#pragma unroll 1
    for (int r = 0; r < 8; ++r) {
      float bv = v[0]; int bi = 0;
#pragma unroll
      for (int j = 1; j < 4; ++j) if (v[j] > bv) { bv = v[j]; bi = j; }
      int be = lane * 4 + bi;
#pragma unroll
      for (int o = 1; o < 64; o <<= 1) { const float ov = __shfl_xor(bv, o); const int oe = __shfl_xor(be, o); if (ov > bv || (ov == bv && oe < be)) { bv = ov; be = oe; } }
      const int ol = be >> 2, oj = be & 3;
      float s_own = 0.f;
#pragma unroll
      for (int j = 0; j < 4; ++j) if (lane == ol && oj == j) { s_own = sc[j]; v[j] = -INFINITY; }
      const float s_w = __shfl(s_own, ol);
      wsum += s_w;
      if (lane == r) { my_e = be; my_s = s_w; }
    }
    if (lane < 8) {
      p.tk_idx[t * 8 + lane] = my_e;
      p.tk_w[t * 8 + lane] = my_s / wsum * 2.5f;
      p.tk_rank[t * 8 + lane] = atomicAdd(&p.counts[my_e], 1);
    }
  }
}
__device__ __forceinline__ void phase_scatter(PR p, int bid, int nb, lds_ptr smem) {
  LAS int* st = (LAS int*)smem;
  __syncthreads();
  if (ltid() < 256) st[ltid() + 1] = (p.counts[ltid()] + 127) / 128 * 128;
  if (ltid() == 0) st[0] = 0;
  __syncthreads();
  if (ltid() == 0) { int s = 0; for (int i = 1; i <= 256; ++i) { s += st[i]; st[i] = s; } }
  __syncthreads();
  if (bid == 0) {
    if (ltid() < 256) { const int e = ltid(); for (int b = st[e] / 128; b < st[e + 1] / 128; ++b) p.blk_exp[b] = e; }
    for (int b = st[256] / 128 + ltid(); b < NBLK128; b += NTHR) p.blk_exp[b] = -1;
    if (ltid() < 8) {
      const int x = ltid(); int pos = 0;
      for (int e = x; e < NE; e += 8) for (int b = st[e] / 128; b < st[e + 1] / 128; b += 2) p.moe_list[x * NBLK128 + pos++] = b;
      p.moe_cnt[x] = pos;
    }
  }
  for (int i = bid * NTHR + ltid(); i < T * 8; i += nb * NTHR) {
    const int e = p.tk_idx[i], pos = st[e] + p.tk_rank[i];
    p.slot_tok[pos] = i >> 3;
    p.slot_of[i] = pos;
  }
}

__global__ void __launch_bounds__(64) k_s5_naive(P p) {
  __shared__ float sre[64], sim[64], cre[16][64], cim[16][64], us[16];
  const int b = blockIdx.x / S5G, g = blockIdx.x % S5G, lane = threadIdx.x;
  const float are = p.abar[(g * 64 + lane) * 2], aim = p.abar[(g * 64 + lane) * 2 + 1];
  float bre[16], bim[16];
  for (int h = 0; h < 16; ++h) { bre[h] = p.bbar[((g * 64 + lane) * 16 + h) * 2]; bim[h] = p.bbar[((g * 64 + lane) * 16 + h) * 2 + 1]; }
  for (int i = lane; i < 1024; i += 64) { cre[i >> 6][i & 63] = p.c_re[g * 1024 + i]; cim[i >> 6][i & 63] = p.c_im[g * 1024 + i]; }
  const float dsk = lane < 16 ? p.s5_d[g * 16 + lane] : 0.f;
  float s_re = 0.f, s_im = 0.f;
  __syncthreads();
  for (int l = 0; l < SEQ; ++l) {
    const size_t t = (size_t)b * SEQ + l;
    if (lane < 16) us[lane] = bf2f(p.proj[t * LDP + OFF_U + g * 16 + lane]);
    __syncthreads();
    float bur = 0.f, bui = 0.f;
    for (int h = 0; h < 16; ++h) { bur += us[h] * bre[h]; bui += us[h] * bim[h]; }
    const float nr = are * s_re - aim * s_im + bur, ni = are * s_im + aim * s_re + bui;
    s_re = nr; s_im = ni;
    sre[lane] = s_re; sim[lane] = s_im;
    __syncthreads();
    if (lane < 16) {
      float y = dsk * us[lane];
      for (int q = 0; q < 64; ++q) y += sre[q] * cre[lane][q] - sim[q] * cim[lane][q];
      p.yA[t * S5W + g * 16 + lane] = f2bf(geluf_(y));
    }
    __syncthreads();
  }
}

__global__ void __launch_bounds__(128) k_gla_naive(P p) {
  __shared__ float qs[32][64], ks[32][64], as[32][64], gl[32][16], w2[16][64], b2[64];
  const int b = blockIdx.x / GH, h = blockIdx.x % GH, tid = threadIdx.x;
  for (int i = tid; i < 16 * 64; i += 128) w2[i >> 6][i & 63] = p.w_gk2[(i >> 6) * GKEY + h * 64 + (i & 63)];
  if (tid < 64) b2[tid] = p.b_gk2[h * 64 + tid];
  float S[64];
  for (int d = 0; d < 64; ++d) S[d] = 0.f;
  for (int l0 = 0; l0 < SEQ; l0 += 32) {
    __syncthreads();
    for (int i = tid; i < 32 * 64; i += 128) {
      const size_t t = (size_t)b * SEQ + l0 + (i >> 6);
      qs[i >> 6][i & 63] = bf2f(p.proj[t * LDP + OFF_Q + h * 64 + (i & 63)]) * 0.125f;
      ks[i >> 6][i & 63] = bf2f(p.proj[t * LDP + OFF_K + h * 64 + (i & 63)]);
    }
    for (int i = tid; i < 32 * 16; i += 128) { const size_t t = (size_t)b * SEQ + l0 + (i >> 4); gl[i >> 4][i & 15] = p.gkl[t * 16 + (i & 15)]; }
    __syncthreads();
    for (int i = tid; i < 32 * 64; i += 128) {
      const int s = i >> 6, d = i & 63;
      float gk = b2[d];
      for (int r = 0; r < 16; ++r) gk += gl[s][r] * w2[r][d];
      as[s][d] = __expf(logsigmoidf_(gk) * (1.f / 16.f));
    }
    __syncthreads();
    for (int s = 0; s < 32; ++s) {
      const size_t t = (size_t)b * SEQ + l0 + s;
      const float v = bf2f(p.proj[t * LDP + OFF_V + h * 128 + tid]);
      float o = 0.f;
      for (int d = 0; d < 64; ++d) { S[d] = as[s][d] * S[d] + ks[s][d] * v; o += qs[s][d] * S[d]; }
      p.oraw[t * GVAL + h * 128 + tid] = o;
    }
  }
}
__global__ void __launch_bounds__(256) k_gla_post(P p) {
  const int idx = blockIdx.x * 4 + (threadIdx.x >> 6), lane = threadIdx.x & 63;
  const int t = idx / GH, h = idx % GH;
  const float o0 = p.oraw[(size_t)t * GVAL + h * 128 + lane], o1 = p.oraw[(size_t)t * GVAL + h * 128 + 64 + lane];
  float ss = o0 * o0 + o1 * o1;
  for (int o = 32; o > 0; o >>= 1) ss += __shfl_xor(ss, o);
  const float r = rsqrtf(ss * (1.f / 128.f) + 1e-6f);
  const float r0 = bf2f(p.proj[(size_t)t * LDP + OFF_R + h * 128 + lane]), r1 = bf2f(p.proj[(size_t)t * LDP + OFF_R + h * 128 + 64 + lane]);
  p.yB[(size_t)t * GVAL + h * 128 + lane] = f2bf(o0 * r * p.gla_norm_g[lane] * siluf_(r0));
  p.yB[(size_t)t * GVAL + h * 128 + 64 + lane] = f2bf(o1 * r * p.gla_norm_g[64 + lane] * siluf_(r1));
}

__global__ void __launch_bounds__(64) k_route(P p) {
  const int t = blockIdx.x * 64 + threadIdx.x;
  const float* lg = p.logits + (size_t)t * NE;
  float gs[8];
#pragma unroll
  for (int g = 0; g < 8; ++g) {
    float m1 = -INFINITY, m2 = -INFINITY;
    for (int j = 0; j < 32; ++j) { const float v = sigmoidf_(lg[g * 32 + j]) + p.router_bias[g * 32 + j]; if (v > m1) { m2 = m1; m1 = v; } else if (v > m2) m2 = v; }
    gs[g] = m1 + m2;
  }
  unsigned gmask = 0;
#pragma unroll
  for (int r = 0; r < 4; ++r) { int best = -1; float bv = -INFINITY;
#pragma unroll
    for (int g = 0; g < 8; ++g) if (!((gmask >> g) & 1u) && gs[g] > bv) { bv = gs[g]; best = g; }
    gmask |= 1u << best; }
  int sel[8]; float sw[8]; float wsum = 0.f;
#pragma unroll
  for (int r = 0; r < 8; ++r) {
    int best = -1; float bv = -INFINITY;
    for (int e = 0; e < NE; ++e) {
      if (!((gmask >> (e >> 5)) & 1u)) continue;
      bool taken = false;
#pragma unroll
      for (int q = 0; q < 8; ++q) taken |= (q < r) && (sel[q] == e);
      if (taken) continue;
      const float v = sigmoidf_(lg[e]) + p.router_bias[e];
      if (v > bv) { bv = v; best = e; }
    }
    best = best < 0 ? r : best;
    sel[r] = best; sw[r] = sigmoidf_(lg[best]); wsum += sw[r];
  }
#pragma unroll
  for (int r = 0; r < 8; ++r) {
    p.tk_idx[t * 8 + r] = sel[r];
    p.tk_w[t * 8 + r] = sw[r] / wsum * 2.5f;
    p.tk_rank[t * 8 + r] = atomicAdd(&p.counts[sel[r]], 1);
  }
}
__global__ void __launch_bounds__(256) k_offsets(P p) {
  __shared__ int pad[256], st[257];
  const int e = threadIdx.x;
  pad[e] = (p.counts[e] + 127) / 128 * 128;
  __syncthreads();
  if (e == 0) { int s = 0; for (int i = 0; i < 256; ++i) { st[i] = s; s += pad[i]; } st[256] = s; }
  __syncthreads();
  p.pad_start[e] = st[e];
  if (e == 0) p.pad_start[256] = st[256];
  for (int b = st[e] / 128; b < st[e + 1] / 128; ++b) p.blk_exp[b] = e;
  for (int b = st[256] / 128 + e; b < NBLK128; b += 256) p.blk_exp[b] = -1;
}
__global__ void __launch_bounds__(256) k_scatter(P p) {
  const int i = blockIdx.x * 256 + threadIdx.x;
  const int e = p.tk_idx[i], pos = p.pad_start[e] + p.tk_rank[i];
  p.slot_tok[pos] = i >> 3;
  p.slot_of[i] = pos;
}

__device__ __forceinline__ void phase_combine(PR p, int bid, int nb) {
  const int lane = ltid() & 63, wid = ltid() >> 6;
  for (int t = bid * 8 + wid; t < T; t += nb * 8) {
    const int b = t / SEQ;
    int so[8]; float w[8];
#pragma unroll
    for (int k = 0; k < 8; ++k) { so[k] = p.slot_of[t * 8 + k]; w[k] = p.tk_w[t * 8 + k]; }
    float v[16], ss = 0.f;
#pragma unroll
    for (int i = 0; i < 4; ++i) {
      const int c0 = lane * 4 + 256 * i;
      f32x4 m = ld_bf4(p.S + (size_t)t * D + c0);
#pragma unroll
      for (int k = 0; k < 8; ++k) { const f32x4 y = ld_bf4(p.Y + (size_t)so[k] * D + c0); m[0] += w[k] * y[0]; m[1] += w[k] * y[1]; m[2] += w[k] * y[2]; m[3] += w[k] * y[3]; }
      const f32x4 xv = *(const f32x4*)(p.x1 + (size_t)t * D + c0), gg = *(const f32x4*)(p.mod + b * 6144 + 5 * D + c0);
#pragma unroll
      for (int j = 0; j < 4; ++j) { v[i * 4 + j] = xv[j] + gg[j] * m[j]; ss += v[i * 4 + j] * v[i * 4 + j]; }
    }
#pragma unroll
    for (int o = 32; o > 0; o >>= 1) ss += __shfl_xor(ss, o);
    const float r = rsqrtf(ss * (1.f / D) + 1e-6f);
#pragma unroll
    for (int i = 0; i < 4; ++i) {
      const int c0 = lane * 4 + 256 * i; const f32x4 fg = *(const f32x4*)(p.final_g + c0);
      f32x4 o; o[0] = v[i * 4] * r * fg[0]; o[1] = v[i * 4 + 1] * r * fg[1]; o[2] = v[i * 4 + 2] * r * fg[2]; o[3] = v[i * 4 + 3] * r * fg[3];
      *(f32x4*)(p.out + (size_t)t * D + c0) = o;
    }
  }
}


template <class Epi>
__global__ void __launch_bounds__(256) k_gemm_naive(const bf16_t* __restrict__ A, int lda, const float* __restrict__ Bm, int ldb, int M, int N, int K, Epi epi) {
  __shared__ float As[16][68];
  __shared__ float Bs[16][68];
  const int tx = threadIdx.x & 15, ty = threadIdx.x >> 4;
  const int row0 = blockIdx.y * 64, col0 = blockIdx.x * 64;
  float acc[4][4];
  for (int i = 0; i < 4; ++i) for (int j = 0; j < 4; ++j) acc[i][j] = 0.f;
  for (int k0 = 0; k0 < K; k0 += 16) {
    { const int r = threadIdx.x >> 2, k4 = (threadIdx.x & 3) * 4;
      const bf16_t* ap = A + (size_t)(row0 + r) * lda + k0 + k4;
      for (int j = 0; j < 4; ++j) As[k4 + j][r] = bf2f(ap[j]); }
    { const int k = threadIdx.x >> 4, c4 = (threadIdx.x & 15) * 4;
      for (int j = 0; j < 4; ++j) { const int cc = col0 + c4 + j; Bs[k][c4 + j] = cc < N ? Bm[(size_t)(k0 + k) * ldb + cc] : 0.f; } }
    __syncthreads();
    for (int k = 0; k < 16; ++k) {
      float a[4], b[4];
      for (int i = 0; i < 4; ++i) a[i] = As[k][ty * 4 + i];
      for (int j = 0; j < 4; ++j) b[j] = Bs[k][tx * 4 + j];
      for (int i = 0; i < 4; ++i) for (int j = 0; j < 4; ++j) acc[i][j] += a[i] * b[j];
    }
    __syncthreads();
  }
  for (int i = 0; i < 4; ++i) for (int j = 0; j < 4; ++j) { const int r = row0 + ty * 4 + i, cc = col0 + tx * 4 + j; if (cc < N) epi(r, cc, acc[i][j]); }
}
struct NEpiProj { bf16_t* o; __device__ void operator()(int r, int c, float v) const { if (c >= WIN_GK && c < WIN_GK + 16) return; const int cc = c < WIN_GK ? c : c - 16; o[(size_t)r * LDP + cc] = f2bf(v); } };
struct NEpiGlu { const bf16_t* yA; const float* b; bf16_t* z; __device__ void operator()(int r, int c, float v) const { const float y = bf2f(yA[(size_t)r * S5W + c]); z[(size_t)r * S5W + c] = f2bf(y * sigmoidf_(v + b[c])); } };
struct NEpiPA { const bf16_t* proj; float* t; __device__ void operator()(int r, int c, float v) const { t[(size_t)r * D + c] = sigmoidf_(bf2f(proj[(size_t)r * LDP + OFF_GA + c])) * v; } };
struct NEpiPB { const bf16_t* proj; const float* t; bf16_t* m; __device__ void operator()(int r, int c, float v) const { m[(size_t)r * D + c] = f2bf(t[(size_t)r * D + c] + sigmoidf_(bf2f(proj[(size_t)r * LDP + OFF_GB + c])) * v); } };
struct NEpiOut { const float* x; const float* mod; float* x1; __device__ void operator()(int r, int c, float v) const { const int b = r / SEQ; x1[(size_t)r * D + c] = x[(size_t)r * D + c] + mod[b * 6144 + 2 * D + c] * v; } };
struct NEpiF32 { float* o; long ld; __device__ void operator()(int r, int c, float v) const { o[(size_t)r * ld + c] = v; } };
struct NEpiShUp { const float* g; bf16_t* h; __device__ void operator()(int r, int c, float v) const { h[(size_t)r * SFF + c] = f2bf(siluf_(g[(size_t)r * SFF + c]) * v); } };
struct NEpiBf { bf16_t* o; long ld; __device__ void operator()(int r, int c, float v) const { o[(size_t)r * ld + c] = f2bf(v); } };
__global__ void __launch_bounds__(256) k_moe_naive(P p) {
  __shared__ float xs[16][1024];
  __shared__ float hs[16][256];
  __shared__ int toks[16];
  const int s0 = blockIdx.x * 16, e = p.blk_exp[s0 / 128], tid = threadIdx.x;
  if (e < 0) return;
  if (tid < 16) toks[tid] = p.slot_tok[s0 + tid];
  __syncthreads();
  bool any = false;
  for (int s = 0; s < 16; ++s) any |= toks[s] >= 0;
  if (!any) return;
  for (int i = tid; i < 16 * 1024; i += 256) { const int s = i >> 10, d = i & 1023; xs[s][d] = toks[s] >= 0 ? bf2f(p.h2[(size_t)toks[s] * D + d]) : 0.f; }
  __syncthreads();
  {
    float ag[16], au[16];
    for (int s = 0; s < 16; ++s) { ag[s] = 0.f; au[s] = 0.f; }
    const float* wg = p.ew_gate + (size_t)e * D * EFF + tid;
    const float* wu = p.ew_up + (size_t)e * D * EFF + tid;
    for (int d = 0; d < D; ++d) {
      const float g = wg[(size_t)d * EFF], u = wu[(size_t)d * EFF];
      for (int s = 0; s < 16; ++s) { const float xv = xs[s][d]; ag[s] += xv * g; au[s] += xv * u; }
    }
    for (int s = 0; s < 16; ++s) hs[s][tid] = bf2f(f2bf(siluf_(ag[s]) * au[s]));
  }
  __syncthreads();
  for (int nb = 0; nb < 4; ++nb) {
    float acc[16];
    for (int s = 0; s < 16; ++s) acc[s] = 0.f;
    const float* wd = p.ew_down + (size_t)e * EFF * D + nb * 256 + tid;
    for (int j = 0; j < EFF; ++j) { const float w = wd[(size_t)j * D]; for (int s = 0; s < 16; ++s) acc[s] += hs[s][j] * w; }
    for (int s = 0; s < 16; ++s) if (toks[s] >= 0) p.Y[(size_t)(s0 + s) * D + nb * 256 + tid] = f2bf(acc[s]);
  }
}

#define SMEM_DECL __shared__ __attribute__((aligned(16))) unsigned char smem_raw[SMEM_BYTES]; const lds_ptr smem = (lds_ptr)smem_raw;


#define XB_TMO      128
#define XB_XCNT(j)  (256  + 64 * (j))
#define XB_XSUB(j)  (1280 + 64 * (j))
#define XB_XGEN(j)  (2304 + 64 * (j))
#define XB_TOP      3328
#define XB_TOPGEN   3392
#define XCD_BAR_WORDS 3456
#define XB_SPIN_CAP (1u << 18)
__device__ __forceinline__ unsigned xb_ld(unsigned* q)              { return __hip_atomic_load(q, __ATOMIC_RELAXED, __HIP_MEMORY_SCOPE_AGENT); }
__device__ __forceinline__ unsigned xb_add(unsigned* q, unsigned v) { return __hip_atomic_fetch_add(q, v, __ATOMIC_RELAXED, __HIP_MEMORY_SCOPE_AGENT); }
__device__ __forceinline__ unsigned xb_xcc_id() { return (unsigned)__builtin_amdgcn_s_getreg((3 << 11) | 20) & 0xFu; }
#define XB_SPIN(cond, bar) do { unsigned _sp = 0; while (cond) { __builtin_amdgcn_s_sleep(1); \
    if ((++_sp & 255u) == 0u) { if (xb_ld(&(bar)[XB_TMO])) break; if (_sp > XB_SPIN_CAP) { atomicAdd(&(bar)[XB_TMO], 1u); break; } } } } while (0)
struct XcdBarrier { unsigned* bar; unsigned x; volatile LAS unsigned* st; };
__device__ __forceinline__ XcdBarrier xcd_barrier_post(unsigned* bar, volatile LAS unsigned* st) {
  XcdBarrier b; b.bar = bar; b.x = xb_xcc_id(); b.st = st;
  if (threadIdx.x == 0) (void)xb_add(&bar[XB_XCNT(b.x)], 1u);
  return b;
}
__device__ __forceinline__ void xcd_barrier_complete(unsigned* bar, unsigned x, unsigned& nloc, unsigned& nx) {
  const unsigned G = gridDim.x * gridDim.y * gridDim.z;
  unsigned sum, cnt, mine, sp = 0u;
  for (;;) {
    sum = 0u; cnt = 0u; mine = 0u;
#pragma unroll
    for (unsigned j = 0; j < 16; ++j) { const unsigned c = xb_ld(&bar[XB_XCNT(j)]); sum += c; cnt += (c > 0u) ? 1u : 0u; mine = (j == x) ? c : mine; }
    if (sum == G) break;
    __builtin_amdgcn_s_sleep(1);
    if ((++sp & 255u) == 0u) { if (xb_ld(&bar[XB_TMO])) break; if (sp > XB_SPIN_CAP) { atomicAdd(&bar[XB_TMO], 1u); break; } }
  }
  nloc = mine > 0u ? mine : 1u; nx = cnt > 0u ? cnt : 1u;
}
__device__ __forceinline__ void xcd_barrier(const XcdBarrier& b) {
  asm volatile("s_waitcnt vmcnt(0)" ::: "memory");
  __syncthreads();
  if (threadIdx.x == 0) {
    unsigned* bar = b.bar;
    __builtin_amdgcn_s_waitcnt(0);
    unsigned nloc = b.st[0], nx = b.st[1];
    if (nloc == 0u) { xcd_barrier_complete(bar, b.x, nloc, nx); b.st[0] = nloc; b.st[1] = nx; }
    const unsigned old = xb_add(&bar[XB_XSUB(b.x)], 1u);
    const unsigned gen = old / nloc;
    if (old + 1u == (gen + 1u) * nloc) {
      __builtin_amdgcn_fence(__ATOMIC_RELEASE, "agent");
      asm volatile("s_waitcnt vmcnt(0)" ::: "memory");
      const unsigned og = xb_add(&bar[XB_TOP], 1u);
      const unsigned tg = og / nx;
      if (og + 1u == (tg + 1u) * nx) xb_add(&bar[XB_TOPGEN], 1u);
      else XB_SPIN(xb_ld(&bar[XB_TOPGEN]) == tg, bar);
      __builtin_amdgcn_fence(__ATOMIC_ACQUIRE, "agent");
      xb_add(&bar[XB_XGEN(b.x)], 1u);
      asm volatile("s_waitcnt vmcnt(0)" ::: "memory");
    } else {
      XB_SPIN(xb_ld(&bar[XB_XGEN(b.x)]) == gen, bar);
      __builtin_amdgcn_fence(__ATOMIC_ACQUIRE, "agent");
      asm volatile("s_waitcnt vmcnt(0)" ::: "memory");
    }
  }
  __syncthreads();
}

__device__ __forceinline__ const __attribute__((address_space(4))) P* kargs() { auto q = __builtin_amdgcn_kernarg_segment_ptr(); asm volatile("" : "+s"(q)); return (const __attribute__((address_space(4))) P*)q; }
#define PK (*kargs())
__global__ void __launch_bounds__(NTHR) k_fused(P p_unused) {
  SMEM_DECL
  const int bid = blockIdx.x, nb = gridDim.x;
  volatile LAS unsigned* xbw = (volatile LAS unsigned*)(smem + SMEM_BYTES - 16);
  if (threadIdx.x == 0) { xbw[0] = 0u; xbw[1] = 0u; }
  __syncthreads();
  const XcdBarrier xb = xcd_barrier_post(PK.bar, xbw);
#define GSYNC() xcd_barrier(xb)
#define RUN(k, ...) do { __VA_ARGS__; if (REP_PHASE == (k)) { __VA_ARGS__; } } while (0)
  RUN(0, phase_prep(PK, bid, nb, smem));                                                                   GSYNC();
  RUN(1, phase_norm<false>(PK, PK.x, PK.norm1_g, 0, D, PK.h1, bid, nb, smem));                                 GSYNC();
  RUN(2, phase_gemm_dense256(PK.h1, D, PK.wb_in, LDP, T, LDP, D, EpiStoreBf{PK.proj, LDP}, bid, nb, smem); gk_rows(PK, bid, nb));     GSYNC();
  RUN(3, phase_mix_local(PK, bid, nb, smem, 3));                                                           GSYNC();
  RUN(4, phase_mix_carry(PK, bid, nb, 3));                                                                 GSYNC();
  RUN(5, phase_mix_final(PK, bid, nb, smem, 3));                                                           GSYNC();
  RUN(6, phase_gemm_dense(PK.yA, S5W, PK.wb_glu, S5W, T, S5W, S5W, EpiGlu{PK.yA, PK.b_glu, PK.zA}, bid, nb, smem));   GSYNC();
  RUN(7, phase_gemm_mixed(PK, bid, nb, smem));                                                             GSYNC();
  RUN(8, phase_gemm_dense256(PK.mixed, D, PK.wb_out, D, T, D, D, EpiOut{PK.x, PK.mod, PK.x1}, bid, nb, smem));    GSYNC();
  RUN(9, phase_norm<false>(PK, PK.x1, PK.norm2_g, 3 * D, 4 * D, PK.h2, bid, nb, smem));                       GSYNC();
  RUN(10, phase_gemm_rs(PK, bid, nb, smem));                                                               GSYNC();
  phase_route(PK, bid, nb);                                                                                GSYNC();
  RUN(12, phase_scatter(PK, bid, nb, smem));                                                               GSYNC();
  phase_moe_pair<1>(PK, bid, nb, smem);                                                                    GSYNC();
  phase_moe_pair<2>(PK, bid, nb, smem);
  RUN(14, phase_gemm_dense256(PK.shH, SFF, PK.wb_sd, D, T, D, SFF, EpiStoreBf{PK.S, D}, bid, nb, smem));        GSYNC();
  RUN(15, phase_combine(PK, bid, nb));
}

static inline size_t al256(size_t v) { return (v + 255) & ~(size_t)255; }

extern "C" void kernel_launch(void* const* d_in, const int* in_sizes, int n_in, void* d_out, int out_size, void* d_ws, size_t ws_size, hipStream_t stream) {
  P p{};
  const float** pin = (const float**)&p;
  for (int i = 0; i < 32; ++i) pin[i] = (const float*)d_in[i];
  p.out = (float*)d_out;
  char* w = (char*)d_ws; size_t off = 0;
  auto take = [&](size_t bytes) { char* r = w + off; off = al256(off + bytes); return (void*)r; };
  p.mod = (float*)take(8 * 6144 * 4);
  p.wb_in = (bf16_t*)take((size_t)D * LDP * 2);
  p.wb_glu = (bf16_t*)take((size_t)S5W * S5W * 2);
  p.wb_pa = (bf16_t*)take((size_t)S5W * D * 2);
  p.wb_pb = (bf16_t*)take((size_t)GVAL * D * 2);
  p.wb_out = (bf16_t*)take((size_t)D * D * 2);
  p.wb_rs = (bf16_t*)take((size_t)D * 768 * 2);
  p.wb_sd = (bf16_t*)take((size_t)SFF * D * 2);
  p.h1 = (bf16_t*)take((size_t)T * D * 2);
  p.gkl = (float*)take((size_t)T * 16 * 4);
  p.proj = (bf16_t*)take((size_t)T * LDP * 2);
  p.abar = (float*)take(S5G * S5P * 2 * 4);
  p.bbar = (float*)take(S5G * S5P * S5H * 2 * 4);
  p.yA = (bf16_t*)take((size_t)T * S5W * 2);
  p.oraw = (float*)take((size_t)T * GVAL * 4);
  p.yB = (bf16_t*)take((size_t)T * GVAL * 2);
  p.zA = (bf16_t*)take((size_t)T * S5W * 2);
  p.mixed = (bf16_t*)take((size_t)T * D * 2);
  p.x1 = (float*)take((size_t)T * D * 4);
  p.h2 = (bf16_t*)take((size_t)T * D * 2);
  p.logits = (float*)take((size_t)T * NE * 4);
  p.tk_idx = (int*)take((size_t)T * 8 * 4);
  p.tk_w = (float*)take((size_t)T * 8 * 4);
  p.tk_rank = (int*)take((size_t)T * 8 * 4);
  p.slot_of = (int*)take((size_t)T * 8 * 4);
  p.counts = (int*)take(256 * 4);
  p.pad_start = (int*)take(257 * 4);
  p.blk_exp = (int*)take(NBLK128 * 4);
  p.slot_tok = (int*)take((size_t)NSLOT * 4);
  p.Y = (bf16_t*)take((size_t)NSLOT * D * 2);
  p.shH = (bf16_t*)take((size_t)T * SFF * 2);
  p.S = (bf16_t*)take((size_t)T * D * 2);
  p.bbarT = (bf16_t*)take((size_t)S5G * 128 * 16 * 2);
  p.cmT = (bf16_t*)take((size_t)S5G * 16 * 128 * 2);
  p.apow64 = (float*)take(S5G * S5P * 2 * 4);
  p.s5E = (float*)take((size_t)NB * 32 * S5G * 64 * 2 * 4);
  p.s5Sin = (float*)take((size_t)NB * 32 * S5G * 64 * 2 * 4);
  p.glaKV = (float*)take((size_t)1024 * 64 * 128 * 4);
  p.glaDec = (float*)take((size_t)1024 * 64 * 4);
  p.glaSin = (bf16_t*)take((size_t)1024 * 64 * 128 * 2);
  p.wgkT = (bf16_t*)take((size_t)16 * D * 2);
  p.moe_list = (int*)take((size_t)8 * NBLK128 * 4);
  p.moe_cnt = (int*)take(64);
  p.moe_ctr = (int*)take(64);
  p.Hbuf = (bf16_t*)take((size_t)NSLOT * EFF * 2);
  p.bar = (unsigned*)take(XCD_BAR_WORDS * 4);
  if (off > ws_size) { fprintf(stderr, "workspace too small: need %zu have %zu\n", off, ws_size); return; }

  static int grid_blocks = 0;
  if (!grid_blocks) {
    int dev = 0, cus = 0, per_cu = 0;
    (void)hipGetDevice(&dev);
    (void)hipDeviceGetAttribute(&cus, hipDeviceAttributeMultiprocessorCount, dev);
    (void)hipOccupancyMaxActiveBlocksPerMultiprocessor(&per_cu, k_fused, NTHR, 0);
    grid_blocks = (per_cu >= 1) ? cus : 0;
    grid_blocks &= ~7;
    if (grid_blocks <= 0) { fprintf(stderr, "occupancy query says the fused kernel does not fit (per_cu=%d cus=%d)\n", per_cu, cus); grid_blocks = 0; return; }
  }
  (void)hipMemsetAsync(p.bar, 0, XCD_BAR_WORDS * 4, stream);
  void* args[] = {&p};
  hipError_t e = hipLaunchCooperativeKernel((const void*)k_fused, dim3(grid_blocks), dim3(NTHR), args, 0, stream);
  if (e != hipSuccess) fprintf(stderr, "cooperative launch failed: %s (grid %d)\n", hipGetErrorString(e), grid_blocks);
}
```

```cpp
#include <hip/hip_runtime.h>
#include <hip/hip_cooperative_groups.h>
namespace cg = cooperative_groups;
#include <cstdint>
#include <cstdio>

typedef unsigned short bf16_t;
typedef short s16x8 __attribute__((ext_vector_type(8)));
typedef short s16x4 __attribute__((ext_vector_type(4)));
typedef float f32x4 __attribute__((ext_vector_type(4)));
typedef unsigned u32x4 __attribute__((ext_vector_type(4)));
typedef unsigned u32x2 __attribute__((ext_vector_type(2)));
#define LAS __attribute__((address_space(3)))
typedef LAS unsigned char* lds_ptr;

constexpr int D = 1024, NB = 8, SEQ = 2048, T = NB * SEQ;
constexpr int S5W = 512, S5G = 32, S5H = 16, S5P = 64;
constexpr int GH = 4, GDK = 64, GDV = 128, GKEY = 256, GVAL = 512, GRANK = 16;
constexpr int NE = 256, TOPK = 8, NGRP = 8, EFF = 256, SFF = 256;
constexpr int INW = 4112, LDP = 4096;
constexpr int OFF_U = 0, OFF_Q = 512, OFF_K = 768, OFF_V = 1024, OFF_R = 1536, OFF_GA = 2048, OFF_GB = 3072;
constexpr int WIN_GK = 1536;
constexpr int NSLOT = 163584, NBLK128 = NSLOT / 128;
constexpr int NTHR = 512;
constexpr int USE_MFMA = 127;
constexpr int USE_NEW = 7;
constexpr int REP_PHASE = -1;
constexpr int MOE_REP_GU = 1, MOE_REP_DN = 1;

__device__ __forceinline__ float bf2f(bf16_t v) { return __uint_as_float(((unsigned)v) << 16); }
__device__ __forceinline__ bf16_t f2bf(float f) { return __builtin_bit_cast(unsigned short, (__bf16)f); }
typedef float f32x2 __attribute__((ext_vector_type(2)));
typedef __bf16 bf16x2_t __attribute__((ext_vector_type(2)));
__device__ __forceinline__ unsigned cvtpk(float lo, float hi) { const f32x2 v = {lo, hi}; return __builtin_bit_cast(unsigned, __builtin_convertvector(v, bf16x2_t)); }
__device__ __forceinline__ float sigmoidf_(float x) { return __builtin_amdgcn_rcpf(1.f + __expf(-x)); }
__device__ __forceinline__ float siluf_(float x) { return x * __builtin_amdgcn_rcpf(1.f + __expf(-x)); }
__device__ __forceinline__ float geluf_(float x) { const float u = 0.7978845608028654f * (x + 0.044715f * x * x * x); return x * __builtin_amdgcn_rcpf(1.f + __expf(-2.f * u)); }
__device__ __forceinline__ float logsigmoidf_(float x) { return fminf(x, 0.f) - __logf(1.f + __expf(-fabsf(x))); }

struct P;
typedef const __attribute__((address_space(4))) P& PR;

__device__ __forceinline__ int ltid() { int t = threadIdx.x; asm volatile("" : "+v"(t)); return t; }

struct P {
  const float *x, *c, *ada_w, *ada_b, *norm1_g, *w_in, *lam_re, *lam_im, *log_dt, *b_re, *b_im, *c_re, *c_im, *s5_d, *w_glu, *b_glu, *w_proj_a,
      *w_gk2, *b_gk2, *gla_norm_g, *w_proj_b, *w_out, *norm2_g, *router_w, *router_bias, *ew_gate, *ew_up, *ew_down, *sw_gate, *sw_up, *sw_down, *final_g;
  float* out;
  float* mod;
  bf16_t* wb_in;
  bf16_t* wb_glu;
  bf16_t* wb_pa;
  bf16_t* wb_pb;
  bf16_t* wb_out;
  bf16_t* wb_rs;
  bf16_t* wb_sd;
  bf16_t* h1;
  float* gkl;
  bf16_t* proj;
  float* abar;
  float* bbar;
  bf16_t* yA;
  float* oraw;
  bf16_t* yB;
  bf16_t* zA;
  bf16_t* mixed;
  float* x1;
  bf16_t* h2;
  float* logits;
  int* tk_idx;
  float* tk_w;
  int* tk_rank;
  int* slot_of;
  int* counts;
  int* pad_start;
  int* blk_exp;
  int* slot_tok;
  bf16_t* Y;
  bf16_t* shH;
  bf16_t* S;
  bf16_t* bbarT;
  bf16_t* cmT;
  float* apow64;
  float* s5E;
  float* s5Sin;
  float* glaKV;
  float* glaDec;
  bf16_t* glaSin;
  bf16_t* wgkT;
  int* moe_list;
  int* moe_cnt;
  int* moe_ctr;
  bf16_t* Hbuf;
  unsigned* bar;
};

constexpr int G_ASZ = 128 * 64, G_BSZ = 32 * 512, G_STAGE = G_ASZ + G_BSZ;

__device__ __forceinline__ int a_off(int r, int c) { return r * 64 + ((c ^ ((0x78 >> (((r >> 2) & 3) * 2)) & 3)) << 4); }
__device__ __forceinline__ int b_off(int k, int ch) { return k * 512 + ((ch ^ ((k & 3) | (((k >> 3) & 1) << 2))) << 5); }
__device__ __forceinline__ s16x4 tr_read(lds_ptr p) { return __builtin_bit_cast(s16x4, __builtin_amdgcn_ds_read_tr16_b64_v4i16((LAS s16x4*)p)); }

struct ALoadDense { const bf16_t* A; long lda; __device__ __forceinline__ const bf16_t* rowptr(int r) const { return A + (size_t)r * lda; } };
struct ALoadGatherLds { const bf16_t* A; LAS int* tk; __device__ __forceinline__ const bf16_t* rowptr(int r) const { int t = tk[r]; t = t < 0 ? 0 : t; return A + (size_t)t * D; } };
struct BLoadBf { const bf16_t* Bm; long ldb;
  __device__ __forceinline__ u32x4 load(int kg, int c8) const { return *(const u32x4*)(Bm + (size_t)kg * ldb + c8 * 8); } };
struct BLoadF32 { const float* Bm; long ldb;
  __device__ __forceinline__ u32x4 load(int kg, int c8) const { const float* q = Bm + (size_t)kg * ldb + c8 * 8; const f32x4 a = *(const f32x4*)q, b = *(const f32x4*)(q + 4);
    u32x4 r; r.x = cvtpk(a[0], a[1]); r.y = cvtpk(a[2], a[3]); r.z = cvtpk(b[0], b[1]); r.w = cvtpk(b[2], b[3]); return r; } };
struct BLoadGU { const float* Wg; const float* Wu; long ldb; int h0;
  __device__ __forceinline__ u32x4 load(int kg, int c8) const { const int col = c8 * 8, w = col >> 6, xx = col & 63; const float* base = (xx < 32) ? Wg : Wu;
    const float* q = base + (size_t)kg * ldb + h0 + 32 * w + (xx & 31); const f32x4 a = *(const f32x4*)q, b = *(const f32x4*)(q + 4);
    u32x4 r; r.x = cvtpk(a[0], a[1]); r.y = cvtpk(a[2], a[3]); r.z = cvtpk(b[0], b[1]); r.w = cvtpk(b[2], b[3]); return r; } };

template <bool A_RES, class AL, class BL>
__device__ __forceinline__ void gemm_mainloop(f32x4 (&acc)[4][4], const AL& al, const BL& bl, int nk, lds_ptr stage, lds_ptr resA) {
  const int tid = ltid(), lane = tid & 63, wid = tid >> 6, wm = wid >> 2, wn = wid & 3, fr = lane & 15, fq = lane >> 4;
  const int ar = tid >> 2, ac = tid & 3;
  const int p0 = tid, p1 = tid + 512;
  const int bk0 = p0 >> 5, bc0 = p0 & 31, bk1 = p1 >> 5, bc1 = p1 & 31;
  const bf16_t* aptr = nullptr;
  if (!A_RES) aptr = al.rowptr(ar) + ac * 8;
  const int a_st = a_off(ar, ac);
  const int b_st0 = b_off(bk0, bc0 >> 1) + (bc0 & 1) * 16, b_st1 = b_off(bk1, bc1 >> 1) + (bc1 & 1) * 16;
  int a_rd[4];
#pragma unroll
  for (int mt = 0; mt < 4; ++mt) a_rd[mt] = a_off(wm * 64 + mt * 16 + fr, fq);
  int b_rd[4][2];
#pragma unroll
  for (int nt = 0; nt < 4; ++nt) {
    b_rd[nt][0] = b_off(8 * fq + (fr >> 2), wn * 4 + nt) + (fr & 3) * 8;
    b_rd[nt][1] = b_off(8 * fq + 4 + (fr >> 2), wn * 4 + nt) + (fr & 3) * 8;
  }
#pragma unroll
  for (int mt = 0; mt < 4; ++mt)
#pragma unroll
    for (int nt = 0; nt < 4; ++nt) acc[mt][nt] = (f32x4){0.f, 0.f, 0.f, 0.f};
  u32x4 areg = {0, 0, 0, 0}, breg0, breg1;
  if (!A_RES) areg = *(const u32x4*)aptr;
  breg0 = bl.load(bk0, bc0); breg1 = bl.load(bk1, bc1);
  __syncthreads();
  if (!A_RES) *(LAS u32x4*)(stage + a_st) = areg;
  *(LAS u32x4*)(stage + G_ASZ + b_st0) = breg0;
  *(LAS u32x4*)(stage + G_ASZ + b_st1) = breg1;
  __syncthreads();
  for (int kt = 0; kt < nk; ++kt) {
    const lds_ptr cur = stage + (kt & 1) * G_STAGE, nxt = stage + ((kt + 1) & 1) * G_STAGE;
    const bool more = kt + 1 < nk;
    if (more) {
      if (!A_RES) areg = *(const u32x4*)(aptr + (kt + 1) * 32);
      breg0 = bl.load((kt + 1) * 32 + bk0, bc0); breg1 = bl.load((kt + 1) * 32 + bk1, bc1);
    }
    s16x8 af[4], bfr[4];
    const lds_ptr abase = A_RES ? (resA + kt * G_ASZ) : cur;
#pragma unroll
    for (int mt = 0; mt < 4; ++mt) af[mt] = *(LAS s16x8*)(abase + a_rd[mt]);
#pragma unroll
    for (int nt = 0; nt < 4; ++nt) {
      const s16x4 lo = tr_read(cur + G_ASZ + b_rd[nt][0]), hi = tr_read(cur + G_ASZ + b_rd[nt][1]);
      bfr[nt] = __builtin_shufflevector(lo, hi, 0, 1, 2, 3, 4, 5, 6, 7);
    }
#pragma unroll
    for (int mt = 0; mt < 4; ++mt)
#pragma unroll
      for (int nt = 0; nt < 4; ++nt) acc[mt][nt] = __builtin_amdgcn_mfma_f32_16x16x32_bf16(bfr[nt], af[mt], acc[mt][nt], 0, 0, 0);
    if (more) {
      if (!A_RES) *(LAS u32x4*)(nxt + a_st) = areg;
      *(LAS u32x4*)(nxt + G_ASZ + b_st0) = breg0;
      *(LAS u32x4*)(nxt + G_ASZ + b_st1) = breg1;
    }
    __syncthreads();
  }
}


struct BRaw { f32x4 v[4]; };
struct BLoadF32R { const float* Bm; long ldb;
  __device__ __forceinline__ void load(BRaw& r, int kbase, int tid) const {
    const float* q = Bm + (size_t)(kbase + (tid >> 6)) * ldb + (tid & 63) * 4;
#pragma unroll
    for (int i = 0; i < 4; ++i) r.v[i] = *(const f32x4*)(q + (size_t)(8 * i) * ldb); } };
struct BLoadGUR { const float* Wg; long du; long ldb; int h0;
  __device__ __forceinline__ void load(BRaw& r, int kbase, int tid) const {
    const int col = (tid & 63) * 4, w = col >> 6, xx = col & 63;
    const float* q = Wg + ((xx < 32) ? 0l : du) + (size_t)(kbase + (tid >> 6)) * ldb + h0 + 32 * w + (xx & 31);
#pragma unroll
    for (int i = 0; i < 4; ++i) r.v[i] = *(const f32x4*)(q + (size_t)(8 * i) * ldb); } };
__device__ __forceinline__ u32x4 cvt8(const f32x4& a, const f32x4& b) { u32x4 r; r.x = cvtpk(a[0], a[1]); r.y = cvtpk(a[2], a[3]); r.z = cvtpk(b[0], b[1]); r.w = cvtpk(b[2], b[3]); return r; }

template <bool A_RES, class AL, class BL>
__device__ __forceinline__ void gemm_mainloop_r3(f32x4 (&acc)[4][4], const AL& al, const BL& bl, int nk, lds_ptr stage, lds_ptr resA) {
  const int tid = ltid(), lane = tid & 63, wid = tid >> 6, wm = wid >> 2, wn = wid & 3, fr = lane & 15, fq = lane >> 4;
  const int ar = tid >> 2, ac = tid & 3;
  const bf16_t* aptr = nullptr;
  if (!A_RES) aptr = al.rowptr(ar) + ac * 8;
  const int a_st = a_off(ar, ac);
  int b_st[4];
#pragma unroll
  for (int i = 0; i < 4; ++i) b_st[i] = G_ASZ + b_off((tid >> 6) + 8 * i, (tid & 63) >> 2) + (tid & 3) * 8;
  int a_rd[4];
#pragma unroll
  for (int mt = 0; mt < 4; ++mt) a_rd[mt] = a_off(wm * 64 + mt * 16 + fr, fq);
  int b_rd[4][2];
#pragma unroll
  for (int nt = 0; nt < 4; ++nt) {
    b_rd[nt][0] = G_ASZ + b_off(8 * fq + (fr >> 2), wn * 4 + nt) + (fr & 3) * 8;
    b_rd[nt][1] = G_ASZ + b_off(8 * fq + 4 + (fr >> 2), wn * 4 + nt) + (fr & 3) * 8;
  }
#pragma unroll
  for (int mt = 0; mt < 4; ++mt)
#pragma unroll
    for (int nt = 0; nt < 4; ++nt) acc[mt][nt] = (f32x4){0.f, 0.f, 0.f, 0.f};
  u32x4 ra0 = {0, 0, 0, 0}, ra1 = {0, 0, 0, 0}, ra2 = {0, 0, 0, 0};
  BRaw rb0, rb1, rb2;
#define R3_LOAD(RA, RB, kt_) do { if (!A_RES) RA = *(const u32x4*)(aptr + (size_t)(kt_) * 32); bl.load(RB, (kt_) * 32, tid); } while (0)
#define R3_STORE(RA, RB, st_) do { const lds_ptr s_ = stage + (st_) * G_STAGE; if (!A_RES) *(LAS u32x4*)(s_ + a_st) = RA; \
    _Pragma("unroll") for (int i_ = 0; i_ < 4; ++i_) { u32x2 o_; o_.x = cvtpk(RB.v[i_][0], RB.v[i_][1]); o_.y = cvtpk(RB.v[i_][2], RB.v[i_][3]); *(LAS u32x2*)(s_ + b_st[i_]) = o_; } } while (0)
#define R3_COMPUTE(kt_) do { const lds_ptr cur = stage + ((kt_) & 1) * G_STAGE; const lds_ptr abase = A_RES ? (resA + (kt_) * G_ASZ) : cur; \
    s16x8 af[4], bfr[4]; \
    _Pragma("unroll") for (int mt = 0; mt < 4; ++mt) af[mt] = *(LAS s16x8*)(abase + a_rd[mt]); \
    _Pragma("unroll") for (int nt = 0; nt < 4; ++nt) { const s16x4 lo = tr_read(cur + b_rd[nt][0]), hi = tr_read(cur + b_rd[nt][1]); bfr[nt] = __builtin_shufflevector(lo, hi, 0, 1, 2, 3, 4, 5, 6, 7); } \
    _Pragma("unroll") for (int mt = 0; mt < 4; ++mt) _Pragma("unroll") for (int nt = 0; nt < 4; ++nt) acc[mt][nt] = __builtin_amdgcn_mfma_f32_16x16x32_bf16(bfr[nt], af[mt], acc[mt][nt], 0, 0, 0); } while (0)
#define R3_BODY_U(kt_, RAN, RBN, RAW, RBW) do { const int kl_ = ((kt_) + 3 < nk) ? (kt_) + 3 : nk - 1; R3_LOAD(RAN, RBN, kl_); __builtin_amdgcn_sched_barrier(0); R3_COMPUTE(kt_); __builtin_amdgcn_sched_barrier(0); R3_STORE(RAW, RBW, ((kt_) + 1) & 1); __syncthreads(); } while (0)
#define R3_BODY_T(kt_, RAW, RBW) do { R3_COMPUTE(kt_); if ((kt_) + 1 < nk) R3_STORE(RAW, RBW, ((kt_) + 1) & 1); __syncthreads(); } while (0)
  R3_LOAD(ra0, rb0, 0);
  R3_LOAD(ra1, rb1, 1);
  R3_LOAD(ra2, rb2, 2);
  __syncthreads();
  R3_STORE(ra0, rb0, 0);
  __syncthreads();
  int kt = 0;
  for (; kt + 3 <= nk; kt += 3) {
    R3_BODY_U(kt, ra0, rb0, ra1, rb1);
    R3_BODY_U(kt + 1, ra1, rb1, ra2, rb2);
    R3_BODY_U(kt + 2, ra2, rb2, ra0, rb0);
  }
  if (kt < nk) { R3_BODY_T(kt, ra1, rb1); if (kt + 1 < nk) R3_BODY_T(kt + 1, ra2, rb2); }
#undef R3_BODY_U
#undef R3_BODY_T
#undef R3_LOAD
#undef R3_STORE
#undef R3_COMPUTE
}

constexpr int G_NST = 4;
#define WAIT_VM(n) asm volatile("s_waitcnt vmcnt(" #n ")" ::: "memory")
template <class AL>
__device__ __forceinline__ void gemm_mainloop_glds(f32x4 (&acc)[4][4], const AL& al, const bf16_t* __restrict__ Bm, long ldb, int nk, lds_ptr ring) {
  const int tid = ltid(), lane = tid & 63, wid = tid >> 6, wm = wid >> 2, wn = wid & 3, fr = lane & 15, fq = lane >> 4;
  const int ar = tid >> 2;
  const bf16_t* aptr = al.rowptr(ar) + (((tid & 3) ^ ((0x78 >> (((ar >> 2) & 3) * 2)) & 3)) << 3);
  const int bk = tid >> 5, pc = tid & 31;
  const int bcol = ((((pc >> 1) ^ ((bk & 3) | (((bk >> 3) & 1) << 2))) << 4) | ((pc & 1) << 3));
  const bf16_t* bptr0 = Bm + (size_t)bk * ldb + bcol;
  const bf16_t* bptr1 = bptr0 + (size_t)16 * ldb;
  const size_t bstep = (size_t)32 * ldb;
  int a_rd[4];
#pragma unroll
  for (int mt = 0; mt < 4; ++mt) a_rd[mt] = a_off(wm * 64 + mt * 16 + fr, fq);
  int b_rd[4][2];
#pragma unroll
  for (int nt = 0; nt < 4; ++nt) {
    b_rd[nt][0] = G_ASZ + b_off(8 * fq + (fr >> 2), wn * 4 + nt) + (fr & 3) * 8;
    b_rd[nt][1] = G_ASZ + b_off(8 * fq + 4 + (fr >> 2), wn * 4 + nt) + (fr & 3) * 8;
  }
#pragma unroll
  for (int mt = 0; mt < 4; ++mt)
#pragma unroll
    for (int nt = 0; nt < 4; ++nt) acc[mt][nt] = (f32x4){0.f, 0.f, 0.f, 0.f};
  const lds_ptr dstl = ring + tid * 16;
#define GLDS_ISSUE(kt_) do { const lds_ptr d_ = dstl + ((kt_) & (G_NST - 1)) * G_STAGE; \
    __builtin_amdgcn_global_load_lds((const unsigned*)(aptr + (size_t)(kt_) * 32), (LAS unsigned*)(d_), 16, 0, 0); \
    __builtin_amdgcn_global_load_lds((const unsigned*)(bptr0 + (size_t)(kt_) * bstep), (LAS unsigned*)(d_ + G_ASZ), 16, 0, 0); \
    __builtin_amdgcn_global_load_lds((const unsigned*)(bptr1 + (size_t)(kt_) * bstep), (LAS unsigned*)(d_ + G_ASZ + 8192), 16, 0, 0); } while (0)
  __syncthreads();
  GLDS_ISSUE(0);
  if (nk > 1) GLDS_ISSUE(1);
  if (nk > 2) GLDS_ISSUE(2);
  for (int kt = 0; kt < nk; ++kt) {
    if (kt + 2 < nk) WAIT_VM(6); else if (kt + 1 < nk) WAIT_VM(3); else WAIT_VM(0);
    __builtin_amdgcn_s_barrier();
    if (kt + 3 < nk) GLDS_ISSUE(kt + 3);
    const lds_ptr cur = ring + (kt & (G_NST - 1)) * G_STAGE;
    s16x8 af[4], bfr[4];
#pragma unroll
    for (int mt = 0; mt < 4; ++mt) af[mt] = *(LAS s16x8*)(cur + a_rd[mt]);
#pragma unroll
    for (int nt = 0; nt < 4; ++nt) {
      const s16x4 lo = tr_read(cur + b_rd[nt][0]), hi = tr_read(cur + b_rd[nt][1]);
      bfr[nt] = __builtin_shufflevector(lo, hi, 0, 1, 2, 3, 4, 5, 6, 7);
    }
#pragma unroll
    for (int mt = 0; mt < 4; ++mt)
#pragma unroll
      for (int nt = 0; nt < 4; ++nt) acc[mt][nt] = __builtin_amdgcn_mfma_f32_16x16x32_bf16(bfr[nt], af[mt], acc[mt][nt], 0, 0, 0);
  }
#undef GLDS_ISSUE
}


constexpr int G2_STAGE = 2 * G_ASZ + G_BSZ;
__device__ __forceinline__ void gemm_mainloop_glds256(f32x4 (&acc)[8][4], const bf16_t* __restrict__ A, long lda, const bf16_t* __restrict__ Bm, long ldb, int nk, lds_ptr ring) {
  const int tid = ltid(), lane = tid & 63, wid = tid >> 6, wm = wid >> 2, wn = wid & 3, fr = lane & 15, fq = lane >> 4;
  const int ar = tid >> 2;
  const bf16_t* aptr0 = A + (size_t)ar * lda + (((tid & 3) ^ ((0x78 >> (((ar >> 2) & 3) * 2)) & 3)) << 3);
  const bf16_t* aptr1 = aptr0 + (size_t)128 * lda;
  const int bk = tid >> 5, pc = tid & 31;
  const int bcol = ((((pc >> 1) ^ ((bk & 3) | (((bk >> 3) & 1) << 2))) << 4) | ((pc & 1) << 3));
  const bf16_t* bptr0 = Bm + (size_t)bk * ldb + bcol;
  const bf16_t* bptr1 = bptr0 + (size_t)16 * ldb;
  const size_t bstep = (size_t)32 * ldb;
  int a_rd[8];
#pragma unroll
  for (int mt = 0; mt < 8; ++mt) a_rd[mt] = wm * G_ASZ + a_off(mt * 16 + fr, fq);
  int b_rd[4][2];
#pragma unroll
  for (int nt = 0; nt < 4; ++nt) {
    b_rd[nt][0] = 2 * G_ASZ + b_off(8 * fq + (fr >> 2), wn * 4 + nt) + (fr & 3) * 8;
    b_rd[nt][1] = 2 * G_ASZ + b_off(8 * fq + 4 + (fr >> 2), wn * 4 + nt) + (fr & 3) * 8;
  }
#pragma unroll
  for (int mt = 0; mt < 8; ++mt)
#pragma unroll
    for (int nt = 0; nt < 4; ++nt) acc[mt][nt] = (f32x4){0.f, 0.f, 0.f, 0.f};
  const lds_ptr dstl = ring + tid * 16;
#define GLDS2_ISSUE(kt_) do { const lds_ptr d_ = dstl + ((kt_) & (G_NST - 1)) * G2_STAGE; \
    __builtin_amdgcn_global_load_lds((const unsigned*)(aptr0 + (size_t)(kt_) * 32), (LAS unsigned*)(d_), 16, 0, 0); \
    __builtin_amdgcn_global_load_lds((const unsigned*)(aptr1 + (size_t)(kt_) * 32), (LAS unsigned*)(d_ + G_ASZ), 16, 0, 0); \
    __builtin_amdgcn_global_load_lds((const unsigned*)(bptr0 + (size_t)(kt_) * bstep), (LAS unsigned*)(d_ + 2 * G_ASZ), 16, 0, 0); \
    __builtin_amdgcn_global_load_lds((const unsigned*)(bptr1 + (size_t)(kt_) * bstep), (LAS unsigned*)(d_ + 2 * G_ASZ + 8192), 16, 0, 0); } while (0)
  __syncthreads();
  GLDS2_ISSUE(0);
  if (nk > 1) GLDS2_ISSUE(1);
  if (nk > 2) GLDS2_ISSUE(2);
  for (int kt = 0; kt < nk; ++kt) {
    if (kt + 2 < nk) WAIT_VM(8); else if (kt + 1 < nk) WAIT_VM(4); else WAIT_VM(0);
    __builtin_amdgcn_s_barrier();
    if (kt + 3 < nk) GLDS2_ISSUE(kt + 3);
    const lds_ptr cur = ring + (kt & (G_NST - 1)) * G2_STAGE;
    s16x8 bfr[4];
#pragma unroll
    for (int nt = 0; nt < 4; ++nt) {
      const s16x4 lo = tr_read(cur + b_rd[nt][0]), hi = tr_read(cur + b_rd[nt][1]);
      bfr[nt] = __builtin_shufflevector(lo, hi, 0, 1, 2, 3, 4, 5, 6, 7);
    }
#pragma unroll
    for (int h = 0; h < 2; ++h) {
      s16x8 af[4];
#pragma unroll
      for (int mt = 0; mt < 4; ++mt) af[mt] = *(LAS s16x8*)(cur + a_rd[h * 4 + mt]);
#pragma unroll
      for (int mt = 0; mt < 4; ++mt)
#pragma unroll
        for (int nt = 0; nt < 4; ++nt) acc[h * 4 + mt][nt] = __builtin_amdgcn_mfma_f32_16x16x32_bf16(bfr[nt], af[mt], acc[h * 4 + mt][nt], 0, 0, 0);
    }
  }
#undef GLDS2_ISSUE
}

__device__ __forceinline__ void tile_map(int round, int bid, int nb, int nMt, int nNt, int& mt, int& nt, bool& valid) {
  if (nb == 256 && (nNt & 3) == 0 && (nMt & 7) == 0) {
    const int xcd = bid & 7, j = bid >> 3, q = round * 8 + xcd, rn = nNt >> 2;
    const int rect_m = q / rn, rect_n = q % rn;
    mt = rect_m * 8 + (j & 7); nt = rect_n * 4 + (j >> 3); valid = mt < nMt;
  } else {
    const int per = (nb + 7) / 8, xcd = bid & 7, j = bid >> 3;
    const int idx = round * nb + xcd * per + j;
    mt = idx / nNt; nt = idx % nNt; valid = (j < per) && (idx < nMt * nNt) && (xcd * per + j < nb);
  }
}

__device__ __forceinline__ void cvt_copy(const float* __restrict__ src, long lds_, bf16_t* __restrict__ dst, long ldd, int rows, int cols, int gtid, int gsz) {
  const int c4 = cols >> 2;
  for (long i = gtid; i < (long)rows * c4; i += gsz) {
    const int r = (int)(i / c4), c = (int)(i % c4) * 4;
    const f32x4 v = *(const f32x4*)(src + (size_t)r * lds_ + c);
    u32x2 o; o.x = cvtpk(v[0], v[1]); o.y = cvtpk(v[2], v[3]);
    *(u32x2*)(dst + (size_t)r * ldd + c) = o;
  }
}
__device__ __forceinline__ void phase_prep(PR p, int bid, int nb, lds_ptr smem) {
  const int gtid = bid * NTHR + ltid(), gsz = nb * NTHR;
  cvt_copy(p.w_in, INW, p.wb_in, LDP, D, WIN_GK, gtid, gsz);
  cvt_copy(p.w_in + WIN_GK + 16, INW, p.wb_in + WIN_GK, LDP, D, LDP - WIN_GK, gtid, gsz);
  cvt_copy(p.w_glu, S5W, p.wb_glu, S5W, S5W, S5W, gtid, gsz);
  cvt_copy(p.w_proj_a, D, p.wb_pa, D, S5W, D, gtid, gsz);
  cvt_copy(p.w_proj_b, D, p.wb_pb, D, GVAL, D, gtid, gsz);
  cvt_copy(p.w_out, D, p.wb_out, D, D, D, gtid, gsz);
  cvt_copy(p.router_w, NE, p.wb_rs, 768, D, NE, gtid, gsz);
  cvt_copy(p.sw_down, D, p.wb_sd, D, SFF, D, gtid, gsz);
  for (long i = gtid; i < (long)D * 512; i += gsz) {
    const int k = (int)(i >> 9), cc = (int)(i & 511), w = cc >> 6, xx = cc & 63;
    const int hcol = 32 * w + (xx & 31);
    const float v = (xx < 32) ? p.sw_gate[(size_t)k * SFF + hcol] : p.sw_up[(size_t)k * SFF + hcol];
    p.wb_rs[(size_t)k * 768 + 256 + cc] = f2bf(v);
  }
  for (int i = gtid; i < 16 * D; i += gsz) { const int n = i >> 10, k = i & 1023; p.wgkT[i] = f2bf(p.w_in[(size_t)k * INW + WIN_GK + n]); }
  for (int i = gtid; i < NSLOT; i += gsz) p.slot_tok[i] = -1;
  if (gtid < 256) p.counts[gtid] = 0;
  if (gtid < 16) p.moe_ctr[gtid] = 0;
  if (ltid() < 8 && bid * 8 + ltid() < S5G * S5P) {
    const int i = bid * 8 + ltid(), g = i / S5P;
    const double lr = p.lam_re[i], li = p.lam_im[i], dt = (double)__expf(p.log_dt[g]);
    const double TWO_PI = 6.283185307179586476925286766559;
    double ang = li * dt; ang -= TWO_PI * floor(ang / TWO_PI);
    const double mag = (double)__expf((float)(lr * dt));
    const double are = mag * (double)cosf((float)ang), aim = mag * (double)sinf((float)ang);
    const double den = lr * lr + li * li, nre = are - 1.0;
    const double cre = (nre * lr + aim * li) / den, cim = (aim * lr - nre * li) / den;
    p.abar[i * 2] = (float)are; p.abar[i * 2 + 1] = (float)aim;
    for (int h = 0; h < S5H; ++h) {
      const double br = p.b_re[i * S5H + h], bi = p.b_im[i * S5H + h];
      p.bbar[(i * S5H + h) * 2] = (float)(cre * br - cim * bi);
      p.bbar[(i * S5H + h) * 2 + 1] = (float)(cre * bi + cim * br);
      const int pq = i & 63;
      p.bbarT[(size_t)(g * 128 + pq) * 16 + h] = f2bf((float)(cre * br - cim * bi));
      p.bbarT[(size_t)(g * 128 + 64 + pq) * 16 + h] = f2bf((float)(cre * bi + cim * br));
    }
    double a64 = 64.0 * li * dt; a64 -= TWO_PI * floor(a64 / TWO_PI);
    const double m64 = (double)__expf((float)(64.0 * lr * dt));
    p.apow64[i * 2] = (float)(m64 * (double)cosf((float)a64)); p.apow64[i * 2 + 1] = (float)(m64 * (double)sinf((float)a64));
  }
  for (int i = gtid; i < S5G * S5H * 128; i += gsz) {
    const int pp = i & 127, ho = (i >> 7) & 15, g = i >> 11;
    p.cmT[i] = f2bf(pp < 64 ? p.c_re[(g * 16 + ho) * 64 + pp] : -p.c_im[(g * 16 + ho) * 64 + pp - 64]);
  }
  LAS float* red = (LAS float*)smem;
  LAS float* sc = (LAS float*)(smem + 16384);
  if (bid < 192) {
    __syncthreads();
    for (int i = ltid(); i < 8 * D; i += NTHR) sc[i] = siluf_(p.c[i]);
    __syncthreads();
  }
  for (int item = bid; item < 192; item += nb) {
    const int cl = ltid() & 31, kg = ltid() >> 5, col = item * 32 + cl;
    float acc[8];
#pragma unroll
    for (int b = 0; b < 8; ++b) acc[b] = 0.f;
    const float* wp = p.ada_w + (size_t)(kg * 64) * 6144 + col;
#pragma unroll 1
    for (int k0 = 0; k0 < 64; k0 += 16) {
      float w[16];
#pragma unroll
      for (int q = 0; q < 16; ++q) w[q] = wp[(size_t)(k0 + q) * 6144];
#pragma unroll
      for (int q = 0; q < 16; ++q)
#pragma unroll
        for (int b = 0; b < 8; ++b) acc[b] += sc[b * D + kg * 64 + k0 + q] * w[q];
    }
    __syncthreads();
#pragma unroll
    for (int b = 0; b < 8; ++b) red[(kg * 8 + b) * 32 + cl] = acc[b];
    __syncthreads();
    if (ltid() < 256) {
      const int b = ltid() >> 5, c2 = ltid() & 31;
      float sum = p.ada_b[item * 32 + c2];
      for (int q = 0; q < 16; ++q) sum += red[(q * 8 + b) * 32 + c2];
      p.mod[b * 6144 + item * 32 + c2] = sum;
    }
  }
}

template <bool WITH_GK>
__device__ __forceinline__ void phase_norm(PR p, const float* __restrict__ xin, const float* __restrict__ g, int sh_off, int sc_off, bf16_t* __restrict__ outp, int bid, int nb, lds_ptr smem) {
  const int lane = ltid() & 63, wid = ltid() >> 6;
  const int stride = nb * 8;
  int row = bid * 8 + wid;
  f32x4 nx[4];
  if (row < T) {
#pragma unroll
    for (int i = 0; i < 4; ++i) nx[i] = *(const f32x4*)(xin + (size_t)row * D + lane * 4 + 256 * i);
  }
  f32x4 gv[4];
#pragma unroll
  for (int i = 0; i < 4; ++i) gv[i] = *(const f32x4*)(g + lane * 4 + 256 * i);
  for (; row < T; row += stride) {
    const int b = row / SEQ;
    f32x4 v[4];
#pragma unroll
    for (int i = 0; i < 4; ++i) v[i] = nx[i];
    const int rn = row + stride;
    if (rn < T) {
#pragma unroll
      for (int i = 0; i < 4; ++i) nx[i] = *(const f32x4*)(xin + (size_t)rn * D + lane * 4 + 256 * i);
    }
    float ss = 0.f;
#pragma unroll
    for (int i = 0; i < 4; ++i) ss += v[i][0] * v[i][0] + v[i][1] * v[i][1] + v[i][2] * v[i][2] + v[i][3] * v[i][3];
#pragma unroll
    for (int o = 32; o > 0; o >>= 1) ss += __shfl_xor(ss, o);
    const float r = rsqrtf(ss * (1.f / D) + 1e-6f);
#pragma unroll
    for (int i = 0; i < 4; ++i) {
      const int c0 = lane * 4 + 256 * i;
      const f32x4 scv = *(const f32x4*)(p.mod + b * 6144 + sc_off + c0), shv = *(const f32x4*)(p.mod + b * 6144 + sh_off + c0);
      float y[4];
#pragma unroll
      for (int j = 0; j < 4; ++j) y[j] = (v[i][j] * r) * gv[i][j] * (1.f + scv[j]) + shv[j];
      u32x2 o; o.x = cvtpk(y[0], y[1]); o.y = cvtpk(y[2], y[3]);
      *(u32x2*)(outp + (size_t)row * D + c0) = o;
    }
  }
}

struct EpiStoreBf {
  bf16_t* O; long ld;
  template <int MT> __device__ __forceinline__ void operator()(const f32x4 (&acc)[MT][4], int mbase, int nbase, int fr, int fq) const {
    bf16_t* rowp = O + (size_t)(mbase + fr) * ld + nbase + fq * 4;
#pragma unroll
    for (int mt = 0; mt < MT; ++mt) {
#pragma unroll
      for (int nt = 0; nt < 4; ++nt) { const f32x4 v = acc[mt][nt]; u32x2 o; o.x = cvtpk(v[0], v[1]); o.y = cvtpk(v[2], v[3]);
        *(u32x2*)(rowp + nt * 16) = o; }
      rowp += 16 * ld;
      __builtin_amdgcn_sched_barrier(0); }
  }
};
__device__ __forceinline__ f32x4 ld_bf4(const bf16_t* q) { const u32x2 w = *(const u32x2*)q; f32x4 r; r[0] = __uint_as_float(w.x << 16); r[1] = __uint_as_float(w.x & 0xffff0000u); r[2] = __uint_as_float(w.y << 16); r[3] = __uint_as_float(w.y & 0xffff0000u); return r; }
struct EpiGlu {
  const bf16_t* yA; const float* b; bf16_t* z;
  template <int MT> __device__ __forceinline__ void operator()(const f32x4 (&acc)[MT][4], int mbase, int nbase, int fr, int fq) const {
#pragma unroll
    for (int mt = 0; mt < MT; ++mt) {
#pragma unroll
      for (int nt = 0; nt < 4; ++nt) { const int row = mbase + mt * 16 + fr, col = nbase + nt * 16 + fq * 4; const f32x4 v = acc[mt][nt];
        const f32x4 y = ld_bf4(yA + (size_t)row * S5W + col); const f32x4 bb = *(const f32x4*)(b + col);
        u32x2 o; o.x = cvtpk(y[0] * sigmoidf_(v[0] + bb[0]), y[1] * sigmoidf_(v[1] + bb[1])); o.y = cvtpk(y[2] * sigmoidf_(v[2] + bb[2]), y[3] * sigmoidf_(v[3] + bb[3]));
        *(u32x2*)(z + (size_t)row * S5W + col) = o; }
      __builtin_amdgcn_sched_barrier(0); }
  }
};
struct EpiOut {
  const float* x; const float* mod; float* x1;
  template <int MT> __device__ __forceinline__ void operator()(const f32x4 (&acc)[MT][4], int mbase, int nbase, int fr, int fq) const {
#pragma unroll
    for (int mt = 0; mt < MT; ++mt) {
#pragma unroll
      for (int nt = 0; nt < 4; ++nt) { const int row = mbase + mt * 16 + fr, col = nbase + nt * 16 + fq * 4, b = row / SEQ; const f32x4 v = acc[mt][nt];
        const f32x4 xv = *(const f32x4*)(x + (size_t)row * D + col), gg = *(const f32x4*)(mod + b * 6144 + 2 * D + col);
        f32x4 o; o[0] = xv[0] + gg[0] * v[0]; o[1] = xv[1] + gg[1] * v[1]; o[2] = xv[2] + gg[2] * v[2]; o[3] = xv[3] + gg[3] * v[3];
        *(f32x4*)(x1 + (size_t)row * D + col) = o; }
      __builtin_amdgcn_sched_barrier(0); }
  }
};

template <class Epi>
__device__ __forceinline__ void phase_gemm_dense(const bf16_t* A, long lda, const bf16_t* Bm, long ldb, int M, int N, int K, const Epi& epi, int bid, int nb, lds_ptr smem) {
  const int nMt = M / 128, nNt = N / 256, ntiles = nMt * nNt, rounds = (ntiles + nb - 1) / nb;
  const int lane = ltid() & 63, wid = ltid() >> 6, wm = wid >> 2, wn = wid & 3, fr = lane & 15, fq = lane >> 4;
  for (int r = 0; r < rounds; ++r) {
    int mt, nt; bool valid; tile_map(r, bid, nb, nMt, nNt, mt, nt, valid);
    if (!valid) continue;
    f32x4 acc[4][4];
    ALoadDense al{A + (size_t)mt * 128 * lda, lda};
    gemm_mainloop_glds(acc, al, Bm + nt * 256, ldb, K / 32, smem);
    epi.template operator()<4>(acc, mt * 128 + wm * 64, nt * 256 + wn * 64, fr, fq);
  }
}


template <class Epi>
__device__ __forceinline__ void phase_gemm_dense256(const bf16_t* A, long lda, const bf16_t* Bm, long ldb, int M, int N, int K, const Epi& epi, int bid, int nb, lds_ptr smem) {
  const int nMt = M / 256, nNt = N / 256, ntiles = nMt * nNt, rounds = (ntiles + nb - 1) / nb;
  const int lane = ltid() & 63, wid = ltid() >> 6, wm = wid >> 2, wn = wid & 3, fr = lane & 15, fq = lane >> 4;
  for (int r = 0; r < rounds; ++r) {
    int mt, nt; bool valid; tile_map(r, bid, nb, nMt, nNt, mt, nt, valid);
    if (!valid) continue;
    f32x4 acc[8][4];
    gemm_mainloop_glds256(acc, A + (size_t)mt * 256 * lda, lda, Bm + nt * 256, ldb, K / 32, smem);
    epi.template operator()<8>(acc, mt * 256 + wm * 128, nt * 256 + wn * 64, fr, fq);
  }
}


constexpr int ST_ROW = 528;
__device__ __forceinline__ void phase_gemm_dense256_bf16(const bf16_t* A, long lda, const bf16_t* Bm, long ldb, int M, int N, int K, bf16_t* O, long ldo, int bid, int nb, lds_ptr smem) {
  const int nMt = M / 256, nNt = N / 256, ntiles = nMt * nNt, rounds = (ntiles + nb - 1) / nb;
  for (int r = 0; r < rounds; ++r) {
    int mt, nt; bool valid; tile_map(r, bid, nb, nMt, nNt, mt, nt, valid);
    if (!valid) continue;
    f32x4 acc[8][4];
    gemm_mainloop_glds256(acc, A + (size_t)mt * 256 * lda, lda, Bm + nt * 256, ldb, K / 32, smem);
    const int t1 = ltid(), l1 = t1 & 63, w1 = t1 >> 6, wm = w1 >> 2;
    bf16_t* ob = O + (size_t)(mt * 256) * ldo + nt * 256 + (t1 & 31) * 8;
#pragma unroll
    for (int h = 0; h < 2; ++h) {
      __syncthreads();
      if (wm == h) {
#pragma unroll
        for (int i = 0; i < 8; ++i)
#pragma unroll
          for (int j = 0; j < 4; ++j) { const f32x4 v = acc[i][j]; u32x2 o; o.x = cvtpk(v[0], v[1]); o.y = cvtpk(v[2], v[3]);
            *(LAS u32x2*)(smem + (i * 16 + (l1 & 15)) * ST_ROW + ((w1 & 3) * 64 + j * 16 + (l1 >> 4) * 4) * 2) = o; }
      }
      __syncthreads();
#pragma unroll
      for (int ps = 0; ps < 8; ++ps) {
        const int row = ps * 16 + (t1 >> 5);
        *(u32x4*)(ob + (size_t)(h * 128 + row) * ldo) = *(LAS u32x4*)(smem + row * ST_ROW + (t1 & 31) * 16);
      }
    }
  }
}

__device__ __forceinline__ void gk_rows(PR p, int bid, int nb) {
  const int lane = ltid() & 63, wid = ltid() >> 6, fr = lane & 15, fq = lane >> 4;
  if (wid >= 4) return;
  for (int r0 = (bid * 4 + wid) * 16; r0 < T; r0 += nb * 64) {
    const bf16_t* ap = p.h1 + (size_t)(r0 + fr) * D + fq * 8;
    const bf16_t* bp = p.wgkT + (size_t)fr * D + fq * 8;
    f32x4 acc = {0.f, 0.f, 0.f, 0.f};
#pragma unroll 1
    for (int k0 = 0; k0 < 32; k0 += 8) {
      s16x8 a[8], b[8];
#pragma unroll
      for (int q = 0; q < 8; ++q) { a[q] = *(const s16x8*)(ap + (k0 + q) * 32); b[q] = *(const s16x8*)(bp + (k0 + q) * 32); }
#pragma unroll
      for (int q = 0; q < 8; ++q) acc = __builtin_amdgcn_mfma_f32_16x16x32_bf16(a[q], b[q], acc, 0, 0, 0);
    }
#pragma unroll
    for (int j = 0; j < 4; ++j) p.gkl[(size_t)(r0 + 4 * fq + j) * 16 + fr] = acc[j];
  }
}

__device__ __forceinline__ void phase_gemm_mixed(PR p, int bid, int nb, lds_ptr smem) {
  const int nMt = T / 128, nNt = D / 256, ntiles = nMt * nNt, rounds = (ntiles + nb - 1) / nb;
  const int lane = ltid() & 63, wid = ltid() >> 6, wm = wid >> 2, wn = wid & 3, fr = lane & 15, fq = lane >> 4;
  for (int r = 0; r < rounds; ++r) {
    int mt, nt; bool valid; tile_map(r, bid, nb, nMt, nNt, mt, nt, valid);
    if (!valid) continue;
    const int mbase = mt * 128 + wm * 64, nbase = nt * 256 + wn * 64;
    const bf16_t* gp = p.proj + (size_t)(mbase + fr) * LDP + nbase + fq * 4;
    u32x2 gte[4][4], pk[4][4];
#pragma unroll
    for (int i = 0; i < 4; ++i)
#pragma unroll
      for (int j = 0; j < 4; ++j) gte[i][j] = *(const u32x2*)(gp + (size_t)(i * 16) * LDP + OFF_GA + j * 16);
    f32x4 acc[4][4];
    { ALoadDense al{p.zA + (size_t)mt * 128 * S5W, S5W}; gemm_mainloop_glds(acc, al, p.wb_pa + nt * 256, D, S5W / 32, smem); }
#pragma unroll
    for (int i = 0; i < 4; ++i)
#pragma unroll
      for (int j = 0; j < 4; ++j) {
        const float g0 = __uint_as_float(gte[i][j].x << 16), g1 = __uint_as_float(gte[i][j].x & 0xffff0000u), g2 = __uint_as_float(gte[i][j].y << 16), g3 = __uint_as_float(gte[i][j].y & 0xffff0000u);
        pk[i][j].x = cvtpk(acc[i][j][0] * sigmoidf_(g0), acc[i][j][1] * sigmoidf_(g1)); pk[i][j].y = cvtpk(acc[i][j][2] * sigmoidf_(g2), acc[i][j][3] * sigmoidf_(g3)); }
#pragma unroll
    for (int i = 0; i < 4; ++i)
#pragma unroll
      for (int j = 0; j < 4; ++j) gte[i][j] = *(const u32x2*)(gp + (size_t)(i * 16) * LDP + OFF_GB + j * 16);
    { ALoadDense al{p.yB + (size_t)mt * 128 * GVAL, GVAL}; gemm_mainloop_glds(acc, al, p.wb_pb + nt * 256, D, GVAL / 32, smem); }
    bf16_t* op = p.mixed + (size_t)(mbase + fr) * D + nbase + fq * 4;
#pragma unroll
    for (int i = 0; i < 4; ++i)
#pragma unroll
      for (int j = 0; j < 4; ++j) {
        const float g0 = __uint_as_float(gte[i][j].x << 16), g1 = __uint_as_float(gte[i][j].x & 0xffff0000u), g2 = __uint_as_float(gte[i][j].y << 16), g3 = __uint_as_float(gte[i][j].y & 0xffff0000u);
        const float a0 = __uint_as_float(pk[i][j].x << 16), a1 = __uint_as_float(pk[i][j].x & 0xffff0000u), a2 = __uint_as_float(pk[i][j].y << 16), a3 = __uint_as_float(pk[i][j].y & 0xffff0000u);
        u32x2 o; o.x = cvtpk(a0 + sigmoidf_(g0) * acc[i][j][0], a1 + sigmoidf_(g1) * acc[i][j][1]); o.y = cvtpk(a2 + sigmoidf_(g2) * acc[i][j][2], a3 + sigmoidf_(g3) * acc[i][j][3]);
        *(u32x2*)(op + (size_t)(i * 16) * D + j * 16) = o; }
  }
}

__device__ __forceinline__ void phase_gemm_rs(PR p, int bid, int nb, lds_ptr smem) {
  const int nMt = T / 256, nNt = 3, ntiles = nMt * nNt, rounds = (ntiles + nb - 1) / nb;
  const int lane = ltid() & 63, wid = ltid() >> 6, wm = wid >> 2, wn = wid & 3, fr = lane & 15, fq = lane >> 4;
  for (int r = 0; r < rounds; ++r) {
    int mt, nt; bool valid; tile_map(r, bid, nb, nMt, nNt, mt, nt, valid);
    if (!valid) continue;
    f32x4 acc[8][4];
    gemm_mainloop_glds256(acc, p.h2 + (size_t)mt * 256 * D, D, p.wb_rs + nt * 256, 768, D / 32, smem);
    const int mbase = mt * 256 + wm * 128;
    if (nt == 0) {
#pragma unroll
      for (int i = 0; i < 8; ++i) {
#pragma unroll
        for (int j = 0; j < 4; ++j) *(f32x4*)(p.logits + (size_t)(mbase + i * 16 + fr) * NE + wn * 64 + j * 16 + fq * 4) = acc[i][j];
        __builtin_amdgcn_sched_barrier(0); }
    } else {
      const int h0 = (nt - 1) * 128 + wn * 32;
#pragma unroll
      for (int i = 0; i < 8; ++i) {
#pragma unroll
        for (int j = 0; j < 2; ++j) { const f32x4 gv = acc[i][j], uv = acc[i][j + 2];
          u32x2 o; o.x = cvtpk(siluf_(gv[0]) * uv[0], siluf_(gv[1]) * uv[1]); o.y = cvtpk(siluf_(gv[2]) * uv[2], siluf_(gv[3]) * uv[3]);
          *(u32x2*)(p.shH + (size_t)(mbase + i * 16 + fr) * SFF + h0 + j * 16 + fq * 4) = o; }
        __builtin_amdgcn_sched_barrier(0); }
    }
  }
}

constexpr int MOE_H_OFF = 2 * G_STAGE;
constexpr int MOE_TOK_OFF = MOE_H_OFF + 65536;
constexpr int SMEM_BYTES = 139264;
__device__ __forceinline__ void phase_moe(PR p, int bid, int nb, lds_ptr smem) {
  const int lane = ltid() & 63, wid = ltid() >> 6, wm = wid >> 2, wn = wid & 3, fr = lane & 15, fq = lane >> 4;
  LAS int* toks = (LAS int*)(smem + MOE_TOK_OFF);
  const lds_ptr Hs = smem + MOE_H_OFF;
  LAS int* qi = (LAS int*)(smem + MOE_TOK_OFF + 512);
  for (int sx = 0; sx < 8; ++sx) {
   const int x = (bid + sx) & 7;
   const int cnt = p.moe_cnt[x];
   for (;;) {
    __syncthreads();
    if (ltid() == 0) qi[0] = atomicAdd(&p.moe_ctr[x], 1);
    __syncthreads();
    const int qidx = qi[0];
    if (qidx >= cnt) break;
    const int blk = p.moe_list[x * NBLK128 + qidx];
    const int e = p.blk_exp[blk];
    if (ltid() < 128) toks[ltid()] = p.slot_tok[blk * 128 + ltid()];
    __syncthreads();
    const float* Wg = p.ew_gate + (size_t)e * D * EFF; const float* Wu = p.ew_up + (size_t)e * D * EFF; const float* Wd = p.ew_down + (size_t)e * EFF * D;
    for (int hp2 = 0; hp2 < 2 * MOE_REP_GU; ++hp2) { const int hp = hp2 & 1;
      f32x4 acc[4][4];
      ALoadGatherLds al2{p.h2, toks};
      BLoadGUR bl{Wg, (long)(Wu - Wg), EFF, hp * 128};
      gemm_mainloop_r3<false>(acc, al2, bl, D / 32, smem, smem);
#pragma unroll
      for (int i = 0; i < 4; ++i)
#pragma unroll
        for (int j = 0; j < 2; ++j) { const f32x4 gv = acc[i][j], uv = acc[i][j + 2]; const int row = wm * 64 + i * 16 + fr, hc = hp * 128 + wn * 32 + j * 16 + fq * 4;
          u32x2 o; o.x = cvtpk(siluf_(gv[0]) * uv[0], siluf_(gv[1]) * uv[1]); o.y = cvtpk(siluf_(gv[2]) * uv[2], siluf_(gv[3]) * uv[3]);
          *(LAS u32x2*)(Hs + (hc >> 5) * G_ASZ + a_off(row, (hc & 31) >> 3) + (hc & 7) * 2) = o; }
    }
    for (int np2 = 0; np2 < 4 * MOE_REP_DN; ++np2) { const int np = np2 & 3;
      f32x4 acc[4][4];
      ALoadDense al{nullptr, 0};
      BLoadF32R bl{Wd + np * 256, D};
      gemm_mainloop_r3<true>(acc, al, bl, EFF / 32, smem, Hs);
#pragma unroll
      for (int i = 0; i < 4; ++i) {
        const int rl = wm * 64 + i * 16 + fr;
        if (toks[rl] >= 0) {
#pragma unroll
          for (int j = 0; j < 4; ++j) { const f32x4 v = acc[i][j]; u32x2 o; o.x = cvtpk(v[0], v[1]); o.y = cvtpk(v[2], v[3]);
            *(u32x2*)(p.Y + (size_t)(blk * 128 + rl) * D + np * 256 + wn * 64 + j * 16 + fq * 4) = o; }
        }
      }
    }
   }
  }
}

struct BStreamGU { const float* Wg; long du; int hp0;
  __device__ __forceinline__ void load(BRaw& r, int s, int tid) const {
    const int hp = hp0 + (s >> 5), kbase = (s & 31) * 32;
    const int col = (tid & 63) * 4, w = col >> 6, xx = col & 63;
    const float* q = Wg + ((xx < 32) ? 0l : du) + (size_t)(kbase + (tid >> 6)) * EFF + hp * 128 + 32 * w + (xx & 31);
#pragma unroll
    for (int i = 0; i < 4; ++i) r.v[i] = *(const f32x4*)(q + (size_t)(8 * i) * EFF); } };
struct BStreamDown { const float* Wd; int np0;
  __device__ __forceinline__ void load(BRaw& r, int s, int tid) const {
    const int np = np0 + (s >> 3), kbase = (s & 7) * 32;
    const float* q = Wd + (size_t)(kbase + (tid >> 6)) * D + np * 256 + (tid & 63) * 4;
#pragma unroll
    for (int i = 0; i < 4; ++i) r.v[i] = *(const f32x4*)(q + (size_t)(8 * i) * D); } };
constexpr int PV_STAGE = 2 * G_ASZ + G_BSZ;
template <int SEG, int NSEG, class AL, class BL, class SE>
__device__ __forceinline__ void gemm_stream_pair(const AL& al, const BL& bl, lds_ptr stage, const SE& segend, bool has2) {
  constexpr int NS = SEG * NSEG;
  const int tid = ltid(), lane = tid & 63, wid = tid >> 6, wm = wid >> 2, wn = wid & 3, fr = lane & 15, fq = lane >> 4;
  const int ar = tid >> 2, ac = tid & 3;
  const bf16_t* aptr0 = al.rowptr(0, ar) + ac * 8;
  const bf16_t* aptr1 = al.rowptr(1, ar) + ac * 8;
  const int a_st = a_off(ar, ac);
  int b_st[4];
#pragma unroll
  for (int i = 0; i < 4; ++i) b_st[i] = 2 * G_ASZ + b_off((tid >> 6) + 8 * i, (tid & 63) >> 2) + (tid & 3) * 8;
  int a_rd[4];
#pragma unroll
  for (int mt = 0; mt < 4; ++mt) a_rd[mt] = a_off(wm * 64 + mt * 16 + fr, fq);
  int b_rd[4][2];
#pragma unroll
  for (int nt = 0; nt < 4; ++nt) {
    b_rd[nt][0] = 2 * G_ASZ + b_off(8 * fq + (fr >> 2), wn * 4 + nt) + (fr & 3) * 8;
    b_rd[nt][1] = 2 * G_ASZ + b_off(8 * fq + 4 + (fr >> 2), wn * 4 + nt) + (fr & 3) * 8;
  }
  f32x4 acc[2][4][4];
#pragma unroll
  for (int h = 0; h < 2; ++h)
#pragma unroll
    for (int mt = 0; mt < 4; ++mt)
#pragma unroll
      for (int nt = 0; nt < 4; ++nt) acc[h][mt][nt] = (f32x4){0.f, 0.f, 0.f, 0.f};
  u32x4 xa0, xb0, xa1, xb1;
  BRaw rb0, rb1;
#define P2_LOAD(XA, XB, RB, s_) do { XA = *(const u32x4*)(aptr0 + (size_t)((s_) % SEG) * 32); XB = *(const u32x4*)(aptr1 + (size_t)((s_) % SEG) * 32); bl.load(RB, (s_), tid); } while (0)
#define P2_STORE(XA, XB, RB, st_) do { const lds_ptr q_ = stage + (st_) * PV_STAGE; *(LAS u32x4*)(q_ + a_st) = XA; *(LAS u32x4*)(q_ + G_ASZ + a_st) = XB; \
    _Pragma("unroll") for (int i_ = 0; i_ < 4; ++i_) { u32x2 o_; o_.x = cvtpk(RB.v[i_][0], RB.v[i_][1]); o_.y = cvtpk(RB.v[i_][2], RB.v[i_][3]); *(LAS u32x2*)(q_ + b_st[i_]) = o_; } } while (0)
#define P2_COMPUTE(s_) do { const lds_ptr cur = stage + ((s_) & 1) * PV_STAGE; s16x8 bfr[4]; \
    _Pragma("unroll") for (int nt = 0; nt < 4; ++nt) { const s16x4 lo = tr_read(cur + b_rd[nt][0]), hi = tr_read(cur + b_rd[nt][1]); bfr[nt] = __builtin_shufflevector(lo, hi, 0, 1, 2, 3, 4, 5, 6, 7); } \
    _Pragma("unroll") for (int h = 0; h < 2; ++h) if (h == 0 || has2) { s16x8 af[4]; \
      _Pragma("unroll") for (int mt = 0; mt < 4; ++mt) af[mt] = *(LAS s16x8*)(cur + h * G_ASZ + a_rd[mt]); \
      _Pragma("unroll") for (int mt = 0; mt < 4; ++mt) _Pragma("unroll") for (int nt = 0; nt < 4; ++nt) acc[h][mt][nt] = __builtin_amdgcn_mfma_f32_16x16x32_bf16(bfr[nt], af[mt], acc[h][mt][nt], 0, 0, 0); } } while (0)
#define P2_SEGEND(s_) do { if (((s_) % SEG) == SEG - 1) { segend((s_) / SEG, acc); \
    _Pragma("unroll") for (int h = 0; h < 2; ++h) _Pragma("unroll") for (int mt = 0; mt < 4; ++mt) _Pragma("unroll") for (int nt = 0; nt < 4; ++nt) acc[h][mt][nt] = (f32x4){0.f, 0.f, 0.f, 0.f}; } } while (0)
#define P2_BODY(s_, XAN, XBN, RBN, XAW, XBW, RBW) do { const int sl_ = ((s_) + 2 < NS) ? (s_) + 2 : NS - 1; P2_LOAD(XAN, XBN, RBN, sl_); __builtin_amdgcn_sched_barrier(0); \
    P2_COMPUTE(s_); __builtin_amdgcn_sched_barrier(0); P2_SEGEND(s_); P2_STORE(XAW, XBW, RBW, ((s_) + 1) & 1); __syncthreads(); } while (0)
  P2_LOAD(xa0, xb0, rb0, 0);
  P2_LOAD(xa1, xb1, rb1, 1);
  __syncthreads();
  P2_STORE(xa0, xb0, rb0, 0);
  __syncthreads();
  for (int s = 0; s < NS; s += 2) {
    P2_BODY(s, xa0, xb0, rb0, xa1, xb1, rb1);
    P2_BODY(s + 1, xa1, xb1, rb1, xa0, xb0, rb0);
  }
#undef P2_LOAD
#undef P2_STORE
#undef P2_COMPUTE
#undef P2_SEGEND
#undef P2_BODY
}
struct APairGather { const bf16_t* A; LAS int* tk; __device__ __forceinline__ const bf16_t* rowptr(int h, int r) const { int t = tk[h * 128 + r]; t = t < 0 ? 0 : t; return A + (size_t)t * D; } };
struct APairDense { const bf16_t* A0; const bf16_t* A1; __device__ __forceinline__ const bf16_t* rowptr(int h, int r) const { return (h ? A1 : A0) + (size_t)r * EFF; } };

constexpr int PV_TOK = 2 * PV_STAGE;
constexpr int PV_Q = PV_TOK + 1024;
constexpr int PV_STG = 69632, PV_STG_ROW = 528;
template <int STG>
__device__ __forceinline__ void phase_moe_pair(PR p, int bid, int nb, lds_ptr smem) {
  LAS int* toks = (LAS int*)(smem + PV_TOK);
  LAS int* qi = (LAS int*)(smem + PV_Q);
  for (int sx = 0; sx < 8; ++sx) {
   const int x = ((int)((unsigned)__builtin_amdgcn_s_getreg((3 << 11) | 20) & 7u) + sx) & 7;
   const int cnt = 2 * p.moe_cnt[x];
   for (;;) {
    __syncthreads();
    if (ltid() == 0) qi[0] = atomicAdd(&p.moe_ctr[(STG - 1) * 8 + x], 1);
    __syncthreads();
    const int qidx = qi[0];
    if (qidx >= cnt) break;
    const int blk = p.moe_list[x * NBLK128 + (qidx >> 1)], sub = qidx & 1;
    const int e = p.blk_exp[blk];
    const bool has2 = (blk + 1 < NBLK128) && (p.blk_exp[blk + 1] == e);
    const int blk2 = has2 ? blk + 1 : blk;
    { const int t = ltid(); if (t < 256) toks[t] = (t < 128) ? p.slot_tok[blk * 128 + t] : (has2 ? p.slot_tok[blk2 * 128 + (t - 128)] : -1); }
    __syncthreads();
    const int lane = ltid() & 63, wid = ltid() >> 6, wm = wid >> 2, wn = wid & 3, fr = lane & 15, fq = lane >> 4;
    if (STG == 1) {
      const float* Wg = p.ew_gate + (size_t)e * D * EFF; const float* Wu = p.ew_up + (size_t)e * D * EFF;
      APairGather al{p.h2, toks};
      BStreamGU bl{Wg, (long)(Wu - Wg), sub};
      auto segH = [&](int hseg, const f32x4 (&acc)[2][4][4]) { const int hp = sub + hseg;
        const int t1 = ltid(), l1 = t1 & 63, w1 = t1 >> 6;
        const lds_ptr stg = smem + PV_STG;
#pragma unroll
        for (int h = 0; h < 2; ++h) {
          if (h == 1 && !has2) continue;
#pragma unroll
          for (int i = 0; i < 4; ++i)
#pragma unroll
            for (int j = 0; j < 2; ++j) { const f32x4 gv = acc[h][i][j], uv = acc[h][i][j + 2];
              u32x2 o; o.x = cvtpk(siluf_(gv[0]) * uv[0], siluf_(gv[1]) * uv[1]); o.y = cvtpk(siluf_(gv[2]) * uv[2], siluf_(gv[3]) * uv[3]);
              *(LAS u32x2*)(stg + ((w1 >> 2) * 64 + i * 16 + (l1 & 15)) * 272 + ((w1 & 3) * 32 + j * 16 + (l1 >> 4) * 4) * 2) = o; }
          __syncthreads();
          bf16_t* hb = p.Hbuf + (size_t)((h ? blk2 : blk) * 128) * EFF + hp * 128 + (t1 & 15) * 8;
#pragma unroll
          for (int ps = 0; ps < 4; ++ps) {
            const int row = ps * 32 + (t1 >> 4);
            *(u32x4*)(hb + (size_t)row * EFF) = *(LAS u32x4*)(stg + row * 272 + (t1 & 15) * 16);
          }
          __syncthreads();
        }
      };
      gemm_stream_pair<32, 1>(al, bl, smem, segH, has2);
    } else {
      const float* Wd = p.ew_down + (size_t)e * EFF * D;
      APairDense al{p.Hbuf + (size_t)blk * 128 * EFF, p.Hbuf + (size_t)blk2 * 128 * EFF};
      BStreamDown bl{Wd, 2 * sub};
      auto segY = [&](int nseg, const f32x4 (&acc)[2][4][4]) { const int np = 2 * sub + nseg;
        const int t1 = ltid(), l1 = t1 & 63, w1 = t1 >> 6;
        const lds_ptr stg = smem + PV_STG;
#pragma unroll
        for (int h = 0; h < 2; ++h) {
          if (h == 1 && !has2) continue;
#pragma unroll
          for (int i = 0; i < 4; ++i)
#pragma unroll
            for (int j = 0; j < 4; ++j) { const f32x4 v = acc[h][i][j]; u32x2 o; o.x = cvtpk(v[0], v[1]); o.y = cvtpk(v[2], v[3]);
              *(LAS u32x2*)(stg + ((w1 >> 2) * 64 + i * 16 + (l1 & 15)) * PV_STG_ROW + ((w1 & 3) * 64 + j * 16 + (l1 >> 4) * 4) * 2) = o; }
          __syncthreads();
          bf16_t* yb = p.Y + (size_t)((h ? blk2 : blk) * 128) * D + np * 256 + (t1 & 31) * 8;
#pragma unroll
          for (int ps = 0; ps < 8; ++ps) {
            const int row = ps * 16 + (t1 >> 5);
            const u32x4 v = *(LAS u32x4*)(stg + row * PV_STG_ROW + (t1 & 31) * 16);
            if (toks[h * 128 + row] >= 0) *(u32x4*)(yb + (size_t)row * D) = v;
          }
          __syncthreads();
        }
      };
      gemm_stream_pair<8, 2>(al, bl, smem, segY, has2);
    }
   }
  }
}

__device__ __forceinline__ void wave_sync() { __syncthreads(); }
constexpr int S5_BU_STRIDE = 132;
constexpr int S5_S_STRIDE = 272;
constexpr int S5_WAVE_LDS = 16 * S5_BU_STRIDE * 4 + 16 * S5_S_STRIDE;
template <bool FINAL>
__device__ __forceinline__ void s5_item(PR p, int b, int c, int g, lds_ptr wl) {
  const int lane = ltid() & 63, fr = lane & 15, fq = lane >> 4;
  LAS float* bu = (LAS float*)wl;
  const lds_ptr Sb = wl + 16 * S5_BU_STRIDE * 4;
  const size_t t0 = (size_t)b * SEQ + (size_t)c * 64;
  const s16x8 zero8 = {0, 0, 0, 0, 0, 0, 0, 0};
  s16x8 bfr[8];
#pragma unroll
  for (int nt = 0; nt < 8; ++nt) { const s16x8 x = *(const s16x8*)(p.bbarT + ((size_t)(g * 128 + nt * 16 + fr) * 16 + (fq & 1) * 8)); bfr[nt] = (fq < 2) ? x : zero8; }
  const float are = p.abar[(g * 64 + lane) * 2], aim = p.abar[(g * 64 + lane) * 2 + 1];
  const size_t sidx = (((size_t)b * 32 + c) * S5G + g) * 64 + lane;
  float sre = 0.f, sim = 0.f;
  s16x8 cfr[4];
  f32x4 dsk = {0.f, 0.f, 0.f, 0.f};
  if (FINAL) {
    sre = p.s5Sin[sidx * 2]; sim = p.s5Sin[sidx * 2 + 1];
#pragma unroll
    for (int ks = 0; ks < 4; ++ks) cfr[ks] = *(const s16x8*)(p.cmT + ((size_t)(g * 16 + fr) * 128 + ks * 32 + fq * 8));
    dsk = *(const f32x4*)(p.s5_d + g * 16 + fq * 4);
  }
  for (int mt = 0; mt < 4; ++mt) {
    const bf16_t* urow = p.proj + (t0 + mt * 16 + fr) * LDP + OFF_U + g * 16;
    const s16x8 ux = *(const s16x8*)(urow + (fq & 1) * 8);
    const s16x8 ufr = (fq < 2) ? ux : zero8;
#pragma unroll
    for (int nt = 0; nt < 8; ++nt) {
      const f32x4 z = {0.f, 0.f, 0.f, 0.f};
      const f32x4 acc = __builtin_amdgcn_mfma_f32_16x16x32_bf16(ufr, bfr[nt], z, 0, 0, 0);
#pragma unroll
      for (int j = 0; j < 4; ++j) bu[(4 * fq + j) * S5_BU_STRIDE + nt * 16 + fr] = acc[j];
    }
    wave_sync();
#pragma unroll
    for (int l = 0; l < 16; ++l) {
      const float br = bu[l * S5_BU_STRIDE + lane], bi = bu[l * S5_BU_STRIDE + 64 + lane];
      const float nr = are * sre - aim * sim + br, ni = are * sim + aim * sre + bi;
      sre = nr; sim = ni;
      if (FINAL) {
        *(LAS bf16_t*)(Sb + l * S5_S_STRIDE + lane * 2) = f2bf(sre);
        *(LAS bf16_t*)(Sb + l * S5_S_STRIDE + (64 + lane) * 2) = f2bf(sim);
      }
    }
    wave_sync();
    if (FINAL) {
      f32x4 y = {0.f, 0.f, 0.f, 0.f};
#pragma unroll
      for (int ks = 0; ks < 4; ++ks) {
        const s16x8 sfr = *(LAS s16x8*)(Sb + fr * S5_S_STRIDE + (ks * 32 + fq * 8) * 2);
        y = __builtin_amdgcn_mfma_f32_16x16x32_bf16(cfr[ks], sfr, y, 0, 0, 0);
      }
      const f32x4 u4 = ld_bf4(urow + fq * 4);
      u32x2 o; o.x = cvtpk(geluf_(y[0] + dsk[0] * u4[0]), geluf_(y[1] + dsk[1] * u4[1])); o.y = cvtpk(geluf_(y[2] + dsk[2] * u4[2]), geluf_(y[3] + dsk[3] * u4[3]));
      *(u32x2*)(p.yA + (t0 + mt * 16 + fr) * S5W + g * 16 + fq * 4) = o;
      wave_sync();
    }
  }
  if (!FINAL) { p.s5E[sidx * 2] = sre; p.s5E[sidx * 2 + 1] = sim; }
}
template <bool FINAL>
__device__ __forceinline__ void s5_block_item(PR p, int item, lds_ptr smem) {
  const int wid = ltid() >> 6;
  const int go = item & 3, c = (item >> 2) & 31, b = item >> 7;
  s5_item<FINAL>(p, b, c, go * 8 + wid, smem + wid * S5_WAVE_LDS);
}

constexpr int GL_QD = 0, GL_KE = 8192, GL_V = 16384, GL_SIN = 32768, GL_GL = 49152, GL_W2 = 53248, GL_TOT = 57344, GL_B2 = 58368, GL_ITEM = 58624;
__device__ __forceinline__ int rowrd_off(int r, int c) { return r * 128 + ((c ^ ((r >> 1) & 7)) << 4); }
__device__ __forceinline__ int tr128_off(int r, int ch) { return r * 128 + ((ch ^ (((r >> 1) & 1) | (((r >> 3) & 1) << 1))) << 5); }
__device__ __forceinline__ int tr256_off(int r, int ch) { return r * 256 + ((ch ^ ((r & 3) | (((r >> 3) & 1) << 2))) << 5); }

__device__ __forceinline__ void gla_front(PR p, int b, int h, int c, lds_ptr il, int t, float (&bl)[16], float& blast) {
  LAS float* gl = (LAS float*)(il + GL_GL); LAS float* w2 = (LAS float*)(il + GL_W2); LAS float* tot = (LAS float*)(il + GL_TOT); LAS float* b2 = (LAS float*)(il + GL_B2);
  const size_t t0 = (size_t)b * SEQ + (size_t)c * 64;
  __syncthreads();
  *(LAS f32x4*)(gl + t * 4) = *(const f32x4*)(p.gkl + t0 * 16 + t * 4);
#pragma unroll
  for (int q = 0; q < 4; ++q) { const int i = t + 256 * q; w2[i] = p.w_gk2[(i >> 6) * GKEY + h * 64 + (i & 63)]; }
  if (t < 64) b2[t] = p.b_gk2[h * 64 + t];
  __syncthreads();
  const int d = t & 63, part = t >> 6;
  float wv[16];
#pragma unroll
  for (int r = 0; r < 16; ++r) wv[r] = w2[r * 64 + d];
  const float bias = b2[d];
  float run = 0.f;
#pragma unroll
  for (int ii = 0; ii < 16; ++ii) {
    const int i = part * 16 + ii;
    float gk = bias;
#pragma unroll
    for (int q = 0; q < 4; ++q) { const f32x4 gv = *(LAS f32x4*)(gl + i * 16 + q * 4); gk += gv[0] * wv[q * 4] + gv[1] * wv[q * 4 + 1] + gv[2] * wv[q * 4 + 2] + gv[3] * wv[q * 4 + 3]; }
    run += logsigmoidf_(gk) * (1.f / 16.f);
    bl[ii] = run;
  }
  tot[part * 64 + d] = run;
  __syncthreads();
  float offs = 0.f, all = 0.f;
#pragma unroll
  for (int q = 0; q < 4; ++q) { const float v = tot[q * 64 + d]; all += v; offs += (q < part) ? v : 0.f; }
#pragma unroll
  for (int ii = 0; ii < 16; ++ii) bl[ii] += offs;
  blast = all;
}

__device__ __forceinline__ void gla_pass1(PR p, int item, lds_ptr smem) {
  const int half = ltid() >> 8, t = ltid() & 255, lane = t & 63, w = t >> 6, fr = lane & 15, fq = lane >> 4;
  const int it = item * 2 + half, c = it & 31, h = (it >> 5) & 3, b = it >> 7;
  const lds_ptr il = smem + half * GL_ITEM;
  const size_t t0 = (size_t)b * SEQ + (size_t)c * 64;
  float bl[16], blast;
  gla_front(p, b, h, c, il, t, bl, blast);
  {
    const int d = t & 63, part = t >> 6;
#pragma unroll
    for (int ii = 0; ii < 16; ++ii) {
      const int i = part * 16 + ii;
      const float kv = bf2f(p.proj[(t0 + i) * LDP + OFF_K + h * 64 + d]);
      *(LAS bf16_t*)(il + GL_KE + tr128_off(i, d >> 4) + (d & 15) * 2) = f2bf(kv * __expf(blast - bl[ii]));
    }
    if (part == 0) p.glaDec[(size_t)it * 64 + d] = __expf(blast);
#pragma unroll
    for (int q = 0; q < 4; ++q) { const int pc = t + 256 * q, r = pc >> 4, c8 = pc & 15;
      *(LAS u32x4*)(il + GL_V + tr256_off(r, c8 >> 1) + (c8 & 1) * 16) = *(const u32x4*)(p.proj + (t0 + r) * LDP + OFF_V + h * 128 + c8 * 8); }
  }
  __syncthreads();
  f32x4 acc[8];
#pragma unroll
  for (int et = 0; et < 8; ++et) acc[et] = (f32x4){0.f, 0.f, 0.f, 0.f};
#pragma unroll
  for (int ks = 0; ks < 2; ++ks) {
    const int r0 = 32 * ks + 8 * fq + (fr >> 2);
    const s16x4 klo = tr_read(il + GL_KE + tr128_off(r0, w) + (fr & 3) * 8), khi = tr_read(il + GL_KE + tr128_off(r0 + 4, w) + (fr & 3) * 8);
    const s16x8 kf = __builtin_shufflevector(klo, khi, 0, 1, 2, 3, 4, 5, 6, 7);
#pragma unroll
    for (int et = 0; et < 8; ++et) {
      const s16x4 vlo = tr_read(il + GL_V + tr256_off(r0, et) + (fr & 3) * 8), vhi = tr_read(il + GL_V + tr256_off(r0 + 4, et) + (fr & 3) * 8);
      const s16x8 vf = __builtin_shufflevector(vlo, vhi, 0, 1, 2, 3, 4, 5, 6, 7);
      acc[et] = __builtin_amdgcn_mfma_f32_16x16x32_bf16(vf, kf, acc[et], 0, 0, 0);
    }
  }
#pragma unroll
  for (int et = 0; et < 8; ++et) *(f32x4*)(p.glaKV + ((size_t)it * 64 + 16 * w + fr) * 128 + et * 16 + fq * 4) = acc[et];
}

__device__ __forceinline__ void gla_pass2(PR p, int item, lds_ptr smem) {
  const int half = ltid() >> 8, t = ltid() & 255, lane = t & 63, w = t >> 6, fr = lane & 15, fq = lane >> 4;
  const int it = item * 2 + half, c = it & 31, h = (it >> 5) & 3, b = it >> 7;
  const lds_ptr il = smem + half * GL_ITEM;
  const size_t t0 = (size_t)b * SEQ + (size_t)c * 64;
  float bl[16], blast;
  gla_front(p, b, h, c, il, t, bl, blast);
  {
    const int d = t & 63, part = t >> 6;
#pragma unroll
    for (int ii = 0; ii < 16; ++ii) {
      const int i = part * 16 + ii;
      const float qv = bf2f(p.proj[(t0 + i) * LDP + OFF_Q + h * 64 + d]) * 0.125f, kv = bf2f(p.proj[(t0 + i) * LDP + OFF_K + h * 64 + d]);
      const int o = rowrd_off(i, d >> 3) + (d & 7) * 2;
      *(LAS bf16_t*)(il + GL_QD + o) = f2bf(qv * __expf(bl[ii]));
      *(LAS bf16_t*)(il + GL_KE + o) = f2bf(kv * __expf(-bl[ii]));
    }
#pragma unroll
    for (int q = 0; q < 4; ++q) { const int pc = t + 256 * q, r = pc >> 4, c8 = pc & 15;
      *(LAS u32x4*)(il + GL_V + tr256_off(r, c8 >> 1) + (c8 & 1) * 16) = *(const u32x4*)(p.proj + (t0 + r) * LDP + OFF_V + h * 128 + c8 * 8);
      *(LAS u32x4*)(il + GL_SIN + tr256_off(r, c8 >> 1) + (c8 & 1) * 16) = *(const u32x4*)(p.glaSin + ((size_t)it * 64 + r) * 128 + c8 * 8); }
  }
  __syncthreads();
  s16x8 qf[2];
#pragma unroll
  for (int ks = 0; ks < 2; ++ks) qf[ks] = *(LAS s16x8*)(il + GL_QD + rowrd_off(16 * w + fr, ks * 4 + fq));
  f32x4 st[4];
#pragma unroll
  for (int jt = 0; jt < 4; ++jt) {
    st[jt] = (f32x4){0.f, 0.f, 0.f, 0.f};
    if (jt <= w) {
#pragma unroll
      for (int ks = 0; ks < 2; ++ks) {
        const s16x8 kf = *(LAS s16x8*)(il + GL_KE + rowrd_off(16 * jt + fr, ks * 4 + fq));
        st[jt] = __builtin_amdgcn_mfma_f32_16x16x32_bf16(kf, qf[ks], st[jt], 0, 0, 0);
      }
      if (jt == w) {
#pragma unroll
        for (int r = 0; r < 4; ++r) st[jt][r] = (4 * fq + r <= fr) ? st[jt][r] : 0.f;
      }
    }
  }
  f32x4 acc[8];
#pragma unroll
  for (int et = 0; et < 8; ++et) acc[et] = (f32x4){0.f, 0.f, 0.f, 0.f};
#pragma unroll
  for (int u = 0; u < 2; ++u) {
    if (2 * u <= w) {
      u32x4 pk; pk.x = cvtpk(st[2 * u][0], st[2 * u][1]); pk.y = cvtpk(st[2 * u][2], st[2 * u][3]); pk.z = cvtpk(st[2 * u + 1][0], st[2 * u + 1][1]); pk.w = cvtpk(st[2 * u + 1][2], st[2 * u + 1][3]);
      const s16x8 pf = __builtin_bit_cast(s16x8, pk);
      const int r0 = 32 * u + 4 * fq + (fr >> 2);
#pragma unroll
      for (int et = 0; et < 8; ++et) {
        const s16x4 vlo = tr_read(il + GL_V + tr256_off(r0, et) + (fr & 3) * 8), vhi = tr_read(il + GL_V + tr256_off(r0 + 16, et) + (fr & 3) * 8);
        const s16x8 vf = __builtin_shufflevector(vlo, vhi, 0, 1, 2, 3, 4, 5, 6, 7);
        acc[et] = __builtin_amdgcn_mfma_f32_16x16x32_bf16(vf, pf, acc[et], 0, 0, 0);
      }
    }
  }
#pragma unroll
  for (int ks = 0; ks < 2; ++ks) {
    const int r0 = 32 * ks + 8 * fq + (fr >> 2);
#pragma unroll
    for (int et = 0; et < 8; ++et) {
      const s16x4 slo = tr_read(il + GL_SIN + tr256_off(r0, et) + (fr & 3) * 8), shi = tr_read(il + GL_SIN + tr256_off(r0 + 4, et) + (fr & 3) * 8);
      const s16x8 sf = __builtin_shufflevector(slo, shi, 0, 1, 2, 3, 4, 5, 6, 7);
      acc[et] = __builtin_amdgcn_mfma_f32_16x16x32_bf16(sf, qf[ks], acc[et], 0, 0, 0);
    }
  }
  float ss = 0.f;
#pragma unroll
  for (int et = 0; et < 8; ++et) ss += acc[et][0] * acc[et][0] + acc[et][1] * acc[et][1] + acc[et][2] * acc[et][2] + acc[et][3] * acc[et][3];
  ss += __shfl_xor(ss, 16); ss += __shfl_xor(ss, 32);
  const float rn = rsqrtf(ss * (1.f / 128.f) + 1e-6f);
  const size_t trow = t0 + 16 * w + fr;
#pragma unroll
  for (int et = 0; et < 8; ++et) {
    const int e = et * 16 + fq * 4;
    const f32x4 ng = *(const f32x4*)(p.gla_norm_g + e), rg = ld_bf4(p.proj + trow * LDP + OFF_R + h * 128 + e);
    u32x2 o; o.x = cvtpk(acc[et][0] * rn * ng[0] * siluf_(rg[0]), acc[et][1] * rn * ng[1] * siluf_(rg[1])); o.y = cvtpk(acc[et][2] * rn * ng[2] * siluf_(rg[2]), acc[et][3] * rn * ng[3] * siluf_(rg[3]));
    *(u32x2*)(p.yB + trow * GVAL + h * 128 + e) = o;
  }
}

__device__ __forceinline__ void phase_mix_local(PR p, int bid, int nb, lds_ptr smem, int which) {
  for (int idx = bid; idx < 1024 + 512; idx += nb) {
    if (idx < 1024) { if (which & 1) { __syncthreads(); s5_block_item<false>(p, idx, smem); } }
    else if (which & 2) gla_pass1(p, idx - 1024, smem);
  }
}
__device__ __forceinline__ void phase_mix_carry(PR p, int bid, int nb, int which) {
  const int gtid = bid * NTHR + ltid(), gsz = nb * NTHR;
  if (which & 1) for (int i = gtid; i < NB * S5G * S5P; i += gsz) {
    const int pq = i & 63, g = (i >> 6) & 31, b = i >> 11;
    const float are = p.apow64[(g * 64 + pq) * 2], aim = p.apow64[(g * 64 + pq) * 2 + 1];
    float sre = 0.f, sim = 0.f;
    for (int c = 0; c < 32; ++c) {
      const size_t sidx = (((size_t)b * 32 + c) * S5G + g) * 64 + pq;
      p.s5Sin[sidx * 2] = sre; p.s5Sin[sidx * 2 + 1] = sim;
      const float er = p.s5E[sidx * 2], ei = p.s5E[sidx * 2 + 1];
      const float nr = are * sre - aim * sim + er, ni = are * sim + aim * sre + ei;
      sre = nr; sim = ni;
    }
  }
  if (which & 2) for (int i = gtid; i < NB * GH * 64 * 128; i += gsz) {
    const int e = i & 127, d = (i >> 7) & 63, bh = i >> 13;
    float S = 0.f;
#pragma unroll 8
    for (int c = 0; c < 32; ++c) {
      const size_t it = (size_t)bh * 32 + c;
      p.glaSin[(it * 64 + d) * 128 + e] = f2bf(S);
      S = p.glaDec[it * 64 + d] * S + p.glaKV[(it * 64 + d) * 128 + e];
    }
  }
}
__device__ __forceinline__ void phase_mix_final(PR p, int bid, int nb, lds_ptr smem, int which) {
  for (int idx = bid; idx < 1024 + 512; idx += nb) {
    if (idx < 1024) { if (which & 1) { __syncthreads(); s5_block_item<true>(p, idx, smem); } }
    else if (which & 2) gla_pass2(p, idx - 1024, smem);
  }
}

__device__ __forceinline__ void phase_route(PR p, int bid, int nb) {
  const int lane = ltid() & 63, wid = ltid() >> 6;
  const f32x4 bias = *(const f32x4*)(p.router_bias + lane * 4);
  for (int t = bid * 8 + wid; t < T; t += nb * 8) {
    const f32x4 lg = *(const f32x4*)(p.logits + (size_t)t * NE + lane * 4);
    float sc[4], v[4];
#pragma unroll
    for (int j = 0; j < 4; ++j) { sc[j] = sigmoidf_(lg[j]); v[j] = sc[j] + bias[j]; }
    float m1 = fmaxf(v[0], v[1]), m2 = fminf(v[0], v[1]);
#pragma unroll
    for (int j = 2; j < 4; ++j) { const float nm1 = fmaxf(m1, v[j]); m2 = fmaxf(fminf(m1, v[j]), m2); m1 = nm1; }
#pragma unroll
    for (int o = 1; o < 8; o <<= 1) { const float o1 = __shfl_xor(m1, o), o2 = __shfl_xor(m2, o); const float nm1 = fmaxf(m1, o1); m2 = fmaxf(fminf(m1, o1), fmaxf(m2, o2)); m1 = nm1; }
    const float gs = m1 + m2;
    const int grp = lane >> 3;
    int rank = 0;
#pragma unroll
    for (int g2 = 0; g2 < 8; ++g2) { const float og = __shfl(gs, g2 * 8); rank += (og > gs || (og == gs && g2 < grp)) ? 1 : 0; }
    const bool gsel = rank < 4;
#pragma unroll
    for (int j = 0; j < 4; ++j) v[j] = gsel ? v[j] : -INFINITY;
    int my_e = 0; float my_s = 0.f, wsum = 0.f;
#pragma unroll 1
    for (int r = 0; r < 8; ++r) {
      float bv = v[0]; int bi = 0;
#pragma unroll
      for (int j = 1; j < 4; ++j) if (v[j] > bv) { bv = v[j]; bi = j; }
      int be = lane * 4 + bi;
#pragma unroll
      for (int o = 1; o < 64; o <<= 1) { const float ov = __shfl_xor(bv, o); const int oe = __shfl_xor(be, o); if (ov > bv || (ov == bv && oe < be)) { bv = ov; be = oe; } }
      const int ol = be >> 2, oj = be & 3;
      float s_own = 0.f;
#pragma unroll
      for (int j = 0; j < 4; ++j) if (lane == ol && oj == j) { s_own = sc[j]; v[j] = -INFINITY; }
      const float s_w = __shfl(s_own, ol);
      wsum += s_w;
      if (lane == r) { my_e = be; my_s = s_w; }
    }
    if (lane < 8) {
      p.tk_idx[t * 8 + lane] = my_e;
      p.tk_w[t * 8 + lane] = my_s / wsum * 2.5f;
      p.tk_rank[t * 8 + lane] = atomicAdd(&p.counts[my_e], 1);
    }
  }
}
__device__ __forceinline__ void phase_scatter(PR p, int bid, int nb, lds_ptr smem) {
  LAS int* st = (LAS int*)smem;
  __syncthreads();
  if (ltid() < 256) st[ltid() + 1] = (p.counts[ltid()] + 127) / 128 * 128;
  if (ltid() == 0) st[0] = 0;
  __syncthreads();
  if (ltid() == 0) { int s = 0; for (int i = 1; i <= 256; ++i) { s += st[i]; st[i] = s; } }
  __syncthreads();
  if (bid == 0) {
    if (ltid() < 256) { const int e = ltid(); for (int b = st[e] / 128; b < st[e + 1] / 128; ++b) p.blk_exp[b] = e; }
    for (int b = st[256] / 128 + ltid(); b < NBLK128; b += NTHR) p.blk_exp[b] = -1;
    if (ltid() < 8) {
      const int x = ltid(); int pos = 0;
      for (int e = x; e < NE; e += 8) for (int b = st[e] / 128; b < st[e + 1] / 128; b += 2) p.moe_list[x * NBLK128 + pos++] = b;
      p.moe_cnt[x] = pos;
    }
  }
  for (int i = bid * NTHR + ltid(); i < T * 8; i += nb * NTHR) {
    const int e = p.tk_idx[i], pos = st[e] + p.tk_rank[i];
    p.slot_tok[pos] = i >> 3;
    p.slot_of[i] = pos;
  }
}

__global__ void __launch_bounds__(64) k_s5_naive(P p) {
  __shared__ float sre[64], sim[64], cre[16][64], cim[16][64], us[16];
  const int b = blockIdx.x / S5G, g = blockIdx.x % S5G, lane = threadIdx.x;
  const float are = p.abar[(g * 64 + lane) * 2], aim = p.abar[(g * 64 + lane) * 2 + 1];
  float bre[16], bim[16];
  for (int h = 0; h < 16; ++h) { bre[h] = p.bbar[((g * 64 + lane) * 16 + h) * 2]; bim[h] = p.bbar[((g * 64 + lane) * 16 + h) * 2 + 1]; }
  for (int i = lane; i < 1024; i += 64) { cre[i >> 6][i & 63] = p.c_re[g * 1024 + i]; cim[i >> 6][i & 63] = p.c_im[g * 1024 + i]; }
  const float dsk = lane < 16 ? p.s5_d[g * 16 + lane] : 0.f;
  float s_re = 0.f, s_im = 0.f;
  __syncthreads();
  for (int l = 0; l < SEQ; ++l) {
    const size_t t = (size_t)b * SEQ + l;
    if (lane < 16) us[lane] = bf2f(p.proj[t * LDP + OFF_U + g * 16 + lane]);
    __syncthreads();
    float bur = 0.f, bui = 0.f;
    for (int h = 0; h < 16; ++h) { bur += us[h] * bre[h]; bui += us[h] * bim[h]; }
    const float nr = are * s_re - aim * s_im + bur, ni = are * s_im + aim * s_re + bui;
    s_re = nr; s_im = ni;
    sre[lane] = s_re; sim[lane] = s_im;
    __syncthreads();
    if (lane < 16) {
      float y = dsk * us[lane];
      for (int q = 0; q < 64; ++q) y += sre[q] * cre[lane][q] - sim[q] * cim[lane][q];
      p.yA[t * S5W + g * 16 + lane] = f2bf(geluf_(y));
    }
    __syncthreads();
  }
}

__global__ void __launch_bounds__(128) k_gla_naive(P p) {
  __shared__ float qs[32][64], ks[32][64], as[32][64], gl[32][16], w2[16][64], b2[64];
  const int b = blockIdx.x / GH, h = blockIdx.x % GH, tid = threadIdx.x;
  for (int i = tid; i < 16 * 64; i += 128) w2[i >> 6][i & 63] = p.w_gk2[(i >> 6) * GKEY + h * 64 + (i & 63)];
  if (tid < 64) b2[tid] = p.b_gk2[h * 64 + tid];
  float S[64];
  for (int d = 0; d < 64; ++d) S[d] = 0.f;
  for (int l0 = 0; l0 < SEQ; l0 += 32) {
    __syncthreads();
    for (int i = tid; i < 32 * 64; i += 128) {
      const size_t t = (size_t)b * SEQ + l0 + (i >> 6);
      qs[i >> 6][i & 63] = bf2f(p.proj[t * LDP + OFF_Q + h * 64 + (i & 63)]) * 0.125f;
      ks[i >> 6][i & 63] = bf2f(p.proj[t * LDP + OFF_K + h * 64 + (i & 63)]);
    }
    for (int i = tid; i < 32 * 16; i += 128) { const size_t t = (size_t)b * SEQ + l0 + (i >> 4); gl[i >> 4][i & 15] = p.gkl[t * 16 + (i & 15)]; }
    __syncthreads();
    for (int i = tid; i < 32 * 64; i += 128) {
      const int s = i >> 6, d = i & 63;
      float gk = b2[d];
      for (int r = 0; r < 16; ++r) gk += gl[s][r] * w2[r][d];
      as[s][d] = __expf(logsigmoidf_(gk) * (1.f / 16.f));
    }
    __syncthreads();
    for (int s = 0; s < 32; ++s) {
      const size_t t = (size_t)b * SEQ + l0 + s;
      const float v = bf2f(p.proj[t * LDP + OFF_V + h * 128 + tid]);
      float o = 0.f;
      for (int d = 0; d < 64; ++d) { S[d] = as[s][d] * S[d] + ks[s][d] * v; o += qs[s][d] * S[d]; }
      p.oraw[t * GVAL + h * 128 + tid] = o;
    }
  }
}
__global__ void __launch_bounds__(256) k_gla_post(P p) {
  const int idx = blockIdx.x * 4 + (threadIdx.x >> 6), lane = threadIdx.x & 63;
  const int t = idx / GH, h = idx % GH;
  const float o0 = p.oraw[(size_t)t * GVAL + h * 128 + lane], o1 = p.oraw[(size_t)t * GVAL + h * 128 + 64 + lane];
  float ss = o0 * o0 + o1 * o1;
  for (int o = 32; o > 0; o >>= 1) ss += __shfl_xor(ss, o);
  const float r = rsqrtf(ss * (1.f / 128.f) + 1e-6f);
  const float r0 = bf2f(p.proj[(size_t)t * LDP + OFF_R + h * 128 + lane]), r1 = bf2f(p.proj[(size_t)t * LDP + OFF_R + h * 128 + 64 + lane]);
  p.yB[(size_t)t * GVAL + h * 128 + lane] = f2bf(o0 * r * p.gla_norm_g[lane] * siluf_(r0));
  p.yB[(size_t)t * GVAL + h * 128 + 64 + lane] = f2bf(o1 * r * p.gla_norm_g[64 + lane] * siluf_(r1));
}

__global__ void __launch_bounds__(64) k_route(P p) {
  const int t = blockIdx.x * 64 + threadIdx.x;
  const float* lg = p.logits + (size_t)t * NE;
  float gs[8];
#pragma unroll
  for (int g = 0; g < 8; ++g) {
    float m1 = -INFINITY, m2 = -INFINITY;
    for (int j = 0; j < 32; ++j) { const float v = sigmoidf_(lg[g * 32 + j]) + p.router_bias[g * 32 + j]; if (v > m1) { m2 = m1; m1 = v; } else if (v > m2) m2 = v; }
    gs[g] = m1 + m2;
  }
  unsigned gmask = 0;
#pragma unroll
  for (int r = 0; r < 4; ++r) { int best = -1; float bv = -INFINITY;
#pragma unroll
    for (int g = 0; g < 8; ++g) if (!((gmask >> g) & 1u) && gs[g] > bv) { bv = gs[g]; best = g; }
    gmask |= 1u << best; }
  int sel[8]; float sw[8]; float wsum = 0.f;
#pragma unroll
  for (int r = 0; r < 8; ++r) {
    int best = -1; float bv = -INFINITY;
    for (int e = 0; e < NE; ++e) {
      if (!((gmask >> (e >> 5)) & 1u)) continue;
      bool taken = false;
#pragma unroll
      for (int q = 0; q < 8; ++q) taken |= (q < r) && (sel[q] == e);
      if (taken) continue;
      const float v = sigmoidf_(lg[e]) + p.router_bias[e];
      if (v > bv) { bv = v; best = e; }
    }
    best = best < 0 ? r : best;
    sel[r] = best; sw[r] = sigmoidf_(lg[best]); wsum += sw[r];
  }
#pragma unroll
  for (int r = 0; r < 8; ++r) {
    p.tk_idx[t * 8 + r] = sel[r];
    p.tk_w[t * 8 + r] = sw[r] / wsum * 2.5f;
    p.tk_rank[t * 8 + r] = atomicAdd(&p.counts[sel[r]], 1);
  }
}
__global__ void __launch_bounds__(256) k_offsets(P p) {
  __shared__ int pad[256], st[257];
  const int e = threadIdx.x;
  pad[e] = (p.counts[e] + 127) / 128 * 128;
  __syncthreads();
  if (e == 0) { int s = 0; for (int i = 0; i < 256; ++i) { st[i] = s; s += pad[i]; } st[256] = s; }
  __syncthreads();
  p.pad_start[e] = st[e];
  if (e == 0) p.pad_start[256] = st[256];
  for (int b = st[e] / 128; b < st[e + 1] / 128; ++b) p.blk_exp[b] = e;
  for (int b = st[256] / 128 + e; b < NBLK128; b += 256) p.blk_exp[b] = -1;
}
__global__ void __launch_bounds__(256) k_scatter(P p) {
  const int i = blockIdx.x * 256 + threadIdx.x;
  const int e = p.tk_idx[i], pos = p.pad_start[e] + p.tk_rank[i];
  p.slot_tok[pos] = i >> 3;
  p.slot_of[i] = pos;
}

__device__ __forceinline__ void phase_combine(PR p, int bid, int nb) {
  const int lane = ltid() & 63, wid = ltid() >> 6;
  for (int t = bid * 8 + wid; t < T; t += nb * 8) {
    const int b = t / SEQ;
    int so[8]; float w[8];
#pragma unroll
    for (int k = 0; k < 8; ++k) { so[k] = p.slot_of[t * 8 + k]; w[k] = p.tk_w[t * 8 + k]; }
    float v[16], ss = 0.f;
#pragma unroll
    for (int i = 0; i < 4; ++i) {
      const int c0 = lane * 4 + 256 * i;
      f32x4 m = ld_bf4(p.S + (size_t)t * D + c0);
#pragma unroll
      for (int k = 0; k < 8; ++k) { const f32x4 y = ld_bf4(p.Y + (size_t)so[k] * D + c0); m[0] += w[k] * y[0]; m[1] += w[k] * y[1]; m[2] += w[k] * y[2]; m[3] += w[k] * y[3]; }
      const f32x4 xv = *(const f32x4*)(p.x1 + (size_t)t * D + c0), gg = *(const f32x4*)(p.mod + b * 6144 + 5 * D + c0);
#pragma unroll
      for (int j = 0; j < 4; ++j) { v[i * 4 + j] = xv[j] + gg[j] * m[j]; ss += v[i * 4 + j] * v[i * 4 + j]; }
    }
#pragma unroll
    for (int o = 32; o > 0; o >>= 1) ss += __shfl_xor(ss, o);
    const float r = rsqrtf(ss * (1.f / D) + 1e-6f);
#pragma unroll
    for (int i = 0; i < 4; ++i) {
      const int c0 = lane * 4 + 256 * i; const f32x4 fg = *(const f32x4*)(p.final_g + c0);
      f32x4 o; o[0] = v[i * 4] * r * fg[0]; o[1] = v[i * 4 + 1] * r * fg[1]; o[2] = v[i * 4 + 2] * r * fg[2]; o[3] = v[i * 4 + 3] * r * fg[3];
      *(f32x4*)(p.out + (size_t)t * D + c0) = o;
    }
  }
}


template <class Epi>
__global__ void __launch_bounds__(256) k_gemm_naive(const bf16_t* __restrict__ A, int lda, const float* __restrict__ Bm, int ldb, int M, int N, int K, Epi epi) {
  __shared__ float As[16][68];
  __shared__ float Bs[16][68];
  const int tx = threadIdx.x & 15, ty = threadIdx.x >> 4;
  const int row0 = blockIdx.y * 64, col0 = blockIdx.x * 64;
  float acc[4][4];
  for (int i = 0; i < 4; ++i) for (int j = 0; j < 4; ++j) acc[i][j] = 0.f;
  for (int k0 = 0; k0 < K; k0 += 16) {
    { const int r = threadIdx.x >> 2, k4 = (threadIdx.x & 3) * 4;
      const bf16_t* ap = A + (size_t)(row0 + r) * lda + k0 + k4;
      for (int j = 0; j < 4; ++j) As[k4 + j][r] = bf2f(ap[j]); }
    { const int k = threadIdx.x >> 4, c4 = (threadIdx.x & 15) * 4;
      for (int j = 0; j < 4; ++j) { const int cc = col0 + c4 + j; Bs[k][c4 + j] = cc < N ? Bm[(size_t)(k0 + k) * ldb + cc] : 0.f; } }
    __syncthreads();
    for (int k = 0; k < 16; ++k) {
      float a[4], b[4];
      for (int i = 0; i < 4; ++i) a[i] = As[k][ty * 4 + i];
      for (int j = 0; j < 4; ++j) b[j] = Bs[k][tx * 4 + j];
      for (int i = 0; i < 4; ++i) for (int j = 0; j < 4; ++j) acc[i][j] += a[i] * b[j];
    }
    __syncthreads();
  }
  for (int i = 0; i < 4; ++i) for (int j = 0; j < 4; ++j) { const int r = row0 + ty * 4 + i, cc = col0 + tx * 4 + j; if (cc < N) epi(r, cc, acc[i][j]); }
}
struct NEpiProj { bf16_t* o; __device__ void operator()(int r, int c, float v) const { if (c >= WIN_GK && c < WIN_GK + 16) return; const int cc = c < WIN_GK ? c : c - 16; o[(size_t)r * LDP + cc] = f2bf(v); } };
struct NEpiGlu { const bf16_t* yA; const float* b; bf16_t* z; __device__ void operator()(int r, int c, float v) const { const float y = bf2f(yA[(size_t)r * S5W + c]); z[(size_t)r * S5W + c] = f2bf(y * sigmoidf_(v + b[c])); } };
struct NEpiPA { const bf16_t* proj; float* t; __device__ void operator()(int r, int c, float v) const { t[(size_t)r * D + c] = sigmoidf_(bf2f(proj[(size_t)r * LDP + OFF_GA + c])) * v; } };
struct NEpiPB { const bf16_t* proj; const float* t; bf16_t* m; __device__ void operator()(int r, int c, float v) const { m[(size_t)r * D + c] = f2bf(t[(size_t)r * D + c] + sigmoidf_(bf2f(proj[(size_t)r * LDP + OFF_GB + c])) * v); } };
struct NEpiOut { const float* x; const float* mod; float* x1; __device__ void operator()(int r, int c, float v) const { const int b = r / SEQ; x1[(size_t)r * D + c] = x[(size_t)r * D + c] + mod[b * 6144 + 2 * D + c] * v; } };
struct NEpiF32 { float* o; long ld; __device__ void operator()(int r, int c, float v) const { o[(size_t)r * ld + c] = v; } };
struct NEpiShUp { const float* g; bf16_t* h; __device__ void operator()(int r, int c, float v) const { h[(size_t)r * SFF + c] = f2bf(siluf_(g[(size_t)r * SFF + c]) * v); } };
struct NEpiBf { bf16_t* o; long ld; __device__ void operator()(int r, int c, float v) const { o[(size_t)r * ld + c] = f2bf(v); } };
__global__ void __launch_bounds__(256) k_moe_naive(P p) {
  __shared__ float xs[16][1024];
  __shared__ float hs[16][256];
  __shared__ int toks[16];
  const int s0 = blockIdx.x * 16, e = p.blk_exp[s0 / 128], tid = threadIdx.x;
  if (e < 0) return;
  if (tid < 16) toks[tid] = p.slot_tok[s0 + tid];
  __syncthreads();
  bool any = false;
  for (int s = 0; s < 16; ++s) any |= toks[s] >= 0;
  if (!any) return;
  for (int i = tid; i < 16 * 1024; i += 256) { const int s = i >> 10, d = i & 1023; xs[s][d] = toks[s] >= 0 ? bf2f(p.h2[(size_t)toks[s] * D + d]) : 0.f; }
  __syncthreads();
  {
    float ag[16], au[16];
    for (int s = 0; s < 16; ++s) { ag[s] = 0.f; au[s] = 0.f; }
    const float* wg = p.ew_gate + (size_t)e * D * EFF + tid;
    const float* wu = p.ew_up + (size_t)e * D * EFF + tid;
    for (int d = 0; d < D; ++d) {
      const float g = wg[(size_t)d * EFF], u = wu[(size_t)d * EFF];
      for (int s = 0; s < 16; ++s) { const float xv = xs[s][d]; ag[s] += xv * g; au[s] += xv * u; }
    }
    for (int s = 0; s < 16; ++s) hs[s][tid] = bf2f(f2bf(siluf_(ag[s]) * au[s]));
  }
  __syncthreads();
  for (int nb = 0; nb < 4; ++nb) {
    float acc[16];
    for (int s = 0; s < 16; ++s) acc[s] = 0.f;
    const float* wd = p.ew_down + (size_t)e * EFF * D + nb * 256 + tid;
    for (int j = 0; j < EFF; ++j) { const float w = wd[(size_t)j * D]; for (int s = 0; s < 16; ++s) acc[s] += hs[s][j] * w; }
    for (int s = 0; s < 16; ++s) if (toks[s] >= 0) p.Y[(size_t)(s0 + s) * D + nb * 256 + tid] = f2bf(acc[s]);
  }
}

#define SMEM_DECL __shared__ __attribute__((aligned(16))) unsigned char smem_raw[SMEM_BYTES]; const lds_ptr smem = (lds_ptr)smem_raw;


#define XB_TMO      128
#define XB_XCNT(j)  (256  + 64 * (j))
#define XB_XSUB(j)  (1280 + 64 * (j))
#define XB_XGEN(j)  (2304 + 64 * (j))
#define XB_TOP      3328
#define XB_TOPGEN   3392
#define XCD_BAR_WORDS 3456
#define XB_SPIN_CAP (1u << 18)
__device__ __forceinline__ unsigned xb_ld(unsigned* q)              { return __hip_atomic_load(q, __ATOMIC_RELAXED, __HIP_MEMORY_SCOPE_AGENT); }
__device__ __forceinline__ unsigned xb_add(unsigned* q, unsigned v) { return __hip_atomic_fetch_add(q, v, __ATOMIC_RELAXED, __HIP_MEMORY_SCOPE_AGENT); }
__device__ __forceinline__ unsigned xb_xcc_id() { return (unsigned)__builtin_amdgcn_s_getreg((3 << 11) | 20) & 0xFu; }
#define XB_SPIN(cond, bar) do { unsigned _sp = 0; while (cond) { __builtin_amdgcn_s_sleep(1); \
    if ((++_sp & 255u) == 0u) { if (xb_ld(&(bar)[XB_TMO])) break; if (_sp > XB_SPIN_CAP) { atomicAdd(&(bar)[XB_TMO], 1u); break; } } } } while (0)
struct XcdBarrier { unsigned* bar; unsigned x; volatile LAS unsigned* st; };
__device__ __forceinline__ XcdBarrier xcd_barrier_post(unsigned* bar, volatile LAS unsigned* st) {
  XcdBarrier b; b.bar = bar; b.x = xb_xcc_id(); b.st = st;
  if (threadIdx.x == 0) (void)xb_add(&bar[XB_XCNT(b.x)], 1u);
  return b;
}
__device__ __forceinline__ void xcd_barrier_complete(unsigned* bar, unsigned x, unsigned& nloc, unsigned& nx) {
  const unsigned G = gridDim.x * gridDim.y * gridDim.z;
  unsigned sum, cnt, mine, sp = 0u;
  for (;;) {
    sum = 0u; cnt = 0u; mine = 0u;
#pragma unroll
    for (unsigned j = 0; j < 16; ++j) { const unsigned c = xb_ld(&bar[XB_XCNT(j)]); sum += c; cnt += (c > 0u) ? 1u : 0u; mine = (j == x) ? c : mine; }
    if (sum == G) break;
    __builtin_amdgcn_s_sleep(1);
    if ((++sp & 255u) == 0u) { if (xb_ld(&bar[XB_TMO])) break; if (sp > XB_SPIN_CAP) { atomicAdd(&bar[XB_TMO], 1u); break; } }
  }
  nloc = mine > 0u ? mine : 1u; nx = cnt > 0u ? cnt : 1u;
}
__device__ __forceinline__ void xcd_barrier(const XcdBarrier& b) {
  asm volatile("s_waitcnt vmcnt(0)" ::: "memory");
  __syncthreads();
  if (threadIdx.x == 0) {
    unsigned* bar = b.bar;
    __builtin_amdgcn_s_waitcnt(0);
    unsigned nloc = b.st[0], nx = b.st[1];
    if (nloc == 0u) { xcd_barrier_complete(bar, b.x, nloc, nx); b.st[0] = nloc; b.st[1] = nx; }
    const unsigned old = xb_add(&bar[XB_XSUB(b.x)], 1u);
    const unsigned gen = old / nloc;
    if (old + 1u == (gen + 1u) * nloc) {
      __builtin_amdgcn_fence(__ATOMIC_RELEASE, "agent");
      asm volatile("s_waitcnt vmcnt(0)" ::: "memory");
      const unsigned og = xb_add(&bar[XB_TOP], 1u);
      const unsigned tg = og / nx;
      if (og + 1u == (tg + 1u) * nx) xb_add(&bar[XB_TOPGEN], 1u);
      else XB_SPIN(xb_ld(&bar[XB_TOPGEN]) == tg, bar);
      __builtin_amdgcn_fence(__ATOMIC_ACQUIRE, "agent");
      xb_add(&bar[XB_XGEN(b.x)], 1u);
      asm volatile("s_waitcnt vmcnt(0)" ::: "memory");
    } else {
      XB_SPIN(xb_ld(&bar[XB_XGEN(b.x)]) == gen, bar);
      __builtin_amdgcn_fence(__ATOMIC_ACQUIRE, "agent");
      asm volatile("s_waitcnt vmcnt(0)" ::: "memory");
    }
  }
  __syncthreads();
}

__device__ __forceinline__ const __attribute__((address_space(4))) P* kargs() { auto q = __builtin_amdgcn_kernarg_segment_ptr(); asm volatile("" : "+s"(q)); return (const __attribute__((address_space(4))) P*)q; }
#define PK (*kargs())
__global__ void __launch_bounds__(NTHR) k_fused(P p_unused) {
  SMEM_DECL
  const int bid = blockIdx.x, nb = gridDim.x;
  volatile LAS unsigned* xbw = (volatile LAS unsigned*)(smem + SMEM_BYTES - 16);
  if (threadIdx.x == 0) { xbw[0] = 0u; xbw[1] = 0u; }
  __syncthreads();
  const XcdBarrier xb = xcd_barrier_post(PK.bar, xbw);
#define GSYNC() xcd_barrier(xb)
#define RUN(k, ...) do { __VA_ARGS__; if (REP_PHASE == (k)) { __VA_ARGS__; } } while (0)
  RUN(0, phase_prep(PK, bid, nb, smem));                                                                   GSYNC();
  RUN(1, phase_norm<false>(PK, PK.x, PK.norm1_g, 0, D, PK.h1, bid, nb, smem));                                 GSYNC();
  RUN(2, phase_gemm_dense256_bf16(PK.h1, D, PK.wb_in, LDP, T, LDP, D, PK.proj, LDP, bid, nb, smem); gk_rows(PK, bid, nb));     GSYNC();
  RUN(3, phase_mix_local(PK, bid, nb, smem, 3));                                                           GSYNC();
  RUN(4, phase_mix_carry(PK, bid, nb, 3));                                                                 GSYNC();
  RUN(5, phase_mix_final(PK, bid, nb, smem, 3));                                                           GSYNC();
  RUN(6, phase_gemm_dense(PK.yA, S5W, PK.wb_glu, S5W, T, S5W, S5W, EpiGlu{PK.yA, PK.b_glu, PK.zA}, bid, nb, smem));   GSYNC();
  RUN(7, phase_gemm_mixed(PK, bid, nb, smem));                                                             GSYNC();
  RUN(8, phase_gemm_dense256(PK.mixed, D, PK.wb_out, D, T, D, D, EpiOut{PK.x, PK.mod, PK.x1}, bid, nb, smem));    GSYNC();
  RUN(9, phase_norm<false>(PK, PK.x1, PK.norm2_g, 3 * D, 4 * D, PK.h2, bid, nb, smem));                       GSYNC();
  RUN(10, phase_gemm_rs(PK, bid, nb, smem));                                                               GSYNC();
  phase_route(PK, bid, nb);                                                                                GSYNC();
  RUN(12, phase_scatter(PK, bid, nb, smem));                                                               GSYNC();
  phase_moe_pair<1>(PK, bid, nb, smem);                                                                    GSYNC();
  phase_moe_pair<2>(PK, bid, nb, smem);
  RUN(14, phase_gemm_dense256_bf16(PK.shH, SFF, PK.wb_sd, D, T, D, SFF, PK.S, D, bid, nb, smem));        GSYNC();
  RUN(15, phase_combine(PK, bid, nb));
}

static inline size_t al256(size_t v) { return (v + 255) & ~(size_t)255; }

extern "C" void kernel_launch(void* const* d_in, const int* in_sizes, int n_in, void* d_out, int out_size, void* d_ws, size_t ws_size, hipStream_t stream) {
  P p{};
  const float** pin = (const float**)&p;
  for (int i = 0; i < 32; ++i) pin[i] = (const float*)d_in[i];
  p.out = (float*)d_out;
  char* w = (char*)d_ws; size_t off = 0;
  auto take = [&](size_t bytes) { char* r = w + off; off = al256(off + bytes); return (void*)r; };
  p.mod = (float*)take(8 * 6144 * 4);
  p.wb_in = (bf16_t*)take((size_t)D * LDP * 2);
  p.wb_glu = (bf16_t*)take((size_t)S5W * S5W * 2);
  p.wb_pa = (bf16_t*)take((size_t)S5W * D * 2);
  p.wb_pb = (bf16_t*)take((size_t)GVAL * D * 2);
  p.wb_out = (bf16_t*)take((size_t)D * D * 2);
  p.wb_rs = (bf16_t*)take((size_t)D * 768 * 2);
  p.wb_sd = (bf16_t*)take((size_t)SFF * D * 2);
  p.h1 = (bf16_t*)take((size_t)T * D * 2);
  p.gkl = (float*)take((size_t)T * 16 * 4);
  p.proj = (bf16_t*)take((size_t)T * LDP * 2);
  p.abar = (float*)take(S5G * S5P * 2 * 4);
  p.bbar = (float*)take(S5G * S5P * S5H * 2 * 4);
  p.yA = (bf16_t*)take((size_t)T * S5W * 2);
  p.oraw = (float*)take((size_t)T * GVAL * 4);
  p.yB = (bf16_t*)take((size_t)T * GVAL * 2);
  p.zA = (bf16_t*)take((size_t)T * S5W * 2);
  p.mixed = (bf16_t*)take((size_t)T * D * 2);
  p.x1 = (float*)take((size_t)T * D * 4);
  p.h2 = (bf16_t*)take((size_t)T * D * 2);
  p.logits = (float*)take((size_t)T * NE * 4);
  p.tk_idx = (int*)take((size_t)T * 8 * 4);
  p.tk_w = (float*)take((size_t)T * 8 * 4);
  p.tk_rank = (int*)take((size_t)T * 8 * 4);
  p.slot_of = (int*)take((size_t)T * 8 * 4);
  p.counts = (int*)take(256 * 4);
  p.pad_start = (int*)take(257 * 4);
  p.blk_exp = (int*)take(NBLK128 * 4);
  p.slot_tok = (int*)take((size_t)NSLOT * 4);
  p.Y = (bf16_t*)take((size_t)NSLOT * D * 2);
  p.shH = (bf16_t*)take((size_t)T * SFF * 2);
  p.S = (bf16_t*)take((size_t)T * D * 2);
  p.bbarT = (bf16_t*)take((size_t)S5G * 128 * 16 * 2);
  p.cmT = (bf16_t*)take((size_t)S5G * 16 * 128 * 2);
  p.apow64 = (float*)take(S5G * S5P * 2 * 4);
  p.s5E = (float*)take((size_t)NB * 32 * S5G * 64 * 2 * 4);
  p.s5Sin = (float*)take((size_t)NB * 32 * S5G * 64 * 2 * 4);
  p.glaKV = (float*)take((size_t)1024 * 64 * 128 * 4);
  p.glaDec = (float*)take((size_t)1024 * 64 * 4);
  p.glaSin = (bf16_t*)take((size_t)1024 * 64 * 128 * 2);
  p.wgkT = (bf16_t*)take((size_t)16 * D * 2);
  p.moe_list = (int*)take((size_t)8 * NBLK128 * 4);
  p.moe_cnt = (int*)take(64);
  p.moe_ctr = (int*)take(64);
  p.Hbuf = (bf16_t*)take((size_t)NSLOT * EFF * 2);
  p.bar = (unsigned*)take(XCD_BAR_WORDS * 4);
  if (off > ws_size) { fprintf(stderr, "workspace too small: need %zu have %zu\n", off, ws_size); return; }

  static int grid_blocks = 0;
  if (!grid_blocks) {
    int dev = 0, cus = 0, per_cu = 0;
    (void)hipGetDevice(&dev);
    (void)hipDeviceGetAttribute(&cus, hipDeviceAttributeMultiprocessorCount, dev);
    (void)hipOccupancyMaxActiveBlocksPerMultiprocessor(&per_cu, k_fused, NTHR, 0);
    grid_blocks = (per_cu >= 1) ? cus : 0;
    grid_blocks &= ~7;
    if (grid_blocks <= 0) { fprintf(stderr, "occupancy query says the fused kernel does not fit (per_cu=%d cus=%d)\n", per_cu, cus); grid_blocks = 0; return; }
  }
  (void)hipMemsetAsync(p.bar, 0, XCD_BAR_WORDS * 4, stream);
  void* args[] = {&p};
  hipError_t e = hipLaunchCooperativeKernel((const void*)k_fused, dim3(grid_blocks), dim3(NTHR), args, 0, stream);
  if (e != hipSuccess) fprintf(stderr, "cooperative launch failed: %s (grid %d)\n", hipGetErrorString(e), grid_blocks);
}
```

```cpp
#include <hip/hip_runtime.h>
#include <hip/hip_cooperative_groups.h>
namespace cg = cooperative_groups;
#include <cstdint>
#include <cstdio>

typedef unsigned short bf16_t;
typedef short s16x8 __attribute__((ext_vector_type(8)));
typedef short s16x4 __attribute__((ext_vector_type(4)));
typedef float f32x4 __attribute__((ext_vector_type(4)));
typedef unsigned u32x4 __attribute__((ext_vector_type(4)));
typedef unsigned u32x2 __attribute__((ext_vector_type(2)));
#define LAS __attribute__((address_space(3)))
typedef LAS unsigned char* lds_ptr;

constexpr int D = 1024, NB = 8, SEQ = 2048, T = NB * SEQ;
constexpr int S5W = 512, S5G = 32, S5H = 16, S5P = 64;
constexpr int GH = 4, GDK = 64, GDV = 128, GKEY = 256, GVAL = 512, GRANK = 16;
constexpr int NE = 256, TOPK = 8, NGRP = 8, EFF = 256, SFF = 256;
constexpr int INW = 4112, LDP = 4096;
constexpr int OFF_U = 0, OFF_Q = 512, OFF_K = 768, OFF_V = 1024, OFF_R = 1536, OFF_GA = 2048, OFF_GB = 3072;
constexpr int WIN_GK = 1536;
constexpr int NSLOT = 163584, NBLK128 = NSLOT / 128;
constexpr int NTHR = 512;
constexpr int USE_MFMA = 127;
constexpr int USE_NEW = 7;
constexpr int REP_PHASE = -1;
constexpr int MOE_REP_GU = 1, MOE_REP_DN = 1;

__device__ __forceinline__ float bf2f(bf16_t v) { return __uint_as_float(((unsigned)v) << 16); }
__device__ __forceinline__ bf16_t f2bf(float f) { return __builtin_bit_cast(unsigned short, (__bf16)f); }
typedef float f32x2 __attribute__((ext_vector_type(2)));
typedef __bf16 bf16x2_t __attribute__((ext_vector_type(2)));
__device__ __forceinline__ unsigned cvtpk(float lo, float hi) { const f32x2 v = {lo, hi}; return __builtin_bit_cast(unsigned, __builtin_convertvector(v, bf16x2_t)); }
__device__ __forceinline__ float sigmoidf_(float x) { return __builtin_amdgcn_rcpf(1.f + __expf(-x)); }
__device__ __forceinline__ float siluf_(float x) { return x * __builtin_amdgcn_rcpf(1.f + __expf(-x)); }
__device__ __forceinline__ float geluf_(float x) { const float u = 0.7978845608028654f * (x + 0.044715f * x * x * x); return x * __builtin_amdgcn_rcpf(1.f + __expf(-2.f * u)); }
__device__ __forceinline__ float logsigmoidf_(float x) { return fminf(x, 0.f) - __logf(1.f + __expf(-fabsf(x))); }

struct P;
typedef const __attribute__((address_space(4))) P& PR;

__device__ __forceinline__ int ltid() { int t = threadIdx.x; asm volatile("" : "+v"(t)); return t; }

struct P {
  const float *x, *c, *ada_w, *ada_b, *norm1_g, *w_in, *lam_re, *lam_im, *log_dt, *b_re, *b_im, *c_re, *c_im, *s5_d, *w_glu, *b_glu, *w_proj_a,
      *w_gk2, *b_gk2, *gla_norm_g, *w_proj_b, *w_out, *norm2_g, *router_w, *router_bias, *ew_gate, *ew_up, *ew_down, *sw_gate, *sw_up, *sw_down, *final_g;
  float* out;
  float* mod;
  bf16_t* wb_in;
  bf16_t* wb_glu;
  bf16_t* wb_pa;
  bf16_t* wb_pb;
  bf16_t* wb_out;
  bf16_t* wb_rs;
  bf16_t* wb_sd;
  bf16_t* h1;
  float* gkl;
  bf16_t* proj;
  float* abar;
  float* bbar;
  bf16_t* yA;
  float* oraw;
  bf16_t* yB;
  bf16_t* zA;
  bf16_t* mixed;
  float* x1;
  bf16_t* h2;
  float* logits;
  int* tk_idx;
  float* tk_w;
  int* tk_rank;
  int* slot_of;
  int* counts;
  int* pad_start;
  int* blk_exp;
  int* slot_tok;
  bf16_t* Y;
  bf16_t* shH;
  bf16_t* S;
  bf16_t* bbarT;
  bf16_t* cmT;
  float* apow64;
  float* s5E;
  float* s5Sin;
  float* glaKV;
  float* glaDec;
  bf16_t* glaSin;
  bf16_t* wgkT;
  int* moe_list;
  int* moe_cnt;
  int* moe_ctr;
  bf16_t* Hbuf;
  unsigned* bar;
};

constexpr int G_ASZ = 128 * 64, G_BSZ = 32 * 512, G_STAGE = G_ASZ + G_BSZ;

__device__ __forceinline__ int a_off(int r, int c) { return r * 64 + ((c ^ ((0x78 >> (((r >> 2) & 3) * 2)) & 3)) << 4); }
__device__ __forceinline__ int b_off(int k, int ch) { return k * 512 + ((ch ^ ((k & 3) | (((k >> 3) & 1) << 2))) << 5); }
__device__ __forceinline__ s16x4 tr_read(lds_ptr p) { return __builtin_bit_cast(s16x4, __builtin_amdgcn_ds_read_tr16_b64_v4i16((LAS s16x4*)p)); }

struct ALoadDense { const bf16_t* A; long lda; __device__ __forceinline__ const bf16_t* rowptr(int r) const { return A + (size_t)r * lda; } };
struct ALoadGatherLds { const bf16_t* A; LAS int* tk; __device__ __forceinline__ const bf16_t* rowptr(int r) const { int t = tk[r]; t = t < 0 ? 0 : t; return A + (size_t)t * D; } };
struct BLoadBf { const bf16_t* Bm; long ldb;
  __device__ __forceinline__ u32x4 load(int kg, int c8) const { return *(const u32x4*)(Bm + (size_t)kg * ldb + c8 * 8); } };
struct BLoadF32 { const float* Bm; long ldb;
  __device__ __forceinline__ u32x4 load(int kg, int c8) const { const float* q = Bm + (size_t)kg * ldb + c8 * 8; const f32x4 a = *(const f32x4*)q, b = *(const f32x4*)(q + 4);
    u32x4 r; r.x = cvtpk(a[0], a[1]); r.y = cvtpk(a[2], a[3]); r.z = cvtpk(b[0], b[1]); r.w = cvtpk(b[2], b[3]); return r; } };
struct BLoadGU { const float* Wg; const float* Wu; long ldb; int h0;
  __device__ __forceinline__ u32x4 load(int kg, int c8) const { const int col = c8 * 8, w = col >> 6, xx = col & 63; const float* base = (xx < 32) ? Wg : Wu;
    const float* q = base + (size_t)kg * ldb + h0 + 32 * w + (xx & 31); const f32x4 a = *(const f32x4*)q, b = *(const f32x4*)(q + 4);
    u32x4 r; r.x = cvtpk(a[0], a[1]); r.y = cvtpk(a[2], a[3]); r.z = cvtpk(b[0], b[1]); r.w = cvtpk(b[2], b[3]); return r; } };

template <bool A_RES, class AL, class BL>
__device__ __forceinline__ void gemm_mainloop(f32x4 (&acc)[4][4], const AL& al, const BL& bl, int nk, lds_ptr stage, lds_ptr resA) {
  const int tid = ltid(), lane = tid & 63, wid = tid >> 6, wm = wid >> 2, wn = wid & 3, fr = lane & 15, fq = lane >> 4;
  const int ar = tid >> 2, ac = tid & 3;
  const int p0 = tid, p1 = tid + 512;
  const int bk0 = p0 >> 5, bc0 = p0 & 31, bk1 = p1 >> 5, bc1 = p1 & 31;
  const bf16_t* aptr = nullptr;
  if (!A_RES) aptr = al.rowptr(ar) + ac * 8;
  const int a_st = a_off(ar, ac);
  const int b_st0 = b_off(bk0, bc0 >> 1) + (bc0 & 1) * 16, b_st1 = b_off(bk1, bc1 >> 1) + (bc1 & 1) * 16;
  int a_rd[4];
#pragma unroll
  for (int mt = 0; mt < 4; ++mt) a_rd[mt] = a_off(wm * 64 + mt * 16 + fr, fq);
  int b_rd[4][2];
#pragma unroll
  for (int nt = 0; nt < 4; ++nt) {
    b_rd[nt][0] = b_off(8 * fq + (fr >> 2), wn * 4 + nt) + (fr & 3) * 8;
    b_rd[nt][1] = b_off(8 * fq + 4 + (fr >> 2), wn * 4 + nt) + (fr & 3) * 8;
  }
#pragma unroll
  for (int mt = 0; mt < 4; ++mt)
#pragma unroll
    for (int nt = 0; nt < 4; ++nt) acc[mt][nt] = (f32x4){0.f, 0.f, 0.f, 0.f};
  u32x4 areg = {0, 0, 0, 0}, breg0, breg1;
  if (!A_RES) areg = *(const u32x4*)aptr;
  breg0 = bl.load(bk0, bc0); breg1 = bl.load(bk1, bc1);
  __syncthreads();
  if (!A_RES) *(LAS u32x4*)(stage + a_st) = areg;
  *(LAS u32x4*)(stage + G_ASZ + b_st0) = breg0;
  *(LAS u32x4*)(stage + G_ASZ + b_st1) = breg1;
  __syncthreads();
  for (int kt = 0; kt < nk; ++kt) {
    const lds_ptr cur = stage + (kt & 1) * G_STAGE, nxt = stage + ((kt + 1) & 1) * G_STAGE;
    const bool more = kt + 1 < nk;
    if (more) {
      if (!A_RES) areg = *(const u32x4*)(aptr + (kt + 1) * 32);
      breg0 = bl.load((kt + 1) * 32 + bk0, bc0); breg1 = bl.load((kt + 1) * 32 + bk1, bc1);
    }
    s16x8 af[4], bfr[4];
    const lds_ptr abase = A_RES ? (resA + kt * G_ASZ) : cur;
#pragma unroll
    for (int mt = 0; mt < 4; ++mt) af[mt] = *(LAS s16x8*)(abase + a_rd[mt]);
#pragma unroll
    for (int nt = 0; nt < 4; ++nt) {
      const s16x4 lo = tr_read(cur + G_ASZ + b_rd[nt][0]), hi = tr_read(cur + G_ASZ + b_rd[nt][1]);
      bfr[nt] = __builtin_shufflevector(lo, hi, 0, 1, 2, 3, 4, 5, 6, 7);
    }
#pragma unroll
    for (int mt = 0; mt < 4; ++mt)
#pragma unroll
      for (int nt = 0; nt < 4; ++nt) acc[mt][nt] = __builtin_amdgcn_mfma_f32_16x16x32_bf16(bfr[nt], af[mt], acc[mt][nt], 0, 0, 0);
    if (more) {
      if (!A_RES) *(LAS u32x4*)(nxt + a_st) = areg;
      *(LAS u32x4*)(nxt + G_ASZ + b_st0) = breg0;
      *(LAS u32x4*)(nxt + G_ASZ + b_st1) = breg1;
    }
    __syncthreads();
  }
}


struct BRaw { f32x4 v[4]; };
struct BLoadF32R { const float* Bm; long ldb;
  __device__ __forceinline__ void load(BRaw& r, int kbase, int tid) const {
    const float* q = Bm + (size_t)(kbase + (tid >> 6)) * ldb + (tid & 63) * 4;
#pragma unroll
    for (int i = 0; i < 4; ++i) r.v[i] = *(const f32x4*)(q + (size_t)(8 * i) * ldb); } };
struct BLoadGUR { const float* Wg; long du; long ldb; int h0;
  __device__ __forceinline__ void load(BRaw& r, int kbase, int tid) const {
    const int col = (tid & 63) * 4, w = col >> 6, xx = col & 63;
    const float* q = Wg + ((xx < 32) ? 0l : du) + (size_t)(kbase + (tid >> 6)) * ldb + h0 + 32 * w + (xx & 31);
#pragma unroll
    for (int i = 0; i < 4; ++i) r.v[i] = *(const f32x4*)(q + (size_t)(8 * i) * ldb); } };
__device__ __forceinline__ u32x4 cvt8(const f32x4& a, const f32x4& b) { u32x4 r; r.x = cvtpk(a[0], a[1]); r.y = cvtpk(a[2], a[3]); r.z = cvtpk(b[0], b[1]); r.w = cvtpk(b[2], b[3]); return r; }

template <bool A_RES, class AL, class BL>
__device__ __forceinline__ void gemm_mainloop_r3(f32x4 (&acc)[4][4], const AL& al, const BL& bl, int nk, lds_ptr stage, lds_ptr resA) {
  const int tid = ltid(), lane = tid & 63, wid = tid >> 6, wm = wid >> 2, wn = wid & 3, fr = lane & 15, fq = lane >> 4;
  const int ar = tid >> 2, ac = tid & 3;
  const bf16_t* aptr = nullptr;
  if (!A_RES) aptr = al.rowptr(ar) + ac * 8;
  const int a_st = a_off(ar, ac);
  int b_st[4];
#pragma unroll
  for (int i = 0; i < 4; ++i) b_st[i] = G_ASZ + b_off((tid >> 6) + 8 * i, (tid & 63) >> 2) + (tid & 3) * 8;
  int a_rd[4];
#pragma unroll
  for (int mt = 0; mt < 4; ++mt) a_rd[mt] = a_off(wm * 64 + mt * 16 + fr, fq);
  int b_rd[4][2];
#pragma unroll
  for (int nt = 0; nt < 4; ++nt) {
    b_rd[nt][0] = G_ASZ + b_off(8 * fq + (fr >> 2), wn * 4 + nt) + (fr & 3) * 8;
    b_rd[nt][1] = G_ASZ + b_off(8 * fq + 4 + (fr >> 2), wn * 4 + nt) + (fr & 3) * 8;
  }
#pragma unroll
  for (int mt = 0; mt < 4; ++mt)
#pragma unroll
    for (int nt = 0; nt < 4; ++nt) acc[mt][nt] = (f32x4){0.f, 0.f, 0.f, 0.f};
  u32x4 ra0 = {0, 0, 0, 0}, ra1 = {0, 0, 0, 0}, ra2 = {0, 0, 0, 0};
  BRaw rb0, rb1, rb2;
#define R3_LOAD(RA, RB, kt_) do { if (!A_RES) RA = *(const u32x4*)(aptr + (size_t)(kt_) * 32); bl.load(RB, (kt_) * 32, tid); } while (0)
#define R3_STORE(RA, RB, st_) do { const lds_ptr s_ = stage + (st_) * G_STAGE; if (!A_RES) *(LAS u32x4*)(s_ + a_st) = RA; \
    _Pragma("unroll") for (int i_ = 0; i_ < 4; ++i_) { u32x2 o_; o_.x = cvtpk(RB.v[i_][0], RB.v[i_][1]); o_.y = cvtpk(RB.v[i_][2], RB.v[i_][3]); *(LAS u32x2*)(s_ + b_st[i_]) = o_; } } while (0)
#define R3_COMPUTE(kt_) do { const lds_ptr cur = stage + ((kt_) & 1) * G_STAGE; const lds_ptr abase = A_RES ? (resA + (kt_) * G_ASZ) : cur; \
    s16x8 af[4], bfr[4]; \
    _Pragma("unroll") for (int mt = 0; mt < 4; ++mt) af[mt] = *(LAS s16x8*)(abase + a_rd[mt]); \
    _Pragma("unroll") for (int nt = 0; nt < 4; ++nt) { const s16x4 lo = tr_read(cur + b_rd[nt][0]), hi = tr_read(cur + b_rd[nt][1]); bfr[nt] = __builtin_shufflevector(lo, hi, 0, 1, 2, 3, 4, 5, 6, 7); } \
    _Pragma("unroll") for (int mt = 0; mt < 4; ++mt) _Pragma("unroll") for (int nt = 0; nt < 4; ++nt) acc[mt][nt] = __builtin_amdgcn_mfma_f32_16x16x32_bf16(bfr[nt], af[mt], acc[mt][nt], 0, 0, 0); } while (0)
#define R3_BODY_U(kt_, RAN, RBN, RAW, RBW) do { const int kl_ = ((kt_) + 3 < nk) ? (kt_) + 3 : nk - 1; R3_LOAD(RAN, RBN, kl_); __builtin_amdgcn_sched_barrier(0); R3_COMPUTE(kt_); __builtin_amdgcn_sched_barrier(0); R3_STORE(RAW, RBW, ((kt_) + 1) & 1); __syncthreads(); } while (0)
#define R3_BODY_T(kt_, RAW, RBW) do { R3_COMPUTE(kt_); if ((kt_) + 1 < nk) R3_STORE(RAW, RBW, ((kt_) + 1) & 1); __syncthreads(); } while (0)
  R3_LOAD(ra0, rb0, 0);
  R3_LOAD(ra1, rb1, 1);
  R3_LOAD(ra2, rb2, 2);
  __syncthreads();
  R3_STORE(ra0, rb0, 0);
  __syncthreads();
  int kt = 0;
  for (; kt + 3 <= nk; kt += 3) {
    R3_BODY_U(kt, ra0, rb0, ra1, rb1);
    R3_BODY_U(kt + 1, ra1, rb1, ra2, rb2);
    R3_BODY_U(kt + 2, ra2, rb2, ra0, rb0);
  }
  if (kt < nk) { R3_BODY_T(kt, ra1, rb1); if (kt + 1 < nk) R3_BODY_T(kt + 1, ra2, rb2); }
#undef R3_BODY_U
#undef R3_BODY_T
#undef R3_LOAD
#undef R3_STORE
#undef R3_COMPUTE
}

constexpr int G_NST = 4;
#define WAIT_VM(n) asm volatile("s_waitcnt vmcnt(" #n ")" ::: "memory")
template <class AL>
__device__ __forceinline__ void gemm_mainloop_glds(f32x4 (&acc)[4][4], const AL& al, const bf16_t* __restrict__ Bm, long ldb, int nk, lds_ptr ring) {
  const int tid = ltid(), lane = tid & 63, wid = tid >> 6, wm = wid >> 2, wn = wid & 3, fr = lane & 15, fq = lane >> 4;
  const int ar = tid >> 2;
  const bf16_t* aptr = al.rowptr(ar) + (((tid & 3) ^ ((0x78 >> (((ar >> 2) & 3) * 2)) & 3)) << 3);
  const int bk = tid >> 5, pc = tid & 31;
  const int bcol = ((((pc >> 1) ^ ((bk & 3) | (((bk >> 3) & 1) << 2))) << 4) | ((pc & 1) << 3));
  const bf16_t* bptr0 = Bm + (size_t)bk * ldb + bcol;
  const bf16_t* bptr1 = bptr0 + (size_t)16 * ldb;
  const size_t bstep = (size_t)32 * ldb;
  int a_rd[4];
#pragma unroll
  for (int mt = 0; mt < 4; ++mt) a_rd[mt] = a_off(wm * 64 + mt * 16 + fr, fq);
  int b_rd[4][2];
#pragma unroll
  for (int nt = 0; nt < 4; ++nt) {
    b_rd[nt][0] = G_ASZ + b_off(8 * fq + (fr >> 2), wn * 4 + nt) + (fr & 3) * 8;
    b_rd[nt][1] = G_ASZ + b_off(8 * fq + 4 + (fr >> 2), wn * 4 + nt) + (fr & 3) * 8;
  }
#pragma unroll
  for (int mt = 0; mt < 4; ++mt)
#pragma unroll
    for (int nt = 0; nt < 4; ++nt) acc[mt][nt] = (f32x4){0.f, 0.f, 0.f, 0.f};
  const lds_ptr dstl = ring + tid * 16;
#define GLDS_ISSUE(kt_) do { const lds_ptr d_ = dstl + ((kt_) & (G_NST - 1)) * G_STAGE; \
    __builtin_amdgcn_global_load_lds((const unsigned*)(aptr + (size_t)(kt_) * 32), (LAS unsigned*)(d_), 16, 0, 0); \
    __builtin_amdgcn_global_load_lds((const unsigned*)(bptr0 + (size_t)(kt_) * bstep), (LAS unsigned*)(d_ + G_ASZ), 16, 0, 0); \
    __builtin_amdgcn_global_load_lds((const unsigned*)(bptr1 + (size_t)(kt_) * bstep), (LAS unsigned*)(d_ + G_ASZ + 8192), 16, 0, 0); } while (0)
  __syncthreads();
  GLDS_ISSUE(0);
  if (nk > 1) GLDS_ISSUE(1);
  if (nk > 2) GLDS_ISSUE(2);
  for (int kt = 0; kt < nk; ++kt) {
    if (kt + 2 < nk) WAIT_VM(6); else if (kt + 1 < nk) WAIT_VM(3); else WAIT_VM(0);
    __builtin_amdgcn_s_barrier();
    if (kt + 3 < nk) GLDS_ISSUE(kt + 3);
    const lds_ptr cur = ring + (kt & (G_NST - 1)) * G_STAGE;
    s16x8 af[4], bfr[4];
#pragma unroll
    for (int mt = 0; mt < 4; ++mt) af[mt] = *(LAS s16x8*)(cur + a_rd[mt]);
#pragma unroll
    for (int nt = 0; nt < 4; ++nt) {
      const s16x4 lo = tr_read(cur + b_rd[nt][0]), hi = tr_read(cur + b_rd[nt][1]);
      bfr[nt] = __builtin_shufflevector(lo, hi, 0, 1, 2, 3, 4, 5, 6, 7);
    }
#pragma unroll
    for (int mt = 0; mt < 4; ++mt)
#pragma unroll
      for (int nt = 0; nt < 4; ++nt) acc[mt][nt] = __builtin_amdgcn_mfma_f32_16x16x32_bf16(bfr[nt], af[mt], acc[mt][nt], 0, 0, 0);
  }
#undef GLDS_ISSUE
}


constexpr int G2_STAGE = 2 * G_ASZ + G_BSZ;
__device__ __forceinline__ void gemm_mainloop_glds256(f32x4 (&acc)[8][4], const bf16_t* __restrict__ A, long lda, const bf16_t* __restrict__ Bm, long ldb, int nk, lds_ptr ring) {
  const int tid = ltid(), lane = tid & 63, wid = tid >> 6, wm = wid >> 2, wn = wid & 3, fr = lane & 15, fq = lane >> 4;
  const int ar = tid >> 2;
  const bf16_t* aptr0 = A + (size_t)ar * lda + (((tid & 3) ^ ((0x78 >> (((ar >> 2) & 3) * 2)) & 3)) << 3);
  const bf16_t* aptr1 = aptr0 + (size_t)128 * lda;
  const int bk = tid >> 5, pc = tid & 31;
  const int bcol = ((((pc >> 1) ^ ((bk & 3) | (((bk >> 3) & 1) << 2))) << 4) | ((pc & 1) << 3));
  const bf16_t* bptr0 = Bm + (size_t)bk * ldb + bcol;
  const bf16_t* bptr1 = bptr0 + (size_t)16 * ldb;
  const size_t bstep = (size_t)32 * ldb;
  int a_rd[8];
#pragma unroll
  for (int mt = 0; mt < 8; ++mt) a_rd[mt] = wm * G_ASZ + a_off(mt * 16 + fr, fq);
  int b_rd[4][2];
#pragma unroll
  for (int nt = 0; nt < 4; ++nt) {
    b_rd[nt][0] = 2 * G_ASZ + b_off(8 * fq + (fr >> 2), wn * 4 + nt) + (fr & 3) * 8;
    b_rd[nt][1] = 2 * G_ASZ + b_off(8 * fq + 4 + (fr >> 2), wn * 4 + nt) + (fr & 3) * 8;
  }
#pragma unroll
  for (int mt = 0; mt < 8; ++mt)
#pragma unroll
    for (int nt = 0; nt < 4; ++nt) acc[mt][nt] = (f32x4){0.f, 0.f, 0.f, 0.f};
  const lds_ptr dstl = ring + tid * 16;
#define GLDS2_ISSUE(kt_) do { const lds_ptr d_ = dstl + ((kt_) & (G_NST - 1)) * G2_STAGE; \
    __builtin_amdgcn_global_load_lds((const unsigned*)(aptr0 + (size_t)(kt_) * 32), (LAS unsigned*)(d_), 16, 0, 0); \
    __builtin_amdgcn_global_load_lds((const unsigned*)(aptr1 + (size_t)(kt_) * 32), (LAS unsigned*)(d_ + G_ASZ), 16, 0, 0); \
    __builtin_amdgcn_global_load_lds((const unsigned*)(bptr0 + (size_t)(kt_) * bstep), (LAS unsigned*)(d_ + 2 * G_ASZ), 16, 0, 0); \
    __builtin_amdgcn_global_load_lds((const unsigned*)(bptr1 + (size_t)(kt_) * bstep), (LAS unsigned*)(d_ + 2 * G_ASZ + 8192), 16, 0, 0); } while (0)
  __syncthreads();
  GLDS2_ISSUE(0);
  if (nk > 1) GLDS2_ISSUE(1);
  if (nk > 2) GLDS2_ISSUE(2);
  for (int kt = 0; kt < nk; ++kt) {
    if (kt + 2 < nk) WAIT_VM(8); else if (kt + 1 < nk) WAIT_VM(4); else WAIT_VM(0);
    __builtin_amdgcn_s_barrier();
    if (kt + 3 < nk) GLDS2_ISSUE(kt + 3);
    const lds_ptr cur = ring + (kt & (G_NST - 1)) * G2_STAGE;
    s16x8 bfr[4];
#pragma unroll
    for (int nt = 0; nt < 4; ++nt) {
      const s16x4 lo = tr_read(cur + b_rd[nt][0]), hi = tr_read(cur + b_rd[nt][1]);
      bfr[nt] = __builtin_shufflevector(lo, hi, 0, 1, 2, 3, 4, 5, 6, 7);
    }
#pragma unroll
    for (int h = 0; h < 2; ++h) {
      s16x8 af[4];
#pragma unroll
      for (int mt = 0; mt < 4; ++mt) af[mt] = *(LAS s16x8*)(cur + a_rd[h * 4 + mt]);
#pragma unroll
      for (int mt = 0; mt < 4; ++mt)
#pragma unroll
        for (int nt = 0; nt < 4; ++nt) acc[h * 4 + mt][nt] = __builtin_amdgcn_mfma_f32_16x16x32_bf16(bfr[nt], af[mt], acc[h * 4 + mt][nt], 0, 0, 0);
    }
  }
#undef GLDS2_ISSUE
}

__device__ __forceinline__ void tile_map(int round, int bid, int nb, int nMt, int nNt, int& mt, int& nt, bool& valid) {
  if (nb == 256 && (nNt & 3) == 0 && (nMt & 7) == 0) {
    const int xcd = bid & 7, j = bid >> 3, q = round * 8 + xcd, rn = nNt >> 2;
    const int rect_m = q / rn, rect_n = q % rn;
    mt = rect_m * 8 + (j & 7); nt = rect_n * 4 + (j >> 3); valid = mt < nMt;
  } else {
    const int per = (nb + 7) / 8, xcd = bid & 7, j = bid >> 3;
    const int idx = round * nb + xcd * per + j;
    mt = idx / nNt; nt = idx % nNt; valid = (j < per) && (idx < nMt * nNt) && (xcd * per + j < nb);
  }
}

__device__ __forceinline__ void cvt_copy(const float* __restrict__ src, long lds_, bf16_t* __restrict__ dst, long ldd, int rows, int cols, int gtid, int gsz) {
  const int c4 = cols >> 2;
  for (long i = gtid; i < (long)rows * c4; i += gsz) {
    const int r = (int)(i / c4), c = (int)(i % c4) * 4;
    const f32x4 v = *(const f32x4*)(src + (size_t)r * lds_ + c);
    u32x2 o; o.x = cvtpk(v[0], v[1]); o.y = cvtpk(v[2], v[3]);
    *(u32x2*)(dst + (size_t)r * ldd + c) = o;
  }
}
__device__ __forceinline__ void phase_prep(PR p, int bid, int nb, lds_ptr smem) {
  const int gtid = bid * NTHR + ltid(), gsz = nb * NTHR;
  cvt_copy(p.w_in, INW, p.wb_in, LDP, D, WIN_GK, gtid, gsz);
  cvt_copy(p.w_in + WIN_GK + 16, INW, p.wb_in + WIN_GK, LDP, D, LDP - WIN_GK, gtid, gsz);
  cvt_copy(p.w_glu, S5W, p.wb_glu, S5W, S5W, S5W, gtid, gsz);
  cvt_copy(p.w_proj_a, D, p.wb_pa, D, S5W, D, gtid, gsz);
  cvt_copy(p.w_proj_b, D, p.wb_pb, D, GVAL, D, gtid, gsz);
  cvt_copy(p.w_out, D, p.wb_out, D, D, D, gtid, gsz);
  cvt_copy(p.router_w, NE, p.wb_rs, 768, D, NE, gtid, gsz);
  cvt_copy(p.sw_down, D, p.wb_sd, D, SFF, D, gtid, gsz);
  for (long i = gtid; i < (long)D * 512; i += gsz) {
    const int k = (int)(i >> 9), cc = (int)(i & 511), w = cc >> 6, xx = cc & 63;
    const int hcol = 32 * w + (xx & 31);
    const float v = (xx < 32) ? p.sw_gate[(size_t)k * SFF + hcol] : p.sw_up[(size_t)k * SFF + hcol];
    p.wb_rs[(size_t)k * 768 + 256 + cc] = f2bf(v);
  }
  for (int i = gtid; i < 16 * D; i += gsz) { const int n = i >> 10, k = i & 1023; p.wgkT[i] = f2bf(p.w_in[(size_t)k * INW + WIN_GK + n]); }
  for (int i = gtid; i < NSLOT; i += gsz) p.slot_tok[i] = -1;
  if (gtid < 256) p.counts[gtid] = 0;
  if (gtid < 16) p.moe_ctr[gtid] = 0;
  if (ltid() < 8 && bid * 8 + ltid() < S5G * S5P) {
    const int i = bid * 8 + ltid(), g = i / S5P;
    const double lr = p.lam_re[i], li = p.lam_im[i], dt = (double)__expf(p.log_dt[g]);
    const double TWO_PI = 6.283185307179586476925286766559;
    double ang = li * dt; ang -= TWO_PI * floor(ang / TWO_PI);
    const double mag = (double)__expf((float)(lr * dt));
    const double are = mag * (double)cosf((float)ang), aim = mag * (double)sinf((float)ang);
    const double den = lr * lr + li * li, nre = are - 1.0;
    const double cre = (nre * lr + aim * li) / den, cim = (aim * lr - nre * li) / den;
    p.abar[i * 2] = (float)are; p.abar[i * 2 + 1] = (float)aim;
    for (int h = 0; h < S5H; ++h) {
      const double br = p.b_re[i * S5H + h], bi = p.b_im[i * S5H + h];
      p.bbar[(i * S5H + h) * 2] = (float)(cre * br - cim * bi);
      p.bbar[(i * S5H + h) * 2 + 1] = (float)(cre * bi + cim * br);
      const int pq = i & 63;
      p.bbarT[(size_t)(g * 128 + pq) * 16 + h] = f2bf((float)(cre * br - cim * bi));
      p.bbarT[(size_t)(g * 128 + 64 + pq) * 16 + h] = f2bf((float)(cre * bi + cim * br));
    }
    double a64 = 64.0 * li * dt; a64 -= TWO_PI * floor(a64 / TWO_PI);
    const double m64 = (double)__expf((float)(64.0 * lr * dt));
    p.apow64[i * 2] = (float)(m64 * (double)cosf((float)a64)); p.apow64[i * 2 + 1] = (float)(m64 * (double)sinf((float)a64));
  }
  for (int i = gtid; i < S5G * S5H * 128; i += gsz) {
    const int pp = i & 127, ho = (i >> 7) & 15, g = i >> 11;
    p.cmT[i] = f2bf(pp < 64 ? p.c_re[(g * 16 + ho) * 64 + pp] : -p.c_im[(g * 16 + ho) * 64 + pp - 64]);
  }
  LAS float* red = (LAS float*)smem;
  LAS float* sc = (LAS float*)(smem + 16384);
  if (bid < 192) {
    __syncthreads();
    for (int i = ltid(); i < 8 * D; i += NTHR) sc[i] = siluf_(p.c[i]);
    __syncthreads();
  }
  for (int item = bid; item < 192; item += nb) {
    const int cl = ltid() & 31, kg = ltid() >> 5, col = item * 32 + cl;
    float acc[8];
#pragma unroll
    for (int b = 0; b < 8; ++b) acc[b] = 0.f;
    const float* wp = p.ada_w + (size_t)(kg * 64) * 6144 + col;
#pragma unroll 1
    for (int k0 = 0; k0 < 64; k0 += 16) {
      float w[16];
#pragma unroll
      for (int q = 0; q < 16; ++q) w[q] = wp[(size_t)(k0 + q) * 6144];
#pragma unroll
      for (int q = 0; q < 16; ++q)
#pragma unroll
        for (int b = 0; b < 8; ++b) acc[b] += sc[b * D + kg * 64 + k0 + q] * w[q];
    }
    __syncthreads();
#pragma unroll
    for (int b = 0; b < 8; ++b) red[(kg * 8 + b) * 32 + cl] = acc[b];
    __syncthreads();
    if (ltid() < 256) {
      const int b = ltid() >> 5, c2 = ltid() & 31;
      float sum = p.ada_b[item * 32 + c2];
      for (int q = 0; q < 16; ++q) sum += red[(q * 8 + b) * 32 + c2];
      p.mod[b * 6144 + item * 32 + c2] = sum;
    }
  }
}

template <bool WITH_GK>
__device__ __forceinline__ void phase_norm(PR p, const float* __restrict__ xin, const float* __restrict__ g, int sh_off, int sc_off, bf16_t* __restrict__ outp, int bid, int nb, lds_ptr smem) {
  const int lane = ltid() & 63, wid = ltid() >> 6;
  const int stride = nb * 8;
  int row = bid * 8 + wid;
  f32x4 nx[4];
  if (row < T) {
#pragma unroll
    for (int i = 0; i < 4; ++i) nx[i] = *(const f32x4*)(xin + (size_t)row * D + lane * 4 + 256 * i);
  }
  f32x4 gv[4];
#pragma unroll
  for (int i = 0; i < 4; ++i) gv[i] = *(const f32x4*)(g + lane * 4 + 256 * i);
  for (; row < T; row += stride) {
    const int b = row / SEQ;
    f32x4 v[4];
#pragma unroll
    for (int i = 0; i < 4; ++i) v[i] = nx[i];
    const int rn = row + stride;
    if (rn < T) {
#pragma unroll
      for (int i = 0; i < 4; ++i) nx[i] = *(const f32x4*)(xin + (size_t)rn * D + lane * 4 + 256 * i);
    }
    float ss = 0.f;
#pragma unroll
    for (int i = 0; i < 4; ++i) ss += v[i][0] * v[i][0] + v[i][1] * v[i][1] + v[i][2] * v[i][2] + v[i][3] * v[i][3];
#pragma unroll
    for (int o = 32; o > 0; o >>= 1) ss += __shfl_xor(ss, o);
    const float r = rsqrtf(ss * (1.f / D) + 1e-6f);
#pragma unroll
    for (int i = 0; i < 4; ++i) {
      const int c0 = lane * 4 + 256 * i;
      const f32x4 scv = *(const f32x4*)(p.mod + b * 6144 + sc_off + c0), shv = *(const f32x4*)(p.mod + b * 6144 + sh_off + c0);
      float y[4];
#pragma unroll
      for (int j = 0; j < 4; ++j) y[j] = (v[i][j] * r) * gv[i][j] * (1.f + scv[j]) + shv[j];
      u32x2 o; o.x = cvtpk(y[0], y[1]); o.y = cvtpk(y[2], y[3]);
      *(u32x2*)(outp + (size_t)row * D + c0) = o;
    }
  }
}

struct EpiStoreBf {
  bf16_t* O; long ld;
  template <int MT> __device__ __forceinline__ void operator()(const f32x4 (&acc)[MT][4], int mbase, int nbase, int fr, int fq) const {
    bf16_t* rowp = O + (size_t)(mbase + fr) * ld + nbase + fq * 4;
#pragma unroll
    for (int mt = 0; mt < MT; ++mt) {
#pragma unroll
      for (int nt = 0; nt < 4; ++nt) { const f32x4 v = acc[mt][nt]; u32x2 o; o.x = cvtpk(v[0], v[1]); o.y = cvtpk(v[2], v[3]);
        *(u32x2*)(rowp + nt * 16) = o; }
      rowp += 16 * ld;
      __builtin_amdgcn_sched_barrier(0); }
  }
};
__device__ __forceinline__ f32x4 ld_bf4(const bf16_t* q) { const u32x2 w = *(const u32x2*)q; f32x4 r; r[0] = __uint_as_float(w.x << 16); r[1] = __uint_as_float(w.x & 0xffff0000u); r[2] = __uint_as_float(w.y << 16); r[3] = __uint_as_float(w.y & 0xffff0000u); return r; }
struct EpiGlu {
  const bf16_t* yA; const float* b; bf16_t* z;
  template <int MT> __device__ __forceinline__ void operator()(const f32x4 (&acc)[MT][4], int mbase, int nbase, int fr, int fq) const {
#pragma unroll
    for (int mt = 0; mt < MT; ++mt) {
#pragma unroll
      for (int nt = 0; nt < 4; ++nt) { const int row = mbase + mt * 16 + fr, col = nbase + nt * 16 + fq * 4; const f32x4 v = acc[mt][nt];
        const f32x4 y = ld_bf4(yA + (size_t)row * S5W + col); const f32x4 bb = *(const f32x4*)(b + col);
        u32x2 o; o.x = cvtpk(y[0] * sigmoidf_(v[0] + bb[0]), y[1] * sigmoidf_(v[1] + bb[1])); o.y = cvtpk(y[2] * sigmoidf_(v[2] + bb[2]), y[3] * sigmoidf_(v[3] + bb[3]));
        *(u32x2*)(z + (size_t)row * S5W + col) = o; }
      __builtin_amdgcn_sched_barrier(0); }
  }
};
struct EpiOut {
  const float* x; const float* mod; float* x1;
  template <int MT> __device__ __forceinline__ void operator()(const f32x4 (&acc)[MT][4], int mbase, int nbase, int fr, int fq) const {
#pragma unroll
    for (int mt = 0; mt < MT; ++mt) {
#pragma unroll
      for (int nt = 0; nt < 4; ++nt) { const int row = mbase + mt * 16 + fr, col = nbase + nt * 16 + fq * 4, b = row / SEQ; const f32x4 v = acc[mt][nt];
        const f32x4 xv = *(const f32x4*)(x + (size_t)row * D + col), gg = *(const f32x4*)(mod + b * 6144 + 2 * D + col);
        f32x4 o; o[0] = xv[0] + gg[0] * v[0]; o[1] = xv[1] + gg[1] * v[1]; o[2] = xv[2] + gg[2] * v[2]; o[3] = xv[3] + gg[3] * v[3];
        *(f32x4*)(x1 + (size_t)row * D + col) = o; }
      __builtin_amdgcn_sched_barrier(0); }
  }
};

template <class Epi>
__device__ __forceinline__ void phase_gemm_dense(const bf16_t* A, long lda, const bf16_t* Bm, long ldb, int M, int N, int K, const Epi& epi, int bid, int nb, lds_ptr smem) {
  const int nMt = M / 128, nNt = N / 256, ntiles = nMt * nNt, rounds = (ntiles + nb - 1) / nb;
  const int lane = ltid() & 63, wid = ltid() >> 6, wm = wid >> 2, wn = wid & 3, fr = lane & 15, fq = lane >> 4;
  for (int r = 0; r < rounds; ++r) {
    int mt, nt; bool valid; tile_map(r, bid, nb, nMt, nNt, mt, nt, valid);
    if (!valid) continue;
    f32x4 acc[4][4];
    ALoadDense al{A + (size_t)mt * 128 * lda, lda};
    gemm_mainloop_glds(acc, al, Bm + nt * 256, ldb, K / 32, smem);
    epi.template operator()<4>(acc, mt * 128 + wm * 64, nt * 256 + wn * 64, fr, fq);
  }
}


template <class Epi>
__device__ __forceinline__ void phase_gemm_dense256(const bf16_t* A, long lda, const bf16_t* Bm, long ldb, int M, int N, int K, const Epi& epi, int bid, int nb, lds_ptr smem) {
  const int nMt = M / 256, nNt = N / 256, ntiles = nMt * nNt, rounds = (ntiles + nb - 1) / nb;
  const int lane = ltid() & 63, wid = ltid() >> 6, wm = wid >> 2, wn = wid & 3, fr = lane & 15, fq = lane >> 4;
  for (int r = 0; r < rounds; ++r) {
    int mt, nt; bool valid; tile_map(r, bid, nb, nMt, nNt, mt, nt, valid);
    if (!valid) continue;
    f32x4 acc[8][4];
    gemm_mainloop_glds256(acc, A + (size_t)mt * 256 * lda, lda, Bm + nt * 256, ldb, K / 32, smem);
    epi.template operator()<8>(acc, mt * 256 + wm * 128, nt * 256 + wn * 64, fr, fq);
  }
}


constexpr int ST_ROW = 528;
__device__ __forceinline__ void phase_gemm_dense256_bf16(const bf16_t* A, long lda, const bf16_t* Bm, long ldb, int M, int N, int K, bf16_t* O, long ldo, int bid, int nb, lds_ptr smem) {
  const int nMt = M / 256, nNt = N / 256, ntiles = nMt * nNt, rounds = (ntiles + nb - 1) / nb;
  for (int r = 0; r < rounds; ++r) {
    int mt, nt; bool valid; tile_map(r, bid, nb, nMt, nNt, mt, nt, valid);
    if (!valid) continue;
    f32x4 acc[8][4];
    gemm_mainloop_glds256(acc, A + (size_t)mt * 256 * lda, lda, Bm + nt * 256, ldb, K / 32, smem);
    const int t1 = ltid(), l1 = t1 & 63, w1 = t1 >> 6, wm = w1 >> 2;
    bf16_t* ob = O + (size_t)(mt * 256) * ldo + nt * 256 + (t1 & 31) * 8;
#pragma unroll
    for (int h = 0; h < 2; ++h) {
      __syncthreads();
      if (wm == h) {
#pragma unroll
        for (int i = 0; i < 8; ++i)
#pragma unroll
          for (int j = 0; j < 4; ++j) { const f32x4 v = acc[i][j]; u32x2 o; o.x = cvtpk(v[0], v[1]); o.y = cvtpk(v[2], v[3]);
            *(LAS u32x2*)(smem + (i * 16 + (l1 & 15)) * ST_ROW + ((w1 & 3) * 64 + j * 16 + (l1 >> 4) * 4) * 2) = o; }
      }
      __syncthreads();
#pragma unroll
      for (int ps = 0; ps < 8; ++ps) {
        const int row = ps * 16 + (t1 >> 5);
        *(u32x4*)(ob + (size_t)(h * 128 + row) * ldo) = *(LAS u32x4*)(smem + row * ST_ROW + (t1 & 31) * 16);
      }
    }
  }
}

__device__ __forceinline__ void gk_rows(PR p, int bid, int nb) {
  const int lane = ltid() & 63, wid = ltid() >> 6, fr = lane & 15, fq = lane >> 4;
  if (wid >= 4) return;
  for (int r0 = (bid * 4 + wid) * 16; r0 < T; r0 += nb * 64) {
    const bf16_t* ap = p.h1 + (size_t)(r0 + fr) * D + fq * 8;
    const bf16_t* bp = p.wgkT + (size_t)fr * D + fq * 8;
    f32x4 acc = {0.f, 0.f, 0.f, 0.f};
#pragma unroll 1
    for (int k0 = 0; k0 < 32; k0 += 8) {
      s16x8 a[8], b[8];
#pragma unroll
      for (int q = 0; q < 8; ++q) { a[q] = *(const s16x8*)(ap + (k0 + q) * 32); b[q] = *(const s16x8*)(bp + (k0 + q) * 32); }
#pragma unroll
      for (int q = 0; q < 8; ++q) acc = __builtin_amdgcn_mfma_f32_16x16x32_bf16(a[q], b[q], acc, 0, 0, 0);
    }
#pragma unroll
    for (int j = 0; j < 4; ++j) p.gkl[(size_t)(r0 + 4 * fq + j) * 16 + fr] = acc[j];
  }
}

__device__ __forceinline__ void phase_gemm_mixed(PR p, int bid, int nb, lds_ptr smem) {
  const int nMt = T / 128, nNt = D / 256, ntiles = nMt * nNt, rounds = (ntiles + nb - 1) / nb;
  const int lane = ltid() & 63, wid = ltid() >> 6, wm = wid >> 2, wn = wid & 3, fr = lane & 15, fq = lane >> 4;
  for (int r = 0; r < rounds; ++r) {
    int mt, nt; bool valid; tile_map(r, bid, nb, nMt, nNt, mt, nt, valid);
    if (!valid) continue;
    const int mbase = mt * 128 + wm * 64, nbase = nt * 256 + wn * 64;
    const bf16_t* gp = p.proj + (size_t)(mbase + fr) * LDP + nbase + fq * 4;
    u32x2 gte[4][4], pk[4][4];
#pragma unroll
    for (int i = 0; i < 4; ++i)
#pragma unroll
      for (int j = 0; j < 4; ++j) gte[i][j] = *(const u32x2*)(gp + (size_t)(i * 16) * LDP + OFF_GA + j * 16);
    f32x4 acc[4][4];
    { ALoadDense al{p.zA + (size_t)mt * 128 * S5W, S5W}; gemm_mainloop_glds(acc, al, p.wb_pa + nt * 256, D, S5W / 32, smem); }
#pragma unroll
    for (int i = 0; i < 4; ++i)
#pragma unroll
      for (int j = 0; j < 4; ++j) {
        const float g0 = __uint_as_float(gte[i][j].x << 16), g1 = __uint_as_float(gte[i][j].x & 0xffff0000u), g2 = __uint_as_float(gte[i][j].y << 16), g3 = __uint_as_float(gte[i][j].y & 0xffff0000u);
        pk[i][j].x = cvtpk(acc[i][j][0] * sigmoidf_(g0), acc[i][j][1] * sigmoidf_(g1)); pk[i][j].y = cvtpk(acc[i][j][2] * sigmoidf_(g2), acc[i][j][3] * sigmoidf_(g3)); }
#pragma unroll
    for (int i = 0; i < 4; ++i)
#pragma unroll
      for (int j = 0; j < 4; ++j) gte[i][j] = *(const u32x2*)(gp + (size_t)(i * 16) * LDP + OFF_GB + j * 16);
    { ALoadDense al{p.yB + (size_t)mt * 128 * GVAL, GVAL}; gemm_mainloop_glds(acc, al, p.wb_pb + nt * 256, D, GVAL / 32, smem); }
    bf16_t* op = p.mixed + (size_t)(mbase + fr) * D + nbase + fq * 4;
#pragma unroll
    for (int i = 0; i < 4; ++i)
#pragma unroll
      for (int j = 0; j < 4; ++j) {
        const float g0 = __uint_as_float(gte[i][j].x << 16), g1 = __uint_as_float(gte[i][j].x & 0xffff0000u), g2 = __uint_as_float(gte[i][j].y << 16), g3 = __uint_as_float(gte[i][j].y & 0xffff0000u);
        const float a0 = __uint_as_float(pk[i][j].x << 16), a1 = __uint_as_float(pk[i][j].x & 0xffff0000u), a2 = __uint_as_float(pk[i][j].y << 16), a3 = __uint_as_float(pk[i][j].y & 0xffff0000u);
        u32x2 o; o.x = cvtpk(a0 + sigmoidf_(g0) * acc[i][j][0], a1 + sigmoidf_(g1) * acc[i][j][1]); o.y = cvtpk(a2 + sigmoidf_(g2) * acc[i][j][2], a3 + sigmoidf_(g3) * acc[i][j][3]);
        *(u32x2*)(op + (size_t)(i * 16) * D + j * 16) = o; }
  }
}

__device__ __forceinline__ void phase_gemm_rs(PR p, int bid, int nb, lds_ptr smem) {
  const int nMt = T / 256, nNt = 3, ntiles = nMt * nNt, rounds = (ntiles + nb - 1) / nb;
  const int lane = ltid() & 63, wid = ltid() >> 6, wm = wid >> 2, wn = wid & 3, fr = lane & 15, fq = lane >> 4;
  for (int r = 0; r < rounds; ++r) {
    int mt, nt; bool valid; tile_map(r, bid, nb, nMt, nNt, mt, nt, valid);
    if (!valid) continue;
    f32x4 acc[8][4];
    gemm_mainloop_glds256(acc, p.h2 + (size_t)mt * 256 * D, D, p.wb_rs + nt * 256, 768, D / 32, smem);
    const int mbase = mt * 256 + wm * 128;
    if (nt == 0) {
#pragma unroll
      for (int i = 0; i < 8; ++i) {
#pragma unroll
        for (int j = 0; j < 4; ++j) *(f32x4*)(p.logits + (size_t)(mbase + i * 16 + fr) * NE + wn * 64 + j * 16 + fq * 4) = acc[i][j];
        __builtin_amdgcn_sched_barrier(0); }
    } else {
      const int h0 = (nt - 1) * 128 + wn * 32;
#pragma unroll
      for (int i = 0; i < 8; ++i) {
#pragma unroll
        for (int j = 0; j < 2; ++j) { const f32x4 gv = acc[i][j], uv = acc[i][j + 2];
          u32x2 o; o.x = cvtpk(siluf_(gv[0]) * uv[0], siluf_(gv[1]) * uv[1]); o.y = cvtpk(siluf_(gv[2]) * uv[2], siluf_(gv[3]) * uv[3]);
          *(u32x2*)(p.shH + (size_t)(mbase + i * 16 + fr) * SFF + h0 + j * 16 + fq * 4) = o; }
        __builtin_amdgcn_sched_barrier(0); }
    }
  }
}

constexpr int MOE_H_OFF = 2 * G_STAGE;
constexpr int MOE_TOK_OFF = MOE_H_OFF + 65536;
constexpr int SMEM_BYTES = 139264;
__device__ __forceinline__ void phase_moe(PR p, int bid, int nb, lds_ptr smem) {
  const int lane = ltid() & 63, wid = ltid() >> 6, wm = wid >> 2, wn = wid & 3, fr = lane & 15, fq = lane >> 4;
  LAS int* toks = (LAS int*)(smem + MOE_TOK_OFF);
  const lds_ptr Hs = smem + MOE_H_OFF;
  LAS int* qi = (LAS int*)(smem + MOE_TOK_OFF + 512);
  for (int sx = 0; sx < 8; ++sx) {
   const int x = (bid + sx) & 7;
   const int cnt = p.moe_cnt[x];
   for (;;) {
    __syncthreads();
    if (ltid() == 0) qi[0] = atomicAdd(&p.moe_ctr[x], 1);
    __syncthreads();
    const int qidx = qi[0];
    if (qidx >= cnt) break;
    const int blk = p.moe_list[x * NBLK128 + qidx];
    const int e = p.blk_exp[blk];
    if (ltid() < 128) toks[ltid()] = p.slot_tok[blk * 128 + ltid()];
    __syncthreads();
    const float* Wg = p.ew_gate + (size_t)e * D * EFF; const float* Wu = p.ew_up + (size_t)e * D * EFF; const float* Wd = p.ew_down + (size_t)e * EFF * D;
    for (int hp2 = 0; hp2 < 2 * MOE_REP_GU; ++hp2) { const int hp = hp2 & 1;
      f32x4 acc[4][4];
      ALoadGatherLds al2{p.h2, toks};
      BLoadGUR bl{Wg, (long)(Wu - Wg), EFF, hp * 128};
      gemm_mainloop_r3<false>(acc, al2, bl, D / 32, smem, smem);
#pragma unroll
      for (int i = 0; i < 4; ++i)
#pragma unroll
        for (int j = 0; j < 2; ++j) { const f32x4 gv = acc[i][j], uv = acc[i][j + 2]; const int row = wm * 64 + i * 16 + fr, hc = hp * 128 + wn * 32 + j * 16 + fq * 4;
          u32x2 o; o.x = cvtpk(siluf_(gv[0]) * uv[0], siluf_(gv[1]) * uv[1]); o.y = cvtpk(siluf_(gv[2]) * uv[2], siluf_(gv[3]) * uv[3]);
          *(LAS u32x2*)(Hs + (hc >> 5) * G_ASZ + a_off(row, (hc & 31) >> 3) + (hc & 7) * 2) = o; }
    }
    for (int np2 = 0; np2 < 4 * MOE_REP_DN; ++np2) { const int np = np2 & 3;
      f32x4 acc[4][4];
      ALoadDense al{nullptr, 0};
      BLoadF32R bl{Wd + np * 256, D};
      gemm_mainloop_r3<true>(acc, al, bl, EFF / 32, smem, Hs);
#pragma unroll
      for (int i = 0; i < 4; ++i) {
        const int rl = wm * 64 + i * 16 + fr;
        if (toks[rl] >= 0) {
#pragma unroll
          for (int j = 0; j < 4; ++j) { const f32x4 v = acc[i][j]; u32x2 o; o.x = cvtpk(v[0], v[1]); o.y = cvtpk(v[2], v[3]);
            *(u32x2*)(p.Y + (size_t)(blk * 128 + rl) * D + np * 256 + wn * 64 + j * 16 + fq * 4) = o; }
        }
      }
    }
   }
  }
}

struct BStreamGU { const float* Wg; long du; int hp0;
  __device__ __forceinline__ void load(BRaw& r, int s, int tid) const {
    const int hp = hp0 + (s >> 5), kbase = (s & 31) * 32;
    const int col = (tid & 63) * 4, w = col >> 6, xx = col & 63;
    const float* q = Wg + ((xx < 32) ? 0l : du) + (size_t)(kbase + (tid >> 6)) * EFF + hp * 128 + 32 * w + (xx & 31);
#pragma unroll
    for (int i = 0; i < 4; ++i) r.v[i] = *(const f32x4*)(q + (size_t)(8 * i) * EFF); } };
struct BStreamDown { const float* Wd; int np0;
  __device__ __forceinline__ void load(BRaw& r, int s, int tid) const {
    const int np = np0 + (s >> 3), kbase = (s & 7) * 32;
    const float* q = Wd + (size_t)(kbase + (tid >> 6)) * D + np * 256 + (tid & 63) * 4;
#pragma unroll
    for (int i = 0; i < 4; ++i) r.v[i] = *(const f32x4*)(q + (size_t)(8 * i) * D); } };
constexpr int PV_STAGE = 2 * G_ASZ + G_BSZ;
template <int SEG, int NSEG, class AL, class BL, class SE>
__device__ __forceinline__ void gemm_stream_pair(const AL& al, const BL& bl, lds_ptr stage, const SE& segend, bool has2) {
  constexpr int NS = SEG * NSEG;
  const int tid = ltid(), lane = tid & 63, wid = tid >> 6, wm = wid >> 2, wn = wid & 3, fr = lane & 15, fq = lane >> 4;
  const int ar = tid >> 2, ac = tid & 3;
  const bf16_t* aptr0 = al.rowptr(0, ar) + ac * 8;
  const bf16_t* aptr1 = al.rowptr(1, ar) + ac * 8;
  const int a_st = a_off(ar, ac);
  int b_st[4];
#pragma unroll
  for (int i = 0; i < 4; ++i) b_st[i] = 2 * G_ASZ + b_off((tid >> 6) + 8 * i, (tid & 63) >> 2) + (tid & 3) * 8;
  int a_rd[4];
#pragma unroll
  for (int mt = 0; mt < 4; ++mt) a_rd[mt] = a_off(wm * 64 + mt * 16 + fr, fq);
  int b_rd[4][2];
#pragma unroll
  for (int nt = 0; nt < 4; ++nt) {
    b_rd[nt][0] = 2 * G_ASZ + b_off(8 * fq + (fr >> 2), wn * 4 + nt) + (fr & 3) * 8;
    b_rd[nt][1] = 2 * G_ASZ + b_off(8 * fq + 4 + (fr >> 2), wn * 4 + nt) + (fr & 3) * 8;
  }
  f32x4 acc[2][4][4];
#pragma unroll
  for (int h = 0; h < 2; ++h)
#pragma unroll
    for (int mt = 0; mt < 4; ++mt)
#pragma unroll
      for (int nt = 0; nt < 4; ++nt) acc[h][mt][nt] = (f32x4){0.f, 0.f, 0.f, 0.f};
  u32x4 xa0, xb0, xa1, xb1;
  BRaw rb0, rb1;
#define P2_LOAD(XA, XB, RB, s_) do { XA = *(const u32x4*)(aptr0 + (size_t)((s_) % SEG) * 32); XB = *(const u32x4*)(aptr1 + (size_t)((s_) % SEG) * 32); bl.load(RB, (s_), tid); } while (0)
#define P2_STORE(XA, XB, RB, st_) do { const lds_ptr q_ = stage + (st_) * PV_STAGE; *(LAS u32x4*)(q_ + a_st) = XA; *(LAS u32x4*)(q_ + G_ASZ + a_st) = XB; \
    _Pragma("unroll") for (int i_ = 0; i_ < 4; ++i_) { u32x2 o_; o_.x = cvtpk(RB.v[i_][0], RB.v[i_][1]); o_.y = cvtpk(RB.v[i_][2], RB.v[i_][3]); *(LAS u32x2*)(q_ + b_st[i_]) = o_; } } while (0)
#define P2_COMPUTE(s_) do { const lds_ptr cur = stage + ((s_) & 1) * PV_STAGE; s16x8 bfr[4]; \
    _Pragma("unroll") for (int nt = 0; nt < 4; ++nt) { const s16x4 lo = tr_read(cur + b_rd[nt][0]), hi = tr_read(cur + b_rd[nt][1]); bfr[nt] = __builtin_shufflevector(lo, hi, 0, 1, 2, 3, 4, 5, 6, 7); } \
    _Pragma("unroll") for (int h = 0; h < 2; ++h) if (h == 0 || has2) { s16x8 af[4]; \
      _Pragma("unroll") for (int mt = 0; mt < 4; ++mt) af[mt] = *(LAS s16x8*)(cur + h * G_ASZ + a_rd[mt]); \
      _Pragma("unroll") for (int mt = 0; mt < 4; ++mt) _Pragma("unroll") for (int nt = 0; nt < 4; ++nt) acc[h][mt][nt] = __builtin_amdgcn_mfma_f32_16x16x32_bf16(bfr[nt], af[mt], acc[h][mt][nt], 0, 0, 0); } } while (0)
#define P2_SEGEND(s_) do { if (((s_) % SEG) == SEG - 1) { segend((s_) / SEG, acc); \
    _Pragma("unroll") for (int h = 0; h < 2; ++h) _Pragma("unroll") for (int mt = 0; mt < 4; ++mt) _Pragma("unroll") for (int nt = 0; nt < 4; ++nt) acc[h][mt][nt] = (f32x4){0.f, 0.f, 0.f, 0.f}; } } while (0)
#define P2_BODY(s_, XAN, XBN, RBN, XAW, XBW, RBW) do { const int sl_ = ((s_) + 2 < NS) ? (s_) + 2 : NS - 1; P2_LOAD(XAN, XBN, RBN, sl_); __builtin_amdgcn_sched_barrier(0); \
    P2_COMPUTE(s_); __builtin_amdgcn_sched_barrier(0); P2_SEGEND(s_); P2_STORE(XAW, XBW, RBW, ((s_) + 1) & 1); __syncthreads(); } while (0)
  P2_LOAD(xa0, xb0, rb0, 0);
  P2_LOAD(xa1, xb1, rb1, 1);
  __syncthreads();
  P2_STORE(xa0, xb0, rb0, 0);
  __syncthreads();
  for (int s = 0; s < NS; s += 2) {
    P2_BODY(s, xa0, xb0, rb0, xa1, xb1, rb1);
    P2_BODY(s + 1, xa1, xb1, rb1, xa0, xb0, rb0);
  }
#undef P2_LOAD
#undef P2_STORE
#undef P2_COMPUTE
#undef P2_SEGEND
#undef P2_BODY
}
struct APairGather { const bf16_t* A; LAS int* tk; __device__ __forceinline__ const bf16_t* rowptr(int h, int r) const { int t = tk[h * 128 + r]; t = t < 0 ? 0 : t; return A + (size_t)t * D; } };
struct APairDense { const bf16_t* A0; const bf16_t* A1; __device__ __forceinline__ const bf16_t* rowptr(int h, int r) const { return (h ? A1 : A0) + (size_t)r * EFF; } };

constexpr int PV_TOK = 2 * PV_STAGE;
constexpr int PV_Q = PV_TOK + 1024;
constexpr int PV_STG = 69632, PV_STG_ROW = 528;
template <int STG>
__device__ __forceinline__ void phase_moe_pair(PR p, int bid, int nb, lds_ptr smem) {
  LAS int* toks = (LAS int*)(smem + PV_TOK);
  LAS int* qi = (LAS int*)(smem + PV_Q);
  for (int sx = 0; sx < 8; ++sx) {
   const int x = ((int)((unsigned)__builtin_amdgcn_s_getreg((3 << 11) | 20) & 7u) + sx) & 7;
   const int cnt = 2 * p.moe_cnt[x];
   for (;;) {
    __syncthreads();
    if (ltid() == 0) qi[0] = atomicAdd(&p.moe_ctr[(STG - 1) * 8 + x], 1);
    __syncthreads();
    const int qidx = qi[0];
    if (qidx >= cnt) break;
    const int blk = p.moe_list[x * NBLK128 + (qidx >> 1)], sub = qidx & 1;
    const int e = p.blk_exp[blk];
    const bool has2 = (blk + 1 < NBLK128) && (p.blk_exp[blk + 1] == e);
    const int blk2 = has2 ? blk + 1 : blk;
    { const int t = ltid(); if (t < 256) toks[t] = (t < 128) ? p.slot_tok[blk * 128 + t] : (has2 ? p.slot_tok[blk2 * 128 + (t - 128)] : -1); }
    __syncthreads();
    const int lane = ltid() & 63, wid = ltid() >> 6, wm = wid >> 2, wn = wid & 3, fr = lane & 15, fq = lane >> 4;
    if (STG == 1) {
      const float* Wg = p.ew_gate + (size_t)e * D * EFF; const float* Wu = p.ew_up + (size_t)e * D * EFF;
      APairGather al{p.h2, toks};
      BStreamGU bl{Wg, (long)(Wu - Wg), sub};
      auto segH = [&](int hseg, const f32x4 (&acc)[2][4][4]) { const int hp = sub + hseg;
        const int t1 = ltid(), l1 = t1 & 63, w1 = t1 >> 6;
        const lds_ptr stg = smem + PV_STG;
#pragma unroll
        for (int h = 0; h < 2; ++h) {
          if (h == 1 && !has2) continue;
#pragma unroll
          for (int i = 0; i < 4; ++i)
#pragma unroll
            for (int j = 0; j < 2; ++j) { const f32x4 gv = acc[h][i][j], uv = acc[h][i][j + 2];
              u32x2 o; o.x = cvtpk(siluf_(gv[0]) * uv[0], siluf_(gv[1]) * uv[1]); o.y = cvtpk(siluf_(gv[2]) * uv[2], siluf_(gv[3]) * uv[3]);
              *(LAS u32x2*)(stg + ((w1 >> 2) * 64 + i * 16 + (l1 & 15)) * 272 + ((w1 & 3) * 32 + j * 16 + (l1 >> 4) * 4) * 2) = o; }
          __syncthreads();
          bf16_t* hb = p.Hbuf + (size_t)((h ? blk2 : blk) * 128) * EFF + hp * 128 + (t1 & 15) * 8;
#pragma unroll
          for (int ps = 0; ps < 4; ++ps) {
            const int row = ps * 32 + (t1 >> 4);
            *(u32x4*)(hb + (size_t)row * EFF) = *(LAS u32x4*)(stg + row * 272 + (t1 & 15) * 16);
          }
          __syncthreads();
        }
      };
      gemm_stream_pair<32, 1>(al, bl, smem, segH, has2);
    } else {
      const float* Wd = p.ew_down + (size_t)e * EFF * D;
      APairDense al{p.Hbuf + (size_t)blk * 128 * EFF, p.Hbuf + (size_t)blk2 * 128 * EFF};
      BStreamDown bl{Wd, 2 * sub};
      auto segY = [&](int nseg, const f32x4 (&acc)[2][4][4]) { const int np = 2 * sub + nseg;
        const int t1 = ltid(), l1 = t1 & 63, w1 = t1 >> 6;
        const lds_ptr stg = smem + PV_STG;
#pragma unroll
        for (int h = 0; h < 2; ++h) {
          if (h == 1 && !has2) continue;
#pragma unroll
          for (int i = 0; i < 4; ++i)
#pragma unroll
            for (int j = 0; j < 4; ++j) { const f32x4 v = acc[h][i][j]; u32x2 o; o.x = cvtpk(v[0], v[1]); o.y = cvtpk(v[2], v[3]);
              *(LAS u32x2*)(stg + ((w1 >> 2) * 64 + i * 16 + (l1 & 15)) * PV_STG_ROW + ((w1 & 3) * 64 + j * 16 + (l1 >> 4) * 4) * 2) = o; }
          __syncthreads();
          bf16_t* yb = p.Y + (size_t)((h ? blk2 : blk) * 128) * D + np * 256 + (t1 & 31) * 8;
#pragma unroll
          for (int ps = 0; ps < 8; ++ps) {
            const int row = ps * 16 + (t1 >> 5);
            const u32x4 v = *(LAS u32x4*)(stg + row * PV_STG_ROW + (t1 & 31) * 16);
            if (toks[h * 128 + row] >= 0) *(u32x4*)(yb + (size_t)row * D) = v;
          }
          __syncthreads();
        }
      };
      gemm_stream_pair<8, 2>(al, bl, smem, segY, has2);
    }
   }
  }
}

__device__ __forceinline__ void wave_sync() { __syncthreads(); }
constexpr int S5_BU_STRIDE = 132;
constexpr int S5_S_STRIDE = 272;
constexpr int S5_WAVE_LDS = 16 * S5_BU_STRIDE * 4 + 16 * S5_S_STRIDE;
template <bool FINAL>
__device__ __forceinline__ void s5_item(PR p, int b, int c, int g, lds_ptr wl) {
  const int lane = ltid() & 63, fr = lane & 15, fq = lane >> 4;
  LAS float* bu = (LAS float*)wl;
  const lds_ptr Sb = wl + 16 * S5_BU_STRIDE * 4;
  const size_t t0 = (size_t)b * SEQ + (size_t)c * 64;
  const s16x8 zero8 = {0, 0, 0, 0, 0, 0, 0, 0};
  s16x8 bfr[8];
#pragma unroll
  for (int nt = 0; nt < 8; ++nt) { const s16x8 x = *(const s16x8*)(p.bbarT + ((size_t)(g * 128 + nt * 16 + fr) * 16 + (fq & 1) * 8)); bfr[nt] = (fq < 2) ? x : zero8; }
  const float are = p.abar[(g * 64 + lane) * 2], aim = p.abar[(g * 64 + lane) * 2 + 1];
  const size_t sidx = (((size_t)b * 32 + c) * S5G + g) * 64 + lane;
  float sre = 0.f, sim = 0.f;
  s16x8 cfr[4];
  f32x4 dsk = {0.f, 0.f, 0.f, 0.f};
  if (FINAL) {
    sre = p.s5Sin[sidx * 2]; sim = p.s5Sin[sidx * 2 + 1];
#pragma unroll
    for (int ks = 0; ks < 4; ++ks) cfr[ks] = *(const s16x8*)(p.cmT + ((size_t)(g * 16 + fr) * 128 + ks * 32 + fq * 8));
    dsk = *(const f32x4*)(p.s5_d + g * 16 + fq * 4);
  }
  for (int mt = 0; mt < 4; ++mt) {
    const bf16_t* urow = p.proj + (t0 + mt * 16 + fr) * LDP + OFF_U + g * 16;
    const s16x8 ux = *(const s16x8*)(urow + (fq & 1) * 8);
    const s16x8 ufr = (fq < 2) ? ux : zero8;
#pragma unroll
    for (int nt = 0; nt < 8; ++nt) {
      const f32x4 z = {0.f, 0.f, 0.f, 0.f};
      const f32x4 acc = __builtin_amdgcn_mfma_f32_16x16x32_bf16(ufr, bfr[nt], z, 0, 0, 0);
#pragma unroll
      for (int j = 0; j < 4; ++j) bu[(4 * fq + j) * S5_BU_STRIDE + nt * 16 + fr] = acc[j];
    }
    wave_sync();
#pragma unroll
    for (int l = 0; l < 16; ++l) {
      const float br = bu[l * S5_BU_STRIDE + lane], bi = bu[l * S5_BU_STRIDE + 64 + lane];
      const float nr = are * sre - aim * sim + br, ni = are * sim + aim * sre + bi;
      sre = nr; sim = ni;
      if (FINAL) {
        *(LAS bf16_t*)(Sb + l * S5_S_STRIDE + lane * 2) = f2bf(sre);
        *(LAS bf16_t*)(Sb + l * S5_S_STRIDE + (64 + lane) * 2) = f2bf(sim);
      }
    }
    wave_sync();
    if (FINAL) {
      f32x4 y = {0.f, 0.f, 0.f, 0.f};
#pragma unroll
      for (int ks = 0; ks < 4; ++ks) {
        const s16x8 sfr = *(LAS s16x8*)(Sb + fr * S5_S_STRIDE + (ks * 32 + fq * 8) * 2);
        y = __builtin_amdgcn_mfma_f32_16x16x32_bf16(cfr[ks], sfr, y, 0, 0, 0);
      }
      const f32x4 u4 = ld_bf4(urow + fq * 4);
      u32x2 o; o.x = cvtpk(geluf_(y[0] + dsk[0] * u4[0]), geluf_(y[1] + dsk[1] * u4[1])); o.y = cvtpk(geluf_(y[2] + dsk[2] * u4[2]), geluf_(y[3] + dsk[3] * u4[3]));
      *(u32x2*)(p.yA + (t0 + mt * 16 + fr) * S5W + g * 16 + fq * 4) = o;
      wave_sync();
    }
  }
  if (!FINAL) { p.s5E[sidx * 2] = sre; p.s5E[sidx * 2 + 1] = sim; }
}
template <bool FINAL>
__device__ __forceinline__ void s5_block_item(PR p, int item, lds_ptr smem) {
  const int wid = ltid() >> 6;
  const int go = item & 3, c = (item >> 2) & 31, b = item >> 7;
  s5_item<FINAL>(p, b, c, go * 8 + wid, smem + wid * S5_WAVE_LDS);
}

constexpr int GL_QD = 0, GL_KE = 8192, GL_V = 16384, GL_SIN = 32768, GL_GL = 49152, GL_W2 = 53248, GL_TOT = 57344, GL_B2 = 58368, GL_ITEM = 58624;
__device__ __forceinline__ int rowrd_off(int r, int c) { return r * 128 + ((c ^ ((r >> 1) & 7)) << 4); }
__device__ __forceinline__ int tr128_off(int r, int ch) { return r * 128 + ((ch ^ (((r >> 1) & 1) | (((r >> 3) & 1) << 1))) << 5); }
__device__ __forceinline__ int tr256_off(int r, int ch) { return r * 256 + ((ch ^ ((r & 3) | (((r >> 3) & 1) << 2))) << 5); }

__device__ __forceinline__ void gla_front(PR p, int b, int h, int c, lds_ptr il, int t, float (&bl)[16], float& blast) {
  LAS float* gl = (LAS float*)(il + GL_GL); LAS float* w2 = (LAS float*)(il + GL_W2); LAS float* tot = (LAS float*)(il + GL_TOT); LAS float* b2 = (LAS float*)(il + GL_B2);
  const size_t t0 = (size_t)b * SEQ + (size_t)c * 64;
  __syncthreads();
  *(LAS f32x4*)(gl + t * 4) = *(const f32x4*)(p.gkl + t0 * 16 + t * 4);
#pragma unroll
  for (int q = 0; q < 4; ++q) { const int i = t + 256 * q; w2[i] = p.w_gk2[(i >> 6) * GKEY + h * 64 + (i & 63)]; }
  if (t < 64) b2[t] = p.b_gk2[h * 64 + t];
  __syncthreads();
  const int d = t & 63, part = t >> 6;
  float wv[16];
#pragma unroll
  for (int r = 0; r < 16; ++r) wv[r] = w2[r * 64 + d];
  const float bias = b2[d];
  float run = 0.f;
#pragma unroll
  for (int ii = 0; ii < 16; ++ii) {
    const int i = part * 16 + ii;
    float gk = bias;
#pragma unroll
    for (int q = 0; q < 4; ++q) { const f32x4 gv = *(LAS f32x4*)(gl + i * 16 + q * 4); gk += gv[0] * wv[q * 4] + gv[1] * wv[q * 4 + 1] + gv[2] * wv[q * 4 + 2] + gv[3] * wv[q * 4 + 3]; }
    run += logsigmoidf_(gk) * (1.f / 16.f);
    bl[ii] = run;
  }
  tot[part * 64 + d] = run;
  __syncthreads();
  float offs = 0.f, all = 0.f;
#pragma unroll
  for (int q = 0; q < 4; ++q) { const float v = tot[q * 64 + d]; all += v; offs += (q < part) ? v : 0.f; }
#pragma unroll
  for (int ii = 0; ii < 16; ++ii) bl[ii] += offs;
  blast = all;
}

__device__ __forceinline__ void gla_pass1(PR p, int item, lds_ptr smem) {
  const int half = ltid() >> 8, t = ltid() & 255, lane = t & 63, w = t >> 6, fr = lane & 15, fq = lane >> 4;
  const int it = item * 2 + half, c = it & 31, h = (it >> 5) & 3, b = it >> 7;
  const lds_ptr il = smem + half * GL_ITEM;
  const size_t t0 = (size_t)b * SEQ + (size_t)c * 64;
  float bl[16], blast;
  gla_front(p, b, h, c, il, t, bl, blast);
  {
    const int d = t & 63, part = t >> 6;
#pragma unroll
    for (int ii = 0; ii < 16; ++ii) {
      const int i = part * 16 + ii;
      const float kv = bf2f(p.proj[(t0 + i) * LDP + OFF_K + h * 64 + d]);
      *(LAS bf16_t*)(il + GL_KE + tr128_off(i, d >> 4) + (d & 15) * 2) = f2bf(kv * __expf(blast - bl[ii]));
    }
    if (part == 0) p.glaDec[(size_t)it * 64 + d] = __expf(blast);
#pragma unroll
    for (int q = 0; q < 4; ++q) { const int pc = t + 256 * q, r = pc >> 4, c8 = pc & 15;
      *(LAS u32x4*)(il + GL_V + tr256_off(r, c8 >> 1) + (c8 & 1) * 16) = *(const u32x4*)(p.proj + (t0 + r) * LDP + OFF_V + h * 128 + c8 * 8); }
  }
  __syncthreads();
  f32x4 acc[8];
#pragma unroll
  for (int et = 0; et < 8; ++et) acc[et] = (f32x4){0.f, 0.f, 0.f, 0.f};
#pragma unroll
  for (int ks = 0; ks < 2; ++ks) {
    const int r0 = 32 * ks + 8 * fq + (fr >> 2);
    const s16x4 klo = tr_read(il + GL_KE + tr128_off(r0, w) + (fr & 3) * 8), khi = tr_read(il + GL_KE + tr128_off(r0 + 4, w) + (fr & 3) * 8);
    const s16x8 kf = __builtin_shufflevector(klo, khi, 0, 1, 2, 3, 4, 5, 6, 7);
#pragma unroll
    for (int et = 0; et < 8; ++et) {
      const s16x4 vlo = tr_read(il + GL_V + tr256_off(r0, et) + (fr & 3) * 8), vhi = tr_read(il + GL_V + tr256_off(r0 + 4, et) + (fr & 3) * 8);
      const s16x8 vf = __builtin_shufflevector(vlo, vhi, 0, 1, 2, 3, 4, 5, 6, 7);
      acc[et] = __builtin_amdgcn_mfma_f32_16x16x32_bf16(vf, kf, acc[et], 0, 0, 0);
    }
  }
#pragma unroll
  for (int et = 0; et < 8; ++et) *(f32x4*)(p.glaKV + ((size_t)it * 64 + 16 * w + fr) * 128 + et * 16 + fq * 4) = acc[et];
}

__device__ __forceinline__ void gla_pass2(PR p, int item, lds_ptr smem) {
  const int half = ltid() >> 8, t = ltid() & 255, lane = t & 63, w = t >> 6, fr = lane & 15, fq = lane >> 4;
  const int it = item * 2 + half, c = it & 31, h = (it >> 5) & 3, b = it >> 7;
  const lds_ptr il = smem + half * GL_ITEM;
  const size_t t0 = (size_t)b * SEQ + (size_t)c * 64;
  float bl[16], blast;
  gla_front(p, b, h, c, il, t, bl, blast);
  {
    const int d = t & 63, part = t >> 6;
#pragma unroll
    for (int ii = 0; ii < 16; ++ii) {
      const int i = part * 16 + ii;
      const float qv = bf2f(p.proj[(t0 + i) * LDP + OFF_Q + h * 64 + d]) * 0.125f, kv = bf2f(p.proj[(t0 + i) * LDP + OFF_K + h * 64 + d]);
      const int o = rowrd_off(i, d >> 3) + (d & 7) * 2;
      *(LAS bf16_t*)(il + GL_QD + o) = f2bf(qv * __expf(bl[ii]));
      *(LAS bf16_t*)(il + GL_KE + o) = f2bf(kv * __expf(-bl[ii]));
    }
#pragma unroll
    for (int q = 0; q < 4; ++q) { const int pc = t + 256 * q, r = pc >> 4, c8 = pc & 15;
      *(LAS u32x4*)(il + GL_V + tr256_off(r, c8 >> 1) + (c8 & 1) * 16) = *(const u32x4*)(p.proj + (t0 + r) * LDP + OFF_V + h * 128 + c8 * 8);
      *(LAS u32x4*)(il + GL_SIN + tr256_off(r, c8 >> 1) + (c8 & 1) * 16) = *(const u32x4*)(p.glaSin + ((size_t)it * 64 + r) * 128 + c8 * 8); }
  }
  __syncthreads();
  s16x8 qf[2];
#pragma unroll
  for (int ks = 0; ks < 2; ++ks) qf[ks] = *(LAS s16x8*)(il + GL_QD + rowrd_off(16 * w + fr, ks * 4 + fq));
  f32x4 st[4];
#pragma unroll
  for (int jt = 0; jt < 4; ++jt) {
    st[jt] = (f32x4){0.f, 0.f, 0.f, 0.f};
    if (jt <= w) {
#pragma unroll
      for (int ks = 0; ks < 2; ++ks) {
        const s16x8 kf = *(LAS s16x8*)(il + GL_KE + rowrd_off(16 * jt + fr, ks * 4 + fq));
        st[jt] = __builtin_amdgcn_mfma_f32_16x16x32_bf16(kf, qf[ks], st[jt], 0, 0, 0);
      }
      if (jt == w) {
#pragma unroll
        for (int r = 0; r < 4; ++r) st[jt][r] = (4 * fq + r <= fr) ? st[jt][r] : 0.f;
      }
    }
  }
  f32x4 acc[8];
#pragma unroll
  for (int et = 0; et < 8; ++et) acc[et] = (f32x4){0.f, 0.f, 0.f, 0.f};
#pragma unroll
  for (int u = 0; u < 2; ++u) {
    if (2 * u <= w) {
      u32x4 pk; pk.x = cvtpk(st[2 * u][0], st[2 * u][1]); pk.y = cvtpk(st[2 * u][2], st[2 * u][3]); pk.z = cvtpk(st[2 * u + 1][0], st[2 * u + 1][1]); pk.w = cvtpk(st[2 * u + 1][2], st[2 * u + 1][3]);
      const s16x8 pf = __builtin_bit_cast(s16x8, pk);
      const int r0 = 32 * u + 4 * fq + (fr >> 2);
#pragma unroll
      for (int et = 0; et < 8; ++et) {
        const s16x4 vlo = tr_read(il + GL_V + tr256_off(r0, et) + (fr & 3) * 8), vhi = tr_read(il + GL_V + tr256_off(r0 + 16, et) + (fr & 3) * 8);
        const s16x8 vf = __builtin_shufflevector(vlo, vhi, 0, 1, 2, 3, 4, 5, 6, 7);
        acc[et] = __builtin_amdgcn_mfma_f32_16x16x32_bf16(vf, pf, acc[et], 0, 0, 0);
      }
    }
  }
#pragma unroll
  for (int ks = 0; ks < 2; ++ks) {
    const int r0 = 32 * ks + 8 * fq + (fr >> 2);
#pragma unroll
    for (int et = 0; et < 8; ++et) {
      const s16x4 slo = tr_read(il + GL_SIN + tr256_off(r0, et) + (fr & 3) * 8), shi = tr_read(il + GL_SIN + tr256_off(r0 + 4, et) + (fr & 3) * 8);
      const s16x8 sf = __builtin_shufflevector(slo, shi, 0, 1, 2, 3, 4, 5, 6, 7);
      acc[et] = __builtin_amdgcn_mfma_f32_16x16x32_bf16(sf, qf[ks], acc[et], 0, 0, 0);
    }
  }
  float ss = 0.f;
#pragma unroll
  for (int et = 0; et < 8; ++et) ss += acc[et][0] * acc[et][0] + acc[et][1] * acc[et][1] + acc[et][2] * acc[et][2] + acc[et][3] * acc[et][3];
  ss += __shfl_xor(ss, 16); ss += __shfl_xor(ss, 32);
  const float rn = rsqrtf(ss * (1.f / 128.f) + 1e-6f);
  const size_t trow = t0 + 16 * w + fr;
#pragma unroll
  for (int et = 0; et < 8; ++et) {
    const int e = et * 16 + fq * 4;
    const f32x4 ng = *(const f32x4*)(p.gla_norm_g + e), rg = ld_bf4(p.proj + trow * LDP + OFF_R + h * 128 + e);
    u32x2 o; o.x = cvtpk(acc[et][0] * rn * ng[0] * siluf_(rg[0]), acc[et][1] * rn * ng[1] * siluf_(rg[1])); o.y = cvtpk(acc[et][2] * rn * ng[2] * siluf_(rg[2]), acc[et][3] * rn * ng[3] * siluf_(rg[3]));
    *(u32x2*)(p.yB + trow * GVAL + h * 128 + e) = o;
  }
}

__device__ __forceinline__ void phase_mix_local(PR p, int bid, int nb, lds_ptr smem, int which) {
  for (int idx = bid; idx < 1024 + 512; idx += nb) {
    if (idx < 1024) { if (which & 1) { __syncthreads(); s5_block_item<false>(p, idx, smem); } }
    else if (which & 2) gla_pass1(p, idx - 1024, smem);
  }
}
__device__ __forceinline__ void phase_mix_carry(PR p, int bid, int nb, int which) {
  const int gtid = bid * NTHR + ltid(), gsz = nb * NTHR;
  if (which & 1) for (int i = gtid; i < NB * S5G * S5P; i += gsz) {
    const int pq = i & 63, g = (i >> 6) & 31, b = i >> 11;
    const float are = p.apow64[(g * 64 + pq) * 2], aim = p.apow64[(g * 64 + pq) * 2 + 1];
    float sre = 0.f, sim = 0.f;
    for (int c = 0; c < 32; ++c) {
      const size_t sidx = (((size_t)b * 32 + c) * S5G + g) * 64 + pq;
      p.s5Sin[sidx * 2] = sre; p.s5Sin[sidx * 2 + 1] = sim;
      const float er = p.s5E[sidx * 2], ei = p.s5E[sidx * 2 + 1];
      const float nr = are * sre - aim * sim + er, ni = are * sim + aim * sre + ei;
      sre = nr; sim = ni;
    }
  }
  if (which & 2) for (int i = gtid; i < NB * GH * 64 * 128; i += gsz) {
    const int e = i & 127, d = (i >> 7) & 63, bh = i >> 13;
    float S = 0.f;
#pragma unroll 8
    for (int c = 0; c < 32; ++c) {
      const size_t it = (size_t)bh * 32 + c;
      p.glaSin[(it * 64 + d) * 128 + e] = f2bf(S);
      S = p.glaDec[it * 64 + d] * S + p.glaKV[(it * 64 + d) * 128 + e];
    }
  }
}
__device__ __forceinline__ void phase_mix_final(PR p, int bid, int nb, lds_ptr smem, int which) {
  for (int idx = bid; idx < 1024 + 512; idx += nb) {
    if (idx < 1024) { if (which & 1) { __syncthreads(); s5_block_item<true>(p, idx, smem); } }
    else if (which & 2) gla_pass2(p, idx - 1024, smem);
  }
}

__device__ __forceinline__ void phase_route(PR p, int bid, int nb) {
  const int lane = ltid() & 63, wid = ltid() >> 6;
  const f32x4 bias = *(const f32x4*)(p.router_bias + lane * 4);
  for (int t = bid * 8 + wid; t < T; t += nb * 8) {
    const f32x4 lg = *(const f32x4*)(p.logits + (size_t)t * NE + lane * 4);
    float sc[4], v[4];
#pragma unroll
    for (int j = 0; j < 4; ++j) { sc[j] = sigmoidf_(lg[j]); v[j] = sc[j] + bias[j]; }
    float m1 = fmaxf(v[0], v[1]), m2 = fminf(v[0], v[1]);
#pragma unroll
    for (int j = 2; j < 4; ++j) { const float nm1 = fmaxf(m1, v[j]); m2 = fmaxf(fminf(m1, v[j]), m2); m1 = nm1; }
#pragma unroll
    for (int o = 1; o < 8; o <<= 1) { const float o1 = __shfl_xor(m1, o), o2 = __shfl_xor(m2, o); const float nm1 = fmaxf(m1, o1); m2 = fmaxf(fminf(m1, o1), fmaxf(m2, o2)); m1 = nm1; }
    const float gs = m1 + m2;
    const int grp = lane >> 3;
    int rank = 0;
#pragma unroll
    for (int g2 = 0; g2 < 8; ++g2) { const float og = __shfl(gs, g2 * 8); rank += (og > gs || (og == gs && g2 < grp)) ? 1 : 0; }
    const bool gsel = rank < 4;
#pragma unroll
    for (int j = 0; j < 4; ++j) v[j] = gsel ? v[j] : -INFINITY;
    int my_e = 0; float my_s = 0.f, wsum = 0.f;
#pragma unroll 1
    for (int r = 0; r < 8; ++r) {
      float bv = v[0]; int bi = 0;
#pragma unroll
      for (int j = 1; j < 4; ++j) if (v[j] > bv) { bv = v[j]; bi = j; }
      int be = lane * 4 + bi;
#pragma unroll
      for (int o = 1; o < 64; o <<= 1) { const float ov = __shfl_xor(bv, o); const int oe = __shfl_xor(be, o); if (ov > bv || (ov == bv && oe < be)) { bv = ov; be = oe; } }
      const int ol = be >> 2, oj = be & 3;
      float s_own = 0.f;
#pragma unroll
      for (int j = 0; j < 4; ++j) if (lane == ol && oj == j) { s_own = sc[j]; v[j] = -INFINITY; }
      const float s_w = __shfl(s_own, ol);
      wsum += s_w;
      if (lane == r) { my_e = be; my_s = s_w; }
    }
    if (lane < 8) {
      p.tk_idx[t * 8 + lane] = my_e;
      p.tk_w[t * 8 + lane] = my_s / wsum * 2.5f;
      p.tk_rank[t * 8 + lane] = atomicAdd(&p.counts[my_e], 1);
    }
  }
}
__device__ __forceinline__ void phase_scatter(PR p, int bid, int nb, lds_ptr smem) {
  LAS int* st = (LAS int*)smem;
  __syncthreads();
  if (ltid() < 256) st[ltid() + 1] = (p.counts[ltid()] + 127) / 128 * 128;
  if (ltid() == 0) st[0] = 0;
  __syncthreads();
  if (ltid() < 64) {
    const int ln = ltid();
    const int c0 = st[4 * ln + 1], c1 = st[4 * ln + 2], c2 = st[4 * ln + 3], c3 = st[4 * ln + 4];
    const int tot = c0 + c1 + c2 + c3;
    int inc = tot;
    #pragma unroll
    for (int o = 1; o < 64; o <<= 1) { const int v = __shfl_up(inc, o, 64); if (ln >= o) inc += v; }
    const int b0 = inc - tot;
    st[4 * ln + 1] = b0 + c0; st[4 * ln + 2] = b0 + c0 + c1; st[4 * ln + 3] = b0 + c0 + c1 + c2; st[4 * ln + 4] = inc;
  }
  __syncthreads();
  if (bid == 0) {
    if (ltid() < 256) { const int e = ltid(); for (int b = st[e] / 128; b < st[e + 1] / 128; ++b) p.blk_exp[b] = e; }
    for (int b = st[256] / 128 + ltid(); b < NBLK128; b += NTHR) p.blk_exp[b] = -1;
  }
  if (bid >= 8 && bid < 16 && ltid() < 64) {
    const int x = bid - 8, ln = ltid() & 63, half = ln >> 5;
    const int e = x + 8 * (ln & 31);
    const int np = (st[e + 1] / 128 - st[e] / 128 + 1) >> 1;
    int inc = np;
    #pragma unroll
    for (int o = 1; o < 32; o <<= 1) { const int v = __shfl_up(inc, o, 32); if ((ln & 31) >= o) inc += v; }
    const int base = inc - np;
    if (half == 0) for (int j = 0; j < np; ++j) p.moe_list[x * NBLK128 + base + j] = st[e] / 128 + 2 * j;
    if (ln == 31) p.moe_cnt[x] = inc;
  }
  for (int i = bid * NTHR + ltid(); i < T * 8; i += nb * NTHR) {
    const int e = p.tk_idx[i], pos = st[e] + p.tk_rank[i];
    p.slot_tok[pos] = i >> 3;
    p.slot_of[i] = pos;
  }
}

__global__ void __launch_bounds__(64) k_s5_naive(P p) {
  __shared__ float sre[64], sim[64], cre[16][64], cim[16][64], us[16];
  const int b = blockIdx.x / S5G, g = blockIdx.x % S5G, lane = threadIdx.x;
  const float are = p.abar[(g * 64 + lane) * 2], aim = p.abar[(g * 64 + lane) * 2 + 1];
  float bre[16], bim[16];
  for (int h = 0; h < 16; ++h) { bre[h] = p.bbar[((g * 64 + lane) * 16 + h) * 2]; bim[h] = p.bbar[((g * 64 + lane) * 16 + h) * 2 + 1]; }
  for (int i = lane; i < 1024; i += 64) { cre[i >> 6][i & 63] = p.c_re[g * 1024 + i]; cim[i >> 6][i & 63] = p.c_im[g * 1024 + i]; }
  const float dsk = lane < 16 ? p.s5_d[g * 16 + lane] : 0.f;
  float s_re = 0.f, s_im = 0.f;
  __syncthreads();
  for (int l = 0; l < SEQ; ++l) {
    const size_t t = (size_t)b * SEQ + l;
    if (lane < 16) us[lane] = bf2f(p.proj[t * LDP + OFF_U + g * 16 + lane]);
    __syncthreads();
    float bur = 0.f, bui = 0.f;
    for (int h = 0; h < 16; ++h) { bur += us[h] * bre[h]; bui += us[h] * bim[h]; }
    const float nr = are * s_re - aim * s_im + bur, ni = are * s_im + aim * s_re + bui;
    s_re = nr; s_im = ni;
    sre[lane] = s_re; sim[lane] = s_im;
    __syncthreads();
    if (lane < 16) {
      float y = dsk * us[lane];
      for (int q = 0; q < 64; ++q) y += sre[q] * cre[lane][q] - sim[q] * cim[lane][q];
      p.yA[t * S5W + g * 16 + lane] = f2bf(geluf_(y));
    }
    __syncthreads();
  }
}

__global__ void __launch_bounds__(128) k_gla_naive(P p) {
  __shared__ float qs[32][64], ks[32][64], as[32][64], gl[32][16], w2[16][64], b2[64];
  const int b = blockIdx.x / GH, h = blockIdx.x % GH, tid = threadIdx.x;
  for (int i = tid; i < 16 * 64; i += 128) w2[i >> 6][i & 63] = p.w_gk2[(i >> 6) * GKEY + h * 64 + (i & 63)];
  if (tid < 64) b2[tid] = p.b_gk2[h * 64 + tid];
  float S[64];
  for (int d = 0; d < 64; ++d) S[d] = 0.f;
  for (int l0 = 0; l0 < SEQ; l0 += 32) {
    __syncthreads();
    for (int i = tid; i < 32 * 64; i += 128) {
      const size_t t = (size_t)b * SEQ + l0 + (i >> 6);
      qs[i >> 6][i & 63] = bf2f(p.proj[t * LDP + OFF_Q + h * 64 + (i & 63)]) * 0.125f;
      ks[i >> 6][i & 63] = bf2f(p.proj[t * LDP + OFF_K + h * 64 + (i & 63)]);
    }
    for (int i = tid; i < 32 * 16; i += 128) { const size_t t = (size_t)b * SEQ + l0 + (i >> 4); gl[i >> 4][i & 15] = p.gkl[t * 16 + (i & 15)]; }
    __syncthreads();
    for (int i = tid; i < 32 * 64; i += 128) {
      const int s = i >> 6, d = i & 63;
      float gk = b2[d];
      for (int r = 0; r < 16; ++r) gk += gl[s][r] * w2[r][d];
      as[s][d] = __expf(logsigmoidf_(gk) * (1.f / 16.f));
    }
    __syncthreads();
    for (int s = 0; s < 32; ++s) {
      const size_t t = (size_t)b * SEQ + l0 + s;
      const float v = bf2f(p.proj[t * LDP + OFF_V + h * 128 + tid]);
      float o = 0.f;
      for (int d = 0; d < 64; ++d) { S[d] = as[s][d] * S[d] + ks[s][d] * v; o += qs[s][d] * S[d]; }
      p.oraw[t * GVAL + h * 128 + tid] = o;
    }
  }
}
__global__ void __launch_bounds__(256) k_gla_post(P p) {
  const int idx = blockIdx.x * 4 + (threadIdx.x >> 6), lane = threadIdx.x & 63;
  const int t = idx / GH, h = idx % GH;
  const float o0 = p.oraw[(size_t)t * GVAL + h * 128 + lane], o1 = p.oraw[(size_t)t * GVAL + h * 128 + 64 + lane];
  float ss = o0 * o0 + o1 * o1;
  for (int o = 32; o > 0; o >>= 1) ss += __shfl_xor(ss, o);
  const float r = rsqrtf(ss * (1.f / 128.f) + 1e-6f);
  const float r0 = bf2f(p.proj[(size_t)t * LDP + OFF_R + h * 128 + lane]), r1 = bf2f(p.proj[(size_t)t * LDP + OFF_R + h * 128 + 64 + lane]);
  p.yB[(size_t)t * GVAL + h * 128 + lane] = f2bf(o0 * r * p.gla_norm_g[lane] * siluf_(r0));
  p.yB[(size_t)t * GVAL + h * 128 + 64 + lane] = f2bf(o1 * r * p.gla_norm_g[64 + lane] * siluf_(r1));
}

__global__ void __launch_bounds__(64) k_route(P p) {
  const int t = blockIdx.x * 64 + threadIdx.x;
  const float* lg = p.logits + (size_t)t * NE;
  float gs[8];
#pragma unroll
  for (int g = 0; g < 8; ++g) {
    float m1 = -INFINITY, m2 = -INFINITY;
    for (int j = 0; j < 32; ++j) { const float v = sigmoidf_(lg[g * 32 + j]) + p.router_bias[g * 32 + j]; if (v > m1) { m2 = m1; m1 = v; } else if (v > m2) m2 = v; }
    gs[g] = m1 + m2;
  }
  unsigned gmask = 0;
#pragma unroll
  for (int r = 0; r < 4; ++r) { int best = -1; float bv = -INFINITY;
#pragma unroll
    for (int g = 0; g < 8; ++g) if (!((gmask >> g) & 1u) && gs[g] > bv) { bv = gs[g]; best = g; }
    gmask |= 1u << best; }
  int sel[8]; float sw[8]; float wsum = 0.f;
#pragma unroll
  for (int r = 0; r < 8; ++r) {
    int best = -1; float bv = -INFINITY;
    for (int e = 0; e < NE; ++e) {
      if (!((gmask >> (e >> 5)) & 1u)) continue;
      bool taken = false;
#pragma unroll
      for (int q = 0; q < 8; ++q) taken |= (q < r) && (sel[q] == e);
      if (taken) continue;
      const float v = sigmoidf_(lg[e]) + p.router_bias[e];
      if (v > bv) { bv = v; best = e; }
    }
    best = best < 0 ? r : best;
    sel[r] = best; sw[r] = sigmoidf_(lg[best]); wsum += sw[r];
  }
#pragma unroll
  for (int r = 0; r < 8; ++r) {
    p.tk_idx[t * 8 + r] = sel[r];
    p.tk_w[t * 8 + r] = sw[r] / wsum * 2.5f;
    p.tk_rank[t * 8 + r] = atomicAdd(&p.counts[sel[r]], 1);
  }
}
__global__ void __launch_bounds__(256) k_offsets(P p) {
  __shared__ int pad[256], st[257];
  const int e = threadIdx.x;
  pad[e] = (p.counts[e] + 127) / 128 * 128;
  __syncthreads();
  if (e == 0) { int s = 0; for (int i = 0; i < 256; ++i) { st[i] = s; s += pad[i]; } st[256] = s; }
  __syncthreads();
  p.pad_start[e] = st[e];
  if (e == 0) p.pad_start[256] = st[256];
  for (int b = st[e] / 128; b < st[e + 1] / 128; ++b) p.blk_exp[b] = e;
  for (int b = st[256] / 128 + e; b < NBLK128; b += 256) p.blk_exp[b] = -1;
}
__global__ void __launch_bounds__(256) k_scatter(P p) {
  const int i = blockIdx.x * 256 + threadIdx.x;
  const int e = p.tk_idx[i], pos = p.pad_start[e] + p.tk_rank[i];
  p.slot_tok[pos] = i >> 3;
  p.slot_of[i] = pos;
}

__device__ __forceinline__ void phase_combine(PR p, int bid, int nb) {
  const int lane = ltid() & 63, wid = ltid() >> 6;
  for (int t = bid * 8 + wid; t < T; t += nb * 8) {
    const int b = t / SEQ;
    int so[8]; float w[8];
#pragma unroll
    for (int k = 0; k < 8; ++k) { so[k] = p.slot_of[t * 8 + k]; w[k] = p.tk_w[t * 8 + k]; }
    float v[16], ss = 0.f;
#pragma unroll
    for (int i = 0; i < 4; ++i) {
      const int c0 = lane * 4 + 256 * i;
      f32x4 m = ld_bf4(p.S + (size_t)t * D + c0);
#pragma unroll
      for (int k = 0; k < 8; ++k) { const f32x4 y = ld_bf4(p.Y + (size_t)so[k] * D + c0); m[0] += w[k] * y[0]; m[1] += w[k] * y[1]; m[2] += w[k] * y[2]; m[3] += w[k] * y[3]; }
      const f32x4 xv = *(const f32x4*)(p.x1 + (size_t)t * D + c0), gg = *(const f32x4*)(p.mod + b * 6144 + 5 * D + c0);
#pragma unroll
      for (int j = 0; j < 4; ++j) { v[i * 4 + j] = xv[j] + gg[j] * m[j]; ss += v[i * 4 + j] * v[i * 4 + j]; }
    }
#pragma unroll
    for (int o = 32; o > 0; o >>= 1) ss += __shfl_xor(ss, o);
    const float r = rsqrtf(ss * (1.f / D) + 1e-6f);
#pragma unroll
    for (int i = 0; i < 4; ++i) {
      const int c0 = lane * 4 + 256 * i; const f32x4 fg = *(const f32x4*)(p.final_g + c0);
      f32x4 o; o[0] = v[i * 4] * r * fg[0]; o[1] = v[i * 4 + 1] * r * fg[1]; o[2] = v[i * 4 + 2] * r * fg[2]; o[3] = v[i * 4 + 3] * r * fg[3];
      *(f32x4*)(p.out + (size_t)t * D + c0) = o;
    }
  }
}


template <class Epi>
__global__ void __launch_bounds__(256) k_gemm_naive(const bf16_t* __restrict__ A, int lda, const float* __restrict__ Bm, int ldb, int M, int N, int K, Epi epi) {
  __shared__ float As[16][68];
  __shared__ float Bs[16][68];
  const int tx = threadIdx.x & 15, ty = threadIdx.x >> 4;
  const int row0 = blockIdx.y * 64, col0 = blockIdx.x * 64;
  float acc[4][4];
  for (int i = 0; i < 4; ++i) for (int j = 0; j < 4; ++j) acc[i][j] = 0.f;
  for (int k0 = 0; k0 < K; k0 += 16) {
    { const int r = threadIdx.x >> 2, k4 = (threadIdx.x & 3) * 4;
      const bf16_t* ap = A + (size_t)(row0 + r) * lda + k0 + k4;
      for (int j = 0; j < 4; ++j) As[k4 + j][r] = bf2f(ap[j]); }
    { const int k = threadIdx.x >> 4, c4 = (threadIdx.x & 15) * 4;
      for (int j = 0; j < 4; ++j) { const int cc = col0 + c4 + j; Bs[k][c4 + j] = cc < N ? Bm[(size_t)(k0 + k) * ldb + cc] : 0.f; } }
    __syncthreads();
    for (int k = 0; k < 16; ++k) {
      float a[4], b[4];
      for (int i = 0; i < 4; ++i) a[i] = As[k][ty * 4 + i];
      for (int j = 0; j < 4; ++j) b[j] = Bs[k][tx * 4 + j];
      for (int i = 0; i < 4; ++i) for (int j = 0; j < 4; ++j) acc[i][j] += a[i] * b[j];
    }
    __syncthreads();
  }
  for (int i = 0; i < 4; ++i) for (int j = 0; j < 4; ++j) { const int r = row0 + ty * 4 + i, cc = col0 + tx * 4 + j; if (cc < N) epi(r, cc, acc[i][j]); }
}
struct NEpiProj { bf16_t* o; __device__ void operator()(int r, int c, float v) const { if (c >= WIN_GK && c < WIN_GK + 16) return; const int cc = c < WIN_GK ? c : c - 16; o[(size_t)r * LDP + cc] = f2bf(v); } };
struct NEpiGlu { const bf16_t* yA; const float* b; bf16_t* z; __device__ void operator()(int r, int c, float v) const { const float y = bf2f(yA[(size_t)r * S5W + c]); z[(size_t)r * S5W + c] = f2bf(y * sigmoidf_(v + b[c])); } };
struct NEpiPA { const bf16_t* proj; float* t; __device__ void operator()(int r, int c, float v) const { t[(size_t)r * D + c] = sigmoidf_(bf2f(proj[(size_t)r * LDP + OFF_GA + c])) * v; } };
struct NEpiPB { const bf16_t* proj; const float* t; bf16_t* m; __device__ void operator()(int r, int c, float v) const { m[(size_t)r * D + c] = f2bf(t[(size_t)r * D + c] + sigmoidf_(bf2f(proj[(size_t)r * LDP + OFF_GB + c])) * v); } };
struct NEpiOut { const float* x; const float* mod; float* x1; __device__ void operator()(int r, int c, float v) const { const int b = r / SEQ; x1[(size_t)r * D + c] = x[(size_t)r * D + c] + mod[b * 6144 + 2 * D + c] * v; } };
struct NEpiF32 { float* o; long ld; __device__ void operator()(int r, int c, float v) const { o[(size_t)r * ld + c] = v; } };
struct NEpiShUp { const float* g; bf16_t* h; __device__ void operator()(int r, int c, float v) const { h[(size_t)r * SFF + c] = f2bf(siluf_(g[(size_t)r * SFF + c]) * v); } };
struct NEpiBf { bf16_t* o; long ld; __device__ void operator()(int r, int c, float v) const { o[(size_t)r * ld + c] = f2bf(v); } };
__global__ void __launch_bounds__(256) k_moe_naive(P p) {
  __shared__ float xs[16][1024];
  __shared__ float hs[16][256];
  __shared__ int toks[16];
  const int s0 = blockIdx.x * 16, e = p.blk_exp[s0 / 128], tid = threadIdx.x;
  if (e < 0) return;
  if (tid < 16) toks[tid] = p.slot_tok[s0 + tid];
  __syncthreads();
  bool any = false;
  for (int s = 0; s < 16; ++s) any |= toks[s] >= 0;
  if (!any) return;
  for (int i = tid; i < 16 * 1024; i += 256) { const int s = i >> 10, d = i & 1023; xs[s][d] = toks[s] >= 0 ? bf2f(p.h2[(size_t)toks[s] * D + d]) : 0.f; }
  __syncthreads();
  {
    float ag[16], au[16];
    for (int s = 0; s < 16; ++s) { ag[s] = 0.f; au[s] = 0.f; }
    const float* wg = p.ew_gate + (size_t)e * D * EFF + tid;
    const float* wu = p.ew_up + (size_t)e * D * EFF + tid;
    for (int d = 0; d < D; ++d) {
      const float g = wg[(size_t)d * EFF], u = wu[(size_t)d * EFF];
      for (int s = 0; s < 16; ++s) { const float xv = xs[s][d]; ag[s] += xv * g; au[s] += xv * u; }
    }
    for (int s = 0; s < 16; ++s) hs[s][tid] = bf2f(f2bf(siluf_(ag[s]) * au[s]));
  }
  __syncthreads();
  for (int nb = 0; nb < 4; ++nb) {
    float acc[16];
    for (int s = 0; s < 16; ++s) acc[s] = 0.f;
    const float* wd = p.ew_down + (size_t)e * EFF * D + nb * 256 + tid;
    for (int j = 0; j < EFF; ++j) { const float w = wd[(size_t)j * D]; for (int s = 0; s < 16; ++s) acc[s] += hs[s][j] * w; }
    for (int s = 0; s < 16; ++s) if (toks[s] >= 0) p.Y[(size_t)(s0 + s) * D + nb * 256 + tid] = f2bf(acc[s]);
  }
}

#define SMEM_DECL __shared__ __attribute__((aligned(16))) unsigned char smem_raw[SMEM_BYTES]; const lds_ptr smem = (lds_ptr)smem_raw;


#define XB_TMO      128
#define XB_XCNT(j)  (256  + 64 * (j))
#define XB_XSUB(j)  (1280 + 64 * (j))
#define XB_XGEN(j)  (2304 + 64 * (j))
#define XB_TOP      3328
#define XB_TOPGEN   3392
#define XCD_BAR_WORDS 3456
#define XB_SPIN_CAP (1u << 18)
__device__ __forceinline__ unsigned xb_ld(unsigned* q)              { return __hip_atomic_load(q, __ATOMIC_RELAXED, __HIP_MEMORY_SCOPE_AGENT); }
__device__ __forceinline__ unsigned xb_add(unsigned* q, unsigned v) { return __hip_atomic_fetch_add(q, v, __ATOMIC_RELAXED, __HIP_MEMORY_SCOPE_AGENT); }
__device__ __forceinline__ unsigned xb_xcc_id() { return (unsigned)__builtin_amdgcn_s_getreg((3 << 11) | 20) & 0xFu; }
#define XB_SPIN(cond, bar) do { unsigned _sp = 0; while (cond) { __builtin_amdgcn_s_sleep(1); \
    if ((++_sp & 255u) == 0u) { if (xb_ld(&(bar)[XB_TMO])) break; if (_sp > XB_SPIN_CAP) { atomicAdd(&(bar)[XB_TMO], 1u); break; } } } } while (0)
struct XcdBarrier { unsigned* bar; unsigned x; volatile LAS unsigned* st; };
__device__ __forceinline__ XcdBarrier xcd_barrier_post(unsigned* bar, volatile LAS unsigned* st) {
  XcdBarrier b; b.bar = bar; b.x = xb_xcc_id(); b.st = st;
  if (threadIdx.x == 0) (void)xb_add(&bar[XB_XCNT(b.x)], 1u);
  return b;
}
__device__ __forceinline__ void xcd_barrier_complete(unsigned* bar, unsigned x, unsigned& nloc, unsigned& nx) {
  const unsigned G = gridDim.x * gridDim.y * gridDim.z;
  unsigned sum, cnt, mine, sp = 0u;
  for (;;) {
    sum = 0u; cnt = 0u; mine = 0u;
#pragma unroll
    for (unsigned j = 0; j < 16; ++j) { const unsigned c = xb_ld(&bar[XB_XCNT(j)]); sum += c; cnt += (c > 0u) ? 1u : 0u; mine = (j == x) ? c : mine; }
    if (sum == G) break;
    __builtin_amdgcn_s_sleep(1);
    if ((++sp & 255u) == 0u) { if (xb_ld(&bar[XB_TMO])) break; if (sp > XB_SPIN_CAP) { atomicAdd(&bar[XB_TMO], 1u); break; } }
  }
  nloc = mine > 0u ? mine : 1u; nx = cnt > 0u ? cnt : 1u;
}
__device__ __forceinline__ void xcd_barrier(const XcdBarrier& b) {
  asm volatile("s_waitcnt vmcnt(0)" ::: "memory");
  __syncthreads();
  if (threadIdx.x == 0) {
    unsigned* bar = b.bar;
    __builtin_amdgcn_s_waitcnt(0);
    unsigned nloc = b.st[0], nx = b.st[1];
    if (nloc == 0u) { xcd_barrier_complete(bar, b.x, nloc, nx); b.st[0] = nloc; b.st[1] = nx; }
    const unsigned old = xb_add(&bar[XB_XSUB(b.x)], 1u);
    const unsigned gen = old / nloc;
    if (old + 1u == (gen + 1u) * nloc) {
      __builtin_amdgcn_fence(__ATOMIC_RELEASE, "agent");
      asm volatile("s_waitcnt vmcnt(0)" ::: "memory");
      const unsigned og = xb_add(&bar[XB_TOP], 1u);
      const unsigned tg = og / nx;
      if (og + 1u == (tg + 1u) * nx) xb_add(&bar[XB_TOPGEN], 1u);
      else XB_SPIN(xb_ld(&bar[XB_TOPGEN]) == tg, bar);
      __builtin_amdgcn_fence(__ATOMIC_ACQUIRE, "agent");
      xb_add(&bar[XB_XGEN(b.x)], 1u);
      asm volatile("s_waitcnt vmcnt(0)" ::: "memory");
    } else {
      XB_SPIN(xb_ld(&bar[XB_XGEN(b.x)]) == gen, bar);
      __builtin_amdgcn_fence(__ATOMIC_ACQUIRE, "agent");
      asm volatile("s_waitcnt vmcnt(0)" ::: "memory");
    }
  }
  __syncthreads();
}

__device__ __forceinline__ const __attribute__((address_space(4))) P* kargs() { auto q = __builtin_amdgcn_kernarg_segment_ptr(); asm volatile("" : "+s"(q)); return (const __attribute__((address_space(4))) P*)q; }
#define PK (*kargs())
__global__ void __launch_bounds__(NTHR) k_fused(P p_unused) {
  SMEM_DECL
  const int bid = blockIdx.x, nb = gridDim.x;
  volatile LAS unsigned* xbw = (volatile LAS unsigned*)(smem + SMEM_BYTES - 16);
  if (threadIdx.x == 0) { xbw[0] = 0u; xbw[1] = 0u; }
  __syncthreads();
  const XcdBarrier xb = xcd_barrier_post(PK.bar, xbw);
#define GSYNC() xcd_barrier(xb)
#define RUN(k, ...) do { __VA_ARGS__; if (REP_PHASE == (k)) { __VA_ARGS__; } } while (0)
  RUN(0, phase_prep(PK, bid, nb, smem));                                                                   GSYNC();
  RUN(1, phase_norm<false>(PK, PK.x, PK.norm1_g, 0, D, PK.h1, bid, nb, smem));                                 GSYNC();
  RUN(2, phase_gemm_dense256_bf16(PK.h1, D, PK.wb_in, LDP, T, LDP, D, PK.proj, LDP, bid, nb, smem); gk_rows(PK, bid, nb));     GSYNC();
  RUN(3, phase_mix_local(PK, bid, nb, smem, 3));                                                           GSYNC();
  RUN(4, phase_mix_carry(PK, bid, nb, 3));                                                                 GSYNC();
  RUN(5, phase_mix_final(PK, bid, nb, smem, 3));                                                           GSYNC();
  RUN(6, phase_gemm_dense(PK.yA, S5W, PK.wb_glu, S5W, T, S5W, S5W, EpiGlu{PK.yA, PK.b_glu, PK.zA}, bid, nb, smem));   GSYNC();
  RUN(7, phase_gemm_mixed(PK, bid, nb, smem));                                                             GSYNC();
  RUN(8, phase_gemm_dense256(PK.mixed, D, PK.wb_out, D, T, D, D, EpiOut{PK.x, PK.mod, PK.x1}, bid, nb, smem));    GSYNC();
  RUN(9, phase_norm<false>(PK, PK.x1, PK.norm2_g, 3 * D, 4 * D, PK.h2, bid, nb, smem));                       GSYNC();
  RUN(10, phase_gemm_rs(PK, bid, nb, smem));                                                               GSYNC();
  phase_route(PK, bid, nb);                                                                                GSYNC();
  RUN(12, phase_scatter(PK, bid, nb, smem));                                                               GSYNC();
  phase_moe_pair<1>(PK, bid, nb, smem);                                                                    GSYNC();
  phase_moe_pair<2>(PK, bid, nb, smem);
  RUN(14, phase_gemm_dense256_bf16(PK.shH, SFF, PK.wb_sd, D, T, D, SFF, PK.S, D, bid, nb, smem));        GSYNC();
  RUN(15, phase_combine(PK, bid, nb));
}

static inline size_t al256(size_t v) { return (v + 255) & ~(size_t)255; }

extern "C" void kernel_launch(void* const* d_in, const int* in_sizes, int n_in, void* d_out, int out_size, void* d_ws, size_t ws_size, hipStream_t stream) {
  P p{};
  const float** pin = (const float**)&p;
  for (int i = 0; i < 32; ++i) pin[i] = (const float*)d_in[i];
  p.out = (float*)d_out;
  char* w = (char*)d_ws; size_t off = 0;
  auto take = [&](size_t bytes) { char* r = w + off; off = al256(off + bytes); return (void*)r; };
  p.mod = (float*)take(8 * 6144 * 4);
  p.wb_in = (bf16_t*)take((size_t)D * LDP * 2);
  p.wb_glu = (bf16_t*)take((size_t)S5W * S5W * 2);
  p.wb_pa = (bf16_t*)take((size_t)S5W * D * 2);
  p.wb_pb = (bf16_t*)take((size_t)GVAL * D * 2);
  p.wb_out = (bf16_t*)take((size_t)D * D * 2);
  p.wb_rs = (bf16_t*)take((size_t)D * 768 * 2);
  p.wb_sd = (bf16_t*)take((size_t)SFF * D * 2);
  p.h1 = (bf16_t*)take((size_t)T * D * 2);
  p.gkl = (float*)take((size_t)T * 16 * 4);
  p.proj = (bf16_t*)take((size_t)T * LDP * 2);
  p.abar = (float*)take(S5G * S5P * 2 * 4);
  p.bbar = (float*)take(S5G * S5P * S5H * 2 * 4);
  p.yA = (bf16_t*)take((size_t)T * S5W * 2);
  p.oraw = (float*)take((size_t)T * GVAL * 4);
  p.yB = (bf16_t*)take((size_t)T * GVAL * 2);
  p.zA = (bf16_t*)take((size_t)T * S5W * 2);
  p.mixed = (bf16_t*)take((size_t)T * D * 2);
  p.x1 = (float*)take((size_t)T * D * 4);
  p.h2 = (bf16_t*)take((size_t)T * D * 2);
  p.logits = (float*)take((size_t)T * NE * 4);
  p.tk_idx = (int*)take((size_t)T * 8 * 4);
  p.tk_w = (float*)take((size_t)T * 8 * 4);
  p.tk_rank = (int*)take((size_t)T * 8 * 4);
  p.slot_of = (int*)take((size_t)T * 8 * 4);
  p.counts = (int*)take(256 * 4);
  p.pad_start = (int*)take(257 * 4);
  p.blk_exp = (int*)take(NBLK128 * 4);
  p.slot_tok = (int*)take((size_t)NSLOT * 4);
  p.Y = (bf16_t*)take((size_t)NSLOT * D * 2);
  p.shH = (bf16_t*)take((size_t)T * SFF * 2);
  p.S = (bf16_t*)take((size_t)T * D * 2);
  p.bbarT = (bf16_t*)take((size_t)S5G * 128 * 16 * 2);
  p.cmT = (bf16_t*)take((size_t)S5G * 16 * 128 * 2);
  p.apow64 = (float*)take(S5G * S5P * 2 * 4);
  p.s5E = (float*)take((size_t)NB * 32 * S5G * 64 * 2 * 4);
  p.s5Sin = (float*)take((size_t)NB * 32 * S5G * 64 * 2 * 4);
  p.glaKV = (float*)take((size_t)1024 * 64 * 128 * 4);
  p.glaDec = (float*)take((size_t)1024 * 64 * 4);
  p.glaSin = (bf16_t*)take((size_t)1024 * 64 * 128 * 2);
  p.wgkT = (bf16_t*)take((size_t)16 * D * 2);
  p.moe_list = (int*)take((size_t)8 * NBLK128 * 4);
  p.moe_cnt = (int*)take(64);
  p.moe_ctr = (int*)take(64);
  p.Hbuf = (bf16_t*)take((size_t)NSLOT * EFF * 2);
  p.bar = (unsigned*)take(XCD_BAR_WORDS * 4);
  if (off > ws_size) { fprintf(stderr, "workspace too small: need %zu have %zu\n", off, ws_size); return; }

  static int grid_blocks = 0;
  if (!grid_blocks) {
    int dev = 0, cus = 0, per_cu = 0;
    (void)hipGetDevice(&dev);
    (void)hipDeviceGetAttribute(&cus, hipDeviceAttributeMultiprocessorCount, dev);
    (void)hipOccupancyMaxActiveBlocksPerMultiprocessor(&per_cu, k_fused, NTHR, 0);
    grid_blocks = (per_cu >= 1) ? cus : 0;
    grid_blocks &= ~7;
    if (grid_blocks <= 0) { fprintf(stderr, "occupancy query says the fused kernel does not fit (per_cu=%d cus=%d)\n", per_cu, cus); grid_blocks = 0; return; }
  }
  (void)hipMemsetAsync(p.bar, 0, XCD_BAR_WORDS * 4, stream);
  void* args[] = {&p};
  hipError_t e = hipLaunchCooperativeKernel((const void*)k_fused, dim3(grid_blocks), dim3(NTHR), args, 0, stream);
  if (e != hipSuccess) fprintf(stderr, "cooperative launch failed: %s (grid %d)\n", hipGetErrorString(e), grid_blocks);
}
```

```cpp
#include <hip/hip_runtime.h>
#include <hip/hip_cooperative_groups.h>
namespace cg = cooperative_groups;
#include <cstdint>
#include <cstdio>

typedef unsigned short bf16_t;
typedef short s16x8 __attribute__((ext_vector_type(8)));
typedef short s16x4 __attribute__((ext_vector_type(4)));
typedef float f32x4 __attribute__((ext_vector_type(4)));
typedef unsigned u32x4 __attribute__((ext_vector_type(4)));
typedef unsigned u32x2 __attribute__((ext_vector_type(2)));
#define LAS __attribute__((address_space(3)))
typedef LAS unsigned char* lds_ptr;

constexpr int D = 1024, NB = 8, SEQ = 2048, T = NB * SEQ;
constexpr int S5W = 512, S5G = 32, S5H = 16, S5P = 64;
constexpr int GH = 4, GDK = 64, GDV = 128, GKEY = 256, GVAL = 512, GRANK = 16;
constexpr int NE = 256, TOPK = 8, NGRP = 8, EFF = 256, SFF = 256;
constexpr int INW = 4112, LDP = 4096;
constexpr int OFF_U = 0, OFF_Q = 512, OFF_K = 768, OFF_V = 1024, OFF_R = 1536, OFF_GA = 2048, OFF_GB = 3072;
constexpr int WIN_GK = 1536;
constexpr int NSLOT = 163584, NBLK128 = NSLOT / 128;
constexpr int NTHR = 512;
constexpr int USE_MFMA = 127;
constexpr int USE_NEW = 7;
constexpr int REP_PHASE = -1, REP_N = 8;
constexpr int MOE_REP_GU = 1, MOE_REP_DN = 1;

__device__ __forceinline__ float bf2f(bf16_t v) { return __uint_as_float(((unsigned)v) << 16); }
__device__ __forceinline__ bf16_t f2bf(float f) { return __builtin_bit_cast(unsigned short, (__bf16)f); }
typedef float f32x2 __attribute__((ext_vector_type(2)));
typedef __bf16 bf16x2_t __attribute__((ext_vector_type(2)));
__device__ __forceinline__ unsigned cvtpk(float lo, float hi) { const f32x2 v = {lo, hi}; return __builtin_bit_cast(unsigned, __builtin_convertvector(v, bf16x2_t)); }
__device__ __forceinline__ float sigmoidf_(float x) { return __builtin_amdgcn_rcpf(1.f + __expf(-x)); }
__device__ __forceinline__ float siluf_(float x) { return x * __builtin_amdgcn_rcpf(1.f + __expf(-x)); }
__device__ __forceinline__ float geluf_(float x) { const float u = 0.7978845608028654f * (x + 0.044715f * x * x * x); return x * __builtin_amdgcn_rcpf(1.f + __expf(-2.f * u)); }
__device__ __forceinline__ float logsigmoidf_(float x) { return fminf(x, 0.f) - __logf(1.f + __expf(-fabsf(x))); }

struct P;
typedef const __attribute__((address_space(4))) P& PR;

__device__ __forceinline__ int ltid() { int t = threadIdx.x; asm volatile("" : "+v"(t)); return t; }

struct P {
  const float *x, *c, *ada_w, *ada_b, *norm1_g, *w_in, *lam_re, *lam_im, *log_dt, *b_re, *b_im, *c_re, *c_im, *s5_d, *w_glu, *b_glu, *w_proj_a,
      *w_gk2, *b_gk2, *gla_norm_g, *w_proj_b, *w_out, *norm2_g, *router_w, *router_bias, *ew_gate, *ew_up, *ew_down, *sw_gate, *sw_up, *sw_down, *final_g;
  float* out;
  float* mod;
  bf16_t* wb_in;
  bf16_t* wb_glu;
  bf16_t* wb_pa;
  bf16_t* wb_pb;
  bf16_t* wb_out;
  bf16_t* wb_rs;
  bf16_t* wb_sd;
  bf16_t* h1;
  float* gkl;
  bf16_t* proj;
  float* abar;
  float* bbar;
  bf16_t* yA;
  float* oraw;
  bf16_t* yB;
  bf16_t* zA;
  bf16_t* mixed;
  float* x1;
  bf16_t* h2;
  float* logits;
  int* tk_idx;
  float* tk_w;
  int* tk_rank;
  int* slot_of;
  int* counts;
  int* pad_start;
  int* blk_exp;
  int* slot_tok;
  bf16_t* Y;
  bf16_t* shH;
  bf16_t* S;
  bf16_t* bbarT;
  bf16_t* cmT;
  float* apow64;
  float* s5E;
  float* s5Sin;
  float* glaKV;
  float* glaDec;
  bf16_t* glaSin;
  bf16_t* wgkT;
  int* moe_list;
  int* moe_cnt;
  int* moe_ctr;
  bf16_t* Hbuf;
  unsigned* bar;
};

constexpr int G_ASZ = 128 * 64, G_BSZ = 32 * 512, G_STAGE = G_ASZ + G_BSZ;

__device__ __forceinline__ int a_off(int r, int c) { return r * 64 + ((c ^ ((0x78 >> (((r >> 2) & 3) * 2)) & 3)) << 4); }
__device__ __forceinline__ int b_off(int k, int ch) { return k * 512 + ((ch ^ ((k & 3) | (((k >> 3) & 1) << 2))) << 5); }
__device__ __forceinline__ s16x4 tr_read(lds_ptr p) { return __builtin_bit_cast(s16x4, __builtin_amdgcn_ds_read_tr16_b64_v4i16((LAS s16x4*)p)); }

struct ALoadDense { const bf16_t* A; long lda; __device__ __forceinline__ const bf16_t* rowptr(int r) const { return A + (size_t)r * lda; } };
struct ALoadGatherLds { const bf16_t* A; LAS int* tk; __device__ __forceinline__ const bf16_t* rowptr(int r) const { int t = tk[r]; t = t < 0 ? 0 : t; return A + (size_t)t * D; } };
struct BLoadBf { const bf16_t* Bm; long ldb;
  __device__ __forceinline__ u32x4 load(int kg, int c8) const { return *(const u32x4*)(Bm + (size_t)kg * ldb + c8 * 8); } };
struct BLoadF32 { const float* Bm; long ldb;
  __device__ __forceinline__ u32x4 load(int kg, int c8) const { const float* q = Bm + (size_t)kg * ldb + c8 * 8; const f32x4 a = *(const f32x4*)q, b = *(const f32x4*)(q + 4);
    u32x4 r; r.x = cvtpk(a[0], a[1]); r.y = cvtpk(a[2], a[3]); r.z = cvtpk(b[0], b[1]); r.w = cvtpk(b[2], b[3]); return r; } };
struct BLoadGU { const float* Wg; const float* Wu; long ldb; int h0;
  __device__ __forceinline__ u32x4 load(int kg, int c8) const { const int col = c8 * 8, w = col >> 6, xx = col & 63; const float* base = (xx < 32) ? Wg : Wu;
    const float* q = base + (size_t)kg * ldb + h0 + 32 * w + (xx & 31); const f32x4 a = *(const f32x4*)q, b = *(const f32x4*)(q + 4);
    u32x4 r; r.x = cvtpk(a[0], a[1]); r.y = cvtpk(a[2], a[3]); r.z = cvtpk(b[0], b[1]); r.w = cvtpk(b[2], b[3]); return r; } };

template <bool A_RES, class AL, class BL>
__device__ __forceinline__ void gemm_mainloop(f32x4 (&acc)[4][4], const AL& al, const BL& bl, int nk, lds_ptr stage, lds_ptr resA) {
  const int tid = ltid(), lane = tid & 63, wid = tid >> 6, wm = wid >> 2, wn = wid & 3, fr = lane & 15, fq = lane >> 4;
  const int ar = tid >> 2, ac = tid & 3;
  const int p0 = tid, p1 = tid + 512;
  const int bk0 = p0 >> 5, bc0 = p0 & 31, bk1 = p1 >> 5, bc1 = p1 & 31;
  const bf16_t* aptr = nullptr;
  if (!A_RES) aptr = al.rowptr(ar) + ac * 8;
  const int a_st = a_off(ar, ac);
  const int b_st0 = b_off(bk0, bc0 >> 1) + (bc0 & 1) * 16, b_st1 = b_off(bk1, bc1 >> 1) + (bc1 & 1) * 16;
  int a_rd[4];
#pragma unroll
  for (int mt = 0; mt < 4; ++mt) a_rd[mt] = a_off(wm * 64 + mt * 16 + fr, fq);
  int b_rd[4][2];
#pragma unroll
  for (int nt = 0; nt < 4; ++nt) {
    b_rd[nt][0] = b_off(8 * fq + (fr >> 2), wn * 4 + nt) + (fr & 3) * 8;
    b_rd[nt][1] = b_off(8 * fq + 4 + (fr >> 2), wn * 4 + nt) + (fr & 3) * 8;
  }
#pragma unroll
  for (int mt = 0; mt < 4; ++mt)
#pragma unroll
    for (int nt = 0; nt < 4; ++nt) acc[mt][nt] = (f32x4){0.f, 0.f, 0.f, 0.f};
  u32x4 areg = {0, 0, 0, 0}, breg0, breg1;
  if (!A_RES) areg = *(const u32x4*)aptr;
  breg0 = bl.load(bk0, bc0); breg1 = bl.load(bk1, bc1);
  __syncthreads();
  if (!A_RES) *(LAS u32x4*)(stage + a_st) = areg;
  *(LAS u32x4*)(stage + G_ASZ + b_st0) = breg0;
  *(LAS u32x4*)(stage + G_ASZ + b_st1) = breg1;
  __syncthreads();
  for (int kt = 0; kt < nk; ++kt) {
    const lds_ptr cur = stage + (kt & 1) * G_STAGE, nxt = stage + ((kt + 1) & 1) * G_STAGE;
    const bool more = kt + 1 < nk;
    if (more) {
      if (!A_RES) areg = *(const u32x4*)(aptr + (kt + 1) * 32);
      breg0 = bl.load((kt + 1) * 32 + bk0, bc0); breg1 = bl.load((kt + 1) * 32 + bk1, bc1);
    }
    s16x8 af[4], bfr[4];
    const lds_ptr abase = A_RES ? (resA + kt * G_ASZ) : cur;
#pragma unroll
    for (int mt = 0; mt < 4; ++mt) af[mt] = *(LAS s16x8*)(abase + a_rd[mt]);
#pragma unroll
    for (int nt = 0; nt < 4; ++nt) {
      const s16x4 lo = tr_read(cur + G_ASZ + b_rd[nt][0]), hi = tr_read(cur + G_ASZ + b_rd[nt][1]);
      bfr[nt] = __builtin_shufflevector(lo, hi, 0, 1, 2, 3, 4, 5, 6, 7);
    }
#pragma unroll
    for (int mt = 0; mt < 4; ++mt)
#pragma unroll
      for (int nt = 0; nt < 4; ++nt) acc[mt][nt] = __builtin_amdgcn_mfma_f32_16x16x32_bf16(bfr[nt], af[mt], acc[mt][nt], 0, 0, 0);
    if (more) {
      if (!A_RES) *(LAS u32x4*)(nxt + a_st) = areg;
      *(LAS u32x4*)(nxt + G_ASZ + b_st0) = breg0;
      *(LAS u32x4*)(nxt + G_ASZ + b_st1) = breg1;
    }
    __syncthreads();
  }
}


struct BRaw { f32x4 v[4]; };
struct BLoadF32R { const float* Bm; long ldb;
  __device__ __forceinline__ void load(BRaw& r, int kbase, int tid) const {
    const float* q = Bm + (size_t)(kbase + (tid >> 6)) * ldb + (tid & 63) * 4;
#pragma unroll
    for (int i = 0; i < 4; ++i) r.v[i] = *(const f32x4*)(q + (size_t)(8 * i) * ldb); } };
struct BLoadGUR { const float* Wg; long du; long ldb; int h0;
  __device__ __forceinline__ void load(BRaw& r, int kbase, int tid) const {
    const int col = (tid & 63) * 4, w = col >> 6, xx = col & 63;
    const float* q = Wg + ((xx < 32) ? 0l : du) + (size_t)(kbase + (tid >> 6)) * ldb + h0 + 32 * w + (xx & 31);
#pragma unroll
    for (int i = 0; i < 4; ++i) r.v[i] = *(const f32x4*)(q + (size_t)(8 * i) * ldb); } };
__device__ __forceinline__ u32x4 cvt8(const f32x4& a, const f32x4& b) { u32x4 r; r.x = cvtpk(a[0], a[1]); r.y = cvtpk(a[2], a[3]); r.z = cvtpk(b[0], b[1]); r.w = cvtpk(b[2], b[3]); return r; }

template <bool A_RES, class AL, class BL>
__device__ __forceinline__ void gemm_mainloop_r3(f32x4 (&acc)[4][4], const AL& al, const BL& bl, int nk, lds_ptr stage, lds_ptr resA) {
  const int tid = ltid(), lane = tid & 63, wid = tid >> 6, wm = wid >> 2, wn = wid & 3, fr = lane & 15, fq = lane >> 4;
  const int ar = tid >> 2, ac = tid & 3;
  const bf16_t* aptr = nullptr;
  if (!A_RES) aptr = al.rowptr(ar) + ac * 8;
  const int a_st = a_off(ar, ac);
  int b_st[4];
#pragma unroll
  for (int i = 0; i < 4; ++i) b_st[i] = G_ASZ + b_off((tid >> 6) + 8 * i, (tid & 63) >> 2) + (tid & 3) * 8;
  int a_rd[4];
#pragma unroll
  for (int mt = 0; mt < 4; ++mt) a_rd[mt] = a_off(wm * 64 + mt * 16 + fr, fq);
  int b_rd[4][2];
#pragma unroll
  for (int nt = 0; nt < 4; ++nt) {
    b_rd[nt][0] = G_ASZ + b_off(8 * fq + (fr >> 2), wn * 4 + nt) + (fr & 3) * 8;
    b_rd[nt][1] = G_ASZ + b_off(8 * fq + 4 + (fr >> 2), wn * 4 + nt) + (fr & 3) * 8;
  }
#pragma unroll
  for (int mt = 0; mt < 4; ++mt)
#pragma unroll
    for (int nt = 0; nt < 4; ++nt) acc[mt][nt] = (f32x4){0.f, 0.f, 0.f, 0.f};
  u32x4 ra0 = {0, 0, 0, 0}, ra1 = {0, 0, 0, 0}, ra2 = {0, 0, 0, 0};
  BRaw rb0, rb1, rb2;
#define R3_LOAD(RA, RB, kt_) do { if (!A_RES) RA = *(const u32x4*)(aptr + (size_t)(kt_) * 32); bl.load(RB, (kt_) * 32, tid); } while (0)
#define R3_STORE(RA, RB, st_) do { const lds_ptr s_ = stage + (st_) * G_STAGE; if (!A_RES) *(LAS u32x4*)(s_ + a_st) = RA; \
    _Pragma("unroll") for (int i_ = 0; i_ < 4; ++i_) { u32x2 o_; o_.x = cvtpk(RB.v[i_][0], RB.v[i_][1]); o_.y = cvtpk(RB.v[i_][2], RB.v[i_][3]); *(LAS u32x2*)(s_ + b_st[i_]) = o_; } } while (0)
#define R3_COMPUTE(kt_) do { const lds_ptr cur = stage + ((kt_) & 1) * G_STAGE; const lds_ptr abase = A_RES ? (resA + (kt_) * G_ASZ) : cur; \
    s16x8 af[4], bfr[4]; \
    _Pragma("unroll") for (int mt = 0; mt < 4; ++mt) af[mt] = *(LAS s16x8*)(abase + a_rd[mt]); \
    _Pragma("unroll") for (int nt = 0; nt < 4; ++nt) { const s16x4 lo = tr_read(cur + b_rd[nt][0]), hi = tr_read(cur + b_rd[nt][1]); bfr[nt] = __builtin_shufflevector(lo, hi, 0, 1, 2, 3, 4, 5, 6, 7); } \
    _Pragma("unroll") for (int mt = 0; mt < 4; ++mt) _Pragma("unroll") for (int nt = 0; nt < 4; ++nt) acc[mt][nt] = __builtin_amdgcn_mfma_f32_16x16x32_bf16(bfr[nt], af[mt], acc[mt][nt], 0, 0, 0); } while (0)
#define R3_BODY_U(kt_, RAN, RBN, RAW, RBW) do { const int kl_ = ((kt_) + 3 < nk) ? (kt_) + 3 : nk - 1; R3_LOAD(RAN, RBN, kl_); __builtin_amdgcn_sched_barrier(0); R3_COMPUTE(kt_); __builtin_amdgcn_sched_barrier(0); R3_STORE(RAW, RBW, ((kt_) + 1) & 1); __syncthreads(); } while (0)
#define R3_BODY_T(kt_, RAW, RBW) do { R3_COMPUTE(kt_); if ((kt_) + 1 < nk) R3_STORE(RAW, RBW, ((kt_) + 1) & 1); __syncthreads(); } while (0)
  R3_LOAD(ra0, rb0, 0);
  R3_LOAD(ra1, rb1, 1);
  R3_LOAD(ra2, rb2, 2);
  __syncthreads();
  R3_STORE(ra0, rb0, 0);
  __syncthreads();
  int kt = 0;
  for (; kt + 3 <= nk; kt += 3) {
    R3_BODY_U(kt, ra0, rb0, ra1, rb1);
    R3_BODY_U(kt + 1, ra1, rb1, ra2, rb2);
    R3_BODY_U(kt + 2, ra2, rb2, ra0, rb0);
  }
  if (kt < nk) { R3_BODY_T(kt, ra1, rb1); if (kt + 1 < nk) R3_BODY_T(kt + 1, ra2, rb2); }
#undef R3_BODY_U
#undef R3_BODY_T
#undef R3_LOAD
#undef R3_STORE
#undef R3_COMPUTE
}

constexpr int G_NST = 4;
#define WAIT_VM(n) asm volatile("s_waitcnt vmcnt(" #n ")" ::: "memory")
template <class AL>
__device__ __forceinline__ void gemm_mainloop_glds(f32x4 (&acc)[4][4], const AL& al, const bf16_t* __restrict__ Bm, long ldb, int nk, lds_ptr ring) {
  const int tid = ltid(), lane = tid & 63, wid = tid >> 6, wm = wid >> 2, wn = wid & 3, fr = lane & 15, fq = lane >> 4;
  const int ar = tid >> 2;
  const bf16_t* aptr = al.rowptr(ar) + (((tid & 3) ^ ((0x78 >> (((ar >> 2) & 3) * 2)) & 3)) << 3);
  const int bk = tid >> 5, pc = tid & 31;
  const int bcol = ((((pc >> 1) ^ ((bk & 3) | (((bk >> 3) & 1) << 2))) << 4) | ((pc & 1) << 3));
  const bf16_t* bptr0 = Bm + (size_t)bk * ldb + bcol;
  const bf16_t* bptr1 = bptr0 + (size_t)16 * ldb;
  const size_t bstep = (size_t)32 * ldb;
  int a_rd[4];
#pragma unroll
  for (int mt = 0; mt < 4; ++mt) a_rd[mt] = a_off(wm * 64 + mt * 16 + fr, fq);
  int b_rd[4][2];
#pragma unroll
  for (int nt = 0; nt < 4; ++nt) {
    b_rd[nt][0] = G_ASZ + b_off(8 * fq + (fr >> 2), wn * 4 + nt) + (fr & 3) * 8;
    b_rd[nt][1] = G_ASZ + b_off(8 * fq + 4 + (fr >> 2), wn * 4 + nt) + (fr & 3) * 8;
  }
#pragma unroll
  for (int mt = 0; mt < 4; ++mt)
#pragma unroll
    for (int nt = 0; nt < 4; ++nt) acc[mt][nt] = (f32x4){0.f, 0.f, 0.f, 0.f};
  const lds_ptr dstl = ring + tid * 16;
#define GLDS_ISSUE(kt_) do { const lds_ptr d_ = dstl + ((kt_) & (G_NST - 1)) * G_STAGE; \
    __builtin_amdgcn_global_load_lds((const unsigned*)(aptr + (size_t)(kt_) * 32), (LAS unsigned*)(d_), 16, 0, 0); \
    __builtin_amdgcn_global_load_lds((const unsigned*)(bptr0 + (size_t)(kt_) * bstep), (LAS unsigned*)(d_ + G_ASZ), 16, 0, 0); \
    __builtin_amdgcn_global_load_lds((const unsigned*)(bptr1 + (size_t)(kt_) * bstep), (LAS unsigned*)(d_ + G_ASZ + 8192), 16, 0, 0); } while (0)
  __syncthreads();
  GLDS_ISSUE(0);
  if (nk > 1) GLDS_ISSUE(1);
  if (nk > 2) GLDS_ISSUE(2);
  for (int kt = 0; kt < nk; ++kt) {
    if (kt + 2 < nk) WAIT_VM(6); else if (kt + 1 < nk) WAIT_VM(3); else WAIT_VM(0);
    __builtin_amdgcn_s_barrier();
    if (kt + 3 < nk) GLDS_ISSUE(kt + 3);
    const lds_ptr cur = ring + (kt & (G_NST - 1)) * G_STAGE;
    s16x8 af[4], bfr[4];
#pragma unroll
    for (int mt = 0; mt < 4; ++mt) af[mt] = *(LAS s16x8*)(cur + a_rd[mt]);
#pragma unroll
    for (int nt = 0; nt < 4; ++nt) {
      const s16x4 lo = tr_read(cur + b_rd[nt][0]), hi = tr_read(cur + b_rd[nt][1]);
      bfr[nt] = __builtin_shufflevector(lo, hi, 0, 1, 2, 3, 4, 5, 6, 7);
    }
#pragma unroll
    for (int mt = 0; mt < 4; ++mt)
#pragma unroll
      for (int nt = 0; nt < 4; ++nt) acc[mt][nt] = __builtin_amdgcn_mfma_f32_16x16x32_bf16(bfr[nt], af[mt], acc[mt][nt], 0, 0, 0);
  }
#undef GLDS_ISSUE
}


constexpr int G2_STAGE = 2 * G_ASZ + G_BSZ;
__device__ __forceinline__ void gemm_mainloop_glds256(f32x4 (&acc)[8][4], const bf16_t* __restrict__ A, long lda, const bf16_t* __restrict__ Bm, long ldb, int nk, lds_ptr ring) {
  const int tid = ltid(), lane = tid & 63, wid = tid >> 6, wm = wid >> 2, wn = wid & 3, fr = lane & 15, fq = lane >> 4;
  const int ar = tid >> 2;
  const bf16_t* aptr0 = A + (size_t)ar * lda + (((tid & 3) ^ ((0x78 >> (((ar >> 2) & 3) * 2)) & 3)) << 3);
  const bf16_t* aptr1 = aptr0 + (size_t)128 * lda;
  const int bk = tid >> 5, pc = tid & 31;
  const int bcol = ((((pc >> 1) ^ ((bk & 3) | (((bk >> 3) & 1) << 2))) << 4) | ((pc & 1) << 3));
  const bf16_t* bptr0 = Bm + (size_t)bk * ldb + bcol;
  const bf16_t* bptr1 = bptr0 + (size_t)16 * ldb;
  const size_t bstep = (size_t)32 * ldb;
  int a_rd[8];
#pragma unroll
  for (int mt = 0; mt < 8; ++mt) a_rd[mt] = wm * G_ASZ + a_off(mt * 16 + fr, fq);
  int b_rd[4][2];
#pragma unroll
  for (int nt = 0; nt < 4; ++nt) {
    b_rd[nt][0] = 2 * G_ASZ + b_off(8 * fq + (fr >> 2), wn * 4 + nt) + (fr & 3) * 8;
    b_rd[nt][1] = 2 * G_ASZ + b_off(8 * fq + 4 + (fr >> 2), wn * 4 + nt) + (fr & 3) * 8;
  }
#pragma unroll
  for (int mt = 0; mt < 8; ++mt)
#pragma unroll
    for (int nt = 0; nt < 4; ++nt) acc[mt][nt] = (f32x4){0.f, 0.f, 0.f, 0.f};
  const lds_ptr dstl = ring + tid * 16;
#define GLDS2_ISSUE(kt_) do { const lds_ptr d_ = dstl + ((kt_) & (G_NST - 1)) * G2_STAGE; \
    __builtin_amdgcn_global_load_lds((const unsigned*)(aptr0 + (size_t)(kt_) * 32), (LAS unsigned*)(d_), 16, 0, 0); \
    __builtin_amdgcn_global_load_lds((const unsigned*)(aptr1 + (size_t)(kt_) * 32), (LAS unsigned*)(d_ + G_ASZ), 16, 0, 0); \
    __builtin_amdgcn_global_load_lds((const unsigned*)(bptr0 + (size_t)(kt_) * bstep), (LAS unsigned*)(d_ + 2 * G_ASZ), 16, 0, 0); \
    __builtin_amdgcn_global_load_lds((const unsigned*)(bptr1 + (size_t)(kt_) * bstep), (LAS unsigned*)(d_ + 2 * G_ASZ + 8192), 16, 0, 0); } while (0)
  __syncthreads();
  GLDS2_ISSUE(0);
  if (nk > 1) GLDS2_ISSUE(1);
  if (nk > 2) GLDS2_ISSUE(2);
  for (int kt = 0; kt < nk; ++kt) {
    if (kt + 2 < nk) WAIT_VM(8); else if (kt + 1 < nk) WAIT_VM(4); else WAIT_VM(0);
    __builtin_amdgcn_s_barrier();
    if (kt + 3 < nk) GLDS2_ISSUE(kt + 3);
    const lds_ptr cur = ring + (kt & (G_NST - 1)) * G2_STAGE;
    s16x8 bfr[4];
#pragma unroll
    for (int nt = 0; nt < 4; ++nt) {
      const s16x4 lo = tr_read(cur + b_rd[nt][0]), hi = tr_read(cur + b_rd[nt][1]);
      bfr[nt] = __builtin_shufflevector(lo, hi, 0, 1, 2, 3, 4, 5, 6, 7);
    }
#pragma unroll
    for (int h = 0; h < 2; ++h) {
      s16x8 af[4];
#pragma unroll
      for (int mt = 0; mt < 4; ++mt) af[mt] = *(LAS s16x8*)(cur + a_rd[h * 4 + mt]);
#pragma unroll
      for (int mt = 0; mt < 4; ++mt)
#pragma unroll
        for (int nt = 0; nt < 4; ++nt) acc[h * 4 + mt][nt] = __builtin_amdgcn_mfma_f32_16x16x32_bf16(bfr[nt], af[mt], acc[h * 4 + mt][nt], 0, 0, 0);
    }
  }
#undef GLDS2_ISSUE
}

__device__ __forceinline__ void tile_map(int round, int bid, int nb, int nMt, int nNt, int& mt, int& nt, bool& valid) {
  if (nb == 256 && (nNt & 3) == 0 && (nMt & 7) == 0) {
    const int xcd = bid & 7, j = bid >> 3, q = round * 8 + xcd, rn = nNt >> 2;
    const int rect_m = q / rn, rect_n = q % rn;
    mt = rect_m * 8 + (j & 7); nt = rect_n * 4 + (j >> 3); valid = mt < nMt;
  } else {
    const int per = (nb + 7) / 8, xcd = bid & 7, j = bid >> 3;
    const int idx = round * nb + xcd * per + j;
    mt = idx / nNt; nt = idx % nNt; valid = (j < per) && (idx < nMt * nNt) && (xcd * per + j < nb);
  }
}

__device__ __forceinline__ void cvt_copy(const float* __restrict__ src, long lds_, bf16_t* __restrict__ dst, long ldd, int rows, int cols, int gtid, int gsz) {
  const int c4 = cols >> 2;
  for (long i = gtid; i < (long)rows * c4; i += gsz) {
    const int r = (int)(i / c4), c = (int)(i % c4) * 4;
    const f32x4 v = *(const f32x4*)(src + (size_t)r * lds_ + c);
    u32x2 o; o.x = cvtpk(v[0], v[1]); o.y = cvtpk(v[2], v[3]);
    *(u32x2*)(dst + (size_t)r * ldd + c) = o;
  }
}
__device__ __forceinline__ void phase_prep(PR p, int bid, int nb, lds_ptr smem) {
  const int gtid = bid * NTHR + ltid(), gsz = nb * NTHR;
  cvt_copy(p.w_in, INW, p.wb_in, LDP, D, WIN_GK, gtid, gsz);
  cvt_copy(p.w_in + WIN_GK + 16, INW, p.wb_in + WIN_GK, LDP, D, LDP - WIN_GK, gtid, gsz);
  cvt_copy(p.w_glu, S5W, p.wb_glu, S5W, S5W, S5W, gtid, gsz);
  cvt_copy(p.w_proj_a, D, p.wb_pa, D, S5W, D, gtid, gsz);
  cvt_copy(p.w_proj_b, D, p.wb_pb, D, GVAL, D, gtid, gsz);
  cvt_copy(p.w_out, D, p.wb_out, D, D, D, gtid, gsz);
  cvt_copy(p.router_w, NE, p.wb_rs, 768, D, NE, gtid, gsz);
  cvt_copy(p.sw_down, D, p.wb_sd, D, SFF, D, gtid, gsz);
  for (long i = gtid; i < (long)D * 512; i += gsz) {
    const int k = (int)(i >> 9), cc = (int)(i & 511), w = cc >> 6, xx = cc & 63;
    const int hcol = 32 * w + (xx & 31);
    const float v = (xx < 32) ? p.sw_gate[(size_t)k * SFF + hcol] : p.sw_up[(size_t)k * SFF + hcol];
    p.wb_rs[(size_t)k * 768 + 256 + cc] = f2bf(v);
  }
  for (int i = gtid; i < 16 * D; i += gsz) { const int n = i >> 10, k = i & 1023; p.wgkT[i] = f2bf(p.w_in[(size_t)k * INW + WIN_GK + n]); }
  for (int i = gtid; i < NSLOT; i += gsz) p.slot_tok[i] = -1;
  if (gtid < 256) p.counts[gtid] = 0;
  if (gtid < 16) p.moe_ctr[gtid] = 0;
  if (ltid() < 8 && bid * 8 + ltid() < S5G * S5P) {
    const int i = bid * 8 + ltid(), g = i / S5P;
    const double lr = p.lam_re[i], li = p.lam_im[i], dt = (double)__expf(p.log_dt[g]);
    const double TWO_PI = 6.283185307179586476925286766559;
    double ang = li * dt; ang -= TWO_PI * floor(ang / TWO_PI);
    const double mag = (double)__expf((float)(lr * dt));
    const double are = mag * (double)cosf((float)ang), aim = mag * (double)sinf((float)ang);
    const double den = lr * lr + li * li, nre = are - 1.0;
    const double cre = (nre * lr + aim * li) / den, cim = (aim * lr - nre * li) / den;
    p.abar[i * 2] = (float)are; p.abar[i * 2 + 1] = (float)aim;
    for (int h = 0; h < S5H; ++h) {
      const double br = p.b_re[i * S5H + h], bi = p.b_im[i * S5H + h];
      p.bbar[(i * S5H + h) * 2] = (float)(cre * br - cim * bi);
      p.bbar[(i * S5H + h) * 2 + 1] = (float)(cre * bi + cim * br);
      const int pq = i & 63;
      p.bbarT[(size_t)(g * 128 + 2 * pq) * 16 + h] = f2bf((float)(cre * br - cim * bi));
      p.bbarT[(size_t)(g * 128 + 2 * pq + 1) * 16 + h] = f2bf((float)(cre * bi + cim * br));
    }
    double a64 = 64.0 * li * dt; a64 -= TWO_PI * floor(a64 / TWO_PI);
    const double m64 = (double)__expf((float)(64.0 * lr * dt));
    p.apow64[i * 2] = (float)(m64 * (double)cosf((float)a64)); p.apow64[i * 2 + 1] = (float)(m64 * (double)sinf((float)a64));
  }
  for (int i = gtid; i < S5G * S5H * 128; i += gsz) {
    const int pp = i & 127, ho = (i >> 7) & 15, g = i >> 11;
    p.cmT[i] = f2bf((pp & 1) ? -p.c_im[(g * 16 + ho) * 64 + (pp >> 1)] : p.c_re[(g * 16 + ho) * 64 + (pp >> 1)]);
  }
  LAS float* red = (LAS float*)smem;
  LAS float* sc = (LAS float*)(smem + 16384);
  if (bid < 192) {
    __syncthreads();
    for (int i = ltid(); i < 8 * D; i += NTHR) sc[i] = siluf_(p.c[i]);
    __syncthreads();
  }
  for (int item = bid; item < 192; item += nb) {
    const int cl = ltid() & 31, kg = ltid() >> 5, col = item * 32 + cl;
    float acc[8];
#pragma unroll
    for (int b = 0; b < 8; ++b) acc[b] = 0.f;
    const float* wp = p.ada_w + (size_t)(kg * 64) * 6144 + col;
#pragma unroll 1
    for (int k0 = 0; k0 < 64; k0 += 16) {
      float w[16];
#pragma unroll
      for (int q = 0; q < 16; ++q) w[q] = wp[(size_t)(k0 + q) * 6144];
#pragma unroll
      for (int q = 0; q < 16; ++q)
#pragma unroll
        for (int b = 0; b < 8; ++b) acc[b] += sc[b * D + kg * 64 + k0 + q] * w[q];
    }
    __syncthreads();
#pragma unroll
    for (int b = 0; b < 8; ++b) red[(kg * 8 + b) * 32 + cl] = acc[b];
    __syncthreads();
    if (ltid() < 256) {
      const int b = ltid() >> 5, c2 = ltid() & 31;
      float sum = p.ada_b[item * 32 + c2];
      for (int q = 0; q < 16; ++q) sum += red[(q * 8 + b) * 32 + c2];
      p.mod[b * 6144 + item * 32 + c2] = sum;
    }
  }
}

template <bool WITH_GK>
__device__ __forceinline__ void phase_norm(PR p, const float* __restrict__ xin, const float* __restrict__ g, int sh_off, int sc_off, bf16_t* __restrict__ outp, int bid, int nb, lds_ptr smem) {
  const int lane = ltid() & 63, wid = ltid() >> 6;
  const int stride = nb * 8;
  int row = bid * 8 + wid;
  f32x4 nx[4];
  if (row < T) {
#pragma unroll
    for (int i = 0; i < 4; ++i) nx[i] = *(const f32x4*)(xin + (size_t)row * D + lane * 4 + 256 * i);
  }
  f32x4 gv[4];
#pragma unroll
  for (int i = 0; i < 4; ++i) gv[i] = *(const f32x4*)(g + lane * 4 + 256 * i);
  for (; row < T; row += stride) {
    const int b = row / SEQ;
    f32x4 v[4];
#pragma unroll
    for (int i = 0; i < 4; ++i) v[i] = nx[i];
    const int rn = row + stride;
    if (rn < T) {
#pragma unroll
      for (int i = 0; i < 4; ++i) nx[i] = *(const f32x4*)(xin + (size_t)rn * D + lane * 4 + 256 * i);
    }
    float ss = 0.f;
#pragma unroll
    for (int i = 0; i < 4; ++i) ss += v[i][0] * v[i][0] + v[i][1] * v[i][1] + v[i][2] * v[i][2] + v[i][3] * v[i][3];
#pragma unroll
    for (int o = 32; o > 0; o >>= 1) ss += __shfl_xor(ss, o);
    const float r = rsqrtf(ss * (1.f / D) + 1e-6f);
#pragma unroll
    for (int i = 0; i < 4; ++i) {
      const int c0 = lane * 4 + 256 * i;
      const f32x4 scv = *(const f32x4*)(p.mod + b * 6144 + sc_off + c0), shv = *(const f32x4*)(p.mod + b * 6144 + sh_off + c0);
      float y[4];
#pragma unroll
      for (int j = 0; j < 4; ++j) y[j] = (v[i][j] * r) * gv[i][j] * (1.f + scv[j]) + shv[j];
      u32x2 o; o.x = cvtpk(y[0], y[1]); o.y = cvtpk(y[2], y[3]);
      *(u32x2*)(outp + (size_t)row * D + c0) = o;
    }
  }
}

struct EpiStoreBf {
  bf16_t* O; long ld;
  template <int MT> __device__ __forceinline__ void operator()(const f32x4 (&acc)[MT][4], int mbase, int nbase, int fr, int fq) const {
    bf16_t* rowp = O + (size_t)(mbase + fr) * ld + nbase + fq * 4;
#pragma unroll
    for (int mt = 0; mt < MT; ++mt) {
#pragma unroll
      for (int nt = 0; nt < 4; ++nt) { const f32x4 v = acc[mt][nt]; u32x2 o; o.x = cvtpk(v[0], v[1]); o.y = cvtpk(v[2], v[3]);
        *(u32x2*)(rowp + nt * 16) = o; }
      rowp += 16 * ld;
      __builtin_amdgcn_sched_barrier(0); }
  }
};
__device__ __forceinline__ f32x4 ld_bf4(const bf16_t* q) { const u32x2 w = *(const u32x2*)q; f32x4 r; r[0] = __uint_as_float(w.x << 16); r[1] = __uint_as_float(w.x & 0xffff0000u); r[2] = __uint_as_float(w.y << 16); r[3] = __uint_as_float(w.y & 0xffff0000u); return r; }
struct EpiGlu {
  const bf16_t* yA; const float* b; bf16_t* z;
  template <int MT> __device__ __forceinline__ void operator()(const f32x4 (&acc)[MT][4], int mbase, int nbase, int fr, int fq) const {
#pragma unroll
    for (int mt = 0; mt < MT; ++mt) {
#pragma unroll
      for (int nt = 0; nt < 4; ++nt) { const int row = mbase + mt * 16 + fr, col = nbase + nt * 16 + fq * 4; const f32x4 v = acc[mt][nt];
        const f32x4 y = ld_bf4(yA + (size_t)row * S5W + col); const f32x4 bb = *(const f32x4*)(b + col);
        u32x2 o; o.x = cvtpk(y[0] * sigmoidf_(v[0] + bb[0]), y[1] * sigmoidf_(v[1] + bb[1])); o.y = cvtpk(y[2] * sigmoidf_(v[2] + bb[2]), y[3] * sigmoidf_(v[3] + bb[3]));
        *(u32x2*)(z + (size_t)row * S5W + col) = o; }
      __builtin_amdgcn_sched_barrier(0); }
  }
};
struct EpiOut {
  const float* x; const float* mod; float* x1;
  template <int MT> __device__ __forceinline__ void operator()(const f32x4 (&acc)[MT][4], int mbase, int nbase, int fr, int fq) const {
#pragma unroll
    for (int mt = 0; mt < MT; ++mt) {
#pragma unroll
      for (int nt = 0; nt < 4; ++nt) { const int row = mbase + mt * 16 + fr, col = nbase + nt * 16 + fq * 4, b = row / SEQ; const f32x4 v = acc[mt][nt];
        const f32x4 xv = *(const f32x4*)(x + (size_t)row * D + col), gg = *(const f32x4*)(mod + b * 6144 + 2 * D + col);
        f32x4 o; o[0] = xv[0] + gg[0] * v[0]; o[1] = xv[1] + gg[1] * v[1]; o[2] = xv[2] + gg[2] * v[2]; o[3] = xv[3] + gg[3] * v[3];
        *(f32x4*)(x1 + (size_t)row * D + col) = o; }
      __builtin_amdgcn_sched_barrier(0); }
  }
};

template <class Epi>
__device__ __forceinline__ void phase_gemm_dense(const bf16_t* A, long lda, const bf16_t* Bm, long ldb, int M, int N, int K, const Epi& epi, int bid, int nb, lds_ptr smem) {
  const int nMt = M / 128, nNt = N / 256, ntiles = nMt * nNt, rounds = (ntiles + nb - 1) / nb;
  const int lane = ltid() & 63, wid = ltid() >> 6, wm = wid >> 2, wn = wid & 3, fr = lane & 15, fq = lane >> 4;
  for (int r = 0; r < rounds; ++r) {
    int mt, nt; bool valid; tile_map(r, bid, nb, nMt, nNt, mt, nt, valid);
    if (!valid) continue;
    f32x4 acc[4][4];
    ALoadDense al{A + (size_t)mt * 128 * lda, lda};
    gemm_mainloop_glds(acc, al, Bm + nt * 256, ldb, K / 32, smem);
    epi.template operator()<4>(acc, mt * 128 + wm * 64, nt * 256 + wn * 64, fr, fq);
  }
}


template <class Epi>
__device__ __forceinline__ void phase_gemm_dense256(const bf16_t* A, long lda, const bf16_t* Bm, long ldb, int M, int N, int K, const Epi& epi, int bid, int nb, lds_ptr smem) {
  const int nMt = M / 256, nNt = N / 256, ntiles = nMt * nNt, rounds = (ntiles + nb - 1) / nb;
  const int lane = ltid() & 63, wid = ltid() >> 6, wm = wid >> 2, wn = wid & 3, fr = lane & 15, fq = lane >> 4;
  for (int r = 0; r < rounds; ++r) {
    int mt, nt; bool valid; tile_map(r, bid, nb, nMt, nNt, mt, nt, valid);
    if (!valid) continue;
    f32x4 acc[8][4];
    gemm_mainloop_glds256(acc, A + (size_t)mt * 256 * lda, lda, Bm + nt * 256, ldb, K / 32, smem);
    epi.template operator()<8>(acc, mt * 256 + wm * 128, nt * 256 + wn * 64, fr, fq);
  }
}


constexpr int ST_ROW = 528;
__device__ __forceinline__ void phase_gemm_dense256_bf16(const bf16_t* A, long lda, const bf16_t* Bm, long ldb, int M, int N, int K, bf16_t* O, long ldo, int bid, int nb, lds_ptr smem) {
  const int nMt = M / 256, nNt = N / 256, ntiles = nMt * nNt, rounds = (ntiles + nb - 1) / nb;
  for (int r = 0; r < rounds; ++r) {
    int mt, nt; bool valid; tile_map(r, bid, nb, nMt, nNt, mt, nt, valid);
    if (!valid) continue;
    f32x4 acc[8][4];
    gemm_mainloop_glds256(acc, A + (size_t)mt * 256 * lda, lda, Bm + nt * 256, ldb, K / 32, smem);
    const int t1 = ltid(), l1 = t1 & 63, w1 = t1 >> 6, wm = w1 >> 2;
    bf16_t* ob = O + (size_t)(mt * 256) * ldo + nt * 256 + (t1 & 31) * 8;
#pragma unroll
    for (int h = 0; h < 2; ++h) {
      __syncthreads();
      if (wm == h) {
#pragma unroll
        for (int i = 0; i < 8; ++i)
#pragma unroll
          for (int j = 0; j < 4; ++j) { const f32x4 v = acc[i][j]; u32x2 o; o.x = cvtpk(v[0], v[1]); o.y = cvtpk(v[2], v[3]);
            *(LAS u32x2*)(smem + (i * 16 + (l1 & 15)) * ST_ROW + ((w1 & 3) * 64 + j * 16 + (l1 >> 4) * 4) * 2) = o; }
      }
      __syncthreads();
#pragma unroll
      for (int ps = 0; ps < 8; ++ps) {
        const int row = ps * 16 + (t1 >> 5);
        *(u32x4*)(ob + (size_t)(h * 128 + row) * ldo) = *(LAS u32x4*)(smem + row * ST_ROW + (t1 & 31) * 16);
      }
    }
  }
}

__device__ __forceinline__ void gk_rows(PR p, int bid, int nb) {
  const int lane = ltid() & 63, wid = ltid() >> 6, fr = lane & 15, fq = lane >> 4;
  if (wid >= 4) return;
  for (int r0 = (bid * 4 + wid) * 16; r0 < T; r0 += nb * 64) {
    const bf16_t* ap = p.h1 + (size_t)(r0 + fr) * D + fq * 8;
    const bf16_t* bp = p.wgkT + (size_t)fr * D + fq * 8;
    f32x4 acc = {0.f, 0.f, 0.f, 0.f};
#pragma unroll 1
    for (int k0 = 0; k0 < 32; k0 += 8) {
      s16x8 a[8], b[8];
#pragma unroll
      for (int q = 0; q < 8; ++q) { a[q] = *(const s16x8*)(ap + (k0 + q) * 32); b[q] = *(const s16x8*)(bp + (k0 + q) * 32); }
#pragma unroll
      for (int q = 0; q < 8; ++q) acc = __builtin_amdgcn_mfma_f32_16x16x32_bf16(a[q], b[q], acc, 0, 0, 0);
    }
#pragma unroll
    for (int j = 0; j < 4; ++j) p.gkl[(size_t)(r0 + 4 * fq + j) * 16 + fr] = acc[j];
  }
}

__device__ __forceinline__ void phase_gemm_mixed(PR p, int bid, int nb, lds_ptr smem) {
  const int nMt = T / 128, nNt = D / 256, ntiles = nMt * nNt, rounds = (ntiles + nb - 1) / nb;
  const int lane = ltid() & 63, wid = ltid() >> 6, wm = wid >> 2, wn = wid & 3, fr = lane & 15, fq = lane >> 4;
  for (int r = 0; r < rounds; ++r) {
    int mt, nt; bool valid; tile_map(r, bid, nb, nMt, nNt, mt, nt, valid);
    if (!valid) continue;
    const int mbase = mt * 128 + wm * 64, nbase = nt * 256 + wn * 64;
    const bf16_t* gp = p.proj + (size_t)(mbase + fr) * LDP + nbase + fq * 4;
    u32x2 gte[4][4], pk[4][4];
#pragma unroll
    for (int i = 0; i < 4; ++i)
#pragma unroll
      for (int j = 0; j < 4; ++j) gte[i][j] = *(const u32x2*)(gp + (size_t)(i * 16) * LDP + OFF_GA + j * 16);
    f32x4 acc[4][4];
    { ALoadDense al{p.zA + (size_t)mt * 128 * S5W, S5W}; gemm_mainloop_glds(acc, al, p.wb_pa + nt * 256, D, S5W / 32, smem); }
#pragma unroll
    for (int i = 0; i < 4; ++i)
#pragma unroll
      for (int j = 0; j < 4; ++j) {
        const float g0 = __uint_as_float(gte[i][j].x << 16), g1 = __uint_as_float(gte[i][j].x & 0xffff0000u), g2 = __uint_as_float(gte[i][j].y << 16), g3 = __uint_as_float(gte[i][j].y & 0xffff0000u);
        pk[i][j].x = cvtpk(acc[i][j][0] * sigmoidf_(g0), acc[i][j][1] * sigmoidf_(g1)); pk[i][j].y = cvtpk(acc[i][j][2] * sigmoidf_(g2), acc[i][j][3] * sigmoidf_(g3)); }
#pragma unroll
    for (int i = 0; i < 4; ++i)
#pragma unroll
      for (int j = 0; j < 4; ++j) gte[i][j] = *(const u32x2*)(gp + (size_t)(i * 16) * LDP + OFF_GB + j * 16);
    { ALoadDense al{p.yB + (size_t)mt * 128 * GVAL, GVAL}; gemm_mainloop_glds(acc, al, p.wb_pb + nt * 256, D, GVAL / 32, smem); }
    bf16_t* op = p.mixed + (size_t)(mbase + fr) * D + nbase + fq * 4;
#pragma unroll
    for (int i = 0; i < 4; ++i)
#pragma unroll
      for (int j = 0; j < 4; ++j) {
        const float g0 = __uint_as_float(gte[i][j].x << 16), g1 = __uint_as_float(gte[i][j].x & 0xffff0000u), g2 = __uint_as_float(gte[i][j].y << 16), g3 = __uint_as_float(gte[i][j].y & 0xffff0000u);
        const float a0 = __uint_as_float(pk[i][j].x << 16), a1 = __uint_as_float(pk[i][j].x & 0xffff0000u), a2 = __uint_as_float(pk[i][j].y << 16), a3 = __uint_as_float(pk[i][j].y & 0xffff0000u);
        u32x2 o; o.x = cvtpk(a0 + sigmoidf_(g0) * acc[i][j][0], a1 + sigmoidf_(g1) * acc[i][j][1]); o.y = cvtpk(a2 + sigmoidf_(g2) * acc[i][j][2], a3 + sigmoidf_(g3) * acc[i][j][3]);
        *(u32x2*)(op + (size_t)(i * 16) * D + j * 16) = o; }
  }
}

__device__ __forceinline__ void phase_gemm_rs(PR p, int bid, int nb, lds_ptr smem) {
  const int nMt = T / 256, nNt = 3, ntiles = nMt * nNt, rounds = (ntiles + nb - 1) / nb;
  const int lane = ltid() & 63, wid = ltid() >> 6, wm = wid >> 2, wn = wid & 3, fr = lane & 15, fq = lane >> 4;
  for (int r = 0; r < rounds; ++r) {
    int mt, nt; bool valid; tile_map(r, bid, nb, nMt, nNt, mt, nt, valid);
    if (!valid) continue;
    f32x4 acc[8][4];
    gemm_mainloop_glds256(acc, p.h2 + (size_t)mt * 256 * D, D, p.wb_rs + nt * 256, 768, D / 32, smem);
    const int mbase = mt * 256 + wm * 128;
    if (nt == 0) {
#pragma unroll
      for (int i = 0; i < 8; ++i) {
#pragma unroll
        for (int j = 0; j < 4; ++j) *(f32x4*)(p.logits + (size_t)(mbase + i * 16 + fr) * NE + wn * 64 + j * 16 + fq * 4) = acc[i][j];
        __builtin_amdgcn_sched_barrier(0); }
    } else {
      const int h0 = (nt - 1) * 128 + wn * 32;
#pragma unroll
      for (int i = 0; i < 8; ++i) {
#pragma unroll
        for (int j = 0; j < 2; ++j) { const f32x4 gv = acc[i][j], uv = acc[i][j + 2];
          u32x2 o; o.x = cvtpk(siluf_(gv[0]) * uv[0], siluf_(gv[1]) * uv[1]); o.y = cvtpk(siluf_(gv[2]) * uv[2], siluf_(gv[3]) * uv[3]);
          *(u32x2*)(p.shH + (size_t)(mbase + i * 16 + fr) * SFF + h0 + j * 16 + fq * 4) = o; }
        __builtin_amdgcn_sched_barrier(0); }
    }
  }
}

constexpr int MOE_H_OFF = 2 * G_STAGE;
constexpr int MOE_TOK_OFF = MOE_H_OFF + 65536;
constexpr int SMEM_BYTES = 139264;
__device__ __forceinline__ void phase_moe(PR p, int bid, int nb, lds_ptr smem) {
  const int lane = ltid() & 63, wid = ltid() >> 6, wm = wid >> 2, wn = wid & 3, fr = lane & 15, fq = lane >> 4;
  LAS int* toks = (LAS int*)(smem + MOE_TOK_OFF);
  const lds_ptr Hs = smem + MOE_H_OFF;
  LAS int* qi = (LAS int*)(smem + MOE_TOK_OFF + 512);
  for (int sx = 0; sx < 8; ++sx) {
   const int x = (bid + sx) & 7;
   const int cnt = p.moe_cnt[x];
   for (;;) {
    __syncthreads();
    if (ltid() == 0) qi[0] = atomicAdd(&p.moe_ctr[x], 1);
    __syncthreads();
    const int qidx = qi[0];
    if (qidx >= cnt) break;
    const int blk = p.moe_list[x * NBLK128 + qidx];
    const int e = p.blk_exp[blk];
    if (ltid() < 128) toks[ltid()] = p.slot_tok[blk * 128 + ltid()];
    __syncthreads();
    const float* Wg = p.ew_gate + (size_t)e * D * EFF; const float* Wu = p.ew_up + (size_t)e * D * EFF; const float* Wd = p.ew_down + (size_t)e * EFF * D;
    for (int hp2 = 0; hp2 < 2 * MOE_REP_GU; ++hp2) { const int hp = hp2 & 1;
      f32x4 acc[4][4];
      ALoadGatherLds al2{p.h2, toks};
      BLoadGUR bl{Wg, (long)(Wu - Wg), EFF, hp * 128};
      gemm_mainloop_r3<false>(acc, al2, bl, D / 32, smem, smem);
#pragma unroll
      for (int i = 0; i < 4; ++i)
#pragma unroll
        for (int j = 0; j < 2; ++j) { const f32x4 gv = acc[i][j], uv = acc[i][j + 2]; const int row = wm * 64 + i * 16 + fr, hc = hp * 128 + wn * 32 + j * 16 + fq * 4;
          u32x2 o; o.x = cvtpk(siluf_(gv[0]) * uv[0], siluf_(gv[1]) * uv[1]); o.y = cvtpk(siluf_(gv[2]) * uv[2], siluf_(gv[3]) * uv[3]);
          *(LAS u32x2*)(Hs + (hc >> 5) * G_ASZ + a_off(row, (hc & 31) >> 3) + (hc & 7) * 2) = o; }
    }
    for (int np2 = 0; np2 < 4 * MOE_REP_DN; ++np2) { const int np = np2 & 3;
      f32x4 acc[4][4];
      ALoadDense al{nullptr, 0};
      BLoadF32R bl{Wd + np * 256, D};
      gemm_mainloop_r3<true>(acc, al, bl, EFF / 32, smem, Hs);
#pragma unroll
      for (int i = 0; i < 4; ++i) {
        const int rl = wm * 64 + i * 16 + fr;
        if (toks[rl] >= 0) {
#pragma unroll
          for (int j = 0; j < 4; ++j) { const f32x4 v = acc[i][j]; u32x2 o; o.x = cvtpk(v[0], v[1]); o.y = cvtpk(v[2], v[3]);
            *(u32x2*)(p.Y + (size_t)(blk * 128 + rl) * D + np * 256 + wn * 64 + j * 16 + fq * 4) = o; }
        }
      }
    }
   }
  }
}

struct BStreamGU { const float* Wg; long du; int hp0;
  __device__ __forceinline__ void load(BRaw& r, int s, int tid) const {
    const int hp = hp0 + (s >> 5), kbase = (s & 31) * 32;
    const int col = (tid & 63) * 4, w = col >> 6, xx = col & 63;
    const float* q = Wg + ((xx < 32) ? 0l : du) + (size_t)(kbase + (tid >> 6)) * EFF + hp * 128 + 32 * w + (xx & 31);
#pragma unroll
    for (int i = 0; i < 4; ++i) r.v[i] = *(const f32x4*)(q + (size_t)(8 * i) * EFF); } };
struct BStreamDown { const float* Wd; int np0;
  __device__ __forceinline__ void load(BRaw& r, int s, int tid) const {
    const int np = np0 + (s >> 3), kbase = (s & 7) * 32;
    const float* q = Wd + (size_t)(kbase + (tid >> 6)) * D + np * 256 + (tid & 63) * 4;
#pragma unroll
    for (int i = 0; i < 4; ++i) r.v[i] = *(const f32x4*)(q + (size_t)(8 * i) * D); } };
constexpr int PV_STAGE = 2 * G_ASZ + G_BSZ;
template <int SEG, int NSEG, class AL, class BL, class SE>
__device__ __forceinline__ void gemm_stream_pair(const AL& al, const BL& bl, lds_ptr stage, const SE& segend, bool has2) {
  constexpr int NS = SEG * NSEG;
  const int tid = ltid(), lane = tid & 63, wid = tid >> 6, wm = wid >> 2, wn = wid & 3, fr = lane & 15, fq = lane >> 4;
  const int ar = tid >> 2, ac = tid & 3;
  const bf16_t* aptr0 = al.rowptr(0, ar) + ac * 8;
  const bf16_t* aptr1 = al.rowptr(1, ar) + ac * 8;
  const int a_st = a_off(ar, ac);
  int b_st[4];
#pragma unroll
  for (int i = 0; i < 4; ++i) b_st[i] = 2 * G_ASZ + b_off((tid >> 6) + 8 * i, (tid & 63) >> 2) + (tid & 3) * 8;
  int a_rd[4];
#pragma unroll
  for (int mt = 0; mt < 4; ++mt) a_rd[mt] = a_off(wm * 64 + mt * 16 + fr, fq);
  int b_rd[4][2];
#pragma unroll
  for (int nt = 0; nt < 4; ++nt) {
    b_rd[nt][0] = 2 * G_ASZ + b_off(8 * fq + (fr >> 2), wn * 4 + nt) + (fr & 3) * 8;
    b_rd[nt][1] = 2 * G_ASZ + b_off(8 * fq + 4 + (fr >> 2), wn * 4 + nt) + (fr & 3) * 8;
  }
  f32x4 acc[2][4][4];
#pragma unroll
  for (int h = 0; h < 2; ++h)
#pragma unroll
    for (int mt = 0; mt < 4; ++mt)
#pragma unroll
      for (int nt = 0; nt < 4; ++nt) acc[h][mt][nt] = (f32x4){0.f, 0.f, 0.f, 0.f};
  u32x4 xa0, xb0, xa1, xb1;
  BRaw rb0, rb1;
#define P2_LOAD(XA, XB, RB, s_) do { XA = *(const u32x4*)(aptr0 + (size_t)((s_) % SEG) * 32); XB = *(const u32x4*)(aptr1 + (size_t)((s_) % SEG) * 32); bl.load(RB, (s_), tid); } while (0)
#define P2_STORE(XA, XB, RB, st_) do { const lds_ptr q_ = stage + (st_) * PV_STAGE; *(LAS u32x4*)(q_ + a_st) = XA; *(LAS u32x4*)(q_ + G_ASZ + a_st) = XB; \
    _Pragma("unroll") for (int i_ = 0; i_ < 4; ++i_) { u32x2 o_; o_.x = cvtpk(RB.v[i_][0], RB.v[i_][1]); o_.y = cvtpk(RB.v[i_][2], RB.v[i_][3]); *(LAS u32x2*)(q_ + b_st[i_]) = o_; } } while (0)
#define P2_COMPUTE(s_) do { const lds_ptr cur = stage + ((s_) & 1) * PV_STAGE; s16x8 bfr[4]; \
    _Pragma("unroll") for (int nt = 0; nt < 4; ++nt) { const s16x4 lo = tr_read(cur + b_rd[nt][0]), hi = tr_read(cur + b_rd[nt][1]); bfr[nt] = __builtin_shufflevector(lo, hi, 0, 1, 2, 3, 4, 5, 6, 7); } \
    _Pragma("unroll") for (int h = 0; h < 2; ++h) if (h == 0 || has2) { s16x8 af[4]; \
      _Pragma("unroll") for (int mt = 0; mt < 4; ++mt) af[mt] = *(LAS s16x8*)(cur + h * G_ASZ + a_rd[mt]); \
      _Pragma("unroll") for (int mt = 0; mt < 4; ++mt) _Pragma("unroll") for (int nt = 0; nt < 4; ++nt) acc[h][mt][nt] = __builtin_amdgcn_mfma_f32_16x16x32_bf16(bfr[nt], af[mt], acc[h][mt][nt], 0, 0, 0); } } while (0)
#define P2_SEGEND(s_) do { if (((s_) % SEG) == SEG - 1) { segend((s_) / SEG, acc); \
    _Pragma("unroll") for (int h = 0; h < 2; ++h) _Pragma("unroll") for (int mt = 0; mt < 4; ++mt) _Pragma("unroll") for (int nt = 0; nt < 4; ++nt) acc[h][mt][nt] = (f32x4){0.f, 0.f, 0.f, 0.f}; } } while (0)
#define P2_BODY(s_, XAN, XBN, RBN, XAW, XBW, RBW) do { const int sl_ = ((s_) + 2 < NS) ? (s_) + 2 : NS - 1; P2_LOAD(XAN, XBN, RBN, sl_); __builtin_amdgcn_sched_barrier(0); \
    P2_COMPUTE(s_); __builtin_amdgcn_sched_barrier(0); P2_SEGEND(s_); P2_STORE(XAW, XBW, RBW, ((s_) + 1) & 1); __syncthreads(); } while (0)
  P2_LOAD(xa0, xb0, rb0, 0);
  P2_LOAD(xa1, xb1, rb1, 1);
  __syncthreads();
  P2_STORE(xa0, xb0, rb0, 0);
  __syncthreads();
  for (int s = 0; s < NS; s += 2) {
    P2_BODY(s, xa0, xb0, rb0, xa1, xb1, rb1);
    P2_BODY(s + 1, xa1, xb1, rb1, xa0, xb0, rb0);
  }
#undef P2_LOAD
#undef P2_STORE
#undef P2_COMPUTE
#undef P2_SEGEND
#undef P2_BODY
}
struct APairGather { const bf16_t* A; LAS int* tk; __device__ __forceinline__ const bf16_t* rowptr(int h, int r) const { int t = tk[h * 128 + r]; t = t < 0 ? 0 : t; return A + (size_t)t * D; } };
struct APairDense { const bf16_t* A0; const bf16_t* A1; __device__ __forceinline__ const bf16_t* rowptr(int h, int r) const { return (h ? A1 : A0) + (size_t)r * EFF; } };

constexpr int PV_TOK = 2 * PV_STAGE;
constexpr int PV_Q = PV_TOK + 1024;
constexpr int PV_STG = 69632, PV_STG_ROW = 528;
template <int STG>
__device__ __forceinline__ void phase_moe_pair(PR p, int bid, int nb, lds_ptr smem) {
  LAS int* toks = (LAS int*)(smem + PV_TOK);
  LAS int* qi = (LAS int*)(smem + PV_Q);
  for (int sx = 0; sx < 8; ++sx) {
   const int x = ((int)((unsigned)__builtin_amdgcn_s_getreg((3 << 11) | 20) & 7u) + sx) & 7;
   const int cnt = 2 * p.moe_cnt[x];
   for (;;) {
    __syncthreads();
    if (ltid() == 0) qi[0] = atomicAdd(&p.moe_ctr[(STG - 1) * 8 + x], 1);
    __syncthreads();
    const int qidx = qi[0];
    if (qidx >= cnt) break;
    const int blk = p.moe_list[x * NBLK128 + (qidx >> 1)], sub = qidx & 1;
    const int e = p.blk_exp[blk];
    const bool has2 = (blk + 1 < NBLK128) && (p.blk_exp[blk + 1] == e);
    const int blk2 = has2 ? blk + 1 : blk;
    { const int t = ltid(); if (t < 256) toks[t] = (t < 128) ? p.slot_tok[blk * 128 + t] : (has2 ? p.slot_tok[blk2 * 128 + (t - 128)] : -1); }
    __syncthreads();
    const int lane = ltid() & 63, wid = ltid() >> 6, wm = wid >> 2, wn = wid & 3, fr = lane & 15, fq = lane >> 4;
    if (STG == 1) {
      const float* Wg = p.ew_gate + (size_t)e * D * EFF; const float* Wu = p.ew_up + (size_t)e * D * EFF;
      APairGather al{p.h2, toks};
      BStreamGU bl{Wg, (long)(Wu - Wg), sub};
      auto segH = [&](int hseg, const f32x4 (&acc)[2][4][4]) { const int hp = sub + hseg;
        const int t1 = ltid(), l1 = t1 & 63, w1 = t1 >> 6;
        const lds_ptr stg = smem + PV_STG;
#pragma unroll
        for (int h = 0; h < 2; ++h) {
          if (h == 1 && !has2) continue;
#pragma unroll
          for (int i = 0; i < 4; ++i)
#pragma unroll
            for (int j = 0; j < 2; ++j) { const f32x4 gv = acc[h][i][j], uv = acc[h][i][j + 2];
              u32x2 o; o.x = cvtpk(siluf_(gv[0]) * uv[0], siluf_(gv[1]) * uv[1]); o.y = cvtpk(siluf_(gv[2]) * uv[2], siluf_(gv[3]) * uv[3]);
              *(LAS u32x2*)(stg + ((w1 >> 2) * 64 + i * 16 + (l1 & 15)) * 272 + ((w1 & 3) * 32 + j * 16 + (l1 >> 4) * 4) * 2) = o; }
          __syncthreads();
          bf16_t* hb = p.Hbuf + (size_t)((h ? blk2 : blk) * 128) * EFF + hp * 128 + (t1 & 15) * 8;
#pragma unroll
          for (int ps = 0; ps < 4; ++ps) {
            const int row = ps * 32 + (t1 >> 4);
            *(u32x4*)(hb + (size_t)row * EFF) = *(LAS u32x4*)(stg + row * 272 + (t1 & 15) * 16);
          }
          __syncthreads();
        }
      };
      gemm_stream_pair<32, 1>(al, bl, smem, segH, has2);
    } else {
      const float* Wd = p.ew_down + (size_t)e * EFF * D;
      APairDense al{p.Hbuf + (size_t)blk * 128 * EFF, p.Hbuf + (size_t)blk2 * 128 * EFF};
      BStreamDown bl{Wd, 2 * sub};
      auto segY = [&](int nseg, const f32x4 (&acc)[2][4][4]) { const int np = 2 * sub + nseg;
        const int t1 = ltid(), l1 = t1 & 63, w1 = t1 >> 6;
        const lds_ptr stg = smem + PV_STG;
#pragma unroll
        for (int h = 0; h < 2; ++h) {
          if (h == 1 && !has2) continue;
#pragma unroll
          for (int i = 0; i < 4; ++i)
#pragma unroll
            for (int j = 0; j < 4; ++j) { const f32x4 v = acc[h][i][j]; u32x2 o; o.x = cvtpk(v[0], v[1]); o.y = cvtpk(v[2], v[3]);
              *(LAS u32x2*)(stg + ((w1 >> 2) * 64 + i * 16 + (l1 & 15)) * PV_STG_ROW + ((w1 & 3) * 64 + j * 16 + (l1 >> 4) * 4) * 2) = o; }
          __syncthreads();
          bf16_t* yb = p.Y + (size_t)((h ? blk2 : blk) * 128) * D + np * 256 + (t1 & 31) * 8;
#pragma unroll
          for (int ps = 0; ps < 8; ++ps) {
            const int row = ps * 16 + (t1 >> 5);
            const u32x4 v = *(LAS u32x4*)(stg + row * PV_STG_ROW + (t1 & 31) * 16);
            if (toks[h * 128 + row] >= 0) *(u32x4*)(yb + (size_t)row * D) = v;
          }
          __syncthreads();
        }
      };
      gemm_stream_pair<8, 2>(al, bl, smem, segY, has2);
    }
   }
  }
}

__device__ __forceinline__ void wave_sync() { asm volatile("s_waitcnt lgkmcnt(0)" ::: "memory"); }
constexpr int S5_BU_STRIDE = 132;
constexpr int S5_S_STRIDE = 272;
constexpr int S5_WAVE_LDS = 16 * S5_BU_STRIDE * 4 + 16 * S5_S_STRIDE;
template <bool FINAL>
__device__ __forceinline__ void s5_item(PR p, int b, int c, int g, lds_ptr wl) {
  const int lane = ltid() & 63, fr = lane & 15, fq = lane >> 4;
  LAS float* bu = (LAS float*)wl;
  const lds_ptr Sb = wl + 16 * S5_BU_STRIDE * 4;
  const size_t t0 = (size_t)b * SEQ + (size_t)c * 64;
  const s16x8 zero8 = {0, 0, 0, 0, 0, 0, 0, 0};
  s16x8 bfr[8];
#pragma unroll
  for (int nt = 0; nt < 8; ++nt) { const s16x8 x = *(const s16x8*)(p.bbarT + ((size_t)(g * 128 + nt * 16 + fr) * 16 + (fq & 1) * 8)); bfr[nt] = (fq < 2) ? x : zero8; }
  const float are = p.abar[(g * 64 + lane) * 2], aim = p.abar[(g * 64 + lane) * 2 + 1];
  const size_t sidx = (((size_t)b * 32 + c) * S5G + g) * 64 + lane;
  float sre = 0.f, sim = 0.f;
  s16x8 cfr[4];
  f32x4 dsk = {0.f, 0.f, 0.f, 0.f};
  if (FINAL) {
    sre = p.s5Sin[sidx * 2]; sim = p.s5Sin[sidx * 2 + 1];
#pragma unroll
    for (int ks = 0; ks < 4; ++ks) cfr[ks] = *(const s16x8*)(p.cmT + ((size_t)(g * 16 + fr) * 128 + ks * 32 + fq * 8));
    dsk = *(const f32x4*)(p.s5_d + g * 16 + fq * 4);
  }
  s16x8 uxs[4]; u32x2 u4s[4];
#pragma unroll
  for (int mt = 0; mt < 4; ++mt) {
    const bf16_t* urow = p.proj + (t0 + mt * 16 + fr) * LDP + OFF_U + g * 16;
    uxs[mt] = *(const s16x8*)(urow + (fq & 1) * 8);
    if (FINAL) u4s[mt] = *(const u32x2*)(urow + fq * 4);
  }
#pragma unroll
  for (int mt = 0; mt < 4; ++mt) {
    const s16x8 ufr = (fq < 2) ? uxs[mt] : zero8;
#pragma unroll
    for (int nt = 0; nt < 8; ++nt) {
      const f32x4 z = {0.f, 0.f, 0.f, 0.f};
      const f32x4 acc = __builtin_amdgcn_mfma_f32_16x16x32_bf16(bfr[nt], ufr, z, 0, 0, 0);
      *(LAS f32x4*)(bu + fr * S5_BU_STRIDE + nt * 16 + 4 * fq) = acc;
    }
    wave_sync();
    f32x2 bv[16];
#pragma unroll
    for (int l = 0; l < 16; ++l) bv[l] = *(LAS f32x2*)(bu + l * S5_BU_STRIDE + 2 * lane);
#pragma unroll
    for (int l = 0; l < 16; ++l) {
      const float nr = are * sre - aim * sim + bv[l].x, ni = are * sim + aim * sre + bv[l].y;
      sre = nr; sim = ni;
      if (FINAL) *(LAS unsigned*)(Sb + l * S5_S_STRIDE + lane * 4) = cvtpk(sre, sim);
    }
    if (FINAL) {
      wave_sync();
      f32x4 y = {0.f, 0.f, 0.f, 0.f};
#pragma unroll
      for (int ks = 0; ks < 4; ++ks) {
        const s16x8 sfr = *(LAS s16x8*)(Sb + fr * S5_S_STRIDE + (ks * 32 + fq * 8) * 2);
        y = __builtin_amdgcn_mfma_f32_16x16x32_bf16(cfr[ks], sfr, y, 0, 0, 0);
      }
      const f32x4 u4 = {__builtin_bit_cast(float, u4s[mt].x << 16), __builtin_bit_cast(float, u4s[mt].x & 0xffff0000u), __builtin_bit_cast(float, u4s[mt].y << 16), __builtin_bit_cast(float, u4s[mt].y & 0xffff0000u)};
      u32x2 o; o.x = cvtpk(geluf_(y[0] + dsk[0] * u4[0]), geluf_(y[1] + dsk[1] * u4[1])); o.y = cvtpk(geluf_(y[2] + dsk[2] * u4[2]), geluf_(y[3] + dsk[3] * u4[3]));
      *(u32x2*)(p.yA + (t0 + mt * 16 + fr) * S5W + g * 16 + fq * 4) = o;
    } else wave_sync();
  }
  if (!FINAL) { p.s5E[sidx * 2] = sre; p.s5E[sidx * 2 + 1] = sim; }
}
template <bool FINAL>
__device__ __forceinline__ void s5_block_item(PR p, int item, lds_ptr smem) {
  const int wid = ltid() >> 6;
  const int go = item & 3, c = (item >> 2) & 31, b = item >> 7;
  s5_item<FINAL>(p, b, c, go * 8 + wid, smem + wid * S5_WAVE_LDS);
}

constexpr int GL_QD = 0, GL_KE = 8192, GL_V = 16384, GL_SIN = 32768, GL_GL = 49152, GL_W2 = 53248, GL_TOT = 57344, GL_B2 = 58368, GL_ITEM = 58624;
__device__ __forceinline__ int rowrd_off(int r, int c) { return r * 128 + ((c ^ ((r >> 1) & 7)) << 4); }
__device__ __forceinline__ int tr128_off(int r, int ch) { return r * 128 + ((ch ^ (((r >> 1) & 1) | (((r >> 3) & 1) << 1))) << 5); }
__device__ __forceinline__ int tr256_off(int r, int ch) { return r * 256 + ((ch ^ ((r & 3) | (((r >> 3) & 1) << 2))) << 5); }

__device__ __forceinline__ void gla_front(PR p, int b, int h, int c, lds_ptr il, int t, float (&bl)[16], float& blast) {
  LAS float* gl = (LAS float*)(il + GL_GL); LAS float* w2 = (LAS float*)(il + GL_W2); LAS float* tot = (LAS float*)(il + GL_TOT); LAS float* b2 = (LAS float*)(il + GL_B2);
  const size_t t0 = (size_t)b * SEQ + (size_t)c * 64;
  __syncthreads();
  *(LAS f32x4*)(gl + t * 4) = *(const f32x4*)(p.gkl + t0 * 16 + t * 4);
#pragma unroll
  for (int q = 0; q < 4; ++q) { const int i = t + 256 * q; w2[i] = p.w_gk2[(i >> 6) * GKEY + h * 64 + (i & 63)]; }
  if (t < 64) b2[t] = p.b_gk2[h * 64 + t];
  __syncthreads();
  const int d = t & 63, part = t >> 6;
  float wv[16];
#pragma unroll
  for (int r = 0; r < 16; ++r) wv[r] = w2[r * 64 + d];
  const float bias = b2[d];
  float run = 0.f;
#pragma unroll
  for (int ii = 0; ii < 16; ++ii) {
    const int i = part * 16 + ii;
    float gk = bias;
#pragma unroll
    for (int q = 0; q < 4; ++q) { const f32x4 gv = *(LAS f32x4*)(gl + i * 16 + q * 4); gk += gv[0] * wv[q * 4] + gv[1] * wv[q * 4 + 1] + gv[2] * wv[q * 4 + 2] + gv[3] * wv[q * 4 + 3]; }
    run += logsigmoidf_(gk) * (1.f / 16.f);
    bl[ii] = run;
  }
  tot[part * 64 + d] = run;
  __syncthreads();
  float offs = 0.f, all = 0.f;
#pragma unroll
  for (int q = 0; q < 4; ++q) { const float v = tot[q * 64 + d]; all += v; offs += (q < part) ? v : 0.f; }
#pragma unroll
  for (int ii = 0; ii < 16; ++ii) bl[ii] += offs;
  blast = all;
}

__device__ __forceinline__ void gla_pass1(PR p, int item, lds_ptr smem) {
  const int half = ltid() >> 8, t = ltid() & 255, lane = t & 63, w = t >> 6, fr = lane & 15, fq = lane >> 4;
  const int it = item * 2 + half, c = it & 31, h = (it >> 5) & 3, b = it >> 7;
  const lds_ptr il = smem + half * GL_ITEM;
  const size_t t0 = (size_t)b * SEQ + (size_t)c * 64;
  float bl[16], blast;
  gla_front(p, b, h, c, il, t, bl, blast);
  {
    const int d = t & 63, part = t >> 6;
#pragma unroll
    for (int ii = 0; ii < 16; ++ii) {
      const int i = part * 16 + ii;
      const float kv = bf2f(p.proj[(t0 + i) * LDP + OFF_K + h * 64 + d]);
      *(LAS bf16_t*)(il + GL_KE + tr128_off(i, d >> 4) + (d & 15) * 2) = f2bf(kv * __expf(blast - bl[ii]));
    }
    if (part == 0) p.glaDec[(size_t)it * 64 + d] = __expf(blast);
#pragma unroll
    for (int q = 0; q < 4; ++q) { const int pc = t + 256 * q, r = pc >> 4, c8 = pc & 15;
      *(LAS u32x4*)(il + GL_V + tr256_off(r, c8 >> 1) + (c8 & 1) * 16) = *(const u32x4*)(p.proj + (t0 + r) * LDP + OFF_V + h * 128 + c8 * 8); }
  }
  __syncthreads();
  f32x4 acc[8];
#pragma unroll
  for (int et = 0; et < 8; ++et) acc[et] = (f32x4){0.f, 0.f, 0.f, 0.f};
#pragma unroll
  for (int ks = 0; ks < 2; ++ks) {
    const int r0 = 32 * ks + 8 * fq + (fr >> 2);
    const s16x4 klo = tr_read(il + GL_KE + tr128_off(r0, w) + (fr & 3) * 8), khi = tr_read(il + GL_KE + tr128_off(r0 + 4, w) + (fr & 3) * 8);
    const s16x8 kf = __builtin_shufflevector(klo, khi, 0, 1, 2, 3, 4, 5, 6, 7);
#pragma unroll
    for (int et = 0; et < 8; ++et) {
      const s16x4 vlo = tr_read(il + GL_V + tr256_off(r0, et) + (fr & 3) * 8), vhi = tr_read(il + GL_V + tr256_off(r0 + 4, et) + (fr & 3) * 8);
      const s16x8 vf = __builtin_shufflevector(vlo, vhi, 0, 1, 2, 3, 4, 5, 6, 7);
      acc[et] = __builtin_amdgcn_mfma_f32_16x16x32_bf16(vf, kf, acc[et], 0, 0, 0);
    }
  }
#pragma unroll
  for (int et = 0; et < 8; ++et) *(f32x4*)(p.glaKV + ((size_t)it * 64 + 16 * w + fr) * 128 + et * 16 + fq * 4) = acc[et];
}

__device__ __forceinline__ void gla_pass2(PR p, int item, lds_ptr smem) {
  const int half = ltid() >> 8, t = ltid() & 255, lane = t & 63, w = t >> 6, fr = lane & 15, fq = lane >> 4;
  const int it = item * 2 + half, c = it & 31, h = (it >> 5) & 3, b = it >> 7;
  const lds_ptr il = smem + half * GL_ITEM;
  const size_t t0 = (size_t)b * SEQ + (size_t)c * 64;
  float bl[16], blast;
  gla_front(p, b, h, c, il, t, bl, blast);
  {
    const int d = t & 63, part = t >> 6;
#pragma unroll
    for (int ii = 0; ii < 16; ++ii) {
      const int i = part * 16 + ii;
      const float qv = bf2f(p.proj[(t0 + i) * LDP + OFF_Q + h * 64 + d]) * 0.125f, kv = bf2f(p.proj[(t0 + i) * LDP + OFF_K + h * 64 + d]);
      const int o = rowrd_off(i, d >> 3) + (d & 7) * 2;
      *(LAS bf16_t*)(il + GL_QD + o) = f2bf(qv * __expf(bl[ii]));
      *(LAS bf16_t*)(il + GL_KE + o) = f2bf(kv * __expf(-bl[ii]));
    }
#pragma unroll
    for (int q = 0; q < 4; ++q) { const int pc = t + 256 * q, r = pc >> 4, c8 = pc & 15;
      *(LAS u32x4*)(il + GL_V + tr256_off(r, c8 >> 1) + (c8 & 1) * 16) = *(const u32x4*)(p.proj + (t0 + r) * LDP + OFF_V + h * 128 + c8 * 8);
      *(LAS u32x4*)(il + GL_SIN + tr256_off(r, c8 >> 1) + (c8 & 1) * 16) = *(const u32x4*)(p.glaSin + ((size_t)it * 64 + r) * 128 + c8 * 8); }
  }
  __syncthreads();
  s16x8 qf[2];
#pragma unroll
  for (int ks = 0; ks < 2; ++ks) qf[ks] = *(LAS s16x8*)(il + GL_QD + rowrd_off(16 * w + fr, ks * 4 + fq));
  f32x4 st[4];
#pragma unroll
  for (int jt = 0; jt < 4; ++jt) {
    st[jt] = (f32x4){0.f, 0.f, 0.f, 0.f};
    if (jt <= w) {
#pragma unroll
      for (int ks = 0; ks < 2; ++ks) {
        const s16x8 kf = *(LAS s16x8*)(il + GL_KE + rowrd_off(16 * jt + fr, ks * 4 + fq));
        st[jt] = __builtin_amdgcn_mfma_f32_16x16x32_bf16(kf, qf[ks], st[jt], 0, 0, 0);
      }
      if (jt == w) {
#pragma unroll
        for (int r = 0; r < 4; ++r) st[jt][r] = (4 * fq + r <= fr) ? st[jt][r] : 0.f;
      }
    }
  }
  f32x4 acc[8];
#pragma unroll
  for (int et = 0; et < 8; ++et) acc[et] = (f32x4){0.f, 0.f, 0.f, 0.f};
#pragma unroll
  for (int u = 0; u < 2; ++u) {
    if (2 * u <= w) {
      u32x4 pk; pk.x = cvtpk(st[2 * u][0], st[2 * u][1]); pk.y = cvtpk(st[2 * u][2], st[2 * u][3]); pk.z = cvtpk(st[2 * u + 1][0], st[2 * u + 1][1]); pk.w = cvtpk(st[2 * u + 1][2], st[2 * u + 1][3]);
      const s16x8 pf = __builtin_bit_cast(s16x8, pk);
      const int r0 = 32 * u + 4 * fq + (fr >> 2);
#pragma unroll
      for (int et = 0; et < 8; ++et) {
        const s16x4 vlo = tr_read(il + GL_V + tr256_off(r0, et) + (fr & 3) * 8), vhi = tr_read(il + GL_V + tr256_off(r0 + 16, et) + (fr & 3) * 8);
        const s16x8 vf = __builtin_shufflevector(vlo, vhi, 0, 1, 2, 3, 4, 5, 6, 7);
        acc[et] = __builtin_amdgcn_mfma_f32_16x16x32_bf16(vf, pf, acc[et], 0, 0, 0);
      }
    }
  }
#pragma unroll
  for (int ks = 0; ks < 2; ++ks) {
    const int r0 = 32 * ks + 8 * fq + (fr >> 2);
#pragma unroll
    for (int et = 0; et < 8; ++et) {
      const s16x4 slo = tr_read(il + GL_SIN + tr256_off(r0, et) + (fr & 3) * 8), shi = tr_read(il + GL_SIN + tr256_off(r0 + 4, et) + (fr & 3) * 8);
      const s16x8 sf = __builtin_shufflevector(slo, shi, 0, 1, 2, 3, 4, 5, 6, 7);
      acc[et] = __builtin_amdgcn_mfma_f32_16x16x32_bf16(sf, qf[ks], acc[et], 0, 0, 0);
    }
  }
  float ss = 0.f;
#pragma unroll
  for (int et = 0; et < 8; ++et) ss += acc[et][0] * acc[et][0] + acc[et][1] * acc[et][1] + acc[et][2] * acc[et][2] + acc[et][3] * acc[et][3];
  ss += __shfl_xor(ss, 16); ss += __shfl_xor(ss, 32);
  const float rn = rsqrtf(ss * (1.f / 128.f) + 1e-6f);
  const size_t trow = t0 + 16 * w + fr;
#pragma unroll
  for (int et = 0; et < 8; ++et) {
    const int e = et * 16 + fq * 4;
    const f32x4 ng = *(const f32x4*)(p.gla_norm_g + e), rg = ld_bf4(p.proj + trow * LDP + OFF_R + h * 128 + e);
    u32x2 o; o.x = cvtpk(acc[et][0] * rn * ng[0] * siluf_(rg[0]), acc[et][1] * rn * ng[1] * siluf_(rg[1])); o.y = cvtpk(acc[et][2] * rn * ng[2] * siluf_(rg[2]), acc[et][3] * rn * ng[3] * siluf_(rg[3]));
    *(u32x2*)(p.yB + trow * GVAL + h * 128 + e) = o;
  }
}

__device__ __forceinline__ void phase_mix_local(PR p, int bid, int nb, lds_ptr smem, int which) {
  for (int idx = bid; idx < 1024 + 512; idx += nb) {
    if (idx < 1024) { if (which & 1) { __syncthreads(); s5_block_item<false>(p, idx, smem); } }
    else if (which & 2) gla_pass1(p, idx - 1024, smem);
  }
}
__device__ __forceinline__ void phase_mix_carry(PR p, int bid, int nb, int which) {
  const int wave = __builtin_amdgcn_readfirstlane(ltid() >> 6), ln = ltid() & 63;
  if (which & 1) {
    for (int j = bid; j < NB * S5G; j += nb) if (wave == 7) {
      const int g = j & 31, b = j >> 5;
      const float2 a = *(const float2*)(p.apow64 + (g * 64 + ln) * 2);
      float2 e[32];
#pragma unroll
      for (int c = 0; c < 32; ++c) e[c] = *(const float2*)(p.s5E + ((((size_t)b * 32 + c) * S5G + g) * 64 + ln) * 2);
      float sre = 0.f, sim = 0.f;
#pragma unroll
      for (int c = 0; c < 32; ++c) {
        *(float2*)(p.s5Sin + ((((size_t)b * 32 + c) * S5G + g) * 64 + ln) * 2) = make_float2(sre, sim);
        const float nr = a.x * sre - a.y * sim + e[c].x, ni = a.x * sim + a.y * sre + e[c].y;
        sre = nr; sim = ni;
      }
    }
  }
  if (which & 2) {
    for (int r = bid * 8 + wave; r < NB * GH * 64; r += nb * 8) {
      const int d = r & 63, bh = r >> 6;
      float2 kv[32]; float dec[32];
#pragma unroll
      for (int c = 0; c < 32; ++c) {
        const size_t it = (size_t)bh * 32 + c;
        kv[c] = *(const float2*)(p.glaKV + (it * 64 + d) * 128 + 2 * ln);
        dec[c] = p.glaDec[it * 64 + d];
      }
      float S0 = 0.f, S1 = 0.f;
#pragma unroll
      for (int c = 0; c < 32; ++c) {
        const size_t it = (size_t)bh * 32 + c;
        *(uint32_t*)(p.glaSin + (it * 64 + d) * 128 + 2 * ln) = cvtpk(S0, S1);
        S0 = dec[c] * S0 + kv[c].x; S1 = dec[c] * S1 + kv[c].y;
      }
    }
  }
}
__device__ __forceinline__ void phase_mix_final(PR p, int bid, int nb, lds_ptr smem, int which) {
  for (int idx = bid; idx < 1024 + 512; idx += nb) {
    if (idx < 1024) { if (which & 1) { __syncthreads(); s5_block_item<true>(p, idx, smem); } }
    else if (which & 2) gla_pass2(p, idx - 1024, smem);
  }
}

__device__ __forceinline__ void phase_route(PR p, int bid, int nb) {
  const int lane = ltid() & 63, wid = ltid() >> 6;
  const f32x4 bias = *(const f32x4*)(p.router_bias + lane * 4);
  for (int t = bid * 8 + wid; t < T; t += nb * 8) {
    const f32x4 lg = *(const f32x4*)(p.logits + (size_t)t * NE + lane * 4);
    float sc[4], v[4];
#pragma unroll
    for (int j = 0; j < 4; ++j) { sc[j] = sigmoidf_(lg[j]); v[j] = sc[j] + bias[j]; }
    float m1 = fmaxf(v[0], v[1]), m2 = fminf(v[0], v[1]);
#pragma unroll
    for (int j = 2; j < 4; ++j) { const float nm1 = fmaxf(m1, v[j]); m2 = fmaxf(fminf(m1, v[j]), m2); m1 = nm1; }
#pragma unroll
    for (int o = 1; o < 8; o <<= 1) { const float o1 = __shfl_xor(m1, o), o2 = __shfl_xor(m2, o); const float nm1 = fmaxf(m1, o1); m2 = fmaxf(fminf(m1, o1), fmaxf(m2, o2)); m1 = nm1; }
    const float gs = m1 + m2;
    const int grp = lane >> 3;
    int rank = 0;
#pragma unroll
    for (int g2 = 0; g2 < 8; ++g2) { const float og = __shfl(gs, g2 * 8); rank += (og > gs || (og == gs && g2 < grp)) ? 1 : 0; }
    const bool gsel = rank < 4;
#pragma unroll
    for (int j = 0; j < 4; ++j) v[j] = gsel ? v[j] : -INFINITY;
    int my_e = 0; float my_s = 0.f, wsum = 0.f;
#pragma unroll 1
    for (int r = 0; r < 8; ++r) {
      float bv = v[0]; int bi = 0;
#pragma unroll
      for (int j = 1; j < 4; ++j) if (v[j] > bv) { bv = v[j]; bi = j; }
      int be = lane * 4 + bi;
#pragma unroll
      for (int o = 1; o < 64; o <<= 1) { const float ov = __shfl_xor(bv, o); const int oe = __shfl_xor(be, o); if (ov > bv || (ov == bv && oe < be)) { bv = ov; be = oe; } }
      const int ol = be >> 2, oj = be & 3;
      float s_own = 0.f;
#pragma unroll
      for (int j = 0; j < 4; ++j) if (lane == ol && oj == j) { s_own = sc[j]; v[j] = -INFINITY; }
      const float s_w = __shfl(s_own, ol);
      wsum += s_w;
      if (lane == r) { my_e = be; my_s = s_w; }
    }
    if (lane < 8) {
      p.tk_idx[t * 8 + lane] = my_e;
      p.tk_w[t * 8 + lane] = my_s / wsum * 2.5f;
      p.tk_rank[t * 8 + lane] = atomicAdd(&p.counts[my_e], 1);
    }
  }
}
__device__ __forceinline__ void phase_scatter(PR p, int bid, int nb, lds_ptr smem) {
  LAS int* st = (LAS int*)smem;
  __syncthreads();
  if (ltid() < 256) st[ltid() + 1] = (p.counts[ltid()] + 127) / 128 * 128;
  if (ltid() == 0) st[0] = 0;
  __syncthreads();
  if (ltid() < 64) {
    const int ln = ltid();
    const int c0 = st[4 * ln + 1], c1 = st[4 * ln + 2], c2 = st[4 * ln + 3], c3 = st[4 * ln + 4];
    const int tot = c0 + c1 + c2 + c3;
    int inc = tot;
    #pragma unroll
    for (int o = 1; o < 64; o <<= 1) { const int v = __shfl_up(inc, o, 64); if (ln >= o) inc += v; }
    const int b0 = inc - tot;
    st[4 * ln + 1] = b0 + c0; st[4 * ln + 2] = b0 + c0 + c1; st[4 * ln + 3] = b0 + c0 + c1 + c2; st[4 * ln + 4] = inc;
  }
  __syncthreads();
  if (bid == 0) {
    if (ltid() < 256) { const int e = ltid(); for (int b = st[e] / 128; b < st[e + 1] / 128; ++b) p.blk_exp[b] = e; }
    for (int b = st[256] / 128 + ltid(); b < NBLK128; b += NTHR) p.blk_exp[b] = -1;
  }
  if (bid >= 8 && bid < 16 && ltid() < 64) {
    const int x = bid - 8, ln = ltid() & 63, half = ln >> 5;
    const int e = x + 8 * (ln & 31);
    const int np = (st[e + 1] / 128 - st[e] / 128 + 1) >> 1;
    int inc = np;
    #pragma unroll
    for (int o = 1; o < 32; o <<= 1) { const int v = __shfl_up(inc, o, 32); if ((ln & 31) >= o) inc += v; }
    const int base = inc - np;
    if (half == 0) for (int j = 0; j < np; ++j) p.moe_list[x * NBLK128 + base + j] = st[e] / 128 + 2 * j;
    if (ln == 31) p.moe_cnt[x] = inc;
  }
  for (int i = bid * NTHR + ltid(); i < T * 8; i += nb * NTHR) {
    const int e = p.tk_idx[i], pos = st[e] + p.tk_rank[i];
    p.slot_tok[pos] = i >> 3;
    p.slot_of[i] = pos;
  }
}

__global__ void __launch_bounds__(64) k_s5_naive(P p) {
  __shared__ float sre[64], sim[64], cre[16][64], cim[16][64], us[16];
  const int b = blockIdx.x / S5G, g = blockIdx.x % S5G, lane = threadIdx.x;
  const float are = p.abar[(g * 64 + lane) * 2], aim = p.abar[(g * 64 + lane) * 2 + 1];
  float bre[16], bim[16];
  for (int h = 0; h < 16; ++h) { bre[h] = p.bbar[((g * 64 + lane) * 16 + h) * 2]; bim[h] = p.bbar[((g * 64 + lane) * 16 + h) * 2 + 1]; }
  for (int i = lane; i < 1024; i += 64) { cre[i >> 6][i & 63] = p.c_re[g * 1024 + i]; cim[i >> 6][i & 63] = p.c_im[g * 1024 + i]; }
  const float dsk = lane < 16 ? p.s5_d[g * 16 + lane] : 0.f;
  float s_re = 0.f, s_im = 0.f;
  __syncthreads();
  for (int l = 0; l < SEQ; ++l) {
    const size_t t = (size_t)b * SEQ + l;
    if (lane < 16) us[lane] = bf2f(p.proj[t * LDP + OFF_U + g * 16 + lane]);
    __syncthreads();
    float bur = 0.f, bui = 0.f;
    for (int h = 0; h < 16; ++h) { bur += us[h] * bre[h]; bui += us[h] * bim[h]; }
    const float nr = are * s_re - aim * s_im + bur, ni = are * s_im + aim * s_re + bui;
    s_re = nr; s_im = ni;
    sre[lane] = s_re; sim[lane] = s_im;
    __syncthreads();
    if (lane < 16) {
      float y = dsk * us[lane];
      for (int q = 0; q < 64; ++q) y += sre[q] * cre[lane][q] - sim[q] * cim[lane][q];
      p.yA[t * S5W + g * 16 + lane] = f2bf(geluf_(y));
    }
    __syncthreads();
  }
}

__global__ void __launch_bounds__(128) k_gla_naive(P p) {
  __shared__ float qs[32][64], ks[32][64], as[32][64], gl[32][16], w2[16][64], b2[64];
  const int b = blockIdx.x / GH, h = blockIdx.x % GH, tid = threadIdx.x;
  for (int i = tid; i < 16 * 64; i += 128) w2[i >> 6][i & 63] = p.w_gk2[(i >> 6) * GKEY + h * 64 + (i & 63)];
  if (tid < 64) b2[tid] = p.b_gk2[h * 64 + tid];
  float S[64];
  for (int d = 0; d < 64; ++d) S[d] = 0.f;
  for (int l0 = 0; l0 < SEQ; l0 += 32) {
    __syncthreads();
    for (int i = tid; i < 32 * 64; i += 128) {
      const size_t t = (size_t)b * SEQ + l0 + (i >> 6);
      qs[i >> 6][i & 63] = bf2f(p.proj[t * LDP + OFF_Q + h * 64 + (i & 63)]) * 0.125f;
      ks[i >> 6][i & 63] = bf2f(p.proj[t * LDP + OFF_K + h * 64 + (i & 63)]);
    }
    for (int i = tid; i < 32 * 16; i += 128) { const size_t t = (size_t)b * SEQ + l0 + (i >> 4); gl[i >> 4][i & 15] = p.gkl[t * 16 + (i & 15)]; }
    __syncthreads();
    for (int i = tid; i < 32 * 64; i += 128) {
      const int s = i >> 6, d = i & 63;
      float gk = b2[d];
      for (int r = 0; r < 16; ++r) gk += gl[s][r] * w2[r][d];
      as[s][d] = __expf(logsigmoidf_(gk) * (1.f / 16.f));
    }
    __syncthreads();
    for (int s = 0; s < 32; ++s) {
      const size_t t = (size_t)b * SEQ + l0 + s;
      const float v = bf2f(p.proj[t * LDP + OFF_V + h * 128 + tid]);
      float o = 0.f;
      for (int d = 0; d < 64; ++d) { S[d] = as[s][d] * S[d] + ks[s][d] * v; o += qs[s][d] * S[d]; }
      p.oraw[t * GVAL + h * 128 + tid] = o;
    }
  }
}
__global__ void __launch_bounds__(256) k_gla_post(P p) {
  const int idx = blockIdx.x * 4 + (threadIdx.x >> 6), lane = threadIdx.x & 63;
  const int t = idx / GH, h = idx % GH;
  const float o0 = p.oraw[(size_t)t * GVAL + h * 128 + lane], o1 = p.oraw[(size_t)t * GVAL + h * 128 + 64 + lane];
  float ss = o0 * o0 + o1 * o1;
  for (int o = 32; o > 0; o >>= 1) ss += __shfl_xor(ss, o);
  const float r = rsqrtf(ss * (1.f / 128.f) + 1e-6f);
  const float r0 = bf2f(p.proj[(size_t)t * LDP + OFF_R + h * 128 + lane]), r1 = bf2f(p.proj[(size_t)t * LDP + OFF_R + h * 128 + 64 + lane]);
  p.yB[(size_t)t * GVAL + h * 128 + lane] = f2bf(o0 * r * p.gla_norm_g[lane] * siluf_(r0));
  p.yB[(size_t)t * GVAL + h * 128 + 64 + lane] = f2bf(o1 * r * p.gla_norm_g[64 + lane] * siluf_(r1));
}

__global__ void __launch_bounds__(64) k_route(P p) {
  const int t = blockIdx.x * 64 + threadIdx.x;
  const float* lg = p.logits + (size_t)t * NE;
  float gs[8];
#pragma unroll
  for (int g = 0; g < 8; ++g) {
    float m1 = -INFINITY, m2 = -INFINITY;
    for (int j = 0; j < 32; ++j) { const float v = sigmoidf_(lg[g * 32 + j]) + p.router_bias[g * 32 + j]; if (v > m1) { m2 = m1; m1 = v; } else if (v > m2) m2 = v; }
    gs[g] = m1 + m2;
  }
  unsigned gmask = 0;
#pragma unroll
  for (int r = 0; r < 4; ++r) { int best = -1; float bv = -INFINITY;
#pragma unroll
    for (int g = 0; g < 8; ++g) if (!((gmask >> g) & 1u) && gs[g] > bv) { bv = gs[g]; best = g; }
    gmask |= 1u << best; }
  int sel[8]; float sw[8]; float wsum = 0.f;
#pragma unroll
  for (int r = 0; r < 8; ++r) {
    int best = -1; float bv = -INFINITY;
    for (int e = 0; e < NE; ++e) {
      if (!((gmask >> (e >> 5)) & 1u)) continue;
      bool taken = false;
#pragma unroll
      for (int q = 0; q < 8; ++q) taken |= (q < r) && (sel[q] == e);
      if (taken) continue;
      const float v = sigmoidf_(lg[e]) + p.router_bias[e];
      if (v > bv) { bv = v; best = e; }
    }
    best = best < 0 ? r : best;
    sel[r] = best; sw[r] = sigmoidf_(lg[best]); wsum += sw[r];
  }
#pragma unroll
  for (int r = 0; r < 8; ++r) {
    p.tk_idx[t * 8 + r] = sel[r];
    p.tk_w[t * 8 + r] = sw[r] / wsum * 2.5f;
    p.tk_rank[t * 8 + r] = atomicAdd(&p.counts[sel[r]], 1);
  }
}
__global__ void __launch_bounds__(256) k_offsets(P p) {
  __shared__ int pad[256], st[257];
  const int e = threadIdx.x;
  pad[e] = (p.counts[e] + 127) / 128 * 128;
  __syncthreads();
  if (e == 0) { int s = 0; for (int i = 0; i < 256; ++i) { st[i] = s; s += pad[i]; } st[256] = s; }
  __syncthreads();
  p.pad_start[e] = st[e];
  if (e == 0) p.pad_start[256] = st[256];
  for (int b = st[e] / 128; b < st[e + 1] / 128; ++b) p.blk_exp[b] = e;
  for (int b = st[256] / 128 + e; b < NBLK128; b += 256) p.blk_exp[b] = -1;
}
__global__ void __launch_bounds__(256) k_scatter(P p) {
  const int i = blockIdx.x * 256 + threadIdx.x;
  const int e = p.tk_idx[i], pos = p.pad_start[e] + p.tk_rank[i];
  p.slot_tok[pos] = i >> 3;
  p.slot_of[i] = pos;
}

__device__ __forceinline__ void phase_combine(PR p, int bid, int nb) {
  const int lane = ltid() & 63, wid = ltid() >> 6;
  for (int t = bid * 8 + wid; t < T; t += nb * 8) {
    const int b = t / SEQ;
    int so[8]; float w[8];
#pragma unroll
    for (int k = 0; k < 8; ++k) { so[k] = p.slot_of[t * 8 + k]; w[k] = p.tk_w[t * 8 + k]; }
    float v[16], ss = 0.f;
#pragma unroll
    for (int i = 0; i < 4; ++i) {
      const int c0 = lane * 4 + 256 * i;
      f32x4 m = ld_bf4(p.S + (size_t)t * D + c0);
#pragma unroll
      for (int k = 0; k < 8; ++k) { const f32x4 y = ld_bf4(p.Y + (size_t)so[k] * D + c0); m[0] += w[k] * y[0]; m[1] += w[k] * y[1]; m[2] += w[k] * y[2]; m[3] += w[k] * y[3]; }
      const f32x4 xv = *(const f32x4*)(p.x1 + (size_t)t * D + c0), gg = *(const f32x4*)(p.mod + b * 6144 + 5 * D + c0);
#pragma unroll
      for (int j = 0; j < 4; ++j) { v[i * 4 + j] = xv[j] + gg[j] * m[j]; ss += v[i * 4 + j] * v[i * 4 + j]; }
    }
#pragma unroll
    for (int o = 32; o > 0; o >>= 1) ss += __shfl_xor(ss, o);
    const float r = rsqrtf(ss * (1.f / D) + 1e-6f);
#pragma unroll
    for (int i = 0; i < 4; ++i) {
      const int c0 = lane * 4 + 256 * i; const f32x4 fg = *(const f32x4*)(p.final_g + c0);
      f32x4 o; o[0] = v[i * 4] * r * fg[0]; o[1] = v[i * 4 + 1] * r * fg[1]; o[2] = v[i * 4 + 2] * r * fg[2]; o[3] = v[i * 4 + 3] * r * fg[3];
      *(f32x4*)(p.out + (size_t)t * D + c0) = o;
    }
  }
}


template <class Epi>
__global__ void __launch_bounds__(256) k_gemm_naive(const bf16_t* __restrict__ A, int lda, const float* __restrict__ Bm, int ldb, int M, int N, int K, Epi epi) {
  __shared__ float As[16][68];
  __shared__ float Bs[16][68];
  const int tx = threadIdx.x & 15, ty = threadIdx.x >> 4;
  const int row0 = blockIdx.y * 64, col0 = blockIdx.x * 64;
  float acc[4][4];
  for (int i = 0; i < 4; ++i) for (int j = 0; j < 4; ++j) acc[i][j] = 0.f;
  for (int k0 = 0; k0 < K; k0 += 16) {
    { const int r = threadIdx.x >> 2, k4 = (threadIdx.x & 3) * 4;
      const bf16_t* ap = A + (size_t)(row0 + r) * lda + k0 + k4;
      for (int j = 0; j < 4; ++j) As[k4 + j][r] = bf2f(ap[j]); }
    { const int k = threadIdx.x >> 4, c4 = (threadIdx.x & 15) * 4;
      for (int j = 0; j < 4; ++j) { const int cc = col0 + c4 + j; Bs[k][c4 + j] = cc < N ? Bm[(size_t)(k0 + k) * ldb + cc] : 0.f; } }
    __syncthreads();
    for (int k = 0; k < 16; ++k) {
      float a[4], b[4];
      for (int i = 0; i < 4; ++i) a[i] = As[k][ty * 4 + i];
      for (int j = 0; j < 4; ++j) b[j] = Bs[k][tx * 4 + j];
      for (int i = 0; i < 4; ++i) for (int j = 0; j < 4; ++j) acc[i][j] += a[i] * b[j];
    }
    __syncthreads();
  }
  for (int i = 0; i < 4; ++i) for (int j = 0; j < 4; ++j) { const int r = row0 + ty * 4 + i, cc = col0 + tx * 4 + j; if (cc < N) epi(r, cc, acc[i][j]); }
}
struct NEpiProj { bf16_t* o; __device__ void operator()(int r, int c, float v) const { if (c >= WIN_GK && c < WIN_GK + 16) return; const int cc = c < WIN_GK ? c : c - 16; o[(size_t)r * LDP + cc] = f2bf(v); } };
struct NEpiGlu { const bf16_t* yA; const float* b; bf16_t* z; __device__ void operator()(int r, int c, float v) const { const float y = bf2f(yA[(size_t)r * S5W + c]); z[(size_t)r * S5W + c] = f2bf(y * sigmoidf_(v + b[c])); } };
struct NEpiPA { const bf16_t* proj; float* t; __device__ void operator()(int r, int c, float v) const { t[(size_t)r * D + c] = sigmoidf_(bf2f(proj[(size_t)r * LDP + OFF_GA + c])) * v; } };
struct NEpiPB { const bf16_t* proj; const float* t; bf16_t* m; __device__ void operator()(int r, int c, float v) const { m[(size_t)r * D + c] = f2bf(t[(size_t)r * D + c] + sigmoidf_(bf2f(proj[(size_t)r * LDP + OFF_GB + c])) * v); } };
struct NEpiOut { const float* x; const float* mod; float* x1; __device__ void operator()(int r, int c, float v) const { const int b = r / SEQ; x1[(size_t)r * D + c] = x[(size_t)r * D + c] + mod[b * 6144 + 2 * D + c] * v; } };
struct NEpiF32 { float* o; long ld; __device__ void operator()(int r, int c, float v) const { o[(size_t)r * ld + c] = v; } };
struct NEpiShUp { const float* g; bf16_t* h; __device__ void operator()(int r, int c, float v) const { h[(size_t)r * SFF + c] = f2bf(siluf_(g[(size_t)r * SFF + c]) * v); } };
struct NEpiBf { bf16_t* o; long ld; __device__ void operator()(int r, int c, float v) const { o[(size_t)r * ld + c] = f2bf(v); } };
__global__ void __launch_bounds__(256) k_moe_naive(P p) {
  __shared__ float xs[16][1024];
  __shared__ float hs[16][256];
  __shared__ int toks[16];
  const int s0 = blockIdx.x * 16, e = p.blk_exp[s0 / 128], tid = threadIdx.x;
  if (e < 0) return;
  if (tid < 16) toks[tid] = p.slot_tok[s0 + tid];
  __syncthreads();
  bool any = false;
  for (int s = 0; s < 16; ++s) any |= toks[s] >= 0;
  if (!any) return;
  for (int i = tid; i < 16 * 1024; i += 256) { const int s = i >> 10, d = i & 1023; xs[s][d] = toks[s] >= 0 ? bf2f(p.h2[(size_t)toks[s] * D + d]) : 0.f; }
  __syncthreads();
  {
    float ag[16], au[16];
    for (int s = 0; s < 16; ++s) { ag[s] = 0.f; au[s] = 0.f; }
    const float* wg = p.ew_gate + (size_t)e * D * EFF + tid;
    const float* wu = p.ew_up + (size_t)e * D * EFF + tid;
    for (int d = 0; d < D; ++d) {
      const float g = wg[(size_t)d * EFF], u = wu[(size_t)d * EFF];
      for (int s = 0; s < 16; ++s) { const float xv = xs[s][d]; ag[s] += xv * g; au[s] += xv * u; }
    }
    for (int s = 0; s < 16; ++s) hs[s][tid] = bf2f(f2bf(siluf_(ag[s]) * au[s]));
  }
  __syncthreads();
  for (int nb = 0; nb < 4; ++nb) {
    float acc[16];
    for (int s = 0; s < 16; ++s) acc[s] = 0.f;
    const float* wd = p.ew_down + (size_t)e * EFF * D + nb * 256 + tid;
    for (int j = 0; j < EFF; ++j) { const float w = wd[(size_t)j * D]; for (int s = 0; s < 16; ++s) acc[s] += hs[s][j] * w; }
    for (int s = 0; s < 16; ++s) if (toks[s] >= 0) p.Y[(size_t)(s0 + s) * D + nb * 256 + tid] = f2bf(acc[s]);
  }
}

#define SMEM_DECL __shared__ __attribute__((aligned(16))) unsigned char smem_raw[SMEM_BYTES]; const lds_ptr smem = (lds_ptr)smem_raw;


#define XB_TMO      128
#define XB_XCNT(j)  (256  + 64 * (j))
#define XB_XSUB(j)  (1280 + 64 * (j))
#define XB_XGEN(j)  (2304 + 64 * (j))
#define XB_TOP      3328
#define XB_TOPGEN   3392
#define XCD_BAR_WORDS 3456
#define XB_SPIN_CAP (1u << 18)
__device__ __forceinline__ unsigned xb_ld(unsigned* q)              { return __hip_atomic_load(q, __ATOMIC_RELAXED, __HIP_MEMORY_SCOPE_AGENT); }
__device__ __forceinline__ unsigned xb_add(unsigned* q, unsigned v) { return __hip_atomic_fetch_add(q, v, __ATOMIC_RELAXED, __HIP_MEMORY_SCOPE_AGENT); }
__device__ __forceinline__ unsigned xb_xcc_id() { return (unsigned)__builtin_amdgcn_s_getreg((3 << 11) | 20) & 0xFu; }
#define XB_SPIN(cond, bar) do { unsigned _sp = 0; while (cond) { __builtin_amdgcn_s_sleep(1); \
    if ((++_sp & 255u) == 0u) { if (xb_ld(&(bar)[XB_TMO])) break; if (_sp > XB_SPIN_CAP) { atomicAdd(&(bar)[XB_TMO], 1u); break; } } } } while (0)
struct XcdBarrier { unsigned* bar; unsigned x; volatile LAS unsigned* st; };
__device__ __forceinline__ XcdBarrier xcd_barrier_post(unsigned* bar, volatile LAS unsigned* st) {
  XcdBarrier b; b.bar = bar; b.x = xb_xcc_id(); b.st = st;
  if (threadIdx.x == 0) (void)xb_add(&bar[XB_XCNT(b.x)], 1u);
  return b;
}
__device__ __forceinline__ void xcd_barrier_complete(unsigned* bar, unsigned x, unsigned& nloc, unsigned& nx) {
  const unsigned G = gridDim.x * gridDim.y * gridDim.z;
  unsigned sum, cnt, mine, sp = 0u;
  for (;;) {
    sum = 0u; cnt = 0u; mine = 0u;
#pragma unroll
    for (unsigned j = 0; j < 16; ++j) { const unsigned c = xb_ld(&bar[XB_XCNT(j)]); sum += c; cnt += (c > 0u) ? 1u : 0u; mine = (j == x) ? c : mine; }
    if (sum == G) break;
    __builtin_amdgcn_s_sleep(1);
    if ((++sp & 255u) == 0u) { if (xb_ld(&bar[XB_TMO])) break; if (sp > XB_SPIN_CAP) { atomicAdd(&bar[XB_TMO], 1u); break; } }
  }
  nloc = mine > 0u ? mine : 1u; nx = cnt > 0u ? cnt : 1u;
}
__device__ __forceinline__ void xcd_barrier(const XcdBarrier& b) {
  asm volatile("s_waitcnt vmcnt(0)" ::: "memory");
  __syncthreads();
  if (threadIdx.x == 0) {
    unsigned* bar = b.bar;
    __builtin_amdgcn_s_waitcnt(0);
    unsigned nloc = b.st[0], nx = b.st[1];
    if (nloc == 0u) { xcd_barrier_complete(bar, b.x, nloc, nx); b.st[0] = nloc; b.st[1] = nx; }
    const unsigned old = xb_add(&bar[XB_XSUB(b.x)], 1u);
    const unsigned gen = old / nloc;
    if (old + 1u == (gen + 1u) * nloc) {
      __builtin_amdgcn_fence(__ATOMIC_RELEASE, "agent");
      asm volatile("s_waitcnt vmcnt(0)" ::: "memory");
      const unsigned og = xb_add(&bar[XB_TOP], 1u);
      const unsigned tg = og / nx;
      if (og + 1u == (tg + 1u) * nx) xb_add(&bar[XB_TOPGEN], 1u);
      else XB_SPIN(xb_ld(&bar[XB_TOPGEN]) == tg, bar);
      __builtin_amdgcn_fence(__ATOMIC_ACQUIRE, "agent");
      xb_add(&bar[XB_XGEN(b.x)], 1u);
      asm volatile("s_waitcnt vmcnt(0)" ::: "memory");
    } else {
      XB_SPIN(xb_ld(&bar[XB_XGEN(b.x)]) == gen, bar);
      __builtin_amdgcn_fence(__ATOMIC_ACQUIRE, "agent");
      asm volatile("s_waitcnt vmcnt(0)" ::: "memory");
    }
  }
  __syncthreads();
}

__device__ __forceinline__ const __attribute__((address_space(4))) P* kargs() { auto q = __builtin_amdgcn_kernarg_segment_ptr(); asm volatile("" : "+s"(q)); return (const __attribute__((address_space(4))) P*)q; }
#define PK (*kargs())
__global__ void __launch_bounds__(NTHR) k_fused(P p_unused) {
  SMEM_DECL
  const int bid = blockIdx.x, nb = gridDim.x;
  volatile LAS unsigned* xbw = (volatile LAS unsigned*)(smem + SMEM_BYTES - 16);
  if (threadIdx.x == 0) { xbw[0] = 0u; xbw[1] = 0u; }
  __syncthreads();
  const XcdBarrier xb = xcd_barrier_post(PK.bar, xbw);
#define GSYNC() xcd_barrier(xb)
#define RUN(k, ...) do { __VA_ARGS__; if (REP_PHASE == (k)) { _Pragma("unroll 1") for (int r_ = 0; r_ < REP_N; ++r_) { __builtin_amdgcn_sched_barrier(0); __VA_ARGS__; } } } while (0)
  RUN(0, phase_prep(PK, bid, nb, smem));                                                                   GSYNC();
  RUN(1, phase_norm<false>(PK, PK.x, PK.norm1_g, 0, D, PK.h1, bid, nb, smem));                                 GSYNC();
  RUN(2, phase_gemm_dense256_bf16(PK.h1, D, PK.wb_in, LDP, T, LDP, D, PK.proj, LDP, bid, nb, smem); gk_rows(PK, bid, nb));     GSYNC();
  RUN(3, phase_mix_local(PK, bid, nb, smem, 3));                                                           GSYNC();
  RUN(4, phase_mix_carry(PK, bid, nb, 3));                                                                 GSYNC();
  RUN(5, phase_mix_final(PK, bid, nb, smem, 3));                                                           GSYNC();
  RUN(6, phase_gemm_dense(PK.yA, S5W, PK.wb_glu, S5W, T, S5W, S5W, EpiGlu{PK.yA, PK.b_glu, PK.zA}, bid, nb, smem));   GSYNC();
  RUN(7, phase_gemm_mixed(PK, bid, nb, smem));                                                             GSYNC();
  RUN(8, phase_gemm_dense256(PK.mixed, D, PK.wb_out, D, T, D, D, EpiOut{PK.x, PK.mod, PK.x1}, bid, nb, smem));    GSYNC();
  RUN(9, phase_norm<false>(PK, PK.x1, PK.norm2_g, 3 * D, 4 * D, PK.h2, bid, nb, smem));                       GSYNC();
  RUN(10, phase_gemm_rs(PK, bid, nb, smem));                                                               GSYNC();
  phase_route(PK, bid, nb);                                                                                GSYNC();
  RUN(12, phase_scatter(PK, bid, nb, smem));                                                               GSYNC();
  phase_moe_pair<1>(PK, bid, nb, smem);                                                                    GSYNC();
  phase_moe_pair<2>(PK, bid, nb, smem);
  RUN(14, phase_gemm_dense256_bf16(PK.shH, SFF, PK.wb_sd, D, T, D, SFF, PK.S, D, bid, nb, smem));        GSYNC();
  RUN(15, phase_combine(PK, bid, nb));
}

static inline size_t al256(size_t v) { return (v + 255) & ~(size_t)255; }

extern "C" void kernel_launch(void* const* d_in, const int* in_sizes, int n_in, void* d_out, int out_size, void* d_ws, size_t ws_size, hipStream_t stream) {
  P p{};
  const float** pin = (const float**)&p;
  for (int i = 0; i < 32; ++i) pin[i] = (const float*)d_in[i];
  p.out = (float*)d_out;
  char* w = (char*)d_ws; size_t off = 0;
  auto take = [&](size_t bytes) { char* r = w + off; off = al256(off + bytes); return (void*)r; };
  p.mod = (float*)take(8 * 6144 * 4);
  p.wb_in = (bf16_t*)take((size_t)D * LDP * 2);
  p.wb_glu = (bf16_t*)take((size_t)S5W * S5W * 2);
  p.wb_pa = (bf16_t*)take((size_t)S5W * D * 2);
  p.wb_pb = (bf16_t*)take((size_t)GVAL * D * 2);
  p.wb_out = (bf16_t*)take((size_t)D * D * 2);
  p.wb_rs = (bf16_t*)take((size_t)D * 768 * 2);
  p.wb_sd = (bf16_t*)take((size_t)SFF * D * 2);
  p.h1 = (bf16_t*)take((size_t)T * D * 2);
  p.gkl = (float*)take((size_t)T * 16 * 4);
  p.proj = (bf16_t*)take((size_t)T * LDP * 2);
  p.abar = (float*)take(S5G * S5P * 2 * 4);
  p.bbar = (float*)take(S5G * S5P * S5H * 2 * 4);
  p.yA = (bf16_t*)take((size_t)T * S5W * 2);
  p.oraw = (float*)take((size_t)T * GVAL * 4);
  p.yB = (bf16_t*)take((size_t)T * GVAL * 2);
  p.zA = (bf16_t*)take((size_t)T * S5W * 2);
  p.mixed = (bf16_t*)take((size_t)T * D * 2);
  p.x1 = (float*)take((size_t)T * D * 4);
  p.h2 = (bf16_t*)take((size_t)T * D * 2);
  p.logits = (float*)take((size_t)T * NE * 4);
  p.tk_idx = (int*)take((size_t)T * 8 * 4);
  p.tk_w = (float*)take((size_t)T * 8 * 4);
  p.tk_rank = (int*)take((size_t)T * 8 * 4);
  p.slot_of = (int*)take((size_t)T * 8 * 4);
  p.counts = (int*)take(256 * 4);
  p.pad_start = (int*)take(257 * 4);
  p.blk_exp = (int*)take(NBLK128 * 4);
  p.slot_tok = (int*)take((size_t)NSLOT * 4);
  p.Y = (bf16_t*)take((size_t)NSLOT * D * 2);
  p.shH = (bf16_t*)take((size_t)T * SFF * 2);
  p.S = (bf16_t*)take((size_t)T * D * 2);
  p.bbarT = (bf16_t*)take((size_t)S5G * 128 * 16 * 2);
  p.cmT = (bf16_t*)take((size_t)S5G * 16 * 128 * 2);
  p.apow64 = (float*)take(S5G * S5P * 2 * 4);
  p.s5E = (float*)take((size_t)NB * 32 * S5G * 64 * 2 * 4);
  p.s5Sin = (float*)take((size_t)NB * 32 * S5G * 64 * 2 * 4);
  p.glaKV = (float*)take((size_t)1024 * 64 * 128 * 4);
  p.glaDec = (float*)take((size_t)1024 * 64 * 4);
  p.glaSin = (bf16_t*)take((size_t)1024 * 64 * 128 * 2);
  p.wgkT = (bf16_t*)take((size_t)16 * D * 2);
  p.moe_list = (int*)take((size_t)8 * NBLK128 * 4);
  p.moe_cnt = (int*)take(64);
  p.moe_ctr = (int*)take(64);
  p.Hbuf = (bf16_t*)take((size_t)NSLOT * EFF * 2);
  p.bar = (unsigned*)take(XCD_BAR_WORDS * 4);
  if (off > ws_size) { fprintf(stderr, "workspace too small: need %zu have %zu\n", off, ws_size); return; }

  static int grid_blocks = 0;
  if (!grid_blocks) {
    int dev = 0, cus = 0, per_cu = 0;
    (void)hipGetDevice(&dev);
    (void)hipDeviceGetAttribute(&cus, hipDeviceAttributeMultiprocessorCount, dev);
    (void)hipOccupancyMaxActiveBlocksPerMultiprocessor(&per_cu, k_fused, NTHR, 0);
    grid_blocks = (per_cu >= 1) ? cus : 0;
    grid_blocks &= ~7;
    if (grid_blocks <= 0) { fprintf(stderr, "occupancy query says the fused kernel does not fit (per_cu=%d cus=%d)\n", per_cu, cus); grid_blocks = 0; return; }
  }
  (void)hipMemsetAsync(p.bar, 0, XCD_BAR_WORDS * 4, stream);
  void* args[] = {&p};
  hipError_t e = hipLaunchCooperativeKernel((const void*)k_fused, dim3(grid_blocks), dim3(NTHR), args, 0, stream);
  if (e != hipSuccess) fprintf(stderr, "cooperative launch failed: %s (grid %d)\n", hipGetErrorString(e), grid_blocks);
}
```

```cpp
#include <hip/hip_runtime.h>
#include <hip/hip_cooperative_groups.h>
namespace cg = cooperative_groups;
#include <cstdint>
#include <cstdio>

typedef unsigned short bf16_t;
typedef short s16x8 __attribute__((ext_vector_type(8)));
typedef short s16x4 __attribute__((ext_vector_type(4)));
typedef float f32x4 __attribute__((ext_vector_type(4)));
typedef unsigned u32x4 __attribute__((ext_vector_type(4)));
typedef unsigned u32x2 __attribute__((ext_vector_type(2)));
#define LAS __attribute__((address_space(3)))
typedef LAS unsigned char* lds_ptr;

constexpr int D = 1024, NB = 8, SEQ = 2048, T = NB * SEQ;
constexpr int S5W = 512, S5G = 32, S5H = 16, S5P = 64;
constexpr int GH = 4, GDK = 64, GDV = 128, GKEY = 256, GVAL = 512, GRANK = 16;
constexpr int NE = 256, TOPK = 8, NGRP = 8, EFF = 256, SFF = 256;
constexpr int INW = 4112, LDP = 4096;
constexpr int OFF_U = 0, OFF_Q = 512, OFF_K = 768, OFF_V = 1024, OFF_R = 1536, OFF_GA = 2048, OFF_GB = 3072;
constexpr int WIN_GK = 1536;
constexpr int NSLOT = 163584, NBLK128 = NSLOT / 128;
constexpr int NTHR = 512;
constexpr int USE_MFMA = 127;
constexpr int USE_NEW = 7;
constexpr int REP_PHASE = -1, REP_N = 8;
constexpr int MOE_REP_GU = 1, MOE_REP_DN = 1;

__device__ __forceinline__ float bf2f(bf16_t v) { return __uint_as_float(((unsigned)v) << 16); }
__device__ __forceinline__ bf16_t f2bf(float f) { return __builtin_bit_cast(unsigned short, (__bf16)f); }
typedef float f32x2 __attribute__((ext_vector_type(2)));
typedef __bf16 bf16x2_t __attribute__((ext_vector_type(2)));
__device__ __forceinline__ unsigned cvtpk(float lo, float hi) { const f32x2 v = {lo, hi}; return __builtin_bit_cast(unsigned, __builtin_convertvector(v, bf16x2_t)); }
__device__ __forceinline__ float sigmoidf_(float x) { return __builtin_amdgcn_rcpf(1.f + __expf(-x)); }
__device__ __forceinline__ float siluf_(float x) { return x * __builtin_amdgcn_rcpf(1.f + __expf(-x)); }
__device__ __forceinline__ float geluf_(float x) { const float u = 0.7978845608028654f * (x + 0.044715f * x * x * x); return x * __builtin_amdgcn_rcpf(1.f + __expf(-2.f * u)); }
__device__ __forceinline__ float logsigmoidf_(float x) { return fminf(x, 0.f) - __logf(1.f + __expf(-fabsf(x))); }

struct P;
typedef const __attribute__((address_space(4))) P& PR;

__device__ __forceinline__ int ltid() { int t = threadIdx.x; asm volatile("" : "+v"(t)); return t; }

struct P {
  const float *x, *c, *ada_w, *ada_b, *norm1_g, *w_in, *lam_re, *lam_im, *log_dt, *b_re, *b_im, *c_re, *c_im, *s5_d, *w_glu, *b_glu, *w_proj_a,
      *w_gk2, *b_gk2, *gla_norm_g, *w_proj_b, *w_out, *norm2_g, *router_w, *router_bias, *ew_gate, *ew_up, *ew_down, *sw_gate, *sw_up, *sw_down, *final_g;
  float* out;
  float* mod;
  bf16_t* wb_in;
  bf16_t* wb_glu;
  bf16_t* wb_pa;
  bf16_t* wb_pb;
  bf16_t* wb_out;
  bf16_t* wb_rs;
  bf16_t* wb_sd;
  bf16_t* h1;
  float* gkl;
  bf16_t* proj;
  float* abar;
  float* bbar;
  bf16_t* yA;
  float* oraw;
  bf16_t* yB;
  bf16_t* zA;
  bf16_t* mixed;
  float* x1;
  bf16_t* h2;
  float* logits;
  int* tk_idx;
  float* tk_w;
  int* tk_rank;
  int* slot_of;
  int* counts;
  int* pad_start;
  int* blk_exp;
  int* slot_tok;
  bf16_t* Y;
  bf16_t* shH;
  bf16_t* S;
  bf16_t* bbarT;
  bf16_t* cmT;
  float* apow64;
  float* s5E;
  float* s5Sin;
  float* glaKV;
  float* glaDec;
  bf16_t* glaSin;
  bf16_t* wgkT;
  int* moe_list;
  int* moe_cnt;
  int* moe_ctr;
  bf16_t* Hbuf;
  unsigned* bar;
};

constexpr int G_ASZ = 128 * 64, G_BSZ = 32 * 512, G_STAGE = G_ASZ + G_BSZ;

__device__ __forceinline__ int a_off(int r, int c) { return r * 64 + ((c ^ ((0x78 >> (((r >> 2) & 3) * 2)) & 3)) << 4); }
__device__ __forceinline__ int b_off(int k, int ch) { return k * 512 + ((ch ^ ((k & 3) | (((k >> 3) & 1) << 2))) << 5); }
__device__ __forceinline__ s16x4 tr_read(lds_ptr p) { return __builtin_bit_cast(s16x4, __builtin_amdgcn_ds_read_tr16_b64_v4i16((LAS s16x4*)p)); }

struct ALoadDense { const bf16_t* A; long lda; __device__ __forceinline__ const bf16_t* rowptr(int r) const { return A + (size_t)r * lda; } };
struct ALoadGatherLds { const bf16_t* A; LAS int* tk; __device__ __forceinline__ const bf16_t* rowptr(int r) const { int t = tk[r]; t = t < 0 ? 0 : t; return A + (size_t)t * D; } };
struct BLoadBf { const bf16_t* Bm; long ldb;
  __device__ __forceinline__ u32x4 load(int kg, int c8) const { return *(const u32x4*)(Bm + (size_t)kg * ldb + c8 * 8); } };
struct BLoadF32 { const float* Bm; long ldb;
  __device__ __forceinline__ u32x4 load(int kg, int c8) const { const float* q = Bm + (size_t)kg * ldb + c8 * 8; const f32x4 a = *(const f32x4*)q, b = *(const f32x4*)(q + 4);
    u32x4 r; r.x = cvtpk(a[0], a[1]); r.y = cvtpk(a[2], a[3]); r.z = cvtpk(b[0], b[1]); r.w = cvtpk(b[2], b[3]); return r; } };
struct BLoadGU { const float* Wg; const float* Wu; long ldb; int h0;
  __device__ __forceinline__ u32x4 load(int kg, int c8) const { const int col = c8 * 8, w = col >> 6, xx = col & 63; const float* base = (xx < 32) ? Wg : Wu;
    const float* q = base + (size_t)kg * ldb + h0 + 32 * w + (xx & 31); const f32x4 a = *(const f32x4*)q, b = *(const f32x4*)(q + 4);
    u32x4 r; r.x = cvtpk(a[0], a[1]); r.y = cvtpk(a[2], a[3]); r.z = cvtpk(b[0], b[1]); r.w = cvtpk(b[2], b[3]); return r; } };

template <bool A_RES, class AL, class BL>
__device__ __forceinline__ void gemm_mainloop(f32x4 (&acc)[4][4], const AL& al, const BL& bl, int nk, lds_ptr stage, lds_ptr resA) {
  const int tid = ltid(), lane = tid & 63, wid = tid >> 6, wm = wid >> 2, wn = wid & 3, fr = lane & 15, fq = lane >> 4;
  const int ar = tid >> 2, ac = tid & 3;
  const int p0 = tid, p1 = tid + 512;
  const int bk0 = p0 >> 5, bc0 = p0 & 31, bk1 = p1 >> 5, bc1 = p1 & 31;
  const bf16_t* aptr = nullptr;
  if (!A_RES) aptr = al.rowptr(ar) + ac * 8;
  const int a_st = a_off(ar, ac);
  const int b_st0 = b_off(bk0, bc0 >> 1) + (bc0 & 1) * 16, b_st1 = b_off(bk1, bc1 >> 1) + (bc1 & 1) * 16;
  int a_rd[4];
#pragma unroll
  for (int mt = 0; mt < 4; ++mt) a_rd[mt] = a_off(wm * 64 + mt * 16 + fr, fq);
  int b_rd[4][2];
#pragma unroll
  for (int nt = 0; nt < 4; ++nt) {
    b_rd[nt][0] = b_off(8 * fq + (fr >> 2), wn * 4 + nt) + (fr & 3) * 8;
    b_rd[nt][1] = b_off(8 * fq + 4 + (fr >> 2), wn * 4 + nt) + (fr & 3) * 8;
  }
#pragma unroll
  for (int mt = 0; mt < 4; ++mt)
#pragma unroll
    for (int nt = 0; nt < 4; ++nt) acc[mt][nt] = (f32x4){0.f, 0.f, 0.f, 0.f};
  u32x4 areg = {0, 0, 0, 0}, breg0, breg1;
  if (!A_RES) areg = *(const u32x4*)aptr;
  breg0 = bl.load(bk0, bc0); breg1 = bl.load(bk1, bc1);
  __syncthreads();
  if (!A_RES) *(LAS u32x4*)(stage + a_st) = areg;
  *(LAS u32x4*)(stage + G_ASZ + b_st0) = breg0;
  *(LAS u32x4*)(stage + G_ASZ + b_st1) = breg1;
  __syncthreads();
  for (int kt = 0; kt < nk; ++kt) {
    const lds_ptr cur = stage + (kt & 1) * G_STAGE, nxt = stage + ((kt + 1) & 1) * G_STAGE;
    const bool more = kt + 1 < nk;
    if (more) {
      if (!A_RES) areg = *(const u32x4*)(aptr + (kt + 1) * 32);
      breg0 = bl.load((kt + 1) * 32 + bk0, bc0); breg1 = bl.load((kt + 1) * 32 + bk1, bc1);
    }
    s16x8 af[4], bfr[4];
    const lds_ptr abase = A_RES ? (resA + kt * G_ASZ) : cur;
#pragma unroll
    for (int mt = 0; mt < 4; ++mt) af[mt] = *(LAS s16x8*)(abase + a_rd[mt]);
#pragma unroll
    for (int nt = 0; nt < 4; ++nt) {
      const s16x4 lo = tr_read(cur + G_ASZ + b_rd[nt][0]), hi = tr_read(cur + G_ASZ + b_rd[nt][1]);
      bfr[nt] = __builtin_shufflevector(lo, hi, 0, 1, 2, 3, 4, 5, 6, 7);
    }
#pragma unroll
    for (int mt = 0; mt < 4; ++mt)
#pragma unroll
      for (int nt = 0; nt < 4; ++nt) acc[mt][nt] = __builtin_amdgcn_mfma_f32_16x16x32_bf16(bfr[nt], af[mt], acc[mt][nt], 0, 0, 0);
    if (more) {
      if (!A_RES) *(LAS u32x4*)(nxt + a_st) = areg;
      *(LAS u32x4*)(nxt + G_ASZ + b_st0) = breg0;
      *(LAS u32x4*)(nxt + G_ASZ + b_st1) = breg1;
    }
    __syncthreads();
  }
}


struct BRaw { f32x4 v[4]; };
struct BLoadF32R { const float* Bm; long ldb;
  __device__ __forceinline__ void load(BRaw& r, int kbase, int tid) const {
    const float* q = Bm + (size_t)(kbase + (tid >> 6)) * ldb + (tid & 63) * 4;
#pragma unroll
    for (int i = 0; i < 4; ++i) r.v[i] = *(const f32x4*)(q + (size_t)(8 * i) * ldb); } };
struct BLoadGUR { const float* Wg; long du; long ldb; int h0;
  __device__ __forceinline__ void load(BRaw& r, int kbase, int tid) const {
    const int col = (tid & 63) * 4, w = col >> 6, xx = col & 63;
    const float* q = Wg + ((xx < 32) ? 0l : du) + (size_t)(kbase + (tid >> 6)) * ldb + h0 + 32 * w + (xx & 31);
#pragma unroll
    for (int i = 0; i < 4; ++i) r.v[i] = *(const f32x4*)(q + (size_t)(8 * i) * ldb); } };
__device__ __forceinline__ u32x4 cvt8(const f32x4& a, const f32x4& b) { u32x4 r; r.x = cvtpk(a[0], a[1]); r.y = cvtpk(a[2], a[3]); r.z = cvtpk(b[0], b[1]); r.w = cvtpk(b[2], b[3]); return r; }

template <bool A_RES, class AL, class BL>
__device__ __forceinline__ void gemm_mainloop_r3(f32x4 (&acc)[4][4], const AL& al, const BL& bl, int nk, lds_ptr stage, lds_ptr resA) {
  const int tid = ltid(), lane = tid & 63, wid = tid >> 6, wm = wid >> 2, wn = wid & 3, fr = lane & 15, fq = lane >> 4;
  const int ar = tid >> 2, ac = tid & 3;
  const bf16_t* aptr = nullptr;
  if (!A_RES) aptr = al.rowptr(ar) + ac * 8;
  const int a_st = a_off(ar, ac);
  int b_st[4];
#pragma unroll
  for (int i = 0; i < 4; ++i) b_st[i] = G_ASZ + b_off((tid >> 6) + 8 * i, (tid & 63) >> 2) + (tid & 3) * 8;
  int a_rd[4];
#pragma unroll
  for (int mt = 0; mt < 4; ++mt) a_rd[mt] = a_off(wm * 64 + mt * 16 + fr, fq);
  int b_rd[4][2];
#pragma unroll
  for (int nt = 0; nt < 4; ++nt) {
    b_rd[nt][0] = G_ASZ + b_off(8 * fq + (fr >> 2), wn * 4 + nt) + (fr & 3) * 8;
    b_rd[nt][1] = G_ASZ + b_off(8 * fq + 4 + (fr >> 2), wn * 4 + nt) + (fr & 3) * 8;
  }
#pragma unroll
  for (int mt = 0; mt < 4; ++mt)
#pragma unroll
    for (int nt = 0; nt < 4; ++nt) acc[mt][nt] = (f32x4){0.f, 0.f, 0.f, 0.f};
  u32x4 ra0 = {0, 0, 0, 0}, ra1 = {0, 0, 0, 0}, ra2 = {0, 0, 0, 0};
  BRaw rb0, rb1, rb2;
#define R3_LOAD(RA, RB, kt_) do { if (!A_RES) RA = *(const u32x4*)(aptr + (size_t)(kt_) * 32); bl.load(RB, (kt_) * 32, tid); } while (0)
#define R3_STORE(RA, RB, st_) do { const lds_ptr s_ = stage + (st_) * G_STAGE; if (!A_RES) *(LAS u32x4*)(s_ + a_st) = RA; \
    _Pragma("unroll") for (int i_ = 0; i_ < 4; ++i_) { u32x2 o_; o_.x = cvtpk(RB.v[i_][0], RB.v[i_][1]); o_.y = cvtpk(RB.v[i_][2], RB.v[i_][3]); *(LAS u32x2*)(s_ + b_st[i_]) = o_; } } while (0)
#define R3_COMPUTE(kt_) do { const lds_ptr cur = stage + ((kt_) & 1) * G_STAGE; const lds_ptr abase = A_RES ? (resA + (kt_) * G_ASZ) : cur; \
    s16x8 af[4], bfr[4]; \
    _Pragma("unroll") for (int mt = 0; mt < 4; ++mt) af[mt] = *(LAS s16x8*)(abase + a_rd[mt]); \
    _Pragma("unroll") for (int nt = 0; nt < 4; ++nt) { const s16x4 lo = tr_read(cur + b_rd[nt][0]), hi = tr_read(cur + b_rd[nt][1]); bfr[nt] = __builtin_shufflevector(lo, hi, 0, 1, 2, 3, 4, 5, 6, 7); } \
    _Pragma("unroll") for (int mt = 0; mt < 4; ++mt) _Pragma("unroll") for (int nt = 0; nt < 4; ++nt) acc[mt][nt] = __builtin_amdgcn_mfma_f32_16x16x32_bf16(bfr[nt], af[mt], acc[mt][nt], 0, 0, 0); } while (0)
#define R3_BODY_U(kt_, RAN, RBN, RAW, RBW) do { const int kl_ = ((kt_) + 3 < nk) ? (kt_) + 3 : nk - 1; R3_LOAD(RAN, RBN, kl_); __builtin_amdgcn_sched_barrier(0); R3_COMPUTE(kt_); __builtin_amdgcn_sched_barrier(0); R3_STORE(RAW, RBW, ((kt_) + 1) & 1); __syncthreads(); } while (0)
#define R3_BODY_T(kt_, RAW, RBW) do { R3_COMPUTE(kt_); if ((kt_) + 1 < nk) R3_STORE(RAW, RBW, ((kt_) + 1) & 1); __syncthreads(); } while (0)
  R3_LOAD(ra0, rb0, 0);
  R3_LOAD(ra1, rb1, 1);
  R3_LOAD(ra2, rb2, 2);
  __syncthreads();
  R3_STORE(ra0, rb0, 0);
  __syncthreads();
  int kt = 0;
  for (; kt + 3 <= nk; kt += 3) {
    R3_BODY_U(kt, ra0, rb0, ra1, rb1);
    R3_BODY_U(kt + 1, ra1, rb1, ra2, rb2);
    R3_BODY_U(kt + 2, ra2, rb2, ra0, rb0);
  }
  if (kt < nk) { R3_BODY_T(kt, ra1, rb1); if (kt + 1 < nk) R3_BODY_T(kt + 1, ra2, rb2); }
#undef R3_BODY_U
#undef R3_BODY_T
#undef R3_LOAD
#undef R3_STORE
#undef R3_COMPUTE
}

constexpr int G_NST = 4;
#define WAIT_VM(n) asm volatile("s_waitcnt vmcnt(" #n ")" ::: "memory")
template <class AL>
__device__ __forceinline__ void gemm_mainloop_glds(f32x4 (&acc)[4][4], const AL& al, const bf16_t* __restrict__ Bm, long ldb, int nk, lds_ptr ring) {
  const int tid = ltid(), lane = tid & 63, wid = tid >> 6, wm = wid >> 2, wn = wid & 3, fr = lane & 15, fq = lane >> 4;
  const int ar = tid >> 2;
  const bf16_t* aptr = al.rowptr(ar) + (((tid & 3) ^ ((0x78 >> (((ar >> 2) & 3) * 2)) & 3)) << 3);
  const int bk = tid >> 5, pc = tid & 31;
  const int bcol = ((((pc >> 1) ^ ((bk & 3) | (((bk >> 3) & 1) << 2))) << 4) | ((pc & 1) << 3));
  const bf16_t* bptr0 = Bm + (size_t)bk * ldb + bcol;
  const bf16_t* bptr1 = bptr0 + (size_t)16 * ldb;
  const size_t bstep = (size_t)32 * ldb;
  int a_rd[4];
#pragma unroll
  for (int mt = 0; mt < 4; ++mt) a_rd[mt] = a_off(wm * 64 + mt * 16 + fr, fq);
  int b_rd[4][2];
#pragma unroll
  for (int nt = 0; nt < 4; ++nt) {
    b_rd[nt][0] = G_ASZ + b_off(8 * fq + (fr >> 2), wn * 4 + nt) + (fr & 3) * 8;
    b_rd[nt][1] = G_ASZ + b_off(8 * fq + 4 + (fr >> 2), wn * 4 + nt) + (fr & 3) * 8;
  }
#pragma unroll
  for (int mt = 0; mt < 4; ++mt)
#pragma unroll
    for (int nt = 0; nt < 4; ++nt) acc[mt][nt] = (f32x4){0.f, 0.f, 0.f, 0.f};
  const lds_ptr dstl = ring + tid * 16;
#define GLDS_ISSUE(kt_) do { const lds_ptr d_ = dstl + ((kt_) & (G_NST - 1)) * G_STAGE; \
    __builtin_amdgcn_global_load_lds((const unsigned*)(aptr + (size_t)(kt_) * 32), (LAS unsigned*)(d_), 16, 0, 0); \
    __builtin_amdgcn_global_load_lds((const unsigned*)(bptr0 + (size_t)(kt_) * bstep), (LAS unsigned*)(d_ + G_ASZ), 16, 0, 0); \
    __builtin_amdgcn_global_load_lds((const unsigned*)(bptr1 + (size_t)(kt_) * bstep), (LAS unsigned*)(d_ + G_ASZ + 8192), 16, 0, 0); } while (0)
  __syncthreads();
  GLDS_ISSUE(0);
  if (nk > 1) GLDS_ISSUE(1);
  if (nk > 2) GLDS_ISSUE(2);
  for (int kt = 0; kt < nk; ++kt) {
    if (kt + 2 < nk) WAIT_VM(6); else if (kt + 1 < nk) WAIT_VM(3); else WAIT_VM(0);
    __builtin_amdgcn_s_barrier();
    if (kt + 3 < nk) GLDS_ISSUE(kt + 3);
    const lds_ptr cur = ring + (kt & (G_NST - 1)) * G_STAGE;
    s16x8 af[4], bfr[4];
#pragma unroll
    for (int mt = 0; mt < 4; ++mt) af[mt] = *(LAS s16x8*)(cur + a_rd[mt]);
#pragma unroll
    for (int nt = 0; nt < 4; ++nt) {
      const s16x4 lo = tr_read(cur + b_rd[nt][0]), hi = tr_read(cur + b_rd[nt][1]);
      bfr[nt] = __builtin_shufflevector(lo, hi, 0, 1, 2, 3, 4, 5, 6, 7);
    }
#pragma unroll
    for (int mt = 0; mt < 4; ++mt)
#pragma unroll
      for (int nt = 0; nt < 4; ++nt) acc[mt][nt] = __builtin_amdgcn_mfma_f32_16x16x32_bf16(bfr[nt], af[mt], acc[mt][nt], 0, 0, 0);
  }
#undef GLDS_ISSUE
}


constexpr int G2_STAGE = 2 * G_ASZ + G_BSZ;
__device__ __forceinline__ void gemm_mainloop_glds256(f32x4 (&acc)[8][4], const bf16_t* __restrict__ A, long lda, const bf16_t* __restrict__ Bm, long ldb, int nk, lds_ptr ring) {
  const int tid = ltid(), lane = tid & 63, wid = tid >> 6, wm = wid >> 2, wn = wid & 3, fr = lane & 15, fq = lane >> 4;
  const int ar = tid >> 2;
  const bf16_t* aptr0 = A + (size_t)ar * lda + (((tid & 3) ^ ((0x78 >> (((ar >> 2) & 3) * 2)) & 3)) << 3);
  const bf16_t* aptr1 = aptr0 + (size_t)128 * lda;
  const int bk = tid >> 5, pc = tid & 31;
  const int bcol = ((((pc >> 1) ^ ((bk & 3) | (((bk >> 3) & 1) << 2))) << 4) | ((pc & 1) << 3));
  const bf16_t* bptr0 = Bm + (size_t)bk * ldb + bcol;
  const bf16_t* bptr1 = bptr0 + (size_t)16 * ldb;
  const size_t bstep = (size_t)32 * ldb;
  int a_rd[8];
#pragma unroll
  for (int mt = 0; mt < 8; ++mt) a_rd[mt] = wm * G_ASZ + a_off(mt * 16 + fr, fq);
  int b_rd[4][2];
#pragma unroll
  for (int nt = 0; nt < 4; ++nt) {
    b_rd[nt][0] = 2 * G_ASZ + b_off(8 * fq + (fr >> 2), wn * 4 + nt) + (fr & 3) * 8;
    b_rd[nt][1] = 2 * G_ASZ + b_off(8 * fq + 4 + (fr >> 2), wn * 4 + nt) + (fr & 3) * 8;
  }
#pragma unroll
  for (int mt = 0; mt < 8; ++mt)
#pragma unroll
    for (int nt = 0; nt < 4; ++nt) acc[mt][nt] = (f32x4){0.f, 0.f, 0.f, 0.f};
  const lds_ptr dstl = ring + tid * 16;
#define GLDS2_ISSUE(kt_) do { const lds_ptr d_ = dstl + ((kt_) & (G_NST - 1)) * G2_STAGE; \
    __builtin_amdgcn_global_load_lds((const unsigned*)(aptr0 + (size_t)(kt_) * 32), (LAS unsigned*)(d_), 16, 0, 0); \
    __builtin_amdgcn_global_load_lds((const unsigned*)(aptr1 + (size_t)(kt_) * 32), (LAS unsigned*)(d_ + G_ASZ), 16, 0, 0); \
    __builtin_amdgcn_global_load_lds((const unsigned*)(bptr0 + (size_t)(kt_) * bstep), (LAS unsigned*)(d_ + 2 * G_ASZ), 16, 0, 0); \
    __builtin_amdgcn_global_load_lds((const unsigned*)(bptr1 + (size_t)(kt_) * bstep), (LAS unsigned*)(d_ + 2 * G_ASZ + 8192), 16, 0, 0); } while (0)
  __syncthreads();
  GLDS2_ISSUE(0);
  if (nk > 1) GLDS2_ISSUE(1);
  if (nk > 2) GLDS2_ISSUE(2);
  for (int kt = 0; kt < nk; ++kt) {
    if (kt + 2 < nk) WAIT_VM(8); else if (kt + 1 < nk) WAIT_VM(4); else WAIT_VM(0);
    __builtin_amdgcn_s_barrier();
    if (kt + 3 < nk) GLDS2_ISSUE(kt + 3);
    const lds_ptr cur = ring + (kt & (G_NST - 1)) * G2_STAGE;
    s16x8 bfr[4];
#pragma unroll
    for (int nt = 0; nt < 4; ++nt) {
      const s16x4 lo = tr_read(cur + b_rd[nt][0]), hi = tr_read(cur + b_rd[nt][1]);
      bfr[nt] = __builtin_shufflevector(lo, hi, 0, 1, 2, 3, 4, 5, 6, 7);
    }
#pragma unroll
    for (int h = 0; h < 2; ++h) {
      s16x8 af[4];
#pragma unroll
      for (int mt = 0; mt < 4; ++mt) af[mt] = *(LAS s16x8*)(cur + a_rd[h * 4 + mt]);
#pragma unroll
      for (int mt = 0; mt < 4; ++mt)
#pragma unroll
        for (int nt = 0; nt < 4; ++nt) acc[h * 4 + mt][nt] = __builtin_amdgcn_mfma_f32_16x16x32_bf16(bfr[nt], af[mt], acc[h * 4 + mt][nt], 0, 0, 0);
    }
  }
#undef GLDS2_ISSUE
}

__device__ __forceinline__ void tile_map(int round, int bid, int nb, int nMt, int nNt, int& mt, int& nt, bool& valid) {
  if (nb == 256 && (nNt & 3) == 0 && (nMt & 7) == 0) {
    const int xcd = bid & 7, j = bid >> 3, q = round * 8 + xcd, rn = nNt >> 2;
    const int rect_m = q / rn, rect_n = q % rn;
    mt = rect_m * 8 + (j & 7); nt = rect_n * 4 + (j >> 3); valid = mt < nMt;
  } else {
    const int per = (nb + 7) / 8, xcd = bid & 7, j = bid >> 3;
    const int idx = round * nb + xcd * per + j;
    mt = idx / nNt; nt = idx % nNt; valid = (j < per) && (idx < nMt * nNt) && (xcd * per + j < nb);
  }
}

__device__ __forceinline__ void cvt_copy(const float* __restrict__ src, long lds_, bf16_t* __restrict__ dst, long ldd, int rows, int cols, int gtid, int gsz) {
  const int c4 = cols >> 2;
  for (long i = gtid; i < (long)rows * c4; i += gsz) {
    const int r = (int)(i / c4), c = (int)(i % c4) * 4;
    const f32x4 v = *(const f32x4*)(src + (size_t)r * lds_ + c);
    u32x2 o; o.x = cvtpk(v[0], v[1]); o.y = cvtpk(v[2], v[3]);
    *(u32x2*)(dst + (size_t)r * ldd + c) = o;
  }
}
__device__ __forceinline__ void phase_prep(PR p, int bid, int nb, lds_ptr smem) {
  const int gtid = bid * NTHR + ltid(), gsz = nb * NTHR;
  cvt_copy(p.w_in, INW, p.wb_in, LDP, D, WIN_GK, gtid, gsz);
  cvt_copy(p.w_in + WIN_GK + 16, INW, p.wb_in + WIN_GK, LDP, D, LDP - WIN_GK, gtid, gsz);
  cvt_copy(p.w_glu, S5W, p.wb_glu, S5W, S5W, S5W, gtid, gsz);
  cvt_copy(p.w_proj_a, D, p.wb_pa, D, S5W, D, gtid, gsz);
  cvt_copy(p.w_proj_b, D, p.wb_pb, D, GVAL, D, gtid, gsz);
  cvt_copy(p.w_out, D, p.wb_out, D, D, D, gtid, gsz);
  cvt_copy(p.router_w, NE, p.wb_rs, 768, D, NE, gtid, gsz);
  cvt_copy(p.sw_down, D, p.wb_sd, D, SFF, D, gtid, gsz);
  for (long i = gtid; i < (long)D * 512; i += gsz) {
    const int k = (int)(i >> 9), cc = (int)(i & 511), w = cc >> 6, xx = cc & 63;
    const int hcol = 32 * w + (xx & 31);
    const float v = (xx < 32) ? p.sw_gate[(size_t)k * SFF + hcol] : p.sw_up[(size_t)k * SFF + hcol];
    p.wb_rs[(size_t)k * 768 + 256 + cc] = f2bf(v);
  }
  for (int i = gtid; i < 16 * D; i += gsz) { const int n = i >> 10, k = i & 1023; p.wgkT[i] = f2bf(p.w_in[(size_t)k * INW + WIN_GK + n]); }
  for (int i = gtid; i < NSLOT; i += gsz) p.slot_tok[i] = -1;
  if (gtid < 256) p.counts[gtid] = 0;
  if (gtid < 16) p.moe_ctr[gtid] = 0;
  if (ltid() < 8 && bid * 8 + ltid() < S5G * S5P) {
    const int i = bid * 8 + ltid(), g = i / S5P;
    const double lr = p.lam_re[i], li = p.lam_im[i], dt = (double)__expf(p.log_dt[g]);
    const double TWO_PI = 6.283185307179586476925286766559;
    double ang = li * dt; ang -= TWO_PI * floor(ang / TWO_PI);
    const double mag = (double)__expf((float)(lr * dt));
    const double are = mag * (double)cosf((float)ang), aim = mag * (double)sinf((float)ang);
    const double den = lr * lr + li * li, nre = are - 1.0;
    const double cre = (nre * lr + aim * li) / den, cim = (aim * lr - nre * li) / den;
    p.abar[i * 2] = (float)are; p.abar[i * 2 + 1] = (float)aim;
    for (int h = 0; h < S5H; ++h) {
      const double br = p.b_re[i * S5H + h], bi = p.b_im[i * S5H + h];
      p.bbar[(i * S5H + h) * 2] = (float)(cre * br - cim * bi);
      p.bbar[(i * S5H + h) * 2 + 1] = (float)(cre * bi + cim * br);
      const int pq = i & 63;
      p.bbarT[(size_t)(g * 128 + 2 * pq) * 16 + h] = f2bf((float)(cre * br - cim * bi));
      p.bbarT[(size_t)(g * 128 + 2 * pq + 1) * 16 + h] = f2bf((float)(cre * bi + cim * br));
    }
    double a64 = 64.0 * li * dt; a64 -= TWO_PI * floor(a64 / TWO_PI);
    const double m64 = (double)__expf((float)(64.0 * lr * dt));
    p.apow64[i * 2] = (float)(m64 * (double)cosf((float)a64)); p.apow64[i * 2 + 1] = (float)(m64 * (double)sinf((float)a64));
  }
  for (int i = gtid; i < S5G * S5H * 128; i += gsz) {
    const int pp = i & 127, ho = (i >> 7) & 15, g = i >> 11;
    p.cmT[i] = f2bf((pp & 1) ? -p.c_im[(g * 16 + ho) * 64 + (pp >> 1)] : p.c_re[(g * 16 + ho) * 64 + (pp >> 1)]);
  }
  LAS float* red = (LAS float*)smem;
  LAS float* sc = (LAS float*)(smem + 16384);
  if (bid < 192) {
    __syncthreads();
    for (int i = ltid(); i < 8 * D; i += NTHR) sc[i] = siluf_(p.c[i]);
    __syncthreads();
  }
  for (int item = bid; item < 192; item += nb) {
    const int cl = ltid() & 31, kg = ltid() >> 5, col = item * 32 + cl;
    float acc[8];
#pragma unroll
    for (int b = 0; b < 8; ++b) acc[b] = 0.f;
    const float* wp = p.ada_w + (size_t)(kg * 64) * 6144 + col;
#pragma unroll 1
    for (int k0 = 0; k0 < 64; k0 += 16) {
      float w[16];
#pragma unroll
      for (int q = 0; q < 16; ++q) w[q] = wp[(size_t)(k0 + q) * 6144];
#pragma unroll
      for (int q = 0; q < 16; ++q)
#pragma unroll
        for (int b = 0; b < 8; ++b) acc[b] += sc[b * D + kg * 64 + k0 + q] * w[q];
    }
    __syncthreads();
#pragma unroll
    for (int b = 0; b < 8; ++b) red[(kg * 8 + b) * 32 + cl] = acc[b];
    __syncthreads();
    if (ltid() < 256) {
      const int b = ltid() >> 5, c2 = ltid() & 31;
      float sum = p.ada_b[item * 32 + c2];
      for (int q = 0; q < 16; ++q) sum += red[(q * 8 + b) * 32 + c2];
      p.mod[b * 6144 + item * 32 + c2] = sum;
    }
  }
}

template <bool WITH_GK>
__device__ __forceinline__ void phase_norm(PR p, const float* __restrict__ xin, const float* __restrict__ g, int sh_off, int sc_off, bf16_t* __restrict__ outp, int bid, int nb, lds_ptr smem) {
  const int lane = ltid() & 63, wid = ltid() >> 6;
  const int stride = nb * 8;
  int row = bid * 8 + wid;
  f32x4 nx[4];
  if (row < T) {
#pragma unroll
    for (int i = 0; i < 4; ++i) nx[i] = *(const f32x4*)(xin + (size_t)row * D + lane * 4 + 256 * i);
  }
  f32x4 gv[4];
#pragma unroll
  for (int i = 0; i < 4; ++i) gv[i] = *(const f32x4*)(g + lane * 4 + 256 * i);
  for (; row < T; row += stride) {
    const int b = row / SEQ;
    f32x4 v[4];
#pragma unroll
    for (int i = 0; i < 4; ++i) v[i] = nx[i];
    const int rn = row + stride;
    if (rn < T) {
#pragma unroll
      for (int i = 0; i < 4; ++i) nx[i] = *(const f32x4*)(xin + (size_t)rn * D + lane * 4 + 256 * i);
    }
    float ss = 0.f;
#pragma unroll
    for (int i = 0; i < 4; ++i) ss += v[i][0] * v[i][0] + v[i][1] * v[i][1] + v[i][2] * v[i][2] + v[i][3] * v[i][3];
#pragma unroll
    for (int o = 32; o > 0; o >>= 1) ss += __shfl_xor(ss, o);
    const float r = rsqrtf(ss * (1.f / D) + 1e-6f);
#pragma unroll
    for (int i = 0; i < 4; ++i) {
      const int c0 = lane * 4 + 256 * i;
      const f32x4 scv = *(const f32x4*)(p.mod + b * 6144 + sc_off + c0), shv = *(const f32x4*)(p.mod + b * 6144 + sh_off + c0);
      float y[4];
#pragma unroll
      for (int j = 0; j < 4; ++j) y[j] = (v[i][j] * r) * gv[i][j] * (1.f + scv[j]) + shv[j];
      u32x2 o; o.x = cvtpk(y[0], y[1]); o.y = cvtpk(y[2], y[3]);
      *(u32x2*)(outp + (size_t)row * D + c0) = o;
    }
  }
}

struct EpiStoreBf {
  bf16_t* O; long ld;
  template <int MT> __device__ __forceinline__ void operator()(const f32x4 (&acc)[MT][4], int mbase, int nbase, int fr, int fq) const {
    bf16_t* rowp = O + (size_t)(mbase + fr) * ld + nbase + fq * 4;
#pragma unroll
    for (int mt = 0; mt < MT; ++mt) {
#pragma unroll
      for (int nt = 0; nt < 4; ++nt) { const f32x4 v = acc[mt][nt]; u32x2 o; o.x = cvtpk(v[0], v[1]); o.y = cvtpk(v[2], v[3]);
        *(u32x2*)(rowp + nt * 16) = o; }
      rowp += 16 * ld;
      __builtin_amdgcn_sched_barrier(0); }
  }
};
__device__ __forceinline__ f32x4 ld_bf4(const bf16_t* q) { const u32x2 w = *(const u32x2*)q; f32x4 r; r[0] = __uint_as_float(w.x << 16); r[1] = __uint_as_float(w.x & 0xffff0000u); r[2] = __uint_as_float(w.y << 16); r[3] = __uint_as_float(w.y & 0xffff0000u); return r; }
struct EpiGlu {
  const bf16_t* yA; const float* b; bf16_t* z;
  template <int MT> __device__ __forceinline__ void operator()(const f32x4 (&acc)[MT][4], int mbase, int nbase, int fr, int fq) const {
#pragma unroll
    for (int mt = 0; mt < MT; ++mt) {
#pragma unroll
      for (int nt = 0; nt < 4; ++nt) { const int row = mbase + mt * 16 + fr, col = nbase + nt * 16 + fq * 4; const f32x4 v = acc[mt][nt];
        const f32x4 y = ld_bf4(yA + (size_t)row * S5W + col); const f32x4 bb = *(const f32x4*)(b + col);
        u32x2 o; o.x = cvtpk(y[0] * sigmoidf_(v[0] + bb[0]), y[1] * sigmoidf_(v[1] + bb[1])); o.y = cvtpk(y[2] * sigmoidf_(v[2] + bb[2]), y[3] * sigmoidf_(v[3] + bb[3]));
        *(u32x2*)(z + (size_t)row * S5W + col) = o; }
      __builtin_amdgcn_sched_barrier(0); }
  }
};
struct EpiOut {
  const float* x; const float* mod; float* x1;
  template <int MT> __device__ __forceinline__ void operator()(const f32x4 (&acc)[MT][4], int mbase, int nbase, int fr, int fq) const {
#pragma unroll
    for (int mt = 0; mt < MT; ++mt) {
#pragma unroll
      for (int nt = 0; nt < 4; ++nt) { const int row = mbase + mt * 16 + fr, col = nbase + nt * 16 + fq * 4, b = row / SEQ; const f32x4 v = acc[mt][nt];
        const f32x4 xv = *(const f32x4*)(x + (size_t)row * D + col), gg = *(const f32x4*)(mod + b * 6144 + 2 * D + col);
        f32x4 o; o[0] = xv[0] + gg[0] * v[0]; o[1] = xv[1] + gg[1] * v[1]; o[2] = xv[2] + gg[2] * v[2]; o[3] = xv[3] + gg[3] * v[3];
        *(f32x4*)(x1 + (size_t)row * D + col) = o; }
      __builtin_amdgcn_sched_barrier(0); }
  }
};

template <class Epi>
__device__ __forceinline__ void phase_gemm_dense(const bf16_t* A, long lda, const bf16_t* Bm, long ldb, int M, int N, int K, const Epi& epi, int bid, int nb, lds_ptr smem) {
  const int nMt = M / 128, nNt = N / 256, ntiles = nMt * nNt, rounds = (ntiles + nb - 1) / nb;
  const int lane = ltid() & 63, wid = ltid() >> 6, wm = wid >> 2, wn = wid & 3, fr = lane & 15, fq = lane >> 4;
  for (int r = 0; r < rounds; ++r) {
    int mt, nt; bool valid; tile_map(r, bid, nb, nMt, nNt, mt, nt, valid);
    if (!valid) continue;
    f32x4 acc[4][4];
    ALoadDense al{A + (size_t)mt * 128 * lda, lda};
    gemm_mainloop_glds(acc, al, Bm + nt * 256, ldb, K / 32, smem);
    epi.template operator()<4>(acc, mt * 128 + wm * 64, nt * 256 + wn * 64, fr, fq);
  }
}


template <class Epi>
__device__ __forceinline__ void phase_gemm_dense256(const bf16_t* A, long lda, const bf16_t* Bm, long ldb, int M, int N, int K, const Epi& epi, int bid, int nb, lds_ptr smem) {
  const int nMt = M / 256, nNt = N / 256, ntiles = nMt * nNt, rounds = (ntiles + nb - 1) / nb;
  const int lane = ltid() & 63, wid = ltid() >> 6, wm = wid >> 2, wn = wid & 3, fr = lane & 15, fq = lane >> 4;
  for (int r = 0; r < rounds; ++r) {
    int mt, nt; bool valid; tile_map(r, bid, nb, nMt, nNt, mt, nt, valid);
    if (!valid) continue;
    f32x4 acc[8][4];
    gemm_mainloop_glds256(acc, A + (size_t)mt * 256 * lda, lda, Bm + nt * 256, ldb, K / 32, smem);
    epi.template operator()<8>(acc, mt * 256 + wm * 128, nt * 256 + wn * 64, fr, fq);
  }
}


constexpr int ST_ROW = 528;
__device__ __forceinline__ void phase_gemm_dense256_bf16(const bf16_t* A, long lda, const bf16_t* Bm, long ldb, int M, int N, int K, bf16_t* O, long ldo, int bid, int nb, lds_ptr smem) {
  const int nMt = M / 256, nNt = N / 256, ntiles = nMt * nNt, rounds = (ntiles + nb - 1) / nb;
  for (int r = 0; r < rounds; ++r) {
    int mt, nt; bool valid; tile_map(r, bid, nb, nMt, nNt, mt, nt, valid);
    if (!valid) continue;
    f32x4 acc[8][4];
    gemm_mainloop_glds256(acc, A + (size_t)mt * 256 * lda, lda, Bm + nt * 256, ldb, K / 32, smem);
    const int t1 = ltid(), l1 = t1 & 63, w1 = t1 >> 6, wm = w1 >> 2;
    bf16_t* ob = O + (size_t)(mt * 256) * ldo + nt * 256 + (t1 & 31) * 8;
#pragma unroll
    for (int h = 0; h < 2; ++h) {
      __syncthreads();
      if (wm == h) {
#pragma unroll
        for (int i = 0; i < 8; ++i)
#pragma unroll
          for (int j = 0; j < 4; ++j) { const f32x4 v = acc[i][j]; u32x2 o; o.x = cvtpk(v[0], v[1]); o.y = cvtpk(v[2], v[3]);
            *(LAS u32x2*)(smem + (i * 16 + (l1 & 15)) * ST_ROW + ((w1 & 3) * 64 + j * 16 + (l1 >> 4) * 4) * 2) = o; }
      }
      __syncthreads();
#pragma unroll
      for (int ps = 0; ps < 8; ++ps) {
        const int row = ps * 16 + (t1 >> 5);
        *(u32x4*)(ob + (size_t)(h * 128 + row) * ldo) = *(LAS u32x4*)(smem + row * ST_ROW + (t1 & 31) * 16);
      }
    }
  }
}

__device__ __forceinline__ void gk_rows(PR p, int bid, int nb) {
  const int lane = ltid() & 63, wid = ltid() >> 6, fr = lane & 15, fq = lane >> 4;
  if (wid >= 4) return;
  for (int r0 = (bid * 4 + wid) * 16; r0 < T; r0 += nb * 64) {
    const bf16_t* ap = p.h1 + (size_t)(r0 + fr) * D + fq * 8;
    const bf16_t* bp = p.wgkT + (size_t)fr * D + fq * 8;
    f32x4 acc = {0.f, 0.f, 0.f, 0.f};
#pragma unroll 1
    for (int k0 = 0; k0 < 32; k0 += 8) {
      s16x8 a[8], b[8];
#pragma unroll
      for (int q = 0; q < 8; ++q) { a[q] = *(const s16x8*)(ap + (k0 + q) * 32); b[q] = *(const s16x8*)(bp + (k0 + q) * 32); }
#pragma unroll
      for (int q = 0; q < 8; ++q) acc = __builtin_amdgcn_mfma_f32_16x16x32_bf16(a[q], b[q], acc, 0, 0, 0);
    }
#pragma unroll
    for (int j = 0; j < 4; ++j) p.gkl[(size_t)(r0 + 4 * fq + j) * 16 + fr] = acc[j];
  }
}

__device__ __forceinline__ void phase_gemm_mixed(PR p, int bid, int nb, lds_ptr smem) {
  const int nMt = T / 128, nNt = D / 256, ntiles = nMt * nNt, rounds = (ntiles + nb - 1) / nb;
  const int lane = ltid() & 63, wid = ltid() >> 6, wm = wid >> 2, wn = wid & 3, fr = lane & 15, fq = lane >> 4;
  for (int r = 0; r < rounds; ++r) {
    int mt, nt; bool valid; tile_map(r, bid, nb, nMt, nNt, mt, nt, valid);
    if (!valid) continue;
    const int mbase = mt * 128 + wm * 64, nbase = nt * 256 + wn * 64;
    const bf16_t* gp = p.proj + (size_t)(mbase + fr) * LDP + nbase + fq * 4;
    u32x2 gte[4][4], pk[4][4];
#pragma unroll
    for (int i = 0; i < 4; ++i)
#pragma unroll
      for (int j = 0; j < 4; ++j) gte[i][j] = *(const u32x2*)(gp + (size_t)(i * 16) * LDP + OFF_GA + j * 16);
    f32x4 acc[4][4];
    { ALoadDense al{p.zA + (size_t)mt * 128 * S5W, S5W}; gemm_mainloop_glds(acc, al, p.wb_pa + nt * 256, D, S5W / 32, smem); }
#pragma unroll
    for (int i = 0; i < 4; ++i)
#pragma unroll
      for (int j = 0; j < 4; ++j) {
        const float g0 = __uint_as_float(gte[i][j].x << 16), g1 = __uint_as_float(gte[i][j].x & 0xffff0000u), g2 = __uint_as_float(gte[i][j].y << 16), g3 = __uint_as_float(gte[i][j].y & 0xffff0000u);
        pk[i][j].x = cvtpk(acc[i][j][0] * sigmoidf_(g0), acc[i][j][1] * sigmoidf_(g1)); pk[i][j].y = cvtpk(acc[i][j][2] * sigmoidf_(g2), acc[i][j][3] * sigmoidf_(g3)); }
#pragma unroll
    for (int i = 0; i < 4; ++i)
#pragma unroll
      for (int j = 0; j < 4; ++j) gte[i][j] = *(const u32x2*)(gp + (size_t)(i * 16) * LDP + OFF_GB + j * 16);
    { ALoadDense al{p.yB + (size_t)mt * 128 * GVAL, GVAL}; gemm_mainloop_glds(acc, al, p.wb_pb + nt * 256, D, GVAL / 32, smem); }
    bf16_t* op = p.mixed + (size_t)(mbase + fr) * D + nbase + fq * 4;
#pragma unroll
    for (int i = 0; i < 4; ++i)
#pragma unroll
      for (int j = 0; j < 4; ++j) {
        const float g0 = __uint_as_float(gte[i][j].x << 16), g1 = __uint_as_float(gte[i][j].x & 0xffff0000u), g2 = __uint_as_float(gte[i][j].y << 16), g3 = __uint_as_float(gte[i][j].y & 0xffff0000u);
        const float a0 = __uint_as_float(pk[i][j].x << 16), a1 = __uint_as_float(pk[i][j].x & 0xffff0000u), a2 = __uint_as_float(pk[i][j].y << 16), a3 = __uint_as_float(pk[i][j].y & 0xffff0000u);
        u32x2 o; o.x = cvtpk(a0 + sigmoidf_(g0) * acc[i][j][0], a1 + sigmoidf_(g1) * acc[i][j][1]); o.y = cvtpk(a2 + sigmoidf_(g2) * acc[i][j][2], a3 + sigmoidf_(g3) * acc[i][j][3]);
        *(u32x2*)(op + (size_t)(i * 16) * D + j * 16) = o; }
  }
}

__device__ __forceinline__ void phase_gemm_rs(PR p, int bid, int nb, lds_ptr smem) {
  const int nMt = T / 256, nNt = 3, ntiles = nMt * nNt, rounds = (ntiles + nb - 1) / nb;
  const int lane = ltid() & 63, wid = ltid() >> 6, wm = wid >> 2, wn = wid & 3, fr = lane & 15, fq = lane >> 4;
  for (int r = 0; r < rounds; ++r) {
    int mt, nt; bool valid; tile_map(r, bid, nb, nMt, nNt, mt, nt, valid);
    if (!valid) continue;
    f32x4 acc[8][4];
    gemm_mainloop_glds256(acc, p.h2 + (size_t)mt * 256 * D, D, p.wb_rs + nt * 256, 768, D / 32, smem);
    const int mbase = mt * 256 + wm * 128;
    if (nt == 0) {
#pragma unroll
      for (int i = 0; i < 8; ++i) {
#pragma unroll
        for (int j = 0; j < 4; ++j) *(f32x4*)(p.logits + (size_t)(mbase + i * 16 + fr) * NE + wn * 64 + j * 16 + fq * 4) = acc[i][j];
        __builtin_amdgcn_sched_barrier(0); }
    } else {
      const int h0 = (nt - 1) * 128 + wn * 32;
#pragma unroll
      for (int i = 0; i < 8; ++i) {
#pragma unroll
        for (int j = 0; j < 2; ++j) { const f32x4 gv = acc[i][j], uv = acc[i][j + 2];
          u32x2 o; o.x = cvtpk(siluf_(gv[0]) * uv[0], siluf_(gv[1]) * uv[1]); o.y = cvtpk(siluf_(gv[2]) * uv[2], siluf_(gv[3]) * uv[3]);
          *(u32x2*)(p.shH + (size_t)(mbase + i * 16 + fr) * SFF + h0 + j * 16 + fq * 4) = o; }
        __builtin_amdgcn_sched_barrier(0); }
    }
  }
}

constexpr int MOE_H_OFF = 2 * G_STAGE;
constexpr int MOE_TOK_OFF = MOE_H_OFF + 65536;
constexpr int SMEM_BYTES = 139264;
__device__ __forceinline__ void phase_moe(PR p, int bid, int nb, lds_ptr smem) {
  const int lane = ltid() & 63, wid = ltid() >> 6, wm = wid >> 2, wn = wid & 3, fr = lane & 15, fq = lane >> 4;
  LAS int* toks = (LAS int*)(smem + MOE_TOK_OFF);
  const lds_ptr Hs = smem + MOE_H_OFF;
  LAS int* qi = (LAS int*)(smem + MOE_TOK_OFF + 512);
  for (int sx = 0; sx < 8; ++sx) {
   const int x = (bid + sx) & 7;
   const int cnt = p.moe_cnt[x];
   for (;;) {
    __syncthreads();
    if (ltid() == 0) qi[0] = atomicAdd(&p.moe_ctr[x], 1);
    __syncthreads();
    const int qidx = qi[0];
    if (qidx >= cnt) break;
    const int blk = p.moe_list[x * NBLK128 + qidx];
    const int e = p.blk_exp[blk];
    if (ltid() < 128) toks[ltid()] = p.slot_tok[blk * 128 + ltid()];
    __syncthreads();
    const float* Wg = p.ew_gate + (size_t)e * D * EFF; const float* Wu = p.ew_up + (size_t)e * D * EFF; const float* Wd = p.ew_down + (size_t)e * EFF * D;
    for (int hp2 = 0; hp2 < 2 * MOE_REP_GU; ++hp2) { const int hp = hp2 & 1;
      f32x4 acc[4][4];
      ALoadGatherLds al2{p.h2, toks};
      BLoadGUR bl{Wg, (long)(Wu - Wg), EFF, hp * 128};
      gemm_mainloop_r3<false>(acc, al2, bl, D / 32, smem, smem);
#pragma unroll
      for (int i = 0; i < 4; ++i)
#pragma unroll
        for (int j = 0; j < 2; ++j) { const f32x4 gv = acc[i][j], uv = acc[i][j + 2]; const int row = wm * 64 + i * 16 + fr, hc = hp * 128 + wn * 32 + j * 16 + fq * 4;
          u32x2 o; o.x = cvtpk(siluf_(gv[0]) * uv[0], siluf_(gv[1]) * uv[1]); o.y = cvtpk(siluf_(gv[2]) * uv[2], siluf_(gv[3]) * uv[3]);
          *(LAS u32x2*)(Hs + (hc >> 5) * G_ASZ + a_off(row, (hc & 31) >> 3) + (hc & 7) * 2) = o; }
    }
    for (int np2 = 0; np2 < 4 * MOE_REP_DN; ++np2) { const int np = np2 & 3;
      f32x4 acc[4][4];
      ALoadDense al{nullptr, 0};
      BLoadF32R bl{Wd + np * 256, D};
      gemm_mainloop_r3<true>(acc, al, bl, EFF / 32, smem, Hs);
#pragma unroll
      for (int i = 0; i < 4; ++i) {
        const int rl = wm * 64 + i * 16 + fr;
        if (toks[rl] >= 0) {
#pragma unroll
          for (int j = 0; j < 4; ++j) { const f32x4 v = acc[i][j]; u32x2 o; o.x = cvtpk(v[0], v[1]); o.y = cvtpk(v[2], v[3]);
            *(u32x2*)(p.Y + (size_t)(blk * 128 + rl) * D + np * 256 + wn * 64 + j * 16 + fq * 4) = o; }
        }
      }
    }
   }
  }
}

struct BStreamGU { const float* Wg; long du; int hp0;
  __device__ __forceinline__ void load(BRaw& r, int s, int tid) const {
    const int hp = hp0 + (s >> 5), kbase = (s & 31) * 32;
    const int col = (tid & 63) * 4, w = col >> 6, xx = col & 63;
    const float* q = Wg + ((xx < 32) ? 0l : du) + (size_t)(kbase + (tid >> 6)) * EFF + hp * 128 + 32 * w + (xx & 31);
#pragma unroll
    for (int i = 0; i < 4; ++i) r.v[i] = *(const f32x4*)(q + (size_t)(8 * i) * EFF); } };
struct BStreamDown { const float* Wd; int np0;
  __device__ __forceinline__ void load(BRaw& r, int s, int tid) const {
    const int np = np0 + (s >> 3), kbase = (s & 7) * 32;
    const float* q = Wd + (size_t)(kbase + (tid >> 6)) * D + np * 256 + (tid & 63) * 4;
#pragma unroll
    for (int i = 0; i < 4; ++i) r.v[i] = *(const f32x4*)(q + (size_t)(8 * i) * D); } };
constexpr int PV_STAGE = 2 * G_ASZ + G_BSZ;
template <int SEG, int NSEG, class AL, class BL, class SE>
__device__ __forceinline__ void gemm_stream_pair(const AL& al, const BL& bl, lds_ptr stage, const SE& segend, bool has2) {
  constexpr int NS = SEG * NSEG;
  const int tid = ltid(), lane = tid & 63, wid = tid >> 6, wm = wid >> 2, wn = wid & 3, fr = lane & 15, fq = lane >> 4;
  const int ar = tid >> 2, ac = tid & 3;
  const bf16_t* aptr0 = al.rowptr(0, ar) + ac * 8;
  const bf16_t* aptr1 = al.rowptr(1, ar) + ac * 8;
  const int a_st = a_off(ar, ac);
  int b_st[4];
#pragma unroll
  for (int i = 0; i < 4; ++i) b_st[i] = 2 * G_ASZ + b_off((tid >> 6) + 8 * i, (tid & 63) >> 2) + (tid & 3) * 8;
  int a_rd[4];
#pragma unroll
  for (int mt = 0; mt < 4; ++mt) a_rd[mt] = a_off(wm * 64 + mt * 16 + fr, fq);
  int b_rd[4][2];
#pragma unroll
  for (int nt = 0; nt < 4; ++nt) {
    b_rd[nt][0] = 2 * G_ASZ + b_off(8 * fq + (fr >> 2), wn * 4 + nt) + (fr & 3) * 8;
    b_rd[nt][1] = 2 * G_ASZ + b_off(8 * fq + 4 + (fr >> 2), wn * 4 + nt) + (fr & 3) * 8;
  }
  f32x4 acc[2][4][4];
#pragma unroll
  for (int h = 0; h < 2; ++h)
#pragma unroll
    for (int mt = 0; mt < 4; ++mt)
#pragma unroll
      for (int nt = 0; nt < 4; ++nt) acc[h][mt][nt] = (f32x4){0.f, 0.f, 0.f, 0.f};
  u32x4 xa0, xb0, xa1, xb1;
  BRaw rb0, rb1;
#define P2_LOAD(XA, XB, RB, s_) do { XA = *(const u32x4*)(aptr0 + (size_t)((s_) % SEG) * 32); XB = *(const u32x4*)(aptr1 + (size_t)((s_) % SEG) * 32); bl.load(RB, (s_), tid); } while (0)
#define P2_STORE(XA, XB, RB, st_) do { const lds_ptr q_ = stage + (st_) * PV_STAGE; *(LAS u32x4*)(q_ + a_st) = XA; *(LAS u32x4*)(q_ + G_ASZ + a_st) = XB; \
    _Pragma("unroll") for (int i_ = 0; i_ < 4; ++i_) { u32x2 o_; o_.x = cvtpk(RB.v[i_][0], RB.v[i_][1]); o_.y = cvtpk(RB.v[i_][2], RB.v[i_][3]); *(LAS u32x2*)(q_ + b_st[i_]) = o_; } } while (0)
#define P2_COMPUTE(s_) do { const lds_ptr cur = stage + ((s_) & 1) * PV_STAGE; s16x8 bfr[4]; \
    _Pragma("unroll") for (int nt = 0; nt < 4; ++nt) { const s16x4 lo = tr_read(cur + b_rd[nt][0]), hi = tr_read(cur + b_rd[nt][1]); bfr[nt] = __builtin_shufflevector(lo, hi, 0, 1, 2, 3, 4, 5, 6, 7); } \
    _Pragma("unroll") for (int h = 0; h < 2; ++h) if (h == 0 || has2) { s16x8 af[4]; \
      _Pragma("unroll") for (int mt = 0; mt < 4; ++mt) af[mt] = *(LAS s16x8*)(cur + h * G_ASZ + a_rd[mt]); \
      _Pragma("unroll") for (int mt = 0; mt < 4; ++mt) _Pragma("unroll") for (int nt = 0; nt < 4; ++nt) acc[h][mt][nt] = __builtin_amdgcn_mfma_f32_16x16x32_bf16(bfr[nt], af[mt], acc[h][mt][nt], 0, 0, 0); } } while (0)
#define P2_SEGEND(s_) do { if (((s_) % SEG) == SEG - 1) { segend((s_) / SEG, acc); \
    _Pragma("unroll") for (int h = 0; h < 2; ++h) _Pragma("unroll") for (int mt = 0; mt < 4; ++mt) _Pragma("unroll") for (int nt = 0; nt < 4; ++nt) acc[h][mt][nt] = (f32x4){0.f, 0.f, 0.f, 0.f}; } } while (0)
#define P2_BODY(s_, XAN, XBN, RBN, XAW, XBW, RBW) do { const int sl_ = ((s_) + 2 < NS) ? (s_) + 2 : NS - 1; P2_LOAD(XAN, XBN, RBN, sl_); __builtin_amdgcn_sched_barrier(0); \
    P2_COMPUTE(s_); __builtin_amdgcn_sched_barrier(0); P2_SEGEND(s_); P2_STORE(XAW, XBW, RBW, ((s_) + 1) & 1); __syncthreads(); } while (0)
  P2_LOAD(xa0, xb0, rb0, 0);
  P2_LOAD(xa1, xb1, rb1, 1);
  __syncthreads();
  P2_STORE(xa0, xb0, rb0, 0);
  __syncthreads();
  for (int s = 0; s < NS; s += 2) {
    P2_BODY(s, xa0, xb0, rb0, xa1, xb1, rb1);
    P2_BODY(s + 1, xa1, xb1, rb1, xa0, xb0, rb0);
  }
#undef P2_LOAD
#undef P2_STORE
#undef P2_COMPUTE
#undef P2_SEGEND
#undef P2_BODY
}
struct APairGather { const bf16_t* A; LAS int* tk; __device__ __forceinline__ const bf16_t* rowptr(int h, int r) const { int t = tk[h * 128 + r]; t = t < 0 ? 0 : t; return A + (size_t)t * D; } };
struct APairDense { const bf16_t* A0; const bf16_t* A1; __device__ __forceinline__ const bf16_t* rowptr(int h, int r) const { return (h ? A1 : A0) + (size_t)r * EFF; } };

constexpr int PV_TOK = 2 * PV_STAGE;
constexpr int PV_Q = PV_TOK + 1024;
constexpr int PV_STG = 69632, PV_STG_ROW = 528;
template <int STG>
__device__ __forceinline__ void phase_moe_pair(PR p, int bid, int nb, lds_ptr smem) {
  LAS int* toks = (LAS int*)(smem + PV_TOK);
  LAS int* qi = (LAS int*)(smem + PV_Q);
  for (int sx = 0; sx < 8; ++sx) {
   const int x = ((int)((unsigned)__builtin_amdgcn_s_getreg((3 << 11) | 20) & 7u) + sx) & 7;
   const int cnt = 2 * p.moe_cnt[x];
   for (;;) {
    __syncthreads();
    if (ltid() == 0) qi[0] = atomicAdd(&p.moe_ctr[(STG - 1) * 8 + x], 1);
    __syncthreads();
    const int qidx = qi[0];
    if (qidx >= cnt) break;
    const int blk = p.moe_list[x * NBLK128 + (qidx >> 1)], sub = qidx & 1;
    const int e = p.blk_exp[blk];
    const bool has2 = (blk + 1 < NBLK128) && (p.blk_exp[blk + 1] == e);
    const int blk2 = has2 ? blk + 1 : blk;
    { const int t = ltid(); if (t < 256) toks[t] = (t < 128) ? p.slot_tok[blk * 128 + t] : (has2 ? p.slot_tok[blk2 * 128 + (t - 128)] : -1); }
    __syncthreads();
    const int lane = ltid() & 63, wid = ltid() >> 6, wm = wid >> 2, wn = wid & 3, fr = lane & 15, fq = lane >> 4;
    if (STG == 1) {
      const float* Wg = p.ew_gate + (size_t)e * D * EFF; const float* Wu = p.ew_up + (size_t)e * D * EFF;
      APairGather al{p.h2, toks};
      BStreamGU bl{Wg, (long)(Wu - Wg), sub};
      auto segH = [&](int hseg, const f32x4 (&acc)[2][4][4]) { const int hp = sub + hseg;
        const int t1 = ltid(), l1 = t1 & 63, w1 = t1 >> 6;
        const lds_ptr stg = smem + PV_STG;
#pragma unroll
        for (int h = 0; h < 2; ++h) {
          if (h == 1 && !has2) continue;
#pragma unroll
          for (int i = 0; i < 4; ++i)
#pragma unroll
            for (int j = 0; j < 2; ++j) { const f32x4 gv = acc[h][i][j], uv = acc[h][i][j + 2];
              u32x2 o; o.x = cvtpk(siluf_(gv[0]) * uv[0], siluf_(gv[1]) * uv[1]); o.y = cvtpk(siluf_(gv[2]) * uv[2], siluf_(gv[3]) * uv[3]);
              *(LAS u32x2*)(stg + ((w1 >> 2) * 64 + i * 16 + (l1 & 15)) * 272 + ((w1 & 3) * 32 + j * 16 + (l1 >> 4) * 4) * 2) = o; }
          __syncthreads();
          bf16_t* hb = p.Hbuf + (size_t)((h ? blk2 : blk) * 128) * EFF + hp * 128 + (t1 & 15) * 8;
#pragma unroll
          for (int ps = 0; ps < 4; ++ps) {
            const int row = ps * 32 + (t1 >> 4);
            *(u32x4*)(hb + (size_t)row * EFF) = *(LAS u32x4*)(stg + row * 272 + (t1 & 15) * 16);
          }
          __syncthreads();
        }
      };
      gemm_stream_pair<32, 1>(al, bl, smem, segH, has2);
    } else {
      const float* Wd = p.ew_down + (size_t)e * EFF * D;
      APairDense al{p.Hbuf + (size_t)blk * 128 * EFF, p.Hbuf + (size_t)blk2 * 128 * EFF};
      BStreamDown bl{Wd, 2 * sub};
      auto segY = [&](int nseg, const f32x4 (&acc)[2][4][4]) { const int np = 2 * sub + nseg;
        const int t1 = ltid(), l1 = t1 & 63, w1 = t1 >> 6;
        const lds_ptr stg = smem + PV_STG;
#pragma unroll
        for (int h = 0; h < 2; ++h) {
          if (h == 1 && !has2) continue;
#pragma unroll
          for (int i = 0; i < 4; ++i)
#pragma unroll
            for (int j = 0; j < 4; ++j) { const f32x4 v = acc[h][i][j]; u32x2 o; o.x = cvtpk(v[0], v[1]); o.y = cvtpk(v[2], v[3]);
              *(LAS u32x2*)(stg + ((w1 >> 2) * 64 + i * 16 + (l1 & 15)) * PV_STG_ROW + ((w1 & 3) * 64 + j * 16 + (l1 >> 4) * 4) * 2) = o; }
          __syncthreads();
          bf16_t* yb = p.Y + (size_t)((h ? blk2 : blk) * 128) * D + np * 256 + (t1 & 31) * 8;
#pragma unroll
          for (int ps = 0; ps < 8; ++ps) {
            const int row = ps * 16 + (t1 >> 5);
            const u32x4 v = *(LAS u32x4*)(stg + row * PV_STG_ROW + (t1 & 31) * 16);
            if (toks[h * 128 + row] >= 0) *(u32x4*)(yb + (size_t)row * D) = v;
          }
          __syncthreads();
        }
      };
      gemm_stream_pair<8, 2>(al, bl, smem, segY, has2);
    }
   }
  }
}

__device__ __forceinline__ void wave_sync() { asm volatile("s_waitcnt lgkmcnt(0)" ::: "memory"); }
constexpr int S5_BU_STRIDE = 132;
constexpr int S5_S_STRIDE = 272;
constexpr int S5_WAVE_LDS = 16 * S5_BU_STRIDE * 4 + 16 * S5_S_STRIDE;
template <bool FINAL>
__device__ __forceinline__ void s5_item(PR p, int b, int c, int g, lds_ptr wl) {
  const int lane = ltid() & 63, fr = lane & 15, fq = lane >> 4;
  LAS float* bu = (LAS float*)wl;
  const lds_ptr Sb = wl + 16 * S5_BU_STRIDE * 4;
  const size_t t0 = (size_t)b * SEQ + (size_t)c * 64;
  const s16x8 zero8 = {0, 0, 0, 0, 0, 0, 0, 0};
  s16x8 bfr[8];
#pragma unroll
  for (int nt = 0; nt < 8; ++nt) { const s16x8 x = *(const s16x8*)(p.bbarT + ((size_t)(g * 128 + nt * 16 + fr) * 16 + (fq & 1) * 8)); bfr[nt] = (fq < 2) ? x : zero8; }
  const float are = p.abar[(g * 64 + lane) * 2], aim = p.abar[(g * 64 + lane) * 2 + 1];
  const size_t sidx = (((size_t)b * 32 + c) * S5G + g) * 64 + lane;
  float sre = 0.f, sim = 0.f;
  s16x8 cfr[4];
  f32x4 dsk = {0.f, 0.f, 0.f, 0.f};
  if (FINAL) {
    sre = p.s5Sin[sidx * 2]; sim = p.s5Sin[sidx * 2 + 1];
#pragma unroll
    for (int ks = 0; ks < 4; ++ks) cfr[ks] = *(const s16x8*)(p.cmT + ((size_t)(g * 16 + fr) * 128 + ks * 32 + fq * 8));
    dsk = *(const f32x4*)(p.s5_d + g * 16 + fq * 4);
  }
  s16x8 uxs[4]; u32x2 u4s[4];
#pragma unroll
  for (int mt = 0; mt < 4; ++mt) {
    const bf16_t* urow = p.proj + (t0 + mt * 16 + fr) * LDP + OFF_U + g * 16;
    uxs[mt] = *(const s16x8*)(urow + (fq & 1) * 8);
    if (FINAL) u4s[mt] = *(const u32x2*)(urow + fq * 4);
  }
#pragma unroll
  for (int mt = 0; mt < 4; ++mt) {
    const s16x8 ufr = (fq < 2) ? uxs[mt] : zero8;
#pragma unroll
    for (int nt = 0; nt < 8; ++nt) {
      const f32x4 z = {0.f, 0.f, 0.f, 0.f};
      const f32x4 acc = __builtin_amdgcn_mfma_f32_16x16x32_bf16(bfr[nt], ufr, z, 0, 0, 0);
      *(LAS f32x4*)(bu + fr * S5_BU_STRIDE + nt * 16 + 4 * fq) = acc;
    }
    wave_sync();
    f32x2 bv[16];
#pragma unroll
    for (int l = 0; l < 16; ++l) bv[l] = *(LAS f32x2*)(bu + l * S5_BU_STRIDE + 2 * lane);
#pragma unroll
    for (int l = 0; l < 16; ++l) {
      const float nr = are * sre - aim * sim + bv[l].x, ni = are * sim + aim * sre + bv[l].y;
      sre = nr; sim = ni;
      if (FINAL) *(LAS unsigned*)(Sb + l * S5_S_STRIDE + lane * 4) = cvtpk(sre, sim);
    }
    if (FINAL) {
      wave_sync();
      f32x4 y = {0.f, 0.f, 0.f, 0.f};
#pragma unroll
      for (int ks = 0; ks < 4; ++ks) {
        const s16x8 sfr = *(LAS s16x8*)(Sb + fr * S5_S_STRIDE + (ks * 32 + fq * 8) * 2);
        y = __builtin_amdgcn_mfma_f32_16x16x32_bf16(cfr[ks], sfr, y, 0, 0, 0);
      }
      const f32x4 u4 = {__builtin_bit_cast(float, u4s[mt].x << 16), __builtin_bit_cast(float, u4s[mt].x & 0xffff0000u), __builtin_bit_cast(float, u4s[mt].y << 16), __builtin_bit_cast(float, u4s[mt].y & 0xffff0000u)};
      u32x2 o; o.x = cvtpk(geluf_(y[0] + dsk[0] * u4[0]), geluf_(y[1] + dsk[1] * u4[1])); o.y = cvtpk(geluf_(y[2] + dsk[2] * u4[2]), geluf_(y[3] + dsk[3] * u4[3]));
      *(u32x2*)(p.yA + (t0 + mt * 16 + fr) * S5W + g * 16 + fq * 4) = o;
    } else wave_sync();
  }
  if (!FINAL) { p.s5E[sidx * 2] = sre; p.s5E[sidx * 2 + 1] = sim; }
}
template <bool FINAL>
__device__ __forceinline__ void s5_block_item(PR p, int item, lds_ptr smem) {
  const int wid = ltid() >> 6;
  const int go = item & 3, c = (item >> 2) & 31, b = item >> 7;
  s5_item<FINAL>(p, b, c, go * 8 + wid, smem + wid * S5_WAVE_LDS);
}

template <bool FINAL>
__device__ __forceinline__ void s5_wave_phase(PR p, int bid, int nb, lds_ptr smem) {
  const int lane = ltid() & 63, fr = lane & 15, fq = lane >> 4, wid = ltid() >> 6;
  const int g = (bid & 3) * 8 + wid;
  const lds_ptr wl = smem + wid * S5_WAVE_LDS;
  LAS float* bu = (LAS float*)wl;
  const lds_ptr Sb = wl + 16 * S5_BU_STRIDE * 4;
  const s16x8 zero8 = {0, 0, 0, 0, 0, 0, 0, 0};
  s16x8 bfr[8];
#pragma unroll
  for (int nt = 0; nt < 8; ++nt) { const s16x8 x = *(const s16x8*)(p.bbarT + ((size_t)(g * 128 + nt * 16 + fr) * 16 + (fq & 1) * 8)); bfr[nt] = (fq < 2) ? x : zero8; }
  const float are = p.abar[(g * 64 + lane) * 2], aim = p.abar[(g * 64 + lane) * 2 + 1];
  s16x8 cfr[4];
  f32x4 dsk = {0.f, 0.f, 0.f, 0.f};
  if (FINAL) {
#pragma unroll
    for (int ks = 0; ks < 4; ++ks) cfr[ks] = *(const s16x8*)(p.cmT + ((size_t)(g * 16 + fr) * 128 + ks * 32 + fq * 8));
    dsk = *(const f32x4*)(p.s5_d + g * 16 + fq * 4);
  }
  s16x8 nux[4]; u32x2 nu4[4]; f32x2 nsin = {0.f, 0.f};
#define S5_ISSUE(IDX) do { const int c_ = ((IDX) >> 2) & 31, b_ = (IDX) >> 7; const size_t t0_ = (size_t)b_ * SEQ + (size_t)c_ * 64; \
    _Pragma("unroll") for (int mt = 0; mt < 4; ++mt) { const bf16_t* urow = p.proj + (t0_ + mt * 16 + fr) * LDP + OFF_U + g * 16; \
      nux[mt] = *(const s16x8*)(urow + (fq & 1) * 8); if (FINAL) nu4[mt] = *(const u32x2*)(urow + fq * 4); } \
    if (FINAL) nsin = *(const f32x2*)(p.s5Sin + ((((size_t)b_ * 32 + c_) * S5G + g) * 64 + lane) * 2); } while (0)
  S5_ISSUE(bid);
#pragma unroll 1
  for (int idx = bid; idx < 1024; idx += nb) {
    const int c = (idx >> 2) & 31, b = idx >> 7;
    const size_t t0 = (size_t)b * SEQ + (size_t)c * 64;
    s16x8 uxs[4]; u32x2 u4s[4];
#pragma unroll
    for (int mt = 0; mt < 4; ++mt) { uxs[mt] = nux[mt]; u4s[mt] = nu4[mt]; }
    float sre = nsin.x, sim = nsin.y;
    __builtin_amdgcn_sched_barrier(0);
    { const int nidx = (idx + nb < 1024) ? idx + nb : idx; S5_ISSUE(nidx); }
    __builtin_amdgcn_sched_barrier(0);
#pragma unroll
    for (int mt = 0; mt < 4; ++mt) {
      const s16x8 ufr = (fq < 2) ? uxs[mt] : zero8;
#pragma unroll
      for (int nt = 0; nt < 8; ++nt) {
        const f32x4 z = {0.f, 0.f, 0.f, 0.f};
        const f32x4 acc = __builtin_amdgcn_mfma_f32_16x16x32_bf16(bfr[nt], ufr, z, 0, 0, 0);
        *(LAS f32x4*)(bu + fr * S5_BU_STRIDE + nt * 16 + 4 * fq) = acc;
      }
      wave_sync();
      f32x2 bv[16];
#pragma unroll
      for (int l = 0; l < 16; ++l) bv[l] = *(LAS f32x2*)(bu + l * S5_BU_STRIDE + 2 * lane);
#pragma unroll
      for (int l = 0; l < 16; ++l) {
        const float nr = are * sre - aim * sim + bv[l].x, ni = are * sim + aim * sre + bv[l].y;
        sre = nr; sim = ni;
        if (FINAL) *(LAS unsigned*)(Sb + l * S5_S_STRIDE + lane * 4) = cvtpk(sre, sim);
      }
      if (FINAL) {
        wave_sync();
        f32x4 y = {0.f, 0.f, 0.f, 0.f};
#pragma unroll
        for (int ks = 0; ks < 4; ++ks) {
          const s16x8 sfr = *(LAS s16x8*)(Sb + fr * S5_S_STRIDE + (ks * 32 + fq * 8) * 2);
          y = __builtin_amdgcn_mfma_f32_16x16x32_bf16(cfr[ks], sfr, y, 0, 0, 0);
        }
        const f32x4 u4 = {__builtin_bit_cast(float, u4s[mt].x << 16), __builtin_bit_cast(float, u4s[mt].x & 0xffff0000u), __builtin_bit_cast(float, u4s[mt].y << 16), __builtin_bit_cast(float, u4s[mt].y & 0xffff0000u)};
        u32x2 o; o.x = cvtpk(geluf_(y[0] + dsk[0] * u4[0]), geluf_(y[1] + dsk[1] * u4[1])); o.y = cvtpk(geluf_(y[2] + dsk[2] * u4[2]), geluf_(y[3] + dsk[3] * u4[3]));
        *(u32x2*)(p.yA + (t0 + mt * 16 + fr) * S5W + g * 16 + fq * 4) = o;
      } else wave_sync();
    }
    if (!FINAL) { const size_t sidx = (((size_t)b * 32 + c) * S5G + g) * 64 + lane; *(f32x2*)(p.s5E + sidx * 2) = (f32x2){sre, sim}; }
  }
#undef S5_ISSUE
}

constexpr int GL_QD = 0, GL_KE = 8192, GL_V = 16384, GL_SIN = 32768, GL_GL = 49152, GL_W2 = 53248, GL_TOT = 57344, GL_B2 = 58368, GL_ITEM = 58624;
__device__ __forceinline__ int rowrd_off(int r, int c) { return r * 128 + ((c ^ ((r >> 1) & 7)) << 4); }
__device__ __forceinline__ int tr128_off(int r, int ch) { return r * 128 + ((ch ^ (((r >> 1) & 1) | (((r >> 3) & 1) << 1))) << 5); }
__device__ __forceinline__ int tr256_off(int r, int ch) { return r * 256 + ((ch ^ ((r & 3) | (((r >> 3) & 1) << 2))) << 5); }

__device__ __forceinline__ void gla_front(lds_ptr il, int t, const f32x4& gklv, const float (&wv)[16], float bias, float (&bl)[16], float& blast) {
  LAS float* gl = (LAS float*)(il + GL_GL); LAS float* tot = (LAS float*)(il + GL_TOT);
  __syncthreads();
  *(LAS f32x4*)(gl + t * 4) = gklv;
  __syncthreads();
  const int d = t & 63, part = t >> 6;
  float run = 0.f;
#pragma unroll
  for (int ii = 0; ii < 16; ++ii) {
    const int i = part * 16 + ii;
    float gk = bias;
#pragma unroll
    for (int q = 0; q < 4; ++q) { const f32x4 gv = *(LAS f32x4*)(gl + i * 16 + q * 4); gk += gv[0] * wv[q * 4] + gv[1] * wv[q * 4 + 1] + gv[2] * wv[q * 4 + 2] + gv[3] * wv[q * 4 + 3]; }
    run += logsigmoidf_(gk) * (1.f / 16.f);
    bl[ii] = run;
  }
  tot[part * 64 + d] = run;
  __syncthreads();
  float offs = 0.f, all = 0.f;
#pragma unroll
  for (int q = 0; q < 4; ++q) { const float v = tot[q * 64 + d]; all += v; offs += (q < part) ? v : 0.f; }
#pragma unroll
  for (int ii = 0; ii < 16; ++ii) bl[ii] += offs;
  blast = all;
}

__device__ __forceinline__ void gla_pass1(PR p, int item, lds_ptr smem, const float (&wv)[16], float bias) {
  const int half = ltid() >> 8, t = ltid() & 255, lane = t & 63, w = t >> 6, fr = lane & 15, fq = lane >> 4;
  const int it = item * 2 + half, c = it & 31, h = (it >> 5) & 3, b = it >> 7;
  const lds_ptr il = smem + half * GL_ITEM;
  const size_t t0 = (size_t)b * SEQ + (size_t)c * 64;
  float bl[16], blast;
  const f32x4 gklv = *(const f32x4*)(p.gkl + t0 * 16 + t * 4);
  bf16_t kraw[16]; u32x4 vraw[4];
#pragma unroll
  for (int ii = 0; ii < 16; ++ii) kraw[ii] = p.proj[(t0 + (t >> 6) * 16 + ii) * LDP + OFF_K + h * 64 + (t & 63)];
#pragma unroll
  for (int q = 0; q < 4; ++q) { const int pc = t + 256 * q, r = pc >> 4, c8 = pc & 15; vraw[q] = *(const u32x4*)(p.proj + (t0 + r) * LDP + OFF_V + h * 128 + c8 * 8); }
  gla_front(il, t, gklv, wv, bias, bl, blast);
  {
    const int d = t & 63, part = t >> 6;
#pragma unroll
    for (int ii = 0; ii < 16; ++ii) {
      const int i = part * 16 + ii;
      const float kv = bf2f(kraw[ii]);
      *(LAS bf16_t*)(il + GL_KE + tr128_off(i, d >> 4) + (d & 15) * 2) = f2bf(kv * __expf(blast - bl[ii]));
    }
    if (part == 0) p.glaDec[(size_t)it * 64 + d] = __expf(blast);
#pragma unroll
    for (int q = 0; q < 4; ++q) { const int pc = t + 256 * q, r = pc >> 4, c8 = pc & 15;
      *(LAS u32x4*)(il + GL_V + tr256_off(r, c8 >> 1) + (c8 & 1) * 16) = vraw[q]; }
  }
  __syncthreads();
  f32x4 acc[8];
#pragma unroll
  for (int et = 0; et < 8; ++et) acc[et] = (f32x4){0.f, 0.f, 0.f, 0.f};
#pragma unroll
  for (int ks = 0; ks < 2; ++ks) {
    const int r0 = 32 * ks + 8 * fq + (fr >> 2);
    const s16x4 klo = tr_read(il + GL_KE + tr128_off(r0, w) + (fr & 3) * 8), khi = tr_read(il + GL_KE + tr128_off(r0 + 4, w) + (fr & 3) * 8);
    const s16x8 kf = __builtin_shufflevector(klo, khi, 0, 1, 2, 3, 4, 5, 6, 7);
#pragma unroll
    for (int et = 0; et < 8; ++et) {
      const s16x4 vlo = tr_read(il + GL_V + tr256_off(r0, et) + (fr & 3) * 8), vhi = tr_read(il + GL_V + tr256_off(r0 + 4, et) + (fr & 3) * 8);
      const s16x8 vf = __builtin_shufflevector(vlo, vhi, 0, 1, 2, 3, 4, 5, 6, 7);
      acc[et] = __builtin_amdgcn_mfma_f32_16x16x32_bf16(vf, kf, acc[et], 0, 0, 0);
    }
  }
#pragma unroll
  for (int et = 0; et < 8; ++et) *(f32x4*)(p.glaKV + ((size_t)it * 64 + 16 * w + fr) * 128 + et * 16 + fq * 4) = acc[et];
}

__device__ __forceinline__ void gla_pass2(PR p, int item, lds_ptr smem, const float (&wv)[16], float bias) {
  const int half = ltid() >> 8, t = ltid() & 255, lane = t & 63, w = t >> 6, fr = lane & 15, fq = lane >> 4;
  const int it = item * 2 + half, c = it & 31, h = (it >> 5) & 3, b = it >> 7;
  const lds_ptr il = smem + half * GL_ITEM;
  const size_t t0 = (size_t)b * SEQ + (size_t)c * 64;
  float bl[16], blast;
  const f32x4 gklv = *(const f32x4*)(p.gkl + t0 * 16 + t * 4);
  bf16_t qraw[16], kraw[16]; u32x4 vraw[4], sraw[4]; u32x2 rgraw[8];
#pragma unroll
  for (int ii = 0; ii < 16; ++ii) { const bf16_t* pr = p.proj + (t0 + (t >> 6) * 16 + ii) * LDP + h * 64 + (t & 63); qraw[ii] = pr[OFF_Q]; kraw[ii] = pr[OFF_K]; }
#pragma unroll
  for (int q = 0; q < 4; ++q) { const int pc = t + 256 * q, r = pc >> 4, c8 = pc & 15;
    vraw[q] = *(const u32x4*)(p.proj + (t0 + r) * LDP + OFF_V + h * 128 + c8 * 8);
    sraw[q] = *(const u32x4*)(p.glaSin + ((size_t)it * 64 + r) * 128 + c8 * 8); }
  const size_t trow = t0 + 16 * w + fr;
#pragma unroll
  for (int et = 0; et < 8; ++et) rgraw[et] = *(const u32x2*)(p.proj + trow * LDP + OFF_R + h * 128 + et * 16 + fq * 4);
  gla_front(il, t, gklv, wv, bias, bl, blast);
  {
    const int d = t & 63, part = t >> 6;
#pragma unroll
    for (int ii = 0; ii < 16; ++ii) {
      const int i = part * 16 + ii;
      const float qv = bf2f(qraw[ii]) * 0.125f, kv = bf2f(kraw[ii]);
      const int o = rowrd_off(i, d >> 3) + (d & 7) * 2;
      *(LAS bf16_t*)(il + GL_QD + o) = f2bf(qv * __expf(bl[ii]));
      *(LAS bf16_t*)(il + GL_KE + o) = f2bf(kv * __expf(-bl[ii]));
    }
#pragma unroll
    for (int q = 0; q < 4; ++q) { const int pc = t + 256 * q, r = pc >> 4, c8 = pc & 15;
      *(LAS u32x4*)(il + GL_V + tr256_off(r, c8 >> 1) + (c8 & 1) * 16) = vraw[q];
      *(LAS u32x4*)(il + GL_SIN + tr256_off(r, c8 >> 1) + (c8 & 1) * 16) = sraw[q]; }
  }
  __syncthreads();
  s16x8 qf[2];
#pragma unroll
  for (int ks = 0; ks < 2; ++ks) qf[ks] = *(LAS s16x8*)(il + GL_QD + rowrd_off(16 * w + fr, ks * 4 + fq));
  f32x4 st[4];
#pragma unroll
  for (int jt = 0; jt < 4; ++jt) {
    st[jt] = (f32x4){0.f, 0.f, 0.f, 0.f};
    if (jt <= w) {
#pragma unroll
      for (int ks = 0; ks < 2; ++ks) {
        const s16x8 kf = *(LAS s16x8*)(il + GL_KE + rowrd_off(16 * jt + fr, ks * 4 + fq));
        st[jt] = __builtin_amdgcn_mfma_f32_16x16x32_bf16(kf, qf[ks], st[jt], 0, 0, 0);
      }
      if (jt == w) {
#pragma unroll
        for (int r = 0; r < 4; ++r) st[jt][r] = (4 * fq + r <= fr) ? st[jt][r] : 0.f;
      }
    }
  }
  f32x4 acc[8];
#pragma unroll
  for (int et = 0; et < 8; ++et) acc[et] = (f32x4){0.f, 0.f, 0.f, 0.f};
#pragma unroll
  for (int u = 0; u < 2; ++u) {
    if (2 * u <= w) {
      u32x4 pk; pk.x = cvtpk(st[2 * u][0], st[2 * u][1]); pk.y = cvtpk(st[2 * u][2], st[2 * u][3]); pk.z = cvtpk(st[2 * u + 1][0], st[2 * u + 1][1]); pk.w = cvtpk(st[2 * u + 1][2], st[2 * u + 1][3]);
      const s16x8 pf = __builtin_bit_cast(s16x8, pk);
      const int r0 = 32 * u + 4 * fq + (fr >> 2);
#pragma unroll
      for (int et = 0; et < 8; ++et) {
        const s16x4 vlo = tr_read(il + GL_V + tr256_off(r0, et) + (fr & 3) * 8), vhi = tr_read(il + GL_V + tr256_off(r0 + 16, et) + (fr & 3) * 8);
        const s16x8 vf = __builtin_shufflevector(vlo, vhi, 0, 1, 2, 3, 4, 5, 6, 7);
        acc[et] = __builtin_amdgcn_mfma_f32_16x16x32_bf16(vf, pf, acc[et], 0, 0, 0);
      }
    }
  }
#pragma unroll
  for (int ks = 0; ks < 2; ++ks) {
    const int r0 = 32 * ks + 8 * fq + (fr >> 2);
#pragma unroll
    for (int et = 0; et < 8; ++et) {
      const s16x4 slo = tr_read(il + GL_SIN + tr256_off(r0, et) + (fr & 3) * 8), shi = tr_read(il + GL_SIN + tr256_off(r0 + 4, et) + (fr & 3) * 8);
      const s16x8 sf = __builtin_shufflevector(slo, shi, 0, 1, 2, 3, 4, 5, 6, 7);
      acc[et] = __builtin_amdgcn_mfma_f32_16x16x32_bf16(sf, qf[ks], acc[et], 0, 0, 0);
    }
  }
  float ss = 0.f;
#pragma unroll
  for (int et = 0; et < 8; ++et) ss += acc[et][0] * acc[et][0] + acc[et][1] * acc[et][1] + acc[et][2] * acc[et][2] + acc[et][3] * acc[et][3];
  ss += __shfl_xor(ss, 16); ss += __shfl_xor(ss, 32);
  const float rn = rsqrtf(ss * (1.f / 128.f) + 1e-6f);
#pragma unroll
  for (int et = 0; et < 8; ++et) {
    const int e = et * 16 + fq * 4;
    const f32x4 ng = *(const f32x4*)(p.gla_norm_g + e);
    const f32x4 rg = {__builtin_bit_cast(float, rgraw[et].x << 16), __builtin_bit_cast(float, rgraw[et].x & 0xffff0000u), __builtin_bit_cast(float, rgraw[et].y << 16), __builtin_bit_cast(float, rgraw[et].y & 0xffff0000u)};
    u32x2 o; o.x = cvtpk(acc[et][0] * rn * ng[0] * siluf_(rg[0]), acc[et][1] * rn * ng[1] * siluf_(rg[1])); o.y = cvtpk(acc[et][2] * rn * ng[2] * siluf_(rg[2]), acc[et][3] * rn * ng[3] * siluf_(rg[3]));
    *(u32x2*)(p.yB + trow * GVAL + h * 128 + e) = o;
  }
}

#define GLA_LOAD_WV(H) do { const int d_ = ltid() & 63; _Pragma("unroll") for (int r_ = 0; r_ < 16; ++r_) wv[r_] = p.w_gk2[r_ * GKEY + (H) * 64 + d_]; bias = p.b_gk2[(H) * 64 + d_]; } while (0)
__device__ __forceinline__ void phase_mix_local(PR p, int bid, int nb, lds_ptr smem, int which) {
  if (which & 1) { __syncthreads(); s5_wave_phase<false>(p, bid, nb, smem); }
  if (which & 2) {
    float wv[16], bias = 0.f; int hprev = -1;
    for (int item = bid; item < 512; item += nb) {
      const int h = ((item * 2 + (ltid() >> 8)) >> 5) & 3;
      if (h != hprev) { GLA_LOAD_WV(h); hprev = h; }
      gla_pass1(p, item, smem, wv, bias);
    }
  }
}
__device__ __forceinline__ void phase_mix_carry(PR p, int bid, int nb, int which) {
  const int wave = __builtin_amdgcn_readfirstlane(ltid() >> 6), ln = ltid() & 63;
  if (which & 1) {
    for (int j = bid; j < NB * S5G; j += nb) if (wave == 7) {
      const int g = j & 31, b = j >> 5;
      const float2 a = *(const float2*)(p.apow64 + (g * 64 + ln) * 2);
      float2 e[32];
#pragma unroll
      for (int c = 0; c < 32; ++c) e[c] = *(const float2*)(p.s5E + ((((size_t)b * 32 + c) * S5G + g) * 64 + ln) * 2);
      float sre = 0.f, sim = 0.f;
#pragma unroll
      for (int c = 0; c < 32; ++c) {
        *(float2*)(p.s5Sin + ((((size_t)b * 32 + c) * S5G + g) * 64 + ln) * 2) = make_float2(sre, sim);
        const float nr = a.x * sre - a.y * sim + e[c].x, ni = a.x * sim + a.y * sre + e[c].y;
        sre = nr; sim = ni;
      }
    }
  }
  if (which & 2) {
    for (int r = bid * 8 + wave; r < NB * GH * 64; r += nb * 8) {
      const int d = r & 63, bh = r >> 6;
      float2 kv[32]; float dec[32];
#pragma unroll
      for (int c = 0; c < 32; ++c) {
        const size_t it = (size_t)bh * 32 + c;
        kv[c] = *(const float2*)(p.glaKV + (it * 64 + d) * 128 + 2 * ln);
        dec[c] = p.glaDec[it * 64 + d];
      }
      float S0 = 0.f, S1 = 0.f;
#pragma unroll
      for (int c = 0; c < 32; ++c) {
        const size_t it = (size_t)bh * 32 + c;
        *(uint32_t*)(p.glaSin + (it * 64 + d) * 128 + 2 * ln) = cvtpk(S0, S1);
        S0 = dec[c] * S0 + kv[c].x; S1 = dec[c] * S1 + kv[c].y;
      }
    }
  }
}
__device__ __forceinline__ void phase_mix_final(PR p, int bid, int nb, lds_ptr smem, int which) {
  if (which & 1) { __syncthreads(); s5_wave_phase<true>(p, bid, nb, smem); }
  if (which & 2) {
    float wv[16], bias = 0.f; int hprev = -1;
    for (int item = bid; item < 512; item += nb) {
      const int h = ((item * 2 + (ltid() >> 8)) >> 5) & 3;
      if (h != hprev) { GLA_LOAD_WV(h); hprev = h; }
      gla_pass2(p, item, smem, wv, bias);
    }
  }
}

__device__ __forceinline__ void phase_route(PR p, int bid, int nb) {
  const int lane = ltid() & 63, wid = ltid() >> 6;
  const f32x4 bias = *(const f32x4*)(p.router_bias + lane * 4);
  for (int t = bid * 8 + wid; t < T; t += nb * 8) {
    const f32x4 lg = *(const f32x4*)(p.logits + (size_t)t * NE + lane * 4);
    float sc[4], v[4];
#pragma unroll
    for (int j = 0; j < 4; ++j) { sc[j] = sigmoidf_(lg[j]); v[j] = sc[j] + bias[j]; }
    float m1 = fmaxf(v[0], v[1]), m2 = fminf(v[0], v[1]);
#pragma unroll
    for (int j = 2; j < 4; ++j) { const float nm1 = fmaxf(m1, v[j]); m2 = fmaxf(fminf(m1, v[j]), m2); m1 = nm1; }
#pragma unroll
    for (int o = 1; o < 8; o <<= 1) { const float o1 = __shfl_xor(m1, o), o2 = __shfl_xor(m2, o); const float nm1 = fmaxf(m1, o1); m2 = fmaxf(fminf(m1, o1), fmaxf(m2, o2)); m1 = nm1; }
    const float gs = m1 + m2;
    const int grp = lane >> 3;
    int rank = 0;
#pragma unroll
    for (int g2 = 0; g2 < 8; ++g2) { const float og = __shfl(gs, g2 * 8); rank += (og > gs || (og == gs && g2 < grp)) ? 1 : 0; }
    const bool gsel = rank < 4;
#pragma unroll
    for (int j = 0; j < 4; ++j) v[j] = gsel ? v[j] : -INFINITY;
    int my_e = 0; float my_s = 0.f, wsum = 0.f;
#pragma unroll 1
    for (int r = 0; r < 8; ++r) {
      float bv = v[0]; int bi = 0;
#pragma unroll
      for (int j = 1; j < 4; ++j) if (v[j] > bv) { bv = v[j]; bi = j; }
      int be = lane * 4 + bi;
#pragma unroll
      for (int o = 1; o < 64; o <<= 1) { const float ov = __shfl_xor(bv, o); const int oe = __shfl_xor(be, o); if (ov > bv || (ov == bv && oe < be)) { bv = ov; be = oe; } }
      const int ol = be >> 2, oj = be & 3;
      float s_own = 0.f;
#pragma unroll
      for (int j = 0; j < 4; ++j) if (lane == ol && oj == j) { s_own = sc[j]; v[j] = -INFINITY; }
      const float s_w = __shfl(s_own, ol);
      wsum += s_w;
      if (lane == r) { my_e = be; my_s = s_w; }
    }
    if (lane < 8) {
      p.tk_idx[t * 8 + lane] = my_e;
      p.tk_w[t * 8 + lane] = my_s / wsum * 2.5f;
      p.tk_rank[t * 8 + lane] = atomicAdd(&p.counts[my_e], 1);
    }
  }
}
__device__ __forceinline__ void phase_scatter(PR p, int bid, int nb, lds_ptr smem) {
  LAS int* st = (LAS int*)smem;
  __syncthreads();
  if (ltid() < 256) st[ltid() + 1] = (p.counts[ltid()] + 127) / 128 * 128;
  if (ltid() == 0) st[0] = 0;
  __syncthreads();
  if (ltid() < 64) {
    const int ln = ltid();
    const int c0 = st[4 * ln + 1], c1 = st[4 * ln + 2], c2 = st[4 * ln + 3], c3 = st[4 * ln + 4];
    const int tot = c0 + c1 + c2 + c3;
    int inc = tot;
    #pragma unroll
    for (int o = 1; o < 64; o <<= 1) { const int v = __shfl_up(inc, o, 64); if (ln >= o) inc += v; }
    const int b0 = inc - tot;
    st[4 * ln + 1] = b0 + c0; st[4 * ln + 2] = b0 + c0 + c1; st[4 * ln + 3] = b0 + c0 + c1 + c2; st[4 * ln + 4] = inc;
  }
  __syncthreads();
  if (bid == 0) {
    if (ltid() < 256) { const int e = ltid(); for (int b = st[e] / 128; b < st[e + 1] / 128; ++b) p.blk_exp[b] = e; }
    for (int b = st[256] / 128 + ltid(); b < NBLK128; b += NTHR) p.blk_exp[b] = -1;
  }
  if (bid >= 8 && bid < 16 && ltid() < 64) {
    const int x = bid - 8, ln = ltid() & 63, half = ln >> 5;
    const int e = x + 8 * (ln & 31);
    const int np = (st[e + 1] / 128 - st[e] / 128 + 1) >> 1;
    int inc = np;
    #pragma unroll
    for (int o = 1; o < 32; o <<= 1) { const int v = __shfl_up(inc, o, 32); if ((ln & 31) >= o) inc += v; }
    const int base = inc - np;
    if (half == 0) for (int j = 0; j < np; ++j) p.moe_list[x * NBLK128 + base + j] = st[e] / 128 + 2 * j;
    if (ln == 31) p.moe_cnt[x] = inc;
  }
  for (int i = bid * NTHR + ltid(); i < T * 8; i += nb * NTHR) {
    const int e = p.tk_idx[i], pos = st[e] + p.tk_rank[i];
    p.slot_tok[pos] = i >> 3;
    p.slot_of[i] = pos;
  }
}

__global__ void __launch_bounds__(64) k_s5_naive(P p) {
  __shared__ float sre[64], sim[64], cre[16][64], cim[16][64], us[16];
  const int b = blockIdx.x / S5G, g = blockIdx.x % S5G, lane = threadIdx.x;
  const float are = p.abar[(g * 64 + lane) * 2], aim = p.abar[(g * 64 + lane) * 2 + 1];
  float bre[16], bim[16];
  for (int h = 0; h < 16; ++h) { bre[h] = p.bbar[((g * 64 + lane) * 16 + h) * 2]; bim[h] = p.bbar[((g * 64 + lane) * 16 + h) * 2 + 1]; }
  for (int i = lane; i < 1024; i += 64) { cre[i >> 6][i & 63] = p.c_re[g * 1024 + i]; cim[i >> 6][i & 63] = p.c_im[g * 1024 + i]; }
  const float dsk = lane < 16 ? p.s5_d[g * 16 + lane] : 0.f;
  float s_re = 0.f, s_im = 0.f;
  __syncthreads();
  for (int l = 0; l < SEQ; ++l) {
    const size_t t = (size_t)b * SEQ + l;
    if (lane < 16) us[lane] = bf2f(p.proj[t * LDP + OFF_U + g * 16 + lane]);
    __syncthreads();
    float bur = 0.f, bui = 0.f;
    for (int h = 0; h < 16; ++h) { bur += us[h] * bre[h]; bui += us[h] * bim[h]; }
    const float nr = are * s_re - aim * s_im + bur, ni = are * s_im + aim * s_re + bui;
    s_re = nr; s_im = ni;
    sre[lane] = s_re; sim[lane] = s_im;
    __syncthreads();
    if (lane < 16) {
      float y = dsk * us[lane];
      for (int q = 0; q < 64; ++q) y += sre[q] * cre[lane][q] - sim[q] * cim[lane][q];
      p.yA[t * S5W + g * 16 + lane] = f2bf(geluf_(y));
    }
    __syncthreads();
  }
}

__global__ void __launch_bounds__(128) k_gla_naive(P p) {
  __shared__ float qs[32][64], ks[32][64], as[32][64], gl[32][16], w2[16][64], b2[64];
  const int b = blockIdx.x / GH, h = blockIdx.x % GH, tid = threadIdx.x;
  for (int i = tid; i < 16 * 64; i += 128) w2[i >> 6][i & 63] = p.w_gk2[(i >> 6) * GKEY + h * 64 + (i & 63)];
  if (tid < 64) b2[tid] = p.b_gk2[h * 64 + tid];
  float S[64];
  for (int d = 0; d < 64; ++d) S[d] = 0.f;
  for (int l0 = 0; l0 < SEQ; l0 += 32) {
    __syncthreads();
    for (int i = tid; i < 32 * 64; i += 128) {
      const size_t t = (size_t)b * SEQ + l0 + (i >> 6);
      qs[i >> 6][i & 63] = bf2f(p.proj[t * LDP + OFF_Q + h * 64 + (i & 63)]) * 0.125f;
      ks[i >> 6][i & 63] = bf2f(p.proj[t * LDP + OFF_K + h * 64 + (i & 63)]);
    }
    for (int i = tid; i < 32 * 16; i += 128) { const size_t t = (size_t)b * SEQ + l0 + (i >> 4); gl[i >> 4][i & 15] = p.gkl[t * 16 + (i & 15)]; }
    __syncthreads();
    for (int i = tid; i < 32 * 64; i += 128) {
      const int s = i >> 6, d = i & 63;
      float gk = b2[d];
      for (int r = 0; r < 16; ++r) gk += gl[s][r] * w2[r][d];
      as[s][d] = __expf(logsigmoidf_(gk) * (1.f / 16.f));
    }
    __syncthreads();
    for (int s = 0; s < 32; ++s) {
      const size_t t = (size_t)b * SEQ + l0 + s;
      const float v = bf2f(p.proj[t * LDP + OFF_V + h * 128 + tid]);
      float o = 0.f;
      for (int d = 0; d < 64; ++d) { S[d] = as[s][d] * S[d] + ks[s][d] * v; o += qs[s][d] * S[d]; }
      p.oraw[t * GVAL + h * 128 + tid] = o;
    }
  }
}
__global__ void __launch_bounds__(256) k_gla_post(P p) {
  const int idx = blockIdx.x * 4 + (threadIdx.x >> 6), lane = threadIdx.x & 63;
  const int t = idx / GH, h = idx % GH;
  const float o0 = p.oraw[(size_t)t * GVAL + h * 128 + lane], o1 = p.oraw[(size_t)t * GVAL + h * 128 + 64 + lane];
  float ss = o0 * o0 + o1 * o1;
  for (int o = 32; o > 0; o >>= 1) ss += __shfl_xor(ss, o);
  const float r = rsqrtf(ss * (1.f / 128.f) + 1e-6f);
  const float r0 = bf2f(p.proj[(size_t)t * LDP + OFF_R + h * 128 + lane]), r1 = bf2f(p.proj[(size_t)t * LDP + OFF_R + h * 128 + 64 + lane]);
  p.yB[(size_t)t * GVAL + h * 128 + lane] = f2bf(o0 * r * p.gla_norm_g[lane] * siluf_(r0));
  p.yB[(size_t)t * GVAL + h * 128 + 64 + lane] = f2bf(o1 * r * p.gla_norm_g[64 + lane] * siluf_(r1));
}

__global__ void __launch_bounds__(64) k_route(P p) {
  const int t = blockIdx.x * 64 + threadIdx.x;
  const float* lg = p.logits + (size_t)t * NE;
  float gs[8];
#pragma unroll
  for (int g = 0; g < 8; ++g) {
    float m1 = -INFINITY, m2 = -INFINITY;
    for (int j = 0; j < 32; ++j) { const float v = sigmoidf_(lg[g * 32 + j]) + p.router_bias[g * 32 + j]; if (v > m1) { m2 = m1; m1 = v; } else if (v > m2) m2 = v; }
    gs[g] = m1 + m2;
  }
  unsigned gmask = 0;
#pragma unroll
  for (int r = 0; r < 4; ++r) { int best = -1; float bv = -INFINITY;
#pragma unroll
    for (int g = 0; g < 8; ++g) if (!((gmask >> g) & 1u) && gs[g] > bv) { bv = gs[g]; best = g; }
    gmask |= 1u << best; }
  int sel[8]; float sw[8]; float wsum = 0.f;
#pragma unroll
  for (int r = 0; r < 8; ++r) {
    int best = -1; float bv = -INFINITY;
    for (int e = 0; e < NE; ++e) {
      if (!((gmask >> (e >> 5)) & 1u)) continue;
      bool taken = false;
#pragma unroll
      for (int q = 0; q < 8; ++q) taken |= (q < r) && (sel[q] == e);
      if (taken) continue;
      const float v = sigmoidf_(lg[e]) + p.router_bias[e];
      if (v > bv) { bv = v; best = e; }
    }
    best = best < 0 ? r : best;
    sel[r] = best; sw[r] = sigmoidf_(lg[best]); wsum += sw[r];
  }
#pragma unroll
  for (int r = 0; r < 8; ++r) {
    p.tk_idx[t * 8 + r] = sel[r];
    p.tk_w[t * 8 + r] = sw[r] / wsum * 2.5f;
    p.tk_rank[t * 8 + r] = atomicAdd(&p.counts[sel[r]], 1);
  }
}
__global__ void __launch_bounds__(256) k_offsets(P p) {
  __shared__ int pad[256], st[257];
  const int e = threadIdx.x;
  pad[e] = (p.counts[e] + 127) / 128 * 128;
  __syncthreads();
  if (e == 0) { int s = 0; for (int i = 0; i < 256; ++i) { st[i] = s; s += pad[i]; } st[256] = s; }
  __syncthreads();
  p.pad_start[e] = st[e];
  if (e == 0) p.pad_start[256] = st[256];
  for (int b = st[e] / 128; b < st[e + 1] / 128; ++b) p.blk_exp[b] = e;
  for (int b = st[256] / 128 + e; b < NBLK128; b += 256) p.blk_exp[b] = -1;
}
__global__ void __launch_bounds__(256) k_scatter(P p) {
  const int i = blockIdx.x * 256 + threadIdx.x;
  const int e = p.tk_idx[i], pos = p.pad_start[e] + p.tk_rank[i];
  p.slot_tok[pos] = i >> 3;
  p.slot_of[i] = pos;
}

__device__ __forceinline__ void phase_combine(PR p, int bid, int nb) {
  const int lane = ltid() & 63, wid = ltid() >> 6;
  for (int t = bid * 8 + wid; t < T; t += nb * 8) {
    const int b = t / SEQ;
    int so[8]; float w[8];
#pragma unroll
    for (int k = 0; k < 8; ++k) { so[k] = p.slot_of[t * 8 + k]; w[k] = p.tk_w[t * 8 + k]; }
    float v[16], ss = 0.f;
#pragma unroll
    for (int i = 0; i < 4; ++i) {
      const int c0 = lane * 4 + 256 * i;
      f32x4 m = ld_bf4(p.S + (size_t)t * D + c0);
#pragma unroll
      for (int k = 0; k < 8; ++k) { const f32x4 y = ld_bf4(p.Y + (size_t)so[k] * D + c0); m[0] += w[k] * y[0]; m[1] += w[k] * y[1]; m[2] += w[k] * y[2]; m[3] += w[k] * y[3]; }
      const f32x4 xv = *(const f32x4*)(p.x1 + (size_t)t * D + c0), gg = *(const f32x4*)(p.mod + b * 6144 + 5 * D + c0);
#pragma unroll
      for (int j = 0; j < 4; ++j) { v[i * 4 + j] = xv[j] + gg[j] * m[j]; ss += v[i * 4 + j] * v[i * 4 + j]; }
    }
#pragma unroll
    for (int o = 32; o > 0; o >>= 1) ss += __shfl_xor(ss, o);
    const float r = rsqrtf(ss * (1.f / D) + 1e-6f);
#pragma unroll
    for (int i = 0; i < 4; ++i) {
      const int c0 = lane * 4 + 256 * i; const f32x4 fg = *(const f32x4*)(p.final_g + c0);
      f32x4 o; o[0] = v[i * 4] * r * fg[0]; o[1] = v[i * 4 + 1] * r * fg[1]; o[2] = v[i * 4 + 2] * r * fg[2]; o[3] = v[i * 4 + 3] * r * fg[3];
      *(f32x4*)(p.out + (size_t)t * D + c0) = o;
    }
  }
}


template <class Epi>
__global__ void __launch_bounds__(256) k_gemm_naive(const bf16_t* __restrict__ A, int lda, const float* __restrict__ Bm, int ldb, int M, int N, int K, Epi epi) {
  __shared__ float As[16][68];
  __shared__ float Bs[16][68];
  const int tx = threadIdx.x & 15, ty = threadIdx.x >> 4;
  const int row0 = blockIdx.y * 64, col0 = blockIdx.x * 64;
  float acc[4][4];
  for (int i = 0; i < 4; ++i) for (int j = 0; j < 4; ++j) acc[i][j] = 0.f;
  for (int k0 = 0; k0 < K; k0 += 16) {
    { const int r = threadIdx.x >> 2, k4 = (threadIdx.x & 3) * 4;
      const bf16_t* ap = A + (size_t)(row0 + r) * lda + k0 + k4;
      for (int j = 0; j < 4; ++j) As[k4 + j][r] = bf2f(ap[j]); }
    { const int k = threadIdx.x >> 4, c4 = (threadIdx.x & 15) * 4;
      for (int j = 0; j < 4; ++j) { const int cc = col0 + c4 + j; Bs[k][c4 + j] = cc < N ? Bm[(size_t)(k0 + k) * ldb + cc] : 0.f; } }
    __syncthreads();
    for (int k = 0; k < 16; ++k) {
      float a[4], b[4];
      for (int i = 0; i < 4; ++i) a[i] = As[k][ty * 4 + i];
      for (int j = 0; j < 4; ++j) b[j] = Bs[k][tx * 4 + j];
      for (int i = 0; i < 4; ++i) for (int j = 0; j < 4; ++j) acc[i][j] += a[i] * b[j];
    }
    __syncthreads();
  }
  for (int i = 0; i < 4; ++i) for (int j = 0; j < 4; ++j) { const int r = row0 + ty * 4 + i, cc = col0 + tx * 4 + j; if (cc < N) epi(r, cc, acc[i][j]); }
}
struct NEpiProj { bf16_t* o; __device__ void operator()(int r, int c, float v) const { if (c >= WIN_GK && c < WIN_GK + 16) return; const int cc = c < WIN_GK ? c : c - 16; o[(size_t)r * LDP + cc] = f2bf(v); } };
struct NEpiGlu { const bf16_t* yA; const float* b; bf16_t* z; __device__ void operator()(int r, int c, float v) const { const float y = bf2f(yA[(size_t)r * S5W + c]); z[(size_t)r * S5W + c] = f2bf(y * sigmoidf_(v + b[c])); } };
struct NEpiPA { const bf16_t* proj; float* t; __device__ void operator()(int r, int c, float v) const { t[(size_t)r * D + c] = sigmoidf_(bf2f(proj[(size_t)r * LDP + OFF_GA + c])) * v; } };
struct NEpiPB { const bf16_t* proj; const float* t; bf16_t* m; __device__ void operator()(int r, int c, float v) const { m[(size_t)r * D + c] = f2bf(t[(size_t)r * D + c] + sigmoidf_(bf2f(proj[(size_t)r * LDP + OFF_GB + c])) * v); } };
struct NEpiOut { const float* x; const float* mod; float* x1; __device__ void operator()(int r, int c, float v) const { const int b = r / SEQ; x1[(size_t)r * D + c] = x[(size_t)r * D + c] + mod[b * 6144 + 2 * D + c] * v; } };
struct NEpiF32 { float* o; long ld; __device__ void operator()(int r, int c, float v) const { o[(size_t)r * ld + c] = v; } };
struct NEpiShUp { const float* g; bf16_t* h; __device__ void operator()(int r, int c, float v) const { h[(size_t)r * SFF + c] = f2bf(siluf_(g[(size_t)r * SFF + c]) * v); } };
struct NEpiBf { bf16_t* o; long ld; __device__ void operator()(int r, int c, float v) const { o[(size_t)r * ld + c] = f2bf(v); } };
__global__ void __launch_bounds__(256) k_moe_naive(P p) {
  __shared__ float xs[16][1024];
  __shared__ float hs[16][256];
  __shared__ int toks[16];
  const int s0 = blockIdx.x * 16, e = p.blk_exp[s0 / 128], tid = threadIdx.x;
  if (e < 0) return;
  if (tid < 16) toks[tid] = p.slot_tok[s0 + tid];
  __syncthreads();
  bool any = false;
  for (int s = 0; s < 16; ++s) any |= toks[s] >= 0;
  if (!any) return;
  for (int i = tid; i < 16 * 1024; i += 256) { const int s = i >> 10, d = i & 1023; xs[s][d] = toks[s] >= 0 ? bf2f(p.h2[(size_t)toks[s] * D + d]) : 0.f; }
  __syncthreads();
  {
    float ag[16], au[16];
    for (int s = 0; s < 16; ++s) { ag[s] = 0.f; au[s] = 0.f; }
    const float* wg = p.ew_gate + (size_t)e * D * EFF + tid;
    const float* wu = p.ew_up + (size_t)e * D * EFF + tid;
    for (int d = 0; d < D; ++d) {
      const float g = wg[(size_t)d * EFF], u = wu[(size_t)d * EFF];
      for (int s = 0; s < 16; ++s) { const float xv = xs[s][d]; ag[s] += xv * g; au[s] += xv * u; }
    }
    for (int s = 0; s < 16; ++s) hs[s][tid] = bf2f(f2bf(siluf_(ag[s]) * au[s]));
  }
  __syncthreads();
  for (int nb = 0; nb < 4; ++nb) {
    float acc[16];
    for (int s = 0; s < 16; ++s) acc[s] = 0.f;
    const float* wd = p.ew_down + (size_t)e * EFF * D + nb * 256 + tid;
    for (int j = 0; j < EFF; ++j) { const float w = wd[(size_t)j * D]; for (int s = 0; s < 16; ++s) acc[s] += hs[s][j] * w; }
    for (int s = 0; s < 16; ++s) if (toks[s] >= 0) p.Y[(size_t)(s0 + s) * D + nb * 256 + tid] = f2bf(acc[s]);
  }
}

#define SMEM_DECL __shared__ __attribute__((aligned(16))) unsigned char smem_raw[SMEM_BYTES]; const lds_ptr smem = (lds_ptr)smem_raw;


#define XB_TMO      128
#define XB_XCNT(j)  (256  + 64 * (j))
#define XB_XSUB(j)  (1280 + 64 * (j))
#define XB_XGEN(j)  (2304 + 64 * (j))
#define XB_TOP      3328
#define XB_TOPGEN   3392
#define XCD_BAR_WORDS 3456
#define XB_SPIN_CAP (1u << 18)
__device__ __forceinline__ unsigned xb_ld(unsigned* q)              { return __hip_atomic_load(q, __ATOMIC_RELAXED, __HIP_MEMORY_SCOPE_AGENT); }
__device__ __forceinline__ unsigned xb_add(unsigned* q, unsigned v) { return __hip_atomic_fetch_add(q, v, __ATOMIC_RELAXED, __HIP_MEMORY_SCOPE_AGENT); }
__device__ __forceinline__ unsigned xb_xcc_id() { return (unsigned)__builtin_amdgcn_s_getreg((3 << 11) | 20) & 0xFu; }
#define XB_SPIN(cond, bar) do { unsigned _sp = 0; while (cond) { __builtin_amdgcn_s_sleep(1); \
    if ((++_sp & 255u) == 0u) { if (xb_ld(&(bar)[XB_TMO])) break; if (_sp > XB_SPIN_CAP) { atomicAdd(&(bar)[XB_TMO], 1u); break; } } } } while (0)
struct XcdBarrier { unsigned* bar; unsigned x; volatile LAS unsigned* st; };
__device__ __forceinline__ XcdBarrier xcd_barrier_post(unsigned* bar, volatile LAS unsigned* st) {
  XcdBarrier b; b.bar = bar; b.x = xb_xcc_id(); b.st = st;
  if (threadIdx.x == 0) (void)xb_add(&bar[XB_XCNT(b.x)], 1u);
  return b;
}
__device__ __forceinline__ void xcd_barrier_complete(unsigned* bar, unsigned x, unsigned& nloc, unsigned& nx) {
  const unsigned G = gridDim.x * gridDim.y * gridDim.z;
  unsigned sum, cnt, mine, sp = 0u;
  for (;;) {
    sum = 0u; cnt = 0u; mine = 0u;
#pragma unroll
    for (unsigned j = 0; j < 16; ++j) { const unsigned c = xb_ld(&bar[XB_XCNT(j)]); sum += c; cnt += (c > 0u) ? 1u : 0u; mine = (j == x) ? c : mine; }
    if (sum == G) break;
    __builtin_amdgcn_s_sleep(1);
    if ((++sp & 255u) == 0u) { if (xb_ld(&bar[XB_TMO])) break; if (sp > XB_SPIN_CAP) { atomicAdd(&bar[XB_TMO], 1u); break; } }
  }
  nloc = mine > 0u ? mine : 1u; nx = cnt > 0u ? cnt : 1u;
}
__device__ __forceinline__ void xcd_barrier(const XcdBarrier& b) {
  asm volatile("s_waitcnt vmcnt(0)" ::: "memory");
  __syncthreads();
  if (threadIdx.x == 0) {
    unsigned* bar = b.bar;
    __builtin_amdgcn_s_waitcnt(0);
    unsigned nloc = b.st[0], nx = b.st[1];
    if (nloc == 0u) { xcd_barrier_complete(bar, b.x, nloc, nx); b.st[0] = nloc; b.st[1] = nx; }
    const unsigned old = xb_add(&bar[XB_XSUB(b.x)], 1u);
    const unsigned gen = old / nloc;
    if (old + 1u == (gen + 1u) * nloc) {
      __builtin_amdgcn_fence(__ATOMIC_RELEASE, "agent");
      asm volatile("s_waitcnt vmcnt(0)" ::: "memory");
      const unsigned og = xb_add(&bar[XB_TOP], 1u);
      const unsigned tg = og / nx;
      if (og + 1u == (tg + 1u) * nx) xb_add(&bar[XB_TOPGEN], 1u);
      else XB_SPIN(xb_ld(&bar[XB_TOPGEN]) == tg, bar);
      __builtin_amdgcn_fence(__ATOMIC_ACQUIRE, "agent");
      xb_add(&bar[XB_XGEN(b.x)], 1u);
      asm volatile("s_waitcnt vmcnt(0)" ::: "memory");
    } else {
      XB_SPIN(xb_ld(&bar[XB_XGEN(b.x)]) == gen, bar);
      __builtin_amdgcn_fence(__ATOMIC_ACQUIRE, "agent");
      asm volatile("s_waitcnt vmcnt(0)" ::: "memory");
    }
  }
  __syncthreads();
}

__device__ __forceinline__ const __attribute__((address_space(4))) P* kargs() { auto q = __builtin_amdgcn_kernarg_segment_ptr(); asm volatile("" : "+s"(q)); return (const __attribute__((address_space(4))) P*)q; }
#define PK (*kargs())
__global__ void __launch_bounds__(NTHR) k_fused(P p_unused) {
  SMEM_DECL
  const int bid = blockIdx.x, nb = gridDim.x;
  volatile LAS unsigned* xbw = (volatile LAS unsigned*)(smem + SMEM_BYTES - 16);
  if (threadIdx.x == 0) { xbw[0] = 0u; xbw[1] = 0u; }
  __syncthreads();
  const XcdBarrier xb = xcd_barrier_post(PK.bar, xbw);
#define GSYNC() xcd_barrier(xb)
#define RUN(k, ...) do { __VA_ARGS__; if (REP_PHASE == (k)) { _Pragma("unroll 1") for (int r_ = 0; r_ < REP_N; ++r_) { __builtin_amdgcn_sched_barrier(0); __VA_ARGS__; } } } while (0)
  RUN(0, phase_prep(PK, bid, nb, smem));                                                                   GSYNC();
  RUN(1, phase_norm<false>(PK, PK.x, PK.norm1_g, 0, D, PK.h1, bid, nb, smem));                                 GSYNC();
  RUN(2, phase_gemm_dense256_bf16(PK.h1, D, PK.wb_in, LDP, T, LDP, D, PK.proj, LDP, bid, nb, smem); gk_rows(PK, bid, nb));     GSYNC();
  RUN(3, phase_mix_local(PK, bid, nb, smem, 3));                                                           GSYNC();
  RUN(4, phase_mix_carry(PK, bid, nb, 3));                                                                 GSYNC();
  RUN(5, phase_mix_final(PK, bid, nb, smem, 3));                                                           GSYNC();
  RUN(6, phase_gemm_dense(PK.yA, S5W, PK.wb_glu, S5W, T, S5W, S5W, EpiGlu{PK.yA, PK.b_glu, PK.zA}, bid, nb, smem));   GSYNC();
  RUN(7, phase_gemm_mixed(PK, bid, nb, smem));                                                             GSYNC();
  RUN(8, phase_gemm_dense256(PK.mixed, D, PK.wb_out, D, T, D, D, EpiOut{PK.x, PK.mod, PK.x1}, bid, nb, smem));    GSYNC();
  RUN(9, phase_norm<false>(PK, PK.x1, PK.norm2_g, 3 * D, 4 * D, PK.h2, bid, nb, smem));                       GSYNC();
  RUN(10, phase_gemm_rs(PK, bid, nb, smem));                                                               GSYNC();
  phase_route(PK, bid, nb);                                                                                GSYNC();
  RUN(12, phase_scatter(PK, bid, nb, smem));                                                               GSYNC();
  phase_moe_pair<1>(PK, bid, nb, smem);                                                                    GSYNC();
  phase_moe_pair<2>(PK, bid, nb, smem);
  RUN(14, phase_gemm_dense256_bf16(PK.shH, SFF, PK.wb_sd, D, T, D, SFF, PK.S, D, bid, nb, smem));        GSYNC();
  RUN(15, phase_combine(PK, bid, nb));
}

static inline size_t al256(size_t v) { return (v + 255) & ~(size_t)255; }

extern "C" void kernel_launch(void* const* d_in, const int* in_sizes, int n_in, void* d_out, int out_size, void* d_ws, size_t ws_size, hipStream_t stream) {
  P p{};
  const float** pin = (const float**)&p;
  for (int i = 0; i < 32; ++i) pin[i] = (const float*)d_in[i];
  p.out = (float*)d_out;
  char* w = (char*)d_ws; size_t off = 0;
  auto take = [&](size_t bytes) { char* r = w + off; off = al256(off + bytes); return (void*)r; };
  p.mod = (float*)take(8 * 6144 * 4);
  p.wb_in = (bf16_t*)take((size_t)D * LDP * 2);
  p.wb_glu = (bf16_t*)take((size_t)S5W * S5W * 2);
  p.wb_pa = (bf16_t*)take((size_t)S5W * D * 2);
  p.wb_pb = (bf16_t*)take((size_t)GVAL * D * 2);
  p.wb_out = (bf16_t*)take((size_t)D * D * 2);
  p.wb_rs = (bf16_t*)take((size_t)D * 768 * 2);
  p.wb_sd = (bf16_t*)take((size_t)SFF * D * 2);
  p.h1 = (bf16_t*)take((size_t)T * D * 2);
  p.gkl = (float*)take((size_t)T * 16 * 4);
  p.proj = (bf16_t*)take((size_t)T * LDP * 2);
  p.abar = (float*)take(S5G * S5P * 2 * 4);
  p.bbar = (float*)take(S5G * S5P * S5H * 2 * 4);
  p.yA = (bf16_t*)take((size_t)T * S5W * 2);
  p.oraw = (float*)take((size_t)T * GVAL * 4);
  p.yB = (bf16_t*)take((size_t)T * GVAL * 2);
  p.zA = (bf16_t*)take((size_t)T * S5W * 2);
  p.mixed = (bf16_t*)take((size_t)T * D * 2);
  p.x1 = (float*)take((size_t)T * D * 4);
  p.h2 = (bf16_t*)take((size_t)T * D * 2);
  p.logits = (float*)take((size_t)T * NE * 4);
  p.tk_idx = (int*)take((size_t)T * 8 * 4);
  p.tk_w = (float*)take((size_t)T * 8 * 4);
  p.tk_rank = (int*)take((size_t)T * 8 * 4);
  p.slot_of = (int*)take((size_t)T * 8 * 4);
  p.counts = (int*)take(256 * 4);
  p.pad_start = (int*)take(257 * 4);
  p.blk_exp = (int*)take(NBLK128 * 4);
  p.slot_tok = (int*)take((size_t)NSLOT * 4);
  p.Y = (bf16_t*)take((size_t)NSLOT * D * 2);
  p.shH = (bf16_t*)take((size_t)T * SFF * 2);
  p.S = (bf16_t*)take((size_t)T * D * 2);
  p.bbarT = (bf16_t*)take((size_t)S5G * 128 * 16 * 2);
  p.cmT = (bf16_t*)take((size_t)S5G * 16 * 128 * 2);
  p.apow64 = (float*)take(S5G * S5P * 2 * 4);
  p.s5E = (float*)take((size_t)NB * 32 * S5G * 64 * 2 * 4);
  p.s5Sin = (float*)take((size_t)NB * 32 * S5G * 64 * 2 * 4);
  p.glaKV = (float*)take((size_t)1024 * 64 * 128 * 4);
  p.glaDec = (float*)take((size_t)1024 * 64 * 4);
  p.glaSin = (bf16_t*)take((size_t)1024 * 64 * 128 * 2);
  p.wgkT = (bf16_t*)take((size_t)16 * D * 2);
  p.moe_list = (int*)take((size_t)8 * NBLK128 * 4);
  p.moe_cnt = (int*)take(64);
  p.moe_ctr = (int*)take(64);
  p.Hbuf = (bf16_t*)take((size_t)NSLOT * EFF * 2);
  p.bar = (unsigned*)take(XCD_BAR_WORDS * 4);
  if (off > ws_size) { fprintf(stderr, "workspace too small: need %zu have %zu\n", off, ws_size); return; }

  static int grid_blocks = 0;
  if (!grid_blocks) {
    int dev = 0, cus = 0, per_cu = 0;
    (void)hipGetDevice(&dev);
    (void)hipDeviceGetAttribute(&cus, hipDeviceAttributeMultiprocessorCount, dev);
    (void)hipOccupancyMaxActiveBlocksPerMultiprocessor(&per_cu, k_fused, NTHR, 0);
    grid_blocks = (per_cu >= 1) ? cus : 0;
    grid_blocks &= ~7;
    if (grid_blocks <= 0) { fprintf(stderr, "occupancy query says the fused kernel does not fit (per_cu=%d cus=%d)\n", per_cu, cus); grid_blocks = 0; return; }
  }
  (void)hipMemsetAsync(p.bar, 0, XCD_BAR_WORDS * 4, stream);
  void* args[] = {&p};
  hipError_t e = hipLaunchCooperativeKernel((const void*)k_fused, dim3(grid_blocks), dim3(NTHR), args, 0, stream);
  if (e != hipSuccess) fprintf(stderr, "cooperative launch failed: %s (grid %d)\n", hipGetErrorString(e), grid_blocks);
}
```

```cpp
#include <hip/hip_runtime.h>
#include <hip/hip_cooperative_groups.h>
namespace cg = cooperative_groups;
#include <cstdint>
#include <cstdio>

typedef unsigned short bf16_t;
typedef short s16x8 __attribute__((ext_vector_type(8)));
typedef short s16x4 __attribute__((ext_vector_type(4)));
typedef float f32x4 __attribute__((ext_vector_type(4)));
typedef unsigned u32x4 __attribute__((ext_vector_type(4)));
typedef unsigned u32x2 __attribute__((ext_vector_type(2)));
#define LAS __attribute__((address_space(3)))
typedef LAS unsigned char* lds_ptr;

constexpr int D = 1024, NB = 8, SEQ = 2048, T = NB * SEQ;
constexpr int S5W = 512, S5G = 32, S5H = 16, S5P = 64;
constexpr int GH = 4, GDK = 64, GDV = 128, GKEY = 256, GVAL = 512, GRANK = 16;
constexpr int NE = 256, TOPK = 8, NGRP = 8, EFF = 256, SFF = 256;
constexpr int INW = 4112, LDP = 4096;
constexpr int OFF_U = 0, OFF_Q = 512, OFF_K = 768, OFF_V = 1024, OFF_R = 1536, OFF_GA = 2048, OFF_GB = 3072;
constexpr int WIN_GK = 1536;
constexpr int NSLOT = 163584, NBLK128 = NSLOT / 128;
constexpr int NTHR = 512;
constexpr int USE_MFMA = 127;
constexpr int USE_NEW = 7;
constexpr int REP_PHASE = -1, REP_N = 8;
constexpr int MOE_REP_GU = 1, MOE_REP_DN = 1;

__device__ __forceinline__ float bf2f(bf16_t v) { return __uint_as_float(((unsigned)v) << 16); }
__device__ __forceinline__ bf16_t f2bf(float f) { return __builtin_bit_cast(unsigned short, (__bf16)f); }
typedef float f32x2 __attribute__((ext_vector_type(2)));
typedef __bf16 bf16x2_t __attribute__((ext_vector_type(2)));
__device__ __forceinline__ unsigned cvtpk(float lo, float hi) { const f32x2 v = {lo, hi}; return __builtin_bit_cast(unsigned, __builtin_convertvector(v, bf16x2_t)); }
__device__ __forceinline__ float sigmoidf_(float x) { return __builtin_amdgcn_rcpf(1.f + __expf(-x)); }
__device__ __forceinline__ float siluf_(float x) { return x * __builtin_amdgcn_rcpf(1.f + __expf(-x)); }
__device__ __forceinline__ float geluf_(float x) { const float u = 0.7978845608028654f * (x + 0.044715f * x * x * x); return x * __builtin_amdgcn_rcpf(1.f + __expf(-2.f * u)); }
__device__ __forceinline__ float logsigmoidf_(float x) { return fminf(x, 0.f) - __logf(1.f + __expf(-fabsf(x))); }

struct P;
typedef const __attribute__((address_space(4))) P& PR;

__device__ __forceinline__ int ltid() { int t = threadIdx.x; asm volatile("" : "+v"(t)); return t; }

struct P {
  const float *x, *c, *ada_w, *ada_b, *norm1_g, *w_in, *lam_re, *lam_im, *log_dt, *b_re, *b_im, *c_re, *c_im, *s5_d, *w_glu, *b_glu, *w_proj_a,
      *w_gk2, *b_gk2, *gla_norm_g, *w_proj_b, *w_out, *norm2_g, *router_w, *router_bias, *ew_gate, *ew_up, *ew_down, *sw_gate, *sw_up, *sw_down, *final_g;
  float* out;
  float* mod;
  bf16_t* wb_in;
  bf16_t* wb_glu;
  bf16_t* wb_pa;
  bf16_t* wb_pb;
  bf16_t* wb_out;
  bf16_t* wb_rs;
  bf16_t* wb_sd;
  bf16_t* h1;
  float* gkl;
  bf16_t* proj;
  float* abar;
  float* bbar;
  bf16_t* yA;
  float* oraw;
  bf16_t* yB;
  bf16_t* zA;
  bf16_t* mixed;
  float* x1;
  bf16_t* h2;
  float* logits;
  int* tk_idx;
  float* tk_w;
  int* tk_rank;
  int* slot_of;
  int* counts;
  int* pad_start;
  int* blk_exp;
  int* slot_tok;
  bf16_t* Y;
  bf16_t* shH;
  bf16_t* S;
  bf16_t* bbarT;
  bf16_t* cmT;
  float* apow64;
  float* s5E;
  float* s5Sin;
  float* glaKV;
  float* glaDec;
  bf16_t* glaSin;
  bf16_t* wgkT;
  int* moe_list;
  int* moe_cnt;
  int* moe_ctr;
  bf16_t* Hbuf;
  unsigned* bar;
};

constexpr int G_ASZ = 128 * 64, G_BSZ = 32 * 512, G_STAGE = G_ASZ + G_BSZ;

__device__ __forceinline__ int a_off(int r, int c) { return r * 64 + ((c ^ ((0x78 >> (((r >> 2) & 3) * 2)) & 3)) << 4); }
__device__ __forceinline__ int b_off(int k, int ch) { return k * 512 + ((ch ^ ((k & 3) | (((k >> 3) & 1) << 2))) << 5); }
__device__ __forceinline__ s16x4 tr_read(lds_ptr p) { return __builtin_bit_cast(s16x4, __builtin_amdgcn_ds_read_tr16_b64_v4i16((LAS s16x4*)p)); }

struct ALoadDense { const bf16_t* A; long lda; __device__ __forceinline__ const bf16_t* rowptr(int r) const { return A + (size_t)r * lda; } };
struct ALoadGatherLds { const bf16_t* A; LAS int* tk; __device__ __forceinline__ const bf16_t* rowptr(int r) const { int t = tk[r]; t = t < 0 ? 0 : t; return A + (size_t)t * D; } };
struct BLoadBf { const bf16_t* Bm; long ldb;
  __device__ __forceinline__ u32x4 load(int kg, int c8) const { return *(const u32x4*)(Bm + (size_t)kg * ldb + c8 * 8); } };
struct BLoadF32 { const float* Bm; long ldb;
  __device__ __forceinline__ u32x4 load(int kg, int c8) const { const float* q = Bm + (size_t)kg * ldb + c8 * 8; const f32x4 a = *(const f32x4*)q, b = *(const f32x4*)(q + 4);
    u32x4 r; r.x = cvtpk(a[0], a[1]); r.y = cvtpk(a[2], a[3]); r.z = cvtpk(b[0], b[1]); r.w = cvtpk(b[2], b[3]); return r; } };
struct BLoadGU { const float* Wg; const float* Wu; long ldb; int h0;
  __device__ __forceinline__ u32x4 load(int kg, int c8) const { const int col = c8 * 8, w = col >> 6, xx = col & 63; const float* base = (xx < 32) ? Wg : Wu;
    const float* q = base + (size_t)kg * ldb + h0 + 32 * w + (xx & 31); const f32x4 a = *(const f32x4*)q, b = *(const f32x4*)(q + 4);
    u32x4 r; r.x = cvtpk(a[0], a[1]); r.y = cvtpk(a[2], a[3]); r.z = cvtpk(b[0], b[1]); r.w = cvtpk(b[2], b[3]); return r; } };

template <bool A_RES, class AL, class BL>
__device__ __forceinline__ void gemm_mainloop(f32x4 (&acc)[4][4], const AL& al, const BL& bl, int nk, lds_ptr stage, lds_ptr resA) {
  const int tid = ltid(), lane = tid & 63, wid = tid >> 6, wm = wid >> 2, wn = wid & 3, fr = lane & 15, fq = lane >> 4;
  const int ar = tid >> 2, ac = tid & 3;
  const int p0 = tid, p1 = tid + 512;
  const int bk0 = p0 >> 5, bc0 = p0 & 31, bk1 = p1 >> 5, bc1 = p1 & 31;
  const bf16_t* aptr = nullptr;
  if (!A_RES) aptr = al.rowptr(ar) + ac * 8;
  const int a_st = a_off(ar, ac);
  const int b_st0 = b_off(bk0, bc0 >> 1) + (bc0 & 1) * 16, b_st1 = b_off(bk1, bc1 >> 1) + (bc1 & 1) * 16;
  int a_rd[4];
#pragma unroll
  for (int mt = 0; mt < 4; ++mt) a_rd[mt] = a_off(wm * 64 + mt * 16 + fr, fq);
  int b_rd[4][2];
#pragma unroll
  for (int nt = 0; nt < 4; ++nt) {
    b_rd[nt][0] = b_off(8 * fq + (fr >> 2), wn * 4 + nt) + (fr & 3) * 8;
    b_rd[nt][1] = b_off(8 * fq + 4 + (fr >> 2), wn * 4 + nt) + (fr & 3) * 8;
  }
#pragma unroll
  for (int mt = 0; mt < 4; ++mt)
#pragma unroll
    for (int nt = 0; nt < 4; ++nt) acc[mt][nt] = (f32x4){0.f, 0.f, 0.f, 0.f};
  u32x4 areg = {0, 0, 0, 0}, breg0, breg1;
  if (!A_RES) areg = *(const u32x4*)aptr;
  breg0 = bl.load(bk0, bc0); breg1 = bl.load(bk1, bc1);
  __syncthreads();
  if (!A_RES) *(LAS u32x4*)(stage + a_st) = areg;
  *(LAS u32x4*)(stage + G_ASZ + b_st0) = breg0;
  *(LAS u32x4*)(stage + G_ASZ + b_st1) = breg1;
  __syncthreads();
  for (int kt = 0; kt < nk; ++kt) {
    const lds_ptr cur = stage + (kt & 1) * G_STAGE, nxt = stage + ((kt + 1) & 1) * G_STAGE;
    const bool more = kt + 1 < nk;
    if (more) {
      if (!A_RES) areg = *(const u32x4*)(aptr + (kt + 1) * 32);
      breg0 = bl.load((kt + 1) * 32 + bk0, bc0); breg1 = bl.load((kt + 1) * 32 + bk1, bc1);
    }
    s16x8 af[4], bfr[4];
    const lds_ptr abase = A_RES ? (resA + kt * G_ASZ) : cur;
#pragma unroll
    for (int mt = 0; mt < 4; ++mt) af[mt] = *(LAS s16x8*)(abase + a_rd[mt]);
#pragma unroll
    for (int nt = 0; nt < 4; ++nt) {
      const s16x4 lo = tr_read(cur + G_ASZ + b_rd[nt][0]), hi = tr_read(cur + G_ASZ + b_rd[nt][1]);
      bfr[nt] = __builtin_shufflevector(lo, hi, 0, 1, 2, 3, 4, 5, 6, 7);
    }
#pragma unroll
    for (int mt = 0; mt < 4; ++mt)
#pragma unroll
      for (int nt = 0; nt < 4; ++nt) acc[mt][nt] = __builtin_amdgcn_mfma_f32_16x16x32_bf16(bfr[nt], af[mt], acc[mt][nt], 0, 0, 0);
    if (more) {
      if (!A_RES) *(LAS u32x4*)(nxt + a_st) = areg;
      *(LAS u32x4*)(nxt + G_ASZ + b_st0) = breg0;
      *(LAS u32x4*)(nxt + G_ASZ + b_st1) = breg1;
    }
    __syncthreads();
  }
}


struct BRaw { f32x4 v[4]; };
struct BLoadF32R { const float* Bm; long ldb;
  __device__ __forceinline__ void load(BRaw& r, int kbase, int tid) const {
    const float* q = Bm + (size_t)(kbase + (tid >> 6)) * ldb + (tid & 63) * 4;
#pragma unroll
    for (int i = 0; i < 4; ++i) r.v[i] = *(const f32x4*)(q + (size_t)(8 * i) * ldb); } };
struct BLoadGUR { const float* Wg; long du; long ldb; int h0;
  __device__ __forceinline__ void load(BRaw& r, int kbase, int tid) const {
    const int col = (tid & 63) * 4, w = col >> 6, xx = col & 63;
    const float* q = Wg + ((xx < 32) ? 0l : du) + (size_t)(kbase + (tid >> 6)) * ldb + h0 + 32 * w + (xx & 31);
#pragma unroll
    for (int i = 0; i < 4; ++i) r.v[i] = *(const f32x4*)(q + (size_t)(8 * i) * ldb); } };
__device__ __forceinline__ u32x4 cvt8(const f32x4& a, const f32x4& b) { u32x4 r; r.x = cvtpk(a[0], a[1]); r.y = cvtpk(a[2], a[3]); r.z = cvtpk(b[0], b[1]); r.w = cvtpk(b[2], b[3]); return r; }

template <bool A_RES, class AL, class BL>
__device__ __forceinline__ void gemm_mainloop_r3(f32x4 (&acc)[4][4], const AL& al, const BL& bl, int nk, lds_ptr stage, lds_ptr resA) {
  const int tid = ltid(), lane = tid & 63, wid = tid >> 6, wm = wid >> 2, wn = wid & 3, fr = lane & 15, fq = lane >> 4;
  const int ar = tid >> 2, ac = tid & 3;
  const bf16_t* aptr = nullptr;
  if (!A_RES) aptr = al.rowptr(ar) + ac * 8;
  const int a_st = a_off(ar, ac);
  int b_st[4];
#pragma unroll
  for (int i = 0; i < 4; ++i) b_st[i] = G_ASZ + b_off((tid >> 6) + 8 * i, (tid & 63) >> 2) + (tid & 3) * 8;
  int a_rd[4];
#pragma unroll
  for (int mt = 0; mt < 4; ++mt) a_rd[mt] = a_off(wm * 64 + mt * 16 + fr, fq);
  int b_rd[4][2];
#pragma unroll
  for (int nt = 0; nt < 4; ++nt) {
    b_rd[nt][0] = G_ASZ + b_off(8 * fq + (fr >> 2), wn * 4 + nt) + (fr & 3) * 8;
    b_rd[nt][1] = G_ASZ + b_off(8 * fq + 4 + (fr >> 2), wn * 4 + nt) + (fr & 3) * 8;
  }
#pragma unroll
  for (int mt = 0; mt < 4; ++mt)
#pragma unroll
    for (int nt = 0; nt < 4; ++nt) acc[mt][nt] = (f32x4){0.f, 0.f, 0.f, 0.f};
  u32x4 ra0 = {0, 0, 0, 0}, ra1 = {0, 0, 0, 0}, ra2 = {0, 0, 0, 0};
  BRaw rb0, rb1, rb2;
#define R3_LOAD(RA, RB, kt_) do { if (!A_RES) RA = *(const u32x4*)(aptr + (size_t)(kt_) * 32); bl.load(RB, (kt_) * 32, tid); } while (0)
#define R3_STORE(RA, RB, st_) do { const lds_ptr s_ = stage + (st_) * G_STAGE; if (!A_RES) *(LAS u32x4*)(s_ + a_st) = RA; \
    _Pragma("unroll") for (int i_ = 0; i_ < 4; ++i_) { u32x2 o_; o_.x = cvtpk(RB.v[i_][0], RB.v[i_][1]); o_.y = cvtpk(RB.v[i_][2], RB.v[i_][3]); *(LAS u32x2*)(s_ + b_st[i_]) = o_; } } while (0)
#define R3_COMPUTE(kt_) do { const lds_ptr cur = stage + ((kt_) & 1) * G_STAGE; const lds_ptr abase = A_RES ? (resA + (kt_) * G_ASZ) : cur; \
    s16x8 af[4], bfr[4]; \
    _Pragma("unroll") for (int mt = 0; mt < 4; ++mt) af[mt] = *(LAS s16x8*)(abase + a_rd[mt]); \
    _Pragma("unroll") for (int nt = 0; nt < 4; ++nt) { const s16x4 lo = tr_read(cur + b_rd[nt][0]), hi = tr_read(cur + b_rd[nt][1]); bfr[nt] = __builtin_shufflevector(lo, hi, 0, 1, 2, 3, 4, 5, 6, 7); } \
    _Pragma("unroll") for (int mt = 0; mt < 4; ++mt) _Pragma("unroll") for (int nt = 0; nt < 4; ++nt) acc[mt][nt] = __builtin_amdgcn_mfma_f32_16x16x32_bf16(bfr[nt], af[mt], acc[mt][nt], 0, 0, 0); } while (0)
#define R3_BODY_U(kt_, RAN, RBN, RAW, RBW) do { const int kl_ = ((kt_) + 3 < nk) ? (kt_) + 3 : nk - 1; R3_LOAD(RAN, RBN, kl_); __builtin_amdgcn_sched_barrier(0); R3_COMPUTE(kt_); __builtin_amdgcn_sched_barrier(0); R3_STORE(RAW, RBW, ((kt_) + 1) & 1); __syncthreads(); } while (0)
#define R3_BODY_T(kt_, RAW, RBW) do { R3_COMPUTE(kt_); if ((kt_) + 1 < nk) R3_STORE(RAW, RBW, ((kt_) + 1) & 1); __syncthreads(); } while (0)
  R3_LOAD(ra0, rb0, 0);
  R3_LOAD(ra1, rb1, 1);
  R3_LOAD(ra2, rb2, 2);
  __syncthreads();
  R3_STORE(ra0, rb0, 0);
  __syncthreads();
  int kt = 0;
  for (; kt + 3 <= nk; kt += 3) {
    R3_BODY_U(kt, ra0, rb0, ra1, rb1);
    R3_BODY_U(kt + 1, ra1, rb1, ra2, rb2);
    R3_BODY_U(kt + 2, ra2, rb2, ra0, rb0);
  }
  if (kt < nk) { R3_BODY_T(kt, ra1, rb1); if (kt + 1 < nk) R3_BODY_T(kt + 1, ra2, rb2); }
#undef R3_BODY_U
#undef R3_BODY_T
#undef R3_LOAD
#undef R3_STORE
#undef R3_COMPUTE
}

constexpr int G_NST = 4;
#define WAIT_VM(n) asm volatile("s_waitcnt vmcnt(" #n ")" ::: "memory")
template <class AL>
__device__ __forceinline__ void gemm_mainloop_glds(f32x4 (&acc)[4][4], const AL& al, const bf16_t* __restrict__ Bm, long ldb, int nk, lds_ptr ring) {
  const int tid = ltid(), lane = tid & 63, wid = tid >> 6, wm = wid >> 2, wn = wid & 3, fr = lane & 15, fq = lane >> 4;
  const int ar = tid >> 2;
  const bf16_t* aptr = al.rowptr(ar) + (((tid & 3) ^ ((0x78 >> (((ar >> 2) & 3) * 2)) & 3)) << 3);
  const int bk = tid >> 5, pc = tid & 31;
  const int bcol = ((((pc >> 1) ^ ((bk & 3) | (((bk >> 3) & 1) << 2))) << 4) | ((pc & 1) << 3));
  const bf16_t* bptr0 = Bm + (size_t)bk * ldb + bcol;
  const bf16_t* bptr1 = bptr0 + (size_t)16 * ldb;
  const size_t bstep = (size_t)32 * ldb;
  int a_rd[4];
#pragma unroll
  for (int mt = 0; mt < 4; ++mt) a_rd[mt] = a_off(wm * 64 + mt * 16 + fr, fq);
  int b_rd[4][2];
#pragma unroll
  for (int nt = 0; nt < 4; ++nt) {
    b_rd[nt][0] = G_ASZ + b_off(8 * fq + (fr >> 2), wn * 4 + nt) + (fr & 3) * 8;
    b_rd[nt][1] = G_ASZ + b_off(8 * fq + 4 + (fr >> 2), wn * 4 + nt) + (fr & 3) * 8;
  }
#pragma unroll
  for (int mt = 0; mt < 4; ++mt)
#pragma unroll
    for (int nt = 0; nt < 4; ++nt) acc[mt][nt] = (f32x4){0.f, 0.f, 0.f, 0.f};
  const lds_ptr dstl = ring + tid * 16;
#define GLDS_ISSUE(kt_) do { const lds_ptr d_ = dstl + ((kt_) & (G_NST - 1)) * G_STAGE; \
    __builtin_amdgcn_global_load_lds((const unsigned*)(aptr + (size_t)(kt_) * 32), (LAS unsigned*)(d_), 16, 0, 0); \
    __builtin_amdgcn_global_load_lds((const unsigned*)(bptr0 + (size_t)(kt_) * bstep), (LAS unsigned*)(d_ + G_ASZ), 16, 0, 0); \
    __builtin_amdgcn_global_load_lds((const unsigned*)(bptr1 + (size_t)(kt_) * bstep), (LAS unsigned*)(d_ + G_ASZ + 8192), 16, 0, 0); } while (0)
  __syncthreads();
  GLDS_ISSUE(0);
  if (nk > 1) GLDS_ISSUE(1);
  if (nk > 2) GLDS_ISSUE(2);
  for (int kt = 0; kt < nk; ++kt) {
    if (kt + 2 < nk) WAIT_VM(6); else if (kt + 1 < nk) WAIT_VM(3); else WAIT_VM(0);
    __builtin_amdgcn_s_barrier();
    if (kt + 3 < nk) GLDS_ISSUE(kt + 3);
    const lds_ptr cur = ring + (kt & (G_NST - 1)) * G_STAGE;
    s16x8 af[4], bfr[4];
#pragma unroll
    for (int mt = 0; mt < 4; ++mt) af[mt] = *(LAS s16x8*)(cur + a_rd[mt]);
#pragma unroll
    for (int nt = 0; nt < 4; ++nt) {
      const s16x4 lo = tr_read(cur + b_rd[nt][0]), hi = tr_read(cur + b_rd[nt][1]);
      bfr[nt] = __builtin_shufflevector(lo, hi, 0, 1, 2, 3, 4, 5, 6, 7);
    }
#pragma unroll
    for (int mt = 0; mt < 4; ++mt)
#pragma unroll
      for (int nt = 0; nt < 4; ++nt) acc[mt][nt] = __builtin_amdgcn_mfma_f32_16x16x32_bf16(bfr[nt], af[mt], acc[mt][nt], 0, 0, 0);
  }
#undef GLDS_ISSUE
}


constexpr int G2_STAGE = 2 * G_ASZ + G_BSZ;
__device__ __forceinline__ void gemm_mainloop_glds256(f32x4 (&acc)[8][4], const bf16_t* __restrict__ A, long lda, const bf16_t* __restrict__ Bm, long ldb, int nk, lds_ptr ring) {
  const int tid = ltid(), lane = tid & 63, wid = tid >> 6, wm = wid >> 2, wn = wid & 3, fr = lane & 15, fq = lane >> 4;
  const int ar = tid >> 2;
  const bf16_t* aptr0 = A + (size_t)ar * lda + (((tid & 3) ^ ((0x78 >> (((ar >> 2) & 3) * 2)) & 3)) << 3);
  const bf16_t* aptr1 = aptr0 + (size_t)128 * lda;
  const int bk = tid >> 5, pc = tid & 31;
  const int bcol = ((((pc >> 1) ^ ((bk & 3) | (((bk >> 3) & 1) << 2))) << 4) | ((pc & 1) << 3));
  const bf16_t* bptr0 = Bm + (size_t)bk * ldb + bcol;
  const bf16_t* bptr1 = bptr0 + (size_t)16 * ldb;
  const size_t bstep = (size_t)32 * ldb;
  int a_rd[8];
#pragma unroll
  for (int mt = 0; mt < 8; ++mt) a_rd[mt] = wm * G_ASZ + a_off(mt * 16 + fr, fq);
  int b_rd[4][2];
#pragma unroll
  for (int nt = 0; nt < 4; ++nt) {
    b_rd[nt][0] = 2 * G_ASZ + b_off(8 * fq + (fr >> 2), wn * 4 + nt) + (fr & 3) * 8;
    b_rd[nt][1] = 2 * G_ASZ + b_off(8 * fq + 4 + (fr >> 2), wn * 4 + nt) + (fr & 3) * 8;
  }
#pragma unroll
  for (int mt = 0; mt < 8; ++mt)
#pragma unroll
    for (int nt = 0; nt < 4; ++nt) acc[mt][nt] = (f32x4){0.f, 0.f, 0.f, 0.f};
  const lds_ptr dstl = ring + tid * 16;
#define GLDS2_ISSUE(kt_) do { const lds_ptr d_ = dstl + ((kt_) & (G_NST - 1)) * G2_STAGE; \
    __builtin_amdgcn_global_load_lds((const unsigned*)(aptr0 + (size_t)(kt_) * 32), (LAS unsigned*)(d_), 16, 0, 0); \
    __builtin_amdgcn_global_load_lds((const unsigned*)(aptr1 + (size_t)(kt_) * 32), (LAS unsigned*)(d_ + G_ASZ), 16, 0, 0); \
    __builtin_amdgcn_global_load_lds((const unsigned*)(bptr0 + (size_t)(kt_) * bstep), (LAS unsigned*)(d_ + 2 * G_ASZ), 16, 0, 0); \
    __builtin_amdgcn_global_load_lds((const unsigned*)(bptr1 + (size_t)(kt_) * bstep), (LAS unsigned*)(d_ + 2 * G_ASZ + 8192), 16, 0, 0); } while (0)
  __syncthreads();
  GLDS2_ISSUE(0);
  if (nk > 1) GLDS2_ISSUE(1);
  if (nk > 2) GLDS2_ISSUE(2);
  for (int kt = 0; kt < nk; ++kt) {
    if (kt + 2 < nk) WAIT_VM(8); else if (kt + 1 < nk) WAIT_VM(4); else WAIT_VM(0);
    __builtin_amdgcn_s_barrier();
    if (kt + 3 < nk) GLDS2_ISSUE(kt + 3);
    const lds_ptr cur = ring + (kt & (G_NST - 1)) * G2_STAGE;
    s16x8 bfr[4];
#pragma unroll
    for (int nt = 0; nt < 4; ++nt) {
      const s16x4 lo = tr_read(cur + b_rd[nt][0]), hi = tr_read(cur + b_rd[nt][1]);
      bfr[nt] = __builtin_shufflevector(lo, hi, 0, 1, 2, 3, 4, 5, 6, 7);
    }
#pragma unroll
    for (int h = 0; h < 2; ++h) {
      s16x8 af[4];
#pragma unroll
      for (int mt = 0; mt < 4; ++mt) af[mt] = *(LAS s16x8*)(cur + a_rd[h * 4 + mt]);
#pragma unroll
      for (int mt = 0; mt < 4; ++mt)
#pragma unroll
        for (int nt = 0; nt < 4; ++nt) acc[h * 4 + mt][nt] = __builtin_amdgcn_mfma_f32_16x16x32_bf16(bfr[nt], af[mt], acc[h * 4 + mt][nt], 0, 0, 0);
    }
  }
#undef GLDS2_ISSUE
}

__device__ __forceinline__ void tile_map(int round, int bid, int nb, int nMt, int nNt, int& mt, int& nt, bool& valid) {
  if (nb == 256 && (nNt & 3) == 0 && (nMt & 7) == 0) {
    const int xcd = bid & 7, j = bid >> 3, q = round * 8 + xcd, rn = nNt >> 2;
    const int rect_m = q / rn, rect_n = q % rn;
    mt = rect_m * 8 + (j & 7); nt = rect_n * 4 + (j >> 3); valid = mt < nMt;
  } else {
    const int per = (nb + 7) / 8, xcd = bid & 7, j = bid >> 3;
    const int idx = round * nb + xcd * per + j;
    mt = idx / nNt; nt = idx % nNt; valid = (j < per) && (idx < nMt * nNt) && (xcd * per + j < nb);
  }
}

__device__ __forceinline__ void cvt_copy(const float* __restrict__ src, long lds_, bf16_t* __restrict__ dst, long ldd, int rows, int cols, int gtid, int gsz) {
  const int c4 = cols >> 2;
  for (long i = gtid; i < (long)rows * c4; i += gsz) {
    const int r = (int)(i / c4), c = (int)(i % c4) * 4;
    const f32x4 v = *(const f32x4*)(src + (size_t)r * lds_ + c);
    u32x2 o; o.x = cvtpk(v[0], v[1]); o.y = cvtpk(v[2], v[3]);
    *(u32x2*)(dst + (size_t)r * ldd + c) = o;
  }
}
__device__ __forceinline__ void phase_prep(PR p, int bid, int nb, lds_ptr smem) {
  const int gtid = bid * NTHR + ltid(), gsz = nb * NTHR;
  cvt_copy(p.w_in, INW, p.wb_in, LDP, D, WIN_GK, gtid, gsz);
  cvt_copy(p.w_in + WIN_GK + 16, INW, p.wb_in + WIN_GK, LDP, D, LDP - WIN_GK, gtid, gsz);
  cvt_copy(p.w_glu, S5W, p.wb_glu, S5W, S5W, S5W, gtid, gsz);
  cvt_copy(p.w_proj_a, D, p.wb_pa, D, S5W, D, gtid, gsz);
  cvt_copy(p.w_proj_b, D, p.wb_pb, D, GVAL, D, gtid, gsz);
  cvt_copy(p.w_out, D, p.wb_out, D, D, D, gtid, gsz);
  cvt_copy(p.router_w, NE, p.wb_rs, 768, D, NE, gtid, gsz);
  cvt_copy(p.sw_down, D, p.wb_sd, D, SFF, D, gtid, gsz);
  for (long i = gtid; i < (long)D * 512; i += gsz) {
    const int k = (int)(i >> 9), cc = (int)(i & 511), w = cc >> 6, xx = cc & 63;
    const int hcol = 32 * w + (xx & 31);
    const float v = (xx < 32) ? p.sw_gate[(size_t)k * SFF + hcol] : p.sw_up[(size_t)k * SFF + hcol];
    p.wb_rs[(size_t)k * 768 + 256 + cc] = f2bf(v);
  }
  for (int i = gtid; i < 16 * D; i += gsz) { const int n = i >> 10, k = i & 1023; p.wgkT[i] = f2bf(p.w_in[(size_t)k * INW + WIN_GK + n]); }
  for (int i = gtid; i < NSLOT; i += gsz) p.slot_tok[i] = -1;
  if (gtid < 256) p.counts[gtid] = 0;
  if (gtid < 16) p.moe_ctr[gtid] = 0;
  if (ltid() < 8 && bid * 8 + ltid() < S5G * S5P) {
    const int i = bid * 8 + ltid(), g = i / S5P;
    const double lr = p.lam_re[i], li = p.lam_im[i], dt = (double)__expf(p.log_dt[g]);
    const double TWO_PI = 6.283185307179586476925286766559;
    double ang = li * dt; ang -= TWO_PI * floor(ang / TWO_PI);
    const double mag = (double)__expf((float)(lr * dt));
    const double are = mag * (double)cosf((float)ang), aim = mag * (double)sinf((float)ang);
    const double den = lr * lr + li * li, nre = are - 1.0;
    const double cre = (nre * lr + aim * li) / den, cim = (aim * lr - nre * li) / den;
    p.abar[i * 2] = (float)are; p.abar[i * 2 + 1] = (float)aim;
    for (int h = 0; h < S5H; ++h) {
      const double br = p.b_re[i * S5H + h], bi = p.b_im[i * S5H + h];
      p.bbar[(i * S5H + h) * 2] = (float)(cre * br - cim * bi);
      p.bbar[(i * S5H + h) * 2 + 1] = (float)(cre * bi + cim * br);
      const int pq = i & 63;
      p.bbarT[(size_t)(g * 128 + 2 * pq) * 16 + h] = f2bf((float)(cre * br - cim * bi));
      p.bbarT[(size_t)(g * 128 + 2 * pq + 1) * 16 + h] = f2bf((float)(cre * bi + cim * br));
    }
    double a64 = 64.0 * li * dt; a64 -= TWO_PI * floor(a64 / TWO_PI);
    const double m64 = (double)__expf((float)(64.0 * lr * dt));
    p.apow64[i * 2] = (float)(m64 * (double)cosf((float)a64)); p.apow64[i * 2 + 1] = (float)(m64 * (double)sinf((float)a64));
  }
  for (int i = gtid; i < S5G * S5H * 128; i += gsz) {
    const int pp = i & 127, ho = (i >> 7) & 15, g = i >> 11;
    p.cmT[i] = f2bf((pp & 1) ? -p.c_im[(g * 16 + ho) * 64 + (pp >> 1)] : p.c_re[(g * 16 + ho) * 64 + (pp >> 1)]);
  }
  LAS float* red = (LAS float*)smem;
  LAS float* sc = (LAS float*)(smem + 16384);
  if (bid < 192) {
    __syncthreads();
    for (int i = ltid(); i < 8 * D; i += NTHR) sc[i] = siluf_(p.c[i]);
    __syncthreads();
  }
  for (int item = bid; item < 192; item += nb) {
    const int cl = ltid() & 31, kg = ltid() >> 5, col = item * 32 + cl;
    float acc[8];
#pragma unroll
    for (int b = 0; b < 8; ++b) acc[b] = 0.f;
    const float* wp = p.ada_w + (size_t)(kg * 64) * 6144 + col;
#pragma unroll 1
    for (int k0 = 0; k0 < 64; k0 += 16) {
      float w[16];
#pragma unroll
      for (int q = 0; q < 16; ++q) w[q] = wp[(size_t)(k0 + q) * 6144];
#pragma unroll
      for (int q = 0; q < 16; ++q)
#pragma unroll
        for (int b = 0; b < 8; ++b) acc[b] += sc[b * D + kg * 64 + k0 + q] * w[q];
    }
    __syncthreads();
#pragma unroll
    for (int b = 0; b < 8; ++b) red[(kg * 8 + b) * 32 + cl] = acc[b];
    __syncthreads();
    if (ltid() < 256) {
      const int b = ltid() >> 5, c2 = ltid() & 31;
      float sum = p.ada_b[item * 32 + c2];
      for (int q = 0; q < 16; ++q) sum += red[(q * 8 + b) * 32 + c2];
      p.mod[b * 6144 + item * 32 + c2] = sum;
    }
  }
}

template <bool WITH_GK>
__device__ __forceinline__ void phase_norm(PR p, const float* __restrict__ xin, const float* __restrict__ g, int sh_off, int sc_off, bf16_t* __restrict__ outp, int bid, int nb, lds_ptr smem) {
  const int lane = ltid() & 63, wid = ltid() >> 6;
  const int stride = nb * 8;
  int row = bid * 8 + wid;
  f32x4 nx[4];
  if (row < T) {
#pragma unroll
    for (int i = 0; i < 4; ++i) nx[i] = *(const f32x4*)(xin + (size_t)row * D + lane * 4 + 256 * i);
  }
  f32x4 gv[4];
#pragma unroll
  for (int i = 0; i < 4; ++i) gv[i] = *(const f32x4*)(g + lane * 4 + 256 * i);
  for (; row < T; row += stride) {
    const int b = row / SEQ;
    f32x4 v[4];
#pragma unroll
    for (int i = 0; i < 4; ++i) v[i] = nx[i];
    const int rn = row + stride;
    if (rn < T) {
#pragma unroll
      for (int i = 0; i < 4; ++i) nx[i] = *(const f32x4*)(xin + (size_t)rn * D + lane * 4 + 256 * i);
    }
    float ss = 0.f;
#pragma unroll
    for (int i = 0; i < 4; ++i) ss += v[i][0] * v[i][0] + v[i][1] * v[i][1] + v[i][2] * v[i][2] + v[i][3] * v[i][3];
#pragma unroll
    for (int o = 32; o > 0; o >>= 1) ss += __shfl_xor(ss, o);
    const float r = rsqrtf(ss * (1.f / D) + 1e-6f);
#pragma unroll
    for (int i = 0; i < 4; ++i) {
      const int c0 = lane * 4 + 256 * i;
      const f32x4 scv = *(const f32x4*)(p.mod + b * 6144 + sc_off + c0), shv = *(const f32x4*)(p.mod + b * 6144 + sh_off + c0);
      float y[4];
#pragma unroll
      for (int j = 0; j < 4; ++j) y[j] = (v[i][j] * r) * gv[i][j] * (1.f + scv[j]) + shv[j];
      u32x2 o; o.x = cvtpk(y[0], y[1]); o.y = cvtpk(y[2], y[3]);
      *(u32x2*)(outp + (size_t)row * D + c0) = o;
    }
  }
}

struct EpiStoreBf {
  bf16_t* O; long ld;
  template <int MT> __device__ __forceinline__ void operator()(const f32x4 (&acc)[MT][4], int mbase, int nbase, int fr, int fq) const {
    bf16_t* rowp = O + (size_t)(mbase + fr) * ld + nbase + fq * 4;
#pragma unroll
    for (int mt = 0; mt < MT; ++mt) {
#pragma unroll
      for (int nt = 0; nt < 4; ++nt) { const f32x4 v = acc[mt][nt]; u32x2 o; o.x = cvtpk(v[0], v[1]); o.y = cvtpk(v[2], v[3]);
        *(u32x2*)(rowp + nt * 16) = o; }
      rowp += 16 * ld;
      __builtin_amdgcn_sched_barrier(0); }
  }
};
__device__ __forceinline__ f32x4 ld_bf4(const bf16_t* q) { const u32x2 w = *(const u32x2*)q; f32x4 r; r[0] = __uint_as_float(w.x << 16); r[1] = __uint_as_float(w.x & 0xffff0000u); r[2] = __uint_as_float(w.y << 16); r[3] = __uint_as_float(w.y & 0xffff0000u); return r; }
struct EpiGlu {
  const bf16_t* yA; const float* b; bf16_t* z;
  template <int MT> __device__ __forceinline__ void operator()(const f32x4 (&acc)[MT][4], int mbase, int nbase, int fr, int fq) const {
#pragma unroll
    for (int mt = 0; mt < MT; ++mt) {
#pragma unroll
      for (int nt = 0; nt < 4; ++nt) { const int row = mbase + mt * 16 + fr, col = nbase + nt * 16 + fq * 4; const f32x4 v = acc[mt][nt];
        const f32x4 y = ld_bf4(yA + (size_t)row * S5W + col); const f32x4 bb = *(const f32x4*)(b + col);
        u32x2 o; o.x = cvtpk(y[0] * sigmoidf_(v[0] + bb[0]), y[1] * sigmoidf_(v[1] + bb[1])); o.y = cvtpk(y[2] * sigmoidf_(v[2] + bb[2]), y[3] * sigmoidf_(v[3] + bb[3]));
        *(u32x2*)(z + (size_t)row * S5W + col) = o; }
      __builtin_amdgcn_sched_barrier(0); }
  }
};
struct EpiOut {
  const float* x; const float* mod; float* x1;
  template <int MT> __device__ __forceinline__ void operator()(const f32x4 (&acc)[MT][4], int mbase, int nbase, int fr, int fq) const {
#pragma unroll
    for (int mt = 0; mt < MT; ++mt) {
#pragma unroll
      for (int nt = 0; nt < 4; ++nt) { const int row = mbase + mt * 16 + fr, col = nbase + nt * 16 + fq * 4, b = row / SEQ; const f32x4 v = acc[mt][nt];
        const f32x4 xv = *(const f32x4*)(x + (size_t)row * D + col), gg = *(const f32x4*)(mod + b * 6144 + 2 * D + col);
        f32x4 o; o[0] = xv[0] + gg[0] * v[0]; o[1] = xv[1] + gg[1] * v[1]; o[2] = xv[2] + gg[2] * v[2]; o[3] = xv[3] + gg[3] * v[3];
        *(f32x4*)(x1 + (size_t)row * D + col) = o; }
      __builtin_amdgcn_sched_barrier(0); }
  }
};

template <class Epi>
__device__ __forceinline__ void phase_gemm_dense(const bf16_t* A, long lda, const bf16_t* Bm, long ldb, int M, int N, int K, const Epi& epi, int bid, int nb, lds_ptr smem) {
  const int nMt = M / 128, nNt = N / 256, ntiles = nMt * nNt, rounds = (ntiles + nb - 1) / nb;
  const int lane = ltid() & 63, wid = ltid() >> 6, wm = wid >> 2, wn = wid & 3, fr = lane & 15, fq = lane >> 4;
  for (int r = 0; r < rounds; ++r) {
    int mt, nt; bool valid; tile_map(r, bid, nb, nMt, nNt, mt, nt, valid);
    if (!valid) continue;
    f32x4 acc[4][4];
    ALoadDense al{A + (size_t)mt * 128 * lda, lda};
    gemm_mainloop_glds(acc, al, Bm + nt * 256, ldb, K / 32, smem);
    epi.template operator()<4>(acc, mt * 128 + wm * 64, nt * 256 + wn * 64, fr, fq);
  }
}


template <class Epi>
__device__ __forceinline__ void phase_gemm_dense256(const bf16_t* A, long lda, const bf16_t* Bm, long ldb, int M, int N, int K, const Epi& epi, int bid, int nb, lds_ptr smem) {
  const int nMt = M / 256, nNt = N / 256, ntiles = nMt * nNt, rounds = (ntiles + nb - 1) / nb;
  const int lane = ltid() & 63, wid = ltid() >> 6, wm = wid >> 2, wn = wid & 3, fr = lane & 15, fq = lane >> 4;
  for (int r = 0; r < rounds; ++r) {
    int mt, nt; bool valid; tile_map(r, bid, nb, nMt, nNt, mt, nt, valid);
    if (!valid) continue;
    f32x4 acc[8][4];
    gemm_mainloop_glds256(acc, A + (size_t)mt * 256 * lda, lda, Bm + nt * 256, ldb, K / 32, smem);
    epi.template operator()<8>(acc, mt * 256 + wm * 128, nt * 256 + wn * 64, fr, fq);
  }
}


constexpr int ST_ROW = 528;
__device__ __forceinline__ void phase_gemm_dense256_bf16(const bf16_t* A, long lda, const bf16_t* Bm, long ldb, int M, int N, int K, bf16_t* O, long ldo, int bid, int nb, lds_ptr smem) {
  const int nMt = M / 256, nNt = N / 256, ntiles = nMt * nNt, rounds = (ntiles + nb - 1) / nb;
  for (int r = 0; r < rounds; ++r) {
    int mt, nt; bool valid; tile_map(r, bid, nb, nMt, nNt, mt, nt, valid);
    if (!valid) continue;
    f32x4 acc[8][4];
    gemm_mainloop_glds256(acc, A + (size_t)mt * 256 * lda, lda, Bm + nt * 256, ldb, K / 32, smem);
    const int t1 = ltid(), l1 = t1 & 63, w1 = t1 >> 6, wm = w1 >> 2;
    bf16_t* ob = O + (size_t)(mt * 256) * ldo + nt * 256 + (t1 & 31) * 8;
#pragma unroll
    for (int h = 0; h < 2; ++h) {
      __syncthreads();
      if (wm == h) {
#pragma unroll
        for (int i = 0; i < 8; ++i)
#pragma unroll
          for (int j = 0; j < 4; ++j) { const f32x4 v = acc[i][j]; u32x2 o; o.x = cvtpk(v[0], v[1]); o.y = cvtpk(v[2], v[3]);
            *(LAS u32x2*)(smem + (i * 16 + (l1 & 15)) * ST_ROW + ((w1 & 3) * 64 + j * 16 + (l1 >> 4) * 4) * 2) = o; }
      }
      __syncthreads();
#pragma unroll
      for (int ps = 0; ps < 8; ++ps) {
        const int row = ps * 16 + (t1 >> 5);
        *(u32x4*)(ob + (size_t)(h * 128 + row) * ldo) = *(LAS u32x4*)(smem + row * ST_ROW + (t1 & 31) * 16);
      }
    }
  }
}

__device__ __forceinline__ void gk_rows(PR p, int bid, int nb) {
  const int lane = ltid() & 63, wid = ltid() >> 6, fr = lane & 15, fq = lane >> 4;
  if (wid >= 4) return;
  for (int r0 = (bid * 4 + wid) * 16; r0 < T; r0 += nb * 64) {
    const bf16_t* ap = p.h1 + (size_t)(r0 + fr) * D + fq * 8;
    const bf16_t* bp = p.wgkT + (size_t)fr * D + fq * 8;
    f32x4 acc = {0.f, 0.f, 0.f, 0.f};
#pragma unroll 1
    for (int k0 = 0; k0 < 32; k0 += 8) {
      s16x8 a[8], b[8];
#pragma unroll
      for (int q = 0; q < 8; ++q) { a[q] = *(const s16x8*)(ap + (k0 + q) * 32); b[q] = *(const s16x8*)(bp + (k0 + q) * 32); }
#pragma unroll
      for (int q = 0; q < 8; ++q) acc = __builtin_amdgcn_mfma_f32_16x16x32_bf16(a[q], b[q], acc, 0, 0, 0);
    }
#pragma unroll
    for (int j = 0; j < 4; ++j) p.gkl[(size_t)(r0 + 4 * fq + j) * 16 + fr] = acc[j];
  }
}

__device__ __forceinline__ void phase_gemm_mixed(PR p, int bid, int nb, lds_ptr smem) {
  const int nMt = T / 128, nNt = D / 256, ntiles = nMt * nNt, rounds = (ntiles + nb - 1) / nb;
  const int lane = ltid() & 63, wid = ltid() >> 6, wm = wid >> 2, wn = wid & 3, fr = lane & 15, fq = lane >> 4;
  for (int r = 0; r < rounds; ++r) {
    int mt, nt; bool valid; tile_map(r, bid, nb, nMt, nNt, mt, nt, valid);
    if (!valid) continue;
    const int mbase = mt * 128 + wm * 64, nbase = nt * 256 + wn * 64;
    const bf16_t* gp = p.proj + (size_t)(mbase + fr) * LDP + nbase + fq * 4;
    u32x2 gte[4][4], pk[4][4];
#pragma unroll
    for (int i = 0; i < 4; ++i)
#pragma unroll
      for (int j = 0; j < 4; ++j) gte[i][j] = *(const u32x2*)(gp + (size_t)(i * 16) * LDP + OFF_GA + j * 16);
    f32x4 acc[4][4];
    { ALoadDense al{p.zA + (size_t)mt * 128 * S5W, S5W}; gemm_mainloop_glds(acc, al, p.wb_pa + nt * 256, D, S5W / 32, smem); }
#pragma unroll
    for (int i = 0; i < 4; ++i)
#pragma unroll
      for (int j = 0; j < 4; ++j) {
        const float g0 = __uint_as_float(gte[i][j].x << 16), g1 = __uint_as_float(gte[i][j].x & 0xffff0000u), g2 = __uint_as_float(gte[i][j].y << 16), g3 = __uint_as_float(gte[i][j].y & 0xffff0000u);
        pk[i][j].x = cvtpk(acc[i][j][0] * sigmoidf_(g0), acc[i][j][1] * sigmoidf_(g1)); pk[i][j].y = cvtpk(acc[i][j][2] * sigmoidf_(g2), acc[i][j][3] * sigmoidf_(g3)); }
#pragma unroll
    for (int i = 0; i < 4; ++i)
#pragma unroll
      for (int j = 0; j < 4; ++j) gte[i][j] = *(const u32x2*)(gp + (size_t)(i * 16) * LDP + OFF_GB + j * 16);
    { ALoadDense al{p.yB + (size_t)mt * 128 * GVAL, GVAL}; gemm_mainloop_glds(acc, al, p.wb_pb + nt * 256, D, GVAL / 32, smem); }
    bf16_t* op = p.mixed + (size_t)(mbase + fr) * D + nbase + fq * 4;
#pragma unroll
    for (int i = 0; i < 4; ++i)
#pragma unroll
      for (int j = 0; j < 4; ++j) {
        const float g0 = __uint_as_float(gte[i][j].x << 16), g1 = __uint_as_float(gte[i][j].x & 0xffff0000u), g2 = __uint_as_float(gte[i][j].y << 16), g3 = __uint_as_float(gte[i][j].y & 0xffff0000u);
        const float a0 = __uint_as_float(pk[i][j].x << 16), a1 = __uint_as_float(pk[i][j].x & 0xffff0000u), a2 = __uint_as_float(pk[i][j].y << 16), a3 = __uint_as_float(pk[i][j].y & 0xffff0000u);
        u32x2 o; o.x = cvtpk(a0 + sigmoidf_(g0) * acc[i][j][0], a1 + sigmoidf_(g1) * acc[i][j][1]); o.y = cvtpk(a2 + sigmoidf_(g2) * acc[i][j][2], a3 + sigmoidf_(g3) * acc[i][j][3]);
        *(u32x2*)(op + (size_t)(i * 16) * D + j * 16) = o; }
  }
}

__device__ __forceinline__ void phase_gemm_rs(PR p, int bid, int nb, lds_ptr smem) {
  const int nMt = T / 256, nNt = 3, ntiles = nMt * nNt, rounds = (ntiles + nb - 1) / nb;
  const int lane = ltid() & 63, wid = ltid() >> 6, wm = wid >> 2, wn = wid & 3, fr = lane & 15, fq = lane >> 4;
  for (int r = 0; r < rounds; ++r) {
    int mt, nt; bool valid; tile_map(r, bid, nb, nMt, nNt, mt, nt, valid);
    if (!valid) continue;
    f32x4 acc[8][4];
    gemm_mainloop_glds256(acc, p.h2 + (size_t)mt * 256 * D, D, p.wb_rs + nt * 256, 768, D / 32, smem);
    const int mbase = mt * 256 + wm * 128;
    if (nt == 0) {
#pragma unroll
      for (int i = 0; i < 8; ++i) {
#pragma unroll
        for (int j = 0; j < 4; ++j) *(f32x4*)(p.logits + (size_t)(mbase + i * 16 + fr) * NE + wn * 64 + j * 16 + fq * 4) = acc[i][j];
        __builtin_amdgcn_sched_barrier(0); }
    } else {
      const int h0 = (nt - 1) * 128 + wn * 32;
#pragma unroll
      for (int i = 0; i < 8; ++i) {
#pragma unroll
        for (int j = 0; j < 2; ++j) { const f32x4 gv = acc[i][j], uv = acc[i][j + 2];
          u32x2 o; o.x = cvtpk(siluf_(gv[0]) * uv[0], siluf_(gv[1]) * uv[1]); o.y = cvtpk(siluf_(gv[2]) * uv[2], siluf_(gv[3]) * uv[3]);
          *(u32x2*)(p.shH + (size_t)(mbase + i * 16 + fr) * SFF + h0 + j * 16 + fq * 4) = o; }
        __builtin_amdgcn_sched_barrier(0); }
    }
  }
}

constexpr int MOE_H_OFF = 2 * G_STAGE;
constexpr int MOE_TOK_OFF = MOE_H_OFF + 65536;
constexpr int SMEM_BYTES = 139264;
__device__ __forceinline__ void phase_moe(PR p, int bid, int nb, lds_ptr smem) {
  const int lane = ltid() & 63, wid = ltid() >> 6, wm = wid >> 2, wn = wid & 3, fr = lane & 15, fq = lane >> 4;
  LAS int* toks = (LAS int*)(smem + MOE_TOK_OFF);
  const lds_ptr Hs = smem + MOE_H_OFF;
  LAS int* qi = (LAS int*)(smem + MOE_TOK_OFF + 512);
  for (int sx = 0; sx < 8; ++sx) {
   const int x = (bid + sx) & 7;
   const int cnt = p.moe_cnt[x];
   for (;;) {
    __syncthreads();
    if (ltid() == 0) qi[0] = atomicAdd(&p.moe_ctr[x], 1);
    __syncthreads();
    const int qidx = qi[0];
    if (qidx >= cnt) break;
    const int blk = p.moe_list[x * NBLK128 + qidx];
    const int e = p.blk_exp[blk];
    if (ltid() < 128) toks[ltid()] = p.slot_tok[blk * 128 + ltid()];
    __syncthreads();
    const float* Wg = p.ew_gate + (size_t)e * D * EFF; const float* Wu = p.ew_up + (size_t)e * D * EFF; const float* Wd = p.ew_down + (size_t)e * EFF * D;
    for (int hp2 = 0; hp2 < 2 * MOE_REP_GU; ++hp2) { const int hp = hp2 & 1;
      f32x4 acc[4][4];
      ALoadGatherLds al2{p.h2, toks};
      BLoadGUR bl{Wg, (long)(Wu - Wg), EFF, hp * 128};
      gemm_mainloop_r3<false>(acc, al2, bl, D / 32, smem, smem);
#pragma unroll
      for (int i = 0; i < 4; ++i)
#pragma unroll
        for (int j = 0; j < 2; ++j) { const f32x4 gv = acc[i][j], uv = acc[i][j + 2]; const int row = wm * 64 + i * 16 + fr, hc = hp * 128 + wn * 32 + j * 16 + fq * 4;
          u32x2 o; o.x = cvtpk(siluf_(gv[0]) * uv[0], siluf_(gv[1]) * uv[1]); o.y = cvtpk(siluf_(gv[2]) * uv[2], siluf_(gv[3]) * uv[3]);
          *(LAS u32x2*)(Hs + (hc >> 5) * G_ASZ + a_off(row, (hc & 31) >> 3) + (hc & 7) * 2) = o; }
    }
    for (int np2 = 0; np2 < 4 * MOE_REP_DN; ++np2) { const int np = np2 & 3;
      f32x4 acc[4][4];
      ALoadDense al{nullptr, 0};
      BLoadF32R bl{Wd + np * 256, D};
      gemm_mainloop_r3<true>(acc, al, bl, EFF / 32, smem, Hs);
#pragma unroll
      for (int i = 0; i < 4; ++i) {
        const int rl = wm * 64 + i * 16 + fr;
        if (toks[rl] >= 0) {
#pragma unroll
          for (int j = 0; j < 4; ++j) { const f32x4 v = acc[i][j]; u32x2 o; o.x = cvtpk(v[0], v[1]); o.y = cvtpk(v[2], v[3]);
            *(u32x2*)(p.Y + (size_t)(blk * 128 + rl) * D + np * 256 + wn * 64 + j * 16 + fq * 4) = o; }
        }
      }
    }
   }
  }
}

struct BStreamGU { const float* Wg; long du; int hp0;
  __device__ __forceinline__ void load(BRaw& r, int s, int tid) const {
    const int hp = hp0 + (s >> 5), kbase = (s & 31) * 32;
    const int col = (tid & 63) * 4, w = col >> 6, xx = col & 63;
    const float* q = Wg + ((xx < 32) ? 0l : du) + (size_t)(kbase + (tid >> 6)) * EFF + hp * 128 + 32 * w + (xx & 31);
#pragma unroll
    for (int i = 0; i < 4; ++i) r.v[i] = *(const f32x4*)(q + (size_t)(8 * i) * EFF); } };
struct BStreamDown { const float* Wd; int np0;
  __device__ __forceinline__ void load(BRaw& r, int s, int tid) const {
    const int np = np0 + (s >> 3), kbase = (s & 7) * 32;
    const float* q = Wd + (size_t)(kbase + (tid >> 6)) * D + np * 256 + (tid & 63) * 4;
#pragma unroll
    for (int i = 0; i < 4; ++i) r.v[i] = *(const f32x4*)(q + (size_t)(8 * i) * D); } };
constexpr int PV_STAGE = 2 * G_ASZ + G_BSZ;
template <int SEG, int NSEG, class AL, class BL, class SE>
__device__ __forceinline__ void gemm_stream_pair(const AL& al, const BL& bl, lds_ptr stage, const SE& segend, bool has2) {
  constexpr int NS = SEG * NSEG;
  const int tid = ltid(), lane = tid & 63, wid = tid >> 6, wm = wid >> 2, wn = wid & 3, fr = lane & 15, fq = lane >> 4;
  const int ar = tid >> 2, ac = tid & 3;
  const bf16_t* aptr0 = al.rowptr(0, ar) + ac * 8;
  const bf16_t* aptr1 = al.rowptr(1, ar) + ac * 8;
  const int a_st = a_off(ar, ac);
  int b_st[4];
#pragma unroll
  for (int i = 0; i < 4; ++i) b_st[i] = 2 * G_ASZ + b_off((tid >> 6) + 8 * i, (tid & 63) >> 2) + (tid & 3) * 8;
  int a_rd[4];
#pragma unroll
  for (int mt = 0; mt < 4; ++mt) a_rd[mt] = a_off(wm * 64 + mt * 16 + fr, fq);
  int b_rd[4][2];
#pragma unroll
  for (int nt = 0; nt < 4; ++nt) {
    b_rd[nt][0] = 2 * G_ASZ + b_off(8 * fq + (fr >> 2), wn * 4 + nt) + (fr & 3) * 8;
    b_rd[nt][1] = 2 * G_ASZ + b_off(8 * fq + 4 + (fr >> 2), wn * 4 + nt) + (fr & 3) * 8;
  }
  f32x4 acc[2][4][4];
#pragma unroll
  for (int h = 0; h < 2; ++h)
#pragma unroll
    for (int mt = 0; mt < 4; ++mt)
#pragma unroll
      for (int nt = 0; nt < 4; ++nt) acc[h][mt][nt] = (f32x4){0.f, 0.f, 0.f, 0.f};
  u32x4 xa0, xb0, xa1, xb1;
  BRaw rb0, rb1;
#define P2_LOAD(XA, XB, RB, s_) do { XA = *(const u32x4*)(aptr0 + (size_t)((s_) % SEG) * 32); XB = *(const u32x4*)(aptr1 + (size_t)((s_) % SEG) * 32); bl.load(RB, (s_), tid); } while (0)
#define P2_STORE(XA, XB, RB, st_) do { const lds_ptr q_ = stage + (st_) * PV_STAGE; *(LAS u32x4*)(q_ + a_st) = XA; *(LAS u32x4*)(q_ + G_ASZ + a_st) = XB; \
    _Pragma("unroll") for (int i_ = 0; i_ < 4; ++i_) { u32x2 o_; o_.x = cvtpk(RB.v[i_][0], RB.v[i_][1]); o_.y = cvtpk(RB.v[i_][2], RB.v[i_][3]); *(LAS u32x2*)(q_ + b_st[i_]) = o_; } } while (0)
#define P2_COMPUTE(s_) do { const lds_ptr cur = stage + ((s_) & 1) * PV_STAGE; s16x8 bfr[4]; \
    _Pragma("unroll") for (int nt = 0; nt < 4; ++nt) { const s16x4 lo = tr_read(cur + b_rd[nt][0]), hi = tr_read(cur + b_rd[nt][1]); bfr[nt] = __builtin_shufflevector(lo, hi, 0, 1, 2, 3, 4, 5, 6, 7); } \
    _Pragma("unroll") for (int h = 0; h < 2; ++h) if (h == 0 || has2) { s16x8 af[4]; \
      _Pragma("unroll") for (int mt = 0; mt < 4; ++mt) af[mt] = *(LAS s16x8*)(cur + h * G_ASZ + a_rd[mt]); \
      _Pragma("unroll") for (int mt = 0; mt < 4; ++mt) _Pragma("unroll") for (int nt = 0; nt < 4; ++nt) acc[h][mt][nt] = __builtin_amdgcn_mfma_f32_16x16x32_bf16(bfr[nt], af[mt], acc[h][mt][nt], 0, 0, 0); } } while (0)
#define P2_SEGEND(s_) do { if (((s_) % SEG) == SEG - 1) { segend((s_) / SEG, acc); \
    _Pragma("unroll") for (int h = 0; h < 2; ++h) _Pragma("unroll") for (int mt = 0; mt < 4; ++mt) _Pragma("unroll") for (int nt = 0; nt < 4; ++nt) acc[h][mt][nt] = (f32x4){0.f, 0.f, 0.f, 0.f}; } } while (0)
#define P2_BODY(s_, XAN, XBN, RBN, XAW, XBW, RBW) do { const int sl_ = ((s_) + 2 < NS) ? (s_) + 2 : NS - 1; P2_LOAD(XAN, XBN, RBN, sl_); __builtin_amdgcn_sched_barrier(0); \
    P2_COMPUTE(s_); __builtin_amdgcn_sched_barrier(0); P2_SEGEND(s_); P2_STORE(XAW, XBW, RBW, ((s_) + 1) & 1); __syncthreads(); } while (0)
  P2_LOAD(xa0, xb0, rb0, 0);
  P2_LOAD(xa1, xb1, rb1, 1);
  __syncthreads();
  P2_STORE(xa0, xb0, rb0, 0);
  __syncthreads();
  for (int s = 0; s < NS; s += 2) {
    P2_BODY(s, xa0, xb0, rb0, xa1, xb1, rb1);
    P2_BODY(s + 1, xa1, xb1, rb1, xa0, xb0, rb0);
  }
#undef P2_LOAD
#undef P2_STORE
#undef P2_COMPUTE
#undef P2_SEGEND
#undef P2_BODY
}
struct APairGather { const bf16_t* A; LAS int* tk; __device__ __forceinline__ const bf16_t* rowptr(int h, int r) const { int t = tk[h * 128 + r]; t = t < 0 ? 0 : t; return A + (size_t)t * D; } };
struct APairDense { const bf16_t* A0; const bf16_t* A1; __device__ __forceinline__ const bf16_t* rowptr(int h, int r) const { return (h ? A1 : A0) + (size_t)r * EFF; } };

constexpr int PV_TOK = 2 * PV_STAGE;
constexpr int PV_Q = PV_TOK + 1024;
constexpr int PV_STG = 69632, PV_STG_ROW = 528;
template <int STG>
__device__ __forceinline__ void phase_moe_pair(PR p, int bid, int nb, lds_ptr smem) {
  LAS int* toks = (LAS int*)(smem + PV_TOK);
  LAS int* qi = (LAS int*)(smem + PV_Q);
  for (int sx = 0; sx < 8; ++sx) {
   const int x = ((int)((unsigned)__builtin_amdgcn_s_getreg((3 << 11) | 20) & 7u) + sx) & 7;
   const int cnt = 2 * p.moe_cnt[x];
   for (;;) {
    __syncthreads();
    if (ltid() == 0) qi[0] = atomicAdd(&p.moe_ctr[(STG - 1) * 8 + x], 1);
    __syncthreads();
    const int qidx = qi[0];
    if (qidx >= cnt) break;
    const int blk = p.moe_list[x * NBLK128 + (qidx >> 1)], sub = qidx & 1;
    const int e = p.blk_exp[blk];
    const bool has2 = (blk + 1 < NBLK128) && (p.blk_exp[blk + 1] == e);
    const int blk2 = has2 ? blk + 1 : blk;
    { const int t = ltid(); if (t < 256) toks[t] = (t < 128) ? p.slot_tok[blk * 128 + t] : (has2 ? p.slot_tok[blk2 * 128 + (t - 128)] : -1); }
    __syncthreads();
    const int lane = ltid() & 63, wid = ltid() >> 6, wm = wid >> 2, wn = wid & 3, fr = lane & 15, fq = lane >> 4;
    if (STG == 1) {
      const float* Wg = p.ew_gate + (size_t)e * D * EFF; const float* Wu = p.ew_up + (size_t)e * D * EFF;
      APairGather al{p.h2, toks};
      BStreamGU bl{Wg, (long)(Wu - Wg), sub};
      auto segH = [&](int hseg, const f32x4 (&acc)[2][4][4]) { const int hp = sub + hseg;
        const int t1 = ltid(), l1 = t1 & 63, w1 = t1 >> 6;
        const lds_ptr stg = smem + PV_STG;
#pragma unroll
        for (int h = 0; h < 2; ++h) {
          if (h == 1 && !has2) continue;
#pragma unroll
          for (int i = 0; i < 4; ++i)
#pragma unroll
            for (int j = 0; j < 2; ++j) { const f32x4 gv = acc[h][i][j], uv = acc[h][i][j + 2];
              u32x2 o; o.x = cvtpk(siluf_(gv[0]) * uv[0], siluf_(gv[1]) * uv[1]); o.y = cvtpk(siluf_(gv[2]) * uv[2], siluf_(gv[3]) * uv[3]);
              *(LAS u32x2*)(stg + ((w1 >> 2) * 64 + i * 16 + (l1 & 15)) * 272 + ((w1 & 3) * 32 + j * 16 + (l1 >> 4) * 4) * 2) = o; }
          __syncthreads();
          bf16_t* hb = p.Hbuf + (size_t)((h ? blk2 : blk) * 128) * EFF + hp * 128 + (t1 & 15) * 8;
#pragma unroll
          for (int ps = 0; ps < 4; ++ps) {
            const int row = ps * 32 + (t1 >> 4);
            *(u32x4*)(hb + (size_t)row * EFF) = *(LAS u32x4*)(stg + row * 272 + (t1 & 15) * 16);
          }
          __syncthreads();
        }
      };
      gemm_stream_pair<32, 1>(al, bl, smem, segH, has2);
    } else {
      const float* Wd = p.ew_down + (size_t)e * EFF * D;
      APairDense al{p.Hbuf + (size_t)blk * 128 * EFF, p.Hbuf + (size_t)blk2 * 128 * EFF};
      BStreamDown bl{Wd, 2 * sub};
      auto segY = [&](int nseg, const f32x4 (&acc)[2][4][4]) { const int np = 2 * sub + nseg;
        const int t1 = ltid(), l1 = t1 & 63, w1 = t1 >> 6;
        const lds_ptr stg = smem + PV_STG;
#pragma unroll
        for (int h = 0; h < 2; ++h) {
          if (h == 1 && !has2) continue;
#pragma unroll
          for (int i = 0; i < 4; ++i)
#pragma unroll
            for (int j = 0; j < 4; ++j) { const f32x4 v = acc[h][i][j]; u32x2 o; o.x = cvtpk(v[0], v[1]); o.y = cvtpk(v[2], v[3]);
              *(LAS u32x2*)(stg + ((w1 >> 2) * 64 + i * 16 + (l1 & 15)) * PV_STG_ROW + ((w1 & 3) * 64 + j * 16 + (l1 >> 4) * 4) * 2) = o; }
          __syncthreads();
          bf16_t* yb = p.Y + (size_t)((h ? blk2 : blk) * 128) * D + np * 256 + (t1 & 31) * 8;
#pragma unroll
          for (int ps = 0; ps < 8; ++ps) {
            const int row = ps * 16 + (t1 >> 5);
            const u32x4 v = *(LAS u32x4*)(stg + row * PV_STG_ROW + (t1 & 31) * 16);
            if (toks[h * 128 + row] >= 0) *(u32x4*)(yb + (size_t)row * D) = v;
          }
          __syncthreads();
        }
      };
      gemm_stream_pair<8, 2>(al, bl, smem, segY, has2);
    }
   }
  }
}

__device__ __forceinline__ void wave_sync() { asm volatile("s_waitcnt lgkmcnt(0)" ::: "memory"); }
constexpr int S5_BU_STRIDE = 132;
constexpr int S5_S_STRIDE = 272;
constexpr int S5_WAVE_LDS = 16 * S5_BU_STRIDE * 4 + 16 * S5_S_STRIDE;
template <bool FINAL>
__device__ __forceinline__ void s5_item(PR p, int b, int c, int g, lds_ptr wl) {
  const int lane = ltid() & 63, fr = lane & 15, fq = lane >> 4;
  LAS float* bu = (LAS float*)wl;
  const lds_ptr Sb = wl + 16 * S5_BU_STRIDE * 4;
  const size_t t0 = (size_t)b * SEQ + (size_t)c * 64;
  const s16x8 zero8 = {0, 0, 0, 0, 0, 0, 0, 0};
  s16x8 bfr[8];
#pragma unroll
  for (int nt = 0; nt < 8; ++nt) { const s16x8 x = *(const s16x8*)(p.bbarT + ((size_t)(g * 128 + nt * 16 + fr) * 16 + (fq & 1) * 8)); bfr[nt] = (fq < 2) ? x : zero8; }
  const float are = p.abar[(g * 64 + lane) * 2], aim = p.abar[(g * 64 + lane) * 2 + 1];
  const size_t sidx = (((size_t)b * 32 + c) * S5G + g) * 64 + lane;
  float sre = 0.f, sim = 0.f;
  s16x8 cfr[4];
  f32x4 dsk = {0.f, 0.f, 0.f, 0.f};
  if (FINAL) {
    sre = p.s5Sin[sidx * 2]; sim = p.s5Sin[sidx * 2 + 1];
#pragma unroll
    for (int ks = 0; ks < 4; ++ks) cfr[ks] = *(const s16x8*)(p.cmT + ((size_t)(g * 16 + fr) * 128 + ks * 32 + fq * 8));
    dsk = *(const f32x4*)(p.s5_d + g * 16 + fq * 4);
  }
  s16x8 uxs[4]; u32x2 u4s[4];
#pragma unroll
  for (int mt = 0; mt < 4; ++mt) {
    const bf16_t* urow = p.proj + (t0 + mt * 16 + fr) * LDP + OFF_U + g * 16;
    uxs[mt] = *(const s16x8*)(urow + (fq & 1) * 8);
    if (FINAL) u4s[mt] = *(const u32x2*)(urow + fq * 4);
  }
#pragma unroll
  for (int mt = 0; mt < 4; ++mt) {
    const s16x8 ufr = (fq < 2) ? uxs[mt] : zero8;
#pragma unroll
    for (int nt = 0; nt < 8; ++nt) {
      const f32x4 z = {0.f, 0.f, 0.f, 0.f};
      const f32x4 acc = __builtin_amdgcn_mfma_f32_16x16x32_bf16(bfr[nt], ufr, z, 0, 0, 0);
      *(LAS f32x4*)(bu + fr * S5_BU_STRIDE + nt * 16 + 4 * fq) = acc;
    }
    wave_sync();
    f32x2 bv[16];
#pragma unroll
    for (int l = 0; l < 16; ++l) bv[l] = *(LAS f32x2*)(bu + l * S5_BU_STRIDE + 2 * lane);
#pragma unroll
    for (int l = 0; l < 16; ++l) {
      const float nr = are * sre - aim * sim + bv[l].x, ni = are * sim + aim * sre + bv[l].y;
      sre = nr; sim = ni;
      if (FINAL) *(LAS unsigned*)(Sb + l * S5_S_STRIDE + lane * 4) = cvtpk(sre, sim);
    }
    if (FINAL) {
      wave_sync();
      f32x4 y = {0.f, 0.f, 0.f, 0.f};
#pragma unroll
      for (int ks = 0; ks < 4; ++ks) {
        const s16x8 sfr = *(LAS s16x8*)(Sb + fr * S5_S_STRIDE + (ks * 32 + fq * 8) * 2);
        y = __builtin_amdgcn_mfma_f32_16x16x32_bf16(cfr[ks], sfr, y, 0, 0, 0);
      }
      const f32x4 u4 = {__builtin_bit_cast(float, u4s[mt].x << 16), __builtin_bit_cast(float, u4s[mt].x & 0xffff0000u), __builtin_bit_cast(float, u4s[mt].y << 16), __builtin_bit_cast(float, u4s[mt].y & 0xffff0000u)};
      u32x2 o; o.x = cvtpk(geluf_(y[0] + dsk[0] * u4[0]), geluf_(y[1] + dsk[1] * u4[1])); o.y = cvtpk(geluf_(y[2] + dsk[2] * u4[2]), geluf_(y[3] + dsk[3] * u4[3]));
      *(u32x2*)(p.yA + (t0 + mt * 16 + fr) * S5W + g * 16 + fq * 4) = o;
    } else wave_sync();
  }
  if (!FINAL) { p.s5E[sidx * 2] = sre; p.s5E[sidx * 2 + 1] = sim; }
}
template <bool FINAL>
__device__ __forceinline__ void s5_block_item(PR p, int item, lds_ptr smem) {
  const int wid = ltid() >> 6;
  const int go = item & 3, c = (item >> 2) & 31, b = item >> 7;
  s5_item<FINAL>(p, b, c, go * 8 + wid, smem + wid * S5_WAVE_LDS);
}

template <bool FINAL>
__device__ __forceinline__ void s5_wave_phase(PR p, int bid, int nb, lds_ptr smem) {
  const int lane = ltid() & 63, fr = lane & 15, fq = lane >> 4, wid = ltid() >> 6;
  const int g = (bid & 3) * 8 + wid;
  const lds_ptr wl = smem + wid * S5_WAVE_LDS;
  LAS float* bu = (LAS float*)wl;
  const lds_ptr Sb = wl + 16 * S5_BU_STRIDE * 4;
  const s16x8 zero8 = {0, 0, 0, 0, 0, 0, 0, 0};
  s16x8 bfr[8];
#pragma unroll
  for (int nt = 0; nt < 8; ++nt) { const s16x8 x = *(const s16x8*)(p.bbarT + ((size_t)(g * 128 + nt * 16 + fr) * 16 + (fq & 1) * 8)); bfr[nt] = (fq < 2) ? x : zero8; }
  const float are = p.abar[(g * 64 + lane) * 2], aim = p.abar[(g * 64 + lane) * 2 + 1];
  s16x8 cfr[4];
  f32x4 dsk = {0.f, 0.f, 0.f, 0.f};
  if (FINAL) {
#pragma unroll
    for (int ks = 0; ks < 4; ++ks) cfr[ks] = *(const s16x8*)(p.cmT + ((size_t)(g * 16 + fr) * 128 + ks * 32 + fq * 8));
    dsk = *(const f32x4*)(p.s5_d + g * 16 + fq * 4);
  }
  s16x8 nux[4]; u32x2 nu4[4]; f32x2 nsin = {0.f, 0.f};
#define S5_ISSUE(IDX) do { const int c_ = ((IDX) >> 2) & 31, b_ = (IDX) >> 7; const size_t t0_ = (size_t)b_ * SEQ + (size_t)c_ * 64; \
    _Pragma("unroll") for (int mt = 0; mt < 4; ++mt) { const bf16_t* urow = p.proj + (t0_ + mt * 16 + fr) * LDP + OFF_U + g * 16; \
      nux[mt] = *(const s16x8*)(urow + (fq & 1) * 8); if (FINAL) nu4[mt] = *(const u32x2*)(urow + fq * 4); } \
    if (FINAL) nsin = *(const f32x2*)(p.s5Sin + ((((size_t)b_ * 32 + c_) * S5G + g) * 64 + lane) * 2); } while (0)
  S5_ISSUE(bid);
#pragma unroll 1
  for (int idx = bid; idx < 1024; idx += nb) {
    const int c = (idx >> 2) & 31, b = idx >> 7;
    const size_t t0 = (size_t)b * SEQ + (size_t)c * 64;
    s16x8 uxs[4]; u32x2 u4s[4];
#pragma unroll
    for (int mt = 0; mt < 4; ++mt) { uxs[mt] = nux[mt]; u4s[mt] = nu4[mt]; }
    float sre = nsin.x, sim = nsin.y;
    __builtin_amdgcn_sched_barrier(0);
    { const int nidx = (idx + nb < 1024) ? idx + nb : idx; S5_ISSUE(nidx); }
    __builtin_amdgcn_sched_barrier(0);
#pragma unroll
    for (int mt = 0; mt < 4; ++mt) {
      const s16x8 ufr = (fq < 2) ? uxs[mt] : zero8;
#pragma unroll
      for (int nt = 0; nt < 8; ++nt) {
        const f32x4 z = {0.f, 0.f, 0.f, 0.f};
        const f32x4 acc = __builtin_amdgcn_mfma_f32_16x16x32_bf16(bfr[nt], ufr, z, 0, 0, 0);
        *(LAS f32x4*)(bu + fr * S5_BU_STRIDE + nt * 16 + 4 * fq) = acc;
      }
      wave_sync();
      f32x2 bv[16];
#pragma unroll
      for (int l = 0; l < 16; ++l) bv[l] = *(LAS f32x2*)(bu + l * S5_BU_STRIDE + 2 * lane);
#pragma unroll
      for (int l = 0; l < 16; ++l) {
        const float nr = are * sre - aim * sim + bv[l].x, ni = are * sim + aim * sre + bv[l].y;
        sre = nr; sim = ni;
        if (FINAL) *(LAS unsigned*)(Sb + l * S5_S_STRIDE + lane * 4) = cvtpk(sre, sim);
      }
      if (FINAL) {
        wave_sync();
        f32x4 y = {0.f, 0.f, 0.f, 0.f};
#pragma unroll
        for (int ks = 0; ks < 4; ++ks) {
          const s16x8 sfr = *(LAS s16x8*)(Sb + fr * S5_S_STRIDE + (ks * 32 + fq * 8) * 2);
          y = __builtin_amdgcn_mfma_f32_16x16x32_bf16(cfr[ks], sfr, y, 0, 0, 0);
        }
        const f32x4 u4 = {__builtin_bit_cast(float, u4s[mt].x << 16), __builtin_bit_cast(float, u4s[mt].x & 0xffff0000u), __builtin_bit_cast(float, u4s[mt].y << 16), __builtin_bit_cast(float, u4s[mt].y & 0xffff0000u)};
        u32x2 o; o.x = cvtpk(geluf_(y[0] + dsk[0] * u4[0]), geluf_(y[1] + dsk[1] * u4[1])); o.y = cvtpk(geluf_(y[2] + dsk[2] * u4[2]), geluf_(y[3] + dsk[3] * u4[3]));
        *(u32x2*)(p.yA + (t0 + mt * 16 + fr) * S5W + g * 16 + fq * 4) = o;
      } else wave_sync();
    }
    if (!FINAL) { const size_t sidx = (((size_t)b * 32 + c) * S5G + g) * 64 + lane; *(f32x2*)(p.s5E + sidx * 2) = (f32x2){sre, sim}; }
  }
#undef S5_ISSUE
}

constexpr int GL_QD = 0, GL_KE = 8192, GL_V = 16384, GL_SIN = 32768, GL_GL = 49152, GL_W2 = 53248, GL_TOT = 57344, GL_B2 = 58368, GL_ITEM = 58624;
__device__ __forceinline__ int rowrd_off(int r, int c) { return r * 128 + ((c ^ ((r >> 1) & 7)) << 4); }
__device__ __forceinline__ int tr128_off(int r, int ch) { return r * 128 + ((ch ^ (((r >> 1) & 1) | (((r >> 3) & 1) << 1))) << 5); }
__device__ __forceinline__ int tr256_off(int r, int ch) { return r * 256 + ((ch ^ ((r & 3) | (((r >> 3) & 1) << 2))) << 5); }

__device__ __forceinline__ void gla_front(lds_ptr il, int t, const f32x4& gklv, const float (&wv)[16], float bias, float (&bl)[16], float& blast) {
  LAS float* gl = (LAS float*)(il + GL_GL); LAS float* tot = (LAS float*)(il + GL_TOT);
  __syncthreads();
  *(LAS f32x4*)(gl + t * 4) = gklv;
  __syncthreads();
  const int d = t & 63, part = t >> 6;
  float run = 0.f;
#pragma unroll
  for (int ii = 0; ii < 16; ++ii) {
    const int i = part * 16 + ii;
    float gk = bias;
#pragma unroll
    for (int q = 0; q < 4; ++q) { const f32x4 gv = *(LAS f32x4*)(gl + i * 16 + q * 4); gk += gv[0] * wv[q * 4] + gv[1] * wv[q * 4 + 1] + gv[2] * wv[q * 4 + 2] + gv[3] * wv[q * 4 + 3]; }
    run += logsigmoidf_(gk) * (1.f / 16.f);
    bl[ii] = run;
  }
  tot[part * 64 + d] = run;
  __syncthreads();
  float offs = 0.f, all = 0.f;
#pragma unroll
  for (int q = 0; q < 4; ++q) { const float v = tot[q * 64 + d]; all += v; offs += (q < part) ? v : 0.f; }
#pragma unroll
  for (int ii = 0; ii < 16; ++ii) bl[ii] += offs;
  blast = all;
}

__device__ __forceinline__ void gla_pass1(PR p, int item, lds_ptr smem, const float (&wv)[16], float bias) {
  const int half = ltid() >> 8, t = ltid() & 255, lane = t & 63, w = t >> 6, fr = lane & 15, fq = lane >> 4;
  const int it = item * 2 + half, c = it & 31, h = (it >> 5) & 3, b = it >> 7;
  const lds_ptr il = smem + half * GL_ITEM;
  const size_t t0 = (size_t)b * SEQ + (size_t)c * 64;
  float bl[16], blast;
  const f32x4 gklv = *(const f32x4*)(p.gkl + t0 * 16 + t * 4);
  bf16_t kraw[16]; u32x4 vraw[4];
#pragma unroll
  for (int ii = 0; ii < 16; ++ii) kraw[ii] = p.proj[(t0 + (t >> 6) * 16 + ii) * LDP + OFF_K + h * 64 + (t & 63)];
#pragma unroll
  for (int q = 0; q < 4; ++q) { const int pc = t + 256 * q, r = pc >> 4, c8 = pc & 15; vraw[q] = *(const u32x4*)(p.proj + (t0 + r) * LDP + OFF_V + h * 128 + c8 * 8); }
  gla_front(il, t, gklv, wv, bias, bl, blast);
  {
    const int d = t & 63, part = t >> 6;
#pragma unroll
    for (int ii = 0; ii < 16; ++ii) {
      const int i = part * 16 + ii;
      const float kv = bf2f(kraw[ii]);
      *(LAS bf16_t*)(il + GL_KE + tr128_off(i, d >> 4) + (d & 15) * 2) = f2bf(kv * __expf(blast - bl[ii]));
    }
    if (part == 0) p.glaDec[(size_t)it * 64 + d] = __expf(blast);
#pragma unroll
    for (int q = 0; q < 4; ++q) { const int pc = t + 256 * q, r = pc >> 4, c8 = pc & 15;
      *(LAS u32x4*)(il + GL_V + tr256_off(r, c8 >> 1) + (c8 & 1) * 16) = vraw[q]; }
  }
  __syncthreads();
  f32x4 acc[8];
#pragma unroll
  for (int et = 0; et < 8; ++et) acc[et] = (f32x4){0.f, 0.f, 0.f, 0.f};
#pragma unroll
  for (int ks = 0; ks < 2; ++ks) {
    const int r0 = 32 * ks + 8 * fq + (fr >> 2);
    const s16x4 klo = tr_read(il + GL_KE + tr128_off(r0, w) + (fr & 3) * 8), khi = tr_read(il + GL_KE + tr128_off(r0 + 4, w) + (fr & 3) * 8);
    const s16x8 kf = __builtin_shufflevector(klo, khi, 0, 1, 2, 3, 4, 5, 6, 7);
#pragma unroll
    for (int et = 0; et < 8; ++et) {
      const s16x4 vlo = tr_read(il + GL_V + tr256_off(r0, et) + (fr & 3) * 8), vhi = tr_read(il + GL_V + tr256_off(r0 + 4, et) + (fr & 3) * 8);
      const s16x8 vf = __builtin_shufflevector(vlo, vhi, 0, 1, 2, 3, 4, 5, 6, 7);
      acc[et] = __builtin_amdgcn_mfma_f32_16x16x32_bf16(vf, kf, acc[et], 0, 0, 0);
    }
  }
#pragma unroll
  for (int et = 0; et < 8; ++et) *(f32x4*)(p.glaKV + ((size_t)it * 64 + 16 * w + fr) * 128 + et * 16 + fq * 4) = acc[et];
}

__device__ __forceinline__ void gla_pass2(PR p, int item, lds_ptr smem, const float (&wv)[16], float bias) {
  const int half = ltid() >> 8, t = ltid() & 255, lane = t & 63, w = t >> 6, fr = lane & 15, fq = lane >> 4;
  const int it = item * 2 + half, c = it & 31, h = (it >> 5) & 3, b = it >> 7;
  const lds_ptr il = smem + half * GL_ITEM;
  const size_t t0 = (size_t)b * SEQ + (size_t)c * 64;
  float bl[16], blast;
  const f32x4 gklv = *(const f32x4*)(p.gkl + t0 * 16 + t * 4);
  bf16_t qraw[16], kraw[16]; u32x4 vraw[4], sraw[4]; u32x2 rgraw[8];
#pragma unroll
  for (int ii = 0; ii < 16; ++ii) { const bf16_t* pr = p.proj + (t0 + (t >> 6) * 16 + ii) * LDP + h * 64 + (t & 63); qraw[ii] = pr[OFF_Q]; kraw[ii] = pr[OFF_K]; }
#pragma unroll
  for (int q = 0; q < 4; ++q) { const int pc = t + 256 * q, r = pc >> 4, c8 = pc & 15;
    vraw[q] = *(const u32x4*)(p.proj + (t0 + r) * LDP + OFF_V + h * 128 + c8 * 8);
    sraw[q] = *(const u32x4*)(p.glaSin + ((size_t)it * 64 + r) * 128 + c8 * 8); }
  const size_t trow = t0 + 16 * w + fr;
#pragma unroll
  for (int et = 0; et < 8; ++et) rgraw[et] = *(const u32x2*)(p.proj + trow * LDP + OFF_R + h * 128 + et * 16 + fq * 4);
  gla_front(il, t, gklv, wv, bias, bl, blast);
  {
    const int d = t & 63, part = t >> 6;
#pragma unroll
    for (int ii = 0; ii < 16; ++ii) {
      const int i = part * 16 + ii;
      const float qv = bf2f(qraw[ii]) * 0.125f, kv = bf2f(kraw[ii]);
      const int o = rowrd_off(i, d >> 3) + (d & 7) * 2;
      *(LAS bf16_t*)(il + GL_QD + o) = f2bf(qv * __expf(bl[ii]));
      *(LAS bf16_t*)(il + GL_KE + o) = f2bf(kv * __expf(-bl[ii]));
    }
#pragma unroll
    for (int q = 0; q < 4; ++q) { const int pc = t + 256 * q, r = pc >> 4, c8 = pc & 15;
      *(LAS u32x4*)(il + GL_V + tr256_off(r, c8 >> 1) + (c8 & 1) * 16) = vraw[q];
      *(LAS u32x4*)(il + GL_SIN + tr256_off(r, c8 >> 1) + (c8 & 1) * 16) = sraw[q]; }
  }
  __syncthreads();
  s16x8 qf[2];
#pragma unroll
  for (int ks = 0; ks < 2; ++ks) qf[ks] = *(LAS s16x8*)(il + GL_QD + rowrd_off(16 * w + fr, ks * 4 + fq));
  f32x4 st[4];
#pragma unroll
  for (int jt = 0; jt < 4; ++jt) {
    st[jt] = (f32x4){0.f, 0.f, 0.f, 0.f};
    if (jt <= w) {
#pragma unroll
      for (int ks = 0; ks < 2; ++ks) {
        const s16x8 kf = *(LAS s16x8*)(il + GL_KE + rowrd_off(16 * jt + fr, ks * 4 + fq));
        st[jt] = __builtin_amdgcn_mfma_f32_16x16x32_bf16(kf, qf[ks], st[jt], 0, 0, 0);
      }
      if (jt == w) {
#pragma unroll
        for (int r = 0; r < 4; ++r) st[jt][r] = (4 * fq + r <= fr) ? st[jt][r] : 0.f;
      }
    }
  }
  f32x4 acc[8];
#pragma unroll
  for (int et = 0; et < 8; ++et) acc[et] = (f32x4){0.f, 0.f, 0.f, 0.f};
#pragma unroll
  for (int u = 0; u < 2; ++u) {
    if (2 * u <= w) {
      u32x4 pk; pk.x = cvtpk(st[2 * u][0], st[2 * u][1]); pk.y = cvtpk(st[2 * u][2], st[2 * u][3]); pk.z = cvtpk(st[2 * u + 1][0], st[2 * u + 1][1]); pk.w = cvtpk(st[2 * u + 1][2], st[2 * u + 1][3]);
      const s16x8 pf = __builtin_bit_cast(s16x8, pk);
      const int r0 = 32 * u + 4 * fq + (fr >> 2);
#pragma unroll
      for (int et = 0; et < 8; ++et) {
        const s16x4 vlo = tr_read(il + GL_V + tr256_off(r0, et) + (fr & 3) * 8), vhi = tr_read(il + GL_V + tr256_off(r0 + 16, et) + (fr & 3) * 8);
        const s16x8 vf = __builtin_shufflevector(vlo, vhi, 0, 1, 2, 3, 4, 5, 6, 7);
        acc[et] = __builtin_amdgcn_mfma_f32_16x16x32_bf16(vf, pf, acc[et], 0, 0, 0);
      }
    }
  }
#pragma unroll
  for (int ks = 0; ks < 2; ++ks) {
    const int r0 = 32 * ks + 8 * fq + (fr >> 2);
#pragma unroll
    for (int et = 0; et < 8; ++et) {
      const s16x4 slo = tr_read(il + GL_SIN + tr256_off(r0, et) + (fr & 3) * 8), shi = tr_read(il + GL_SIN + tr256_off(r0 + 4, et) + (fr & 3) * 8);
      const s16x8 sf = __builtin_shufflevector(slo, shi, 0, 1, 2, 3, 4, 5, 6, 7);
      acc[et] = __builtin_amdgcn_mfma_f32_16x16x32_bf16(sf, qf[ks], acc[et], 0, 0, 0);
    }
  }
  float ss = 0.f;
#pragma unroll
  for (int et = 0; et < 8; ++et) ss += acc[et][0] * acc[et][0] + acc[et][1] * acc[et][1] + acc[et][2] * acc[et][2] + acc[et][3] * acc[et][3];
  ss += __shfl_xor(ss, 16); ss += __shfl_xor(ss, 32);
  const float rn = rsqrtf(ss * (1.f / 128.f) + 1e-6f);
#pragma unroll
  for (int et = 0; et < 8; ++et) {
    const int e = et * 16 + fq * 4;
    const f32x4 ng = *(const f32x4*)(p.gla_norm_g + e);
    const f32x4 rg = {__builtin_bit_cast(float, rgraw[et].x << 16), __builtin_bit_cast(float, rgraw[et].x & 0xffff0000u), __builtin_bit_cast(float, rgraw[et].y << 16), __builtin_bit_cast(float, rgraw[et].y & 0xffff0000u)};
    u32x2 o; o.x = cvtpk(acc[et][0] * rn * ng[0] * siluf_(rg[0]), acc[et][1] * rn * ng[1] * siluf_(rg[1])); o.y = cvtpk(acc[et][2] * rn * ng[2] * siluf_(rg[2]), acc[et][3] * rn * ng[3] * siluf_(rg[3]));
    *(u32x2*)(p.yB + trow * GVAL + h * 128 + e) = o;
  }
}

#define GLA_LOAD_WV(H) do { const int d_ = ltid() & 63; _Pragma("unroll") for (int r_ = 0; r_ < 16; ++r_) wv[r_] = p.w_gk2[r_ * GKEY + (H) * 64 + d_]; bias = p.b_gk2[(H) * 64 + d_]; } while (0)
__device__ __forceinline__ void phase_mix_local(PR p, int bid, int nb, lds_ptr smem, int which) {
  if (which & 1) { __syncthreads(); s5_wave_phase<false>(p, bid, nb, smem); }
  if (which & 2) {
    float wv[16], bias = 0.f; int hprev = -1;
    for (int item = bid; item < 512; item += nb) {
      const int h = ((item * 2 + (ltid() >> 8)) >> 5) & 3;
      if (h != hprev) { GLA_LOAD_WV(h); hprev = h; }
      gla_pass1(p, item, smem, wv, bias);
    }
  }
}
__device__ __forceinline__ void phase_mix_carry(PR p, int bid, int nb, int which) {
  const int wave = __builtin_amdgcn_readfirstlane(ltid() >> 6), ln = ltid() & 63;
  if (which & 1) {
    for (int j = bid; j < NB * S5G; j += nb) if (wave == 7) {
      const int g = j & 31, b = j >> 5;
      const float2 a = *(const float2*)(p.apow64 + (g * 64 + ln) * 2);
      float2 e[32];
#pragma unroll
      for (int c = 0; c < 32; ++c) e[c] = *(const float2*)(p.s5E + ((((size_t)b * 32 + c) * S5G + g) * 64 + ln) * 2);
      float sre = 0.f, sim = 0.f;
#pragma unroll
      for (int c = 0; c < 32; ++c) {
        *(float2*)(p.s5Sin + ((((size_t)b * 32 + c) * S5G + g) * 64 + ln) * 2) = make_float2(sre, sim);
        const float nr = a.x * sre - a.y * sim + e[c].x, ni = a.x * sim + a.y * sre + e[c].y;
        sre = nr; sim = ni;
      }
    }
  }
  if (which & 2) {
    for (int r = bid * 8 + wave; r < NB * GH * 64; r += nb * 8) {
      const int d = r & 63, bh = r >> 6;
      float2 kv[32]; float dec[32];
#pragma unroll
      for (int c = 0; c < 32; ++c) {
        const size_t it = (size_t)bh * 32 + c;
        kv[c] = *(const float2*)(p.glaKV + (it * 64 + d) * 128 + 2 * ln);
        dec[c] = p.glaDec[it * 64 + d];
      }
      float S0 = 0.f, S1 = 0.f;
#pragma unroll
      for (int c = 0; c < 32; ++c) {
        const size_t it = (size_t)bh * 32 + c;
        *(uint32_t*)(p.glaSin + (it * 64 + d) * 128 + 2 * ln) = cvtpk(S0, S1);
        S0 = dec[c] * S0 + kv[c].x; S1 = dec[c] * S1 + kv[c].y;
      }
    }
  }
}
__device__ __forceinline__ void phase_mix_final(PR p, int bid, int nb, lds_ptr smem, int which) {
  if (which & 1) { __syncthreads(); s5_wave_phase<true>(p, bid, nb, smem); }
  if (which & 2) {
    float wv[16], bias = 0.f; int hprev = -1;
    for (int item = bid; item < 512; item += nb) {
      const int h = ((item * 2 + (ltid() >> 8)) >> 5) & 3;
      if (h != hprev) { GLA_LOAD_WV(h); hprev = h; }
      gla_pass2(p, item, smem, wv, bias);
    }
  }
}

template <int CTRL> __device__ __forceinline__ float dppf(float x) { return __builtin_bit_cast(float, __builtin_amdgcn_update_dpp(0, __builtin_bit_cast(int, x), CTRL, 0xF, 0xF, false)); }
__device__ __forceinline__ float rlf(float x, int l) { return __builtin_bit_cast(float, __builtin_amdgcn_readlane(__builtin_bit_cast(int, x), l)); }
__device__ __forceinline__ float wave_max(float x) {
  x = fmaxf(x, dppf<0xB1>(x)); x = fmaxf(x, dppf<0x4E>(x)); x = fmaxf(x, dppf<0x141>(x)); x = fmaxf(x, dppf<0x140>(x));
  return fmaxf(fmaxf(rlf(x, 0), rlf(x, 16)), fmaxf(rlf(x, 32), rlf(x, 48)));
}
__device__ __forceinline__ float wave_sum(float x) {
  x += dppf<0xB1>(x); x += dppf<0x4E>(x); x += dppf<0x141>(x); x += dppf<0x140>(x);
  return (rlf(x, 0) + rlf(x, 16)) + (rlf(x, 32) + rlf(x, 48));
}
__device__ __forceinline__ void phase_route(PR p, int bid, int nb) {
  const int lane = ltid() & 63, wid = ltid() >> 6;
  const f32x4 bias = *(const f32x4*)(p.router_bias + lane * 4);
  const int stride = nb * 8;
  int t = bid * 8 + wid;
  f32x4 nlg = {0.f, 0.f, 0.f, 0.f};
  if (t < T) nlg = *(const f32x4*)(p.logits + (size_t)t * NE + lane * 4);
  int pend_t = -1, pend_rank = 0;
  for (; t < T; t += stride) {
    const f32x4 lg = nlg;
    { const int tn = (t + stride < T) ? t + stride : t; nlg = *(const f32x4*)(p.logits + (size_t)tn * NE + lane * 4); }
    float sc[4], v[4];
#pragma unroll
    for (int j = 0; j < 4; ++j) { sc[j] = sigmoidf_(lg[j]); v[j] = sc[j] + bias[j]; }
    float m1 = fmaxf(v[0], v[1]), m2 = fminf(v[0], v[1]);
#pragma unroll
    for (int j = 2; j < 4; ++j) { const float nm1 = fmaxf(m1, v[j]); m2 = fmaxf(fminf(m1, v[j]), m2); m1 = nm1; }
    { const float o1 = dppf<0xB1>(m1), o2 = dppf<0xB1>(m2); const float nm1 = fmaxf(m1, o1); m2 = fmaxf(fminf(m1, o1), fmaxf(m2, o2)); m1 = nm1; }
    { const float o1 = dppf<0x4E>(m1), o2 = dppf<0x4E>(m2); const float nm1 = fmaxf(m1, o1); m2 = fmaxf(fminf(m1, o1), fmaxf(m2, o2)); m1 = nm1; }
    { const float o1 = dppf<0x141>(m1), o2 = dppf<0x141>(m2); const float nm1 = fmaxf(m1, o1); m2 = fmaxf(fminf(m1, o1), fmaxf(m2, o2)); m1 = nm1; }
    const float gs = m1 + m2;
    const int grp = lane >> 3;
    int rank = 0;
#pragma unroll
    for (int g2 = 0; g2 < 8; ++g2) { const float og = rlf(gs, g2 * 8); rank += (og > gs || (og == gs && g2 < grp)) ? 1 : 0; }
    const bool gsel = rank < 4;
#pragma unroll
    for (int j = 0; j < 4; ++j) v[j] = gsel ? v[j] : -INFINITY;
    int my_e = 0; float my_s = 0.f, wsum = 0.f;
#pragma unroll 1
    for (int r = 0; r < 8; ++r) {
      const float wm = wave_max(fmaxf(fmaxf(v[0], v[1]), fmaxf(v[2], v[3])));
      const int my_j = (v[0] == wm) ? 0 : (v[1] == wm) ? 1 : (v[2] == wm) ? 2 : (v[3] == wm) ? 3 : 4;
      const unsigned long long ball = __ballot(my_j < 4);
      const int ol = ball ? (int)__builtin_ctzll(ball) : 0;
      const int oj = __builtin_amdgcn_readlane(my_j, ol) & 3;
      const int be = ol * 4 + oj;
      float s_own = 0.f;
#pragma unroll
      for (int j = 0; j < 4; ++j) if (lane == ol && oj == j) { s_own = sc[j]; v[j] = -INFINITY; }
      const float s_w = rlf(s_own, ol);
      wsum += s_w;
      if (lane == r) { my_e = be; my_s = s_w; }
    }
    if (pend_t >= 0 && lane < 8) p.tk_rank[pend_t * 8 + lane] = pend_rank;
    if (lane < 8) {
      p.tk_idx[t * 8 + lane] = my_e;
      p.tk_w[t * 8 + lane] = my_s / wsum * 2.5f;
      pend_rank = atomicAdd(&p.counts[my_e], 1);
    }
    pend_t = t;
  }
  if (pend_t >= 0 && lane < 8) p.tk_rank[pend_t * 8 + lane] = pend_rank;
}
__device__ __forceinline__ void phase_scatter(PR p, int bid, int nb, lds_ptr smem) {
  LAS int* st = (LAS int*)smem;
  __syncthreads();
  if (ltid() < 256) st[ltid() + 1] = (p.counts[ltid()] + 127) / 128 * 128;
  if (ltid() == 0) st[0] = 0;
  __syncthreads();
  if (ltid() < 64) {
    const int ln = ltid();
    const int c0 = st[4 * ln + 1], c1 = st[4 * ln + 2], c2 = st[4 * ln + 3], c3 = st[4 * ln + 4];
    const int tot = c0 + c1 + c2 + c3;
    int inc = tot;
    #pragma unroll
    for (int o = 1; o < 64; o <<= 1) { const int v = __shfl_up(inc, o, 64); if (ln >= o) inc += v; }
    const int b0 = inc - tot;
    st[4 * ln + 1] = b0 + c0; st[4 * ln + 2] = b0 + c0 + c1; st[4 * ln + 3] = b0 + c0 + c1 + c2; st[4 * ln + 4] = inc;
  }
  __syncthreads();
  if (bid == 0) {
    if (ltid() < 256) { const int e = ltid(); for (int b = st[e] / 128; b < st[e + 1] / 128; ++b) p.blk_exp[b] = e; }
    for (int b = st[256] / 128 + ltid(); b < NBLK128; b += NTHR) p.blk_exp[b] = -1;
  }
  if (bid >= 8 && bid < 16 && ltid() < 64) {
    const int x = bid - 8, ln = ltid() & 63, half = ln >> 5;
    const int e = x + 8 * (ln & 31);
    const int np = (st[e + 1] / 128 - st[e] / 128 + 1) >> 1;
    int inc = np;
    #pragma unroll
    for (int o = 1; o < 32; o <<= 1) { const int v = __shfl_up(inc, o, 32); if ((ln & 31) >= o) inc += v; }
    const int base = inc - np;
    if (half == 0) for (int j = 0; j < np; ++j) p.moe_list[x * NBLK128 + base + j] = st[e] / 128 + 2 * j;
    if (ln == 31) p.moe_cnt[x] = inc;
  }
  for (int i = bid * NTHR + ltid(); i < T * 8; i += nb * NTHR) {
    const int e = p.tk_idx[i], pos = st[e] + p.tk_rank[i];
    p.slot_tok[pos] = i >> 3;
    p.slot_of[i] = pos;
  }
}

__global__ void __launch_bounds__(64) k_s5_naive(P p) {
  __shared__ float sre[64], sim[64], cre[16][64], cim[16][64], us[16];
  const int b = blockIdx.x / S5G, g = blockIdx.x % S5G, lane = threadIdx.x;
  const float are = p.abar[(g * 64 + lane) * 2], aim = p.abar[(g * 64 + lane) * 2 + 1];
  float bre[16], bim[16];
  for (int h = 0; h < 16; ++h) { bre[h] = p.bbar[((g * 64 + lane) * 16 + h) * 2]; bim[h] = p.bbar[((g * 64 + lane) * 16 + h) * 2 + 1]; }
  for (int i = lane; i < 1024; i += 64) { cre[i >> 6][i & 63] = p.c_re[g * 1024 + i]; cim[i >> 6][i & 63] = p.c_im[g * 1024 + i]; }
  const float dsk = lane < 16 ? p.s5_d[g * 16 + lane] : 0.f;
  float s_re = 0.f, s_im = 0.f;
  __syncthreads();
  for (int l = 0; l < SEQ; ++l) {
    const size_t t = (size_t)b * SEQ + l;
    if (lane < 16) us[lane] = bf2f(p.proj[t * LDP + OFF_U + g * 16 + lane]);
    __syncthreads();
    float bur = 0.f, bui = 0.f;
    for (int h = 0; h < 16; ++h) { bur += us[h] * bre[h]; bui += us[h] * bim[h]; }
    const float nr = are * s_re - aim * s_im + bur, ni = are * s_im + aim * s_re + bui;
    s_re = nr; s_im = ni;
    sre[lane] = s_re; sim[lane] = s_im;
    __syncthreads();
    if (lane < 16) {
      float y = dsk * us[lane];
      for (int q = 0; q < 64; ++q) y += sre[q] * cre[lane][q] - sim[q] * cim[lane][q];
      p.yA[t * S5W + g * 16 + lane] = f2bf(geluf_(y));
    }
    __syncthreads();
  }
}

__global__ void __launch_bounds__(128) k_gla_naive(P p) {
  __shared__ float qs[32][64], ks[32][64], as[32][64], gl[32][16], w2[16][64], b2[64];
  const int b = blockIdx.x / GH, h = blockIdx.x % GH, tid = threadIdx.x;
  for (int i = tid; i < 16 * 64; i += 128) w2[i >> 6][i & 63] = p.w_gk2[(i >> 6) * GKEY + h * 64 + (i & 63)];
  if (tid < 64) b2[tid] = p.b_gk2[h * 64 + tid];
  float S[64];
  for (int d = 0; d < 64; ++d) S[d] = 0.f;
  for (int l0 = 0; l0 < SEQ; l0 += 32) {
    __syncthreads();
    for (int i = tid; i < 32 * 64; i += 128) {
      const size_t t = (size_t)b * SEQ + l0 + (i >> 6);
      qs[i >> 6][i & 63] = bf2f(p.proj[t * LDP + OFF_Q + h * 64 + (i & 63)]) * 0.125f;
      ks[i >> 6][i & 63] = bf2f(p.proj[t * LDP + OFF_K + h * 64 + (i & 63)]);
    }
    for (int i = tid; i < 32 * 16; i += 128) { const size_t t = (size_t)b * SEQ + l0 + (i >> 4); gl[i >> 4][i & 15] = p.gkl[t * 16 + (i & 15)]; }
    __syncthreads();
    for (int i = tid; i < 32 * 64; i += 128) {
      const int s = i >> 6, d = i & 63;
      float gk = b2[d];
      for (int r = 0; r < 16; ++r) gk += gl[s][r] * w2[r][d];
      as[s][d] = __expf(logsigmoidf_(gk) * (1.f / 16.f));
    }
    __syncthreads();
    for (int s = 0; s < 32; ++s) {
      const size_t t = (size_t)b * SEQ + l0 + s;
      const float v = bf2f(p.proj[t * LDP + OFF_V + h * 128 + tid]);
      float o = 0.f;
      for (int d = 0; d < 64; ++d) { S[d] = as[s][d] * S[d] + ks[s][d] * v; o += qs[s][d] * S[d]; }
      p.oraw[t * GVAL + h * 128 + tid] = o;
    }
  }
}
__global__ void __launch_bounds__(256) k_gla_post(P p) {
  const int idx = blockIdx.x * 4 + (threadIdx.x >> 6), lane = threadIdx.x & 63;
  const int t = idx / GH, h = idx % GH;
  const float o0 = p.oraw[(size_t)t * GVAL + h * 128 + lane], o1 = p.oraw[(size_t)t * GVAL + h * 128 + 64 + lane];
  float ss = o0 * o0 + o1 * o1;
  for (int o = 32; o > 0; o >>= 1) ss += __shfl_xor(ss, o);
  const float r = rsqrtf(ss * (1.f / 128.f) + 1e-6f);
  const float r0 = bf2f(p.proj[(size_t)t * LDP + OFF_R + h * 128 + lane]), r1 = bf2f(p.proj[(size_t)t * LDP + OFF_R + h * 128 + 64 + lane]);
  p.yB[(size_t)t * GVAL + h * 128 + lane] = f2bf(o0 * r * p.gla_norm_g[lane] * siluf_(r0));
  p.yB[(size_t)t * GVAL + h * 128 + 64 + lane] = f2bf(o1 * r * p.gla_norm_g[64 + lane] * siluf_(r1));
}

__global__ void __launch_bounds__(64) k_route(P p) {
  const int t = blockIdx.x * 64 + threadIdx.x;
  const float* lg = p.logits + (size_t)t * NE;
  float gs[8];
#pragma unroll
  for (int g = 0; g < 8; ++g) {
    float m1 = -INFINITY, m2 = -INFINITY;
    for (int j = 0; j < 32; ++j) { const float v = sigmoidf_(lg[g * 32 + j]) + p.router_bias[g * 32 + j]; if (v > m1) { m2 = m1; m1 = v; } else if (v > m2) m2 = v; }
    gs[g] = m1 + m2;
  }
  unsigned gmask = 0;
#pragma unroll
  for (int r = 0; r < 4; ++r) { int best = -1; float bv = -INFINITY;
#pragma unroll
    for (int g = 0; g < 8; ++g) if (!((gmask >> g) & 1u) && gs[g] > bv) { bv = gs[g]; best = g; }
    gmask |= 1u << best; }
  int sel[8]; float sw[8]; float wsum = 0.f;
#pragma unroll
  for (int r = 0; r < 8; ++r) {
    int best = -1; float bv = -INFINITY;
    for (int e = 0; e < NE; ++e) {
      if (!((gmask >> (e >> 5)) & 1u)) continue;
      bool taken = false;
#pragma unroll
      for (int q = 0; q < 8; ++q) taken |= (q < r) && (sel[q] == e);
      if (taken) continue;
      const float v = sigmoidf_(lg[e]) + p.router_bias[e];
      if (v > bv) { bv = v; best = e; }
    }
    best = best < 0 ? r : best;
    sel[r] = best; sw[r] = sigmoidf_(lg[best]); wsum += sw[r];
  }
#pragma unroll
  for (int r = 0; r < 8; ++r) {
    p.tk_idx[t * 8 + r] = sel[r];
    p.tk_w[t * 8 + r] = sw[r] / wsum * 2.5f;
    p.tk_rank[t * 8 + r] = atomicAdd(&p.counts[sel[r]], 1);
  }
}
__global__ void __launch_bounds__(256) k_offsets(P p) {
  __shared__ int pad[256], st[257];
  const int e = threadIdx.x;
  pad[e] = (p.counts[e] + 127) / 128 * 128;
  __syncthreads();
  if (e == 0) { int s = 0; for (int i = 0; i < 256; ++i) { st[i] = s; s += pad[i]; } st[256] = s; }
  __syncthreads();
  p.pad_start[e] = st[e];
  if (e == 0) p.pad_start[256] = st[256];
  for (int b = st[e] / 128; b < st[e + 1] / 128; ++b) p.blk_exp[b] = e;
  for (int b = st[256] / 128 + e; b < NBLK128; b += 256) p.blk_exp[b] = -1;
}
__global__ void __launch_bounds__(256) k_scatter(P p) {
  const int i = blockIdx.x * 256 + threadIdx.x;
  const int e = p.tk_idx[i], pos = p.pad_start[e] + p.tk_rank[i];
  p.slot_tok[pos] = i >> 3;
  p.slot_of[i] = pos;
}

__device__ __forceinline__ void phase_combine(PR p, int bid, int nb) {
  const int lane = ltid() & 63, wid = ltid() >> 6;
  for (int t = bid * 8 + wid; t < T; t += nb * 8) {
    const int b = t / SEQ;
    int so[8]; float w[8];
#pragma unroll
    for (int k = 0; k < 8; ++k) { so[k] = p.slot_of[t * 8 + k]; w[k] = p.tk_w[t * 8 + k]; }
    float v[16], ss = 0.f;
#pragma unroll
    for (int i = 0; i < 4; ++i) {
      const int c0 = lane * 4 + 256 * i;
      f32x4 m = ld_bf4(p.S + (size_t)t * D + c0);
#pragma unroll
      for (int k = 0; k < 8; ++k) { const f32x4 y = ld_bf4(p.Y + (size_t)so[k] * D + c0); m[0] += w[k] * y[0]; m[1] += w[k] * y[1]; m[2] += w[k] * y[2]; m[3] += w[k] * y[3]; }
      const f32x4 xv = *(const f32x4*)(p.x1 + (size_t)t * D + c0), gg = *(const f32x4*)(p.mod + b * 6144 + 5 * D + c0);
#pragma unroll
      for (int j = 0; j < 4; ++j) { v[i * 4 + j] = xv[j] + gg[j] * m[j]; ss += v[i * 4 + j] * v[i * 4 + j]; }
    }
#pragma unroll
    for (int o = 32; o > 0; o >>= 1) ss += __shfl_xor(ss, o);
    const float r = rsqrtf(ss * (1.f / D) + 1e-6f);
#pragma unroll
    for (int i = 0; i < 4; ++i) {
      const int c0 = lane * 4 + 256 * i; const f32x4 fg = *(const f32x4*)(p.final_g + c0);
      f32x4 o; o[0] = v[i * 4] * r * fg[0]; o[1] = v[i * 4 + 1] * r * fg[1]; o[2] = v[i * 4 + 2] * r * fg[2]; o[3] = v[i * 4 + 3] * r * fg[3];
      *(f32x4*)(p.out + (size_t)t * D + c0) = o;
    }
  }
}


template <class Epi>
__global__ void __launch_bounds__(256) k_gemm_naive(const bf16_t* __restrict__ A, int lda, const float* __restrict__ Bm, int ldb, int M, int N, int K, Epi epi) {
  __shared__ float As[16][68];
  __shared__ float Bs[16][68];
  const int tx = threadIdx.x & 15, ty = threadIdx.x >> 4;
  const int row0 = blockIdx.y * 64, col0 = blockIdx.x * 64;
  float acc[4][4];
  for (int i = 0; i < 4; ++i) for (int j = 0; j < 4; ++j) acc[i][j] = 0.f;
  for (int k0 = 0; k0 < K; k0 += 16) {
    { const int r = threadIdx.x >> 2, k4 = (threadIdx.x & 3) * 4;
      const bf16_t* ap = A + (size_t)(row0 + r) * lda + k0 + k4;
      for (int j = 0; j < 4; ++j) As[k4 + j][r] = bf2f(ap[j]); }
    { const int k = threadIdx.x >> 4, c4 = (threadIdx.x & 15) * 4;
      for (int j = 0; j < 4; ++j) { const int cc = col0 + c4 + j; Bs[k][c4 + j] = cc < N ? Bm[(size_t)(k0 + k) * ldb + cc] : 0.f; } }
    __syncthreads();
    for (int k = 0; k < 16; ++k) {
      float a[4], b[4];
      for (int i = 0; i < 4; ++i) a[i] = As[k][ty * 4 + i];
      for (int j = 0; j < 4; ++j) b[j] = Bs[k][tx * 4 + j];
      for (int i = 0; i < 4; ++i) for (int j = 0; j < 4; ++j) acc[i][j] += a[i] * b[j];
    }
    __syncthreads();
  }
  for (int i = 0; i < 4; ++i) for (int j = 0; j < 4; ++j) { const int r = row0 + ty * 4 + i, cc = col0 + tx * 4 + j; if (cc < N) epi(r, cc, acc[i][j]); }
}
struct NEpiProj { bf16_t* o; __device__ void operator()(int r, int c, float v) const { if (c >= WIN_GK && c < WIN_GK + 16) return; const int cc = c < WIN_GK ? c : c - 16; o[(size_t)r * LDP + cc] = f2bf(v); } };
struct NEpiGlu { const bf16_t* yA; const float* b; bf16_t* z; __device__ void operator()(int r, int c, float v) const { const float y = bf2f(yA[(size_t)r * S5W + c]); z[(size_t)r * S5W + c] = f2bf(y * sigmoidf_(v + b[c])); } };
struct NEpiPA { const bf16_t* proj; float* t; __device__ void operator()(int r, int c, float v) const { t[(size_t)r * D + c] = sigmoidf_(bf2f(proj[(size_t)r * LDP + OFF_GA + c])) * v; } };
struct NEpiPB { const bf16_t* proj; const float* t; bf16_t* m; __device__ void operator()(int r, int c, float v) const { m[(size_t)r * D + c] = f2bf(t[(size_t)r * D + c] + sigmoidf_(bf2f(proj[(size_t)r * LDP + OFF_GB + c])) * v); } };
struct NEpiOut { const float* x; const float* mod; float* x1; __device__ void operator()(int r, int c, float v) const { const int b = r / SEQ; x1[(size_t)r * D + c] = x[(size_t)r * D + c] + mod[b * 6144 + 2 * D + c] * v; } };
struct NEpiF32 { float* o; long ld; __device__ void operator()(int r, int c, float v) const { o[(size_t)r * ld + c] = v; } };
struct NEpiShUp { const float* g; bf16_t* h; __device__ void operator()(int r, int c, float v) const { h[(size_t)r * SFF + c] = f2bf(siluf_(g[(size_t)r * SFF + c]) * v); } };
struct NEpiBf { bf16_t* o; long ld; __device__ void operator()(int r, int c, float v) const { o[(size_t)r * ld + c] = f2bf(v); } };
__global__ void __launch_bounds__(256) k_moe_naive(P p) {
  __shared__ float xs[16][1024];
  __shared__ float hs[16][256];
  __shared__ int toks[16];
  const int s0 = blockIdx.x * 16, e = p.blk_exp[s0 / 128], tid = threadIdx.x;
  if (e < 0) return;
  if (tid < 16) toks[tid] = p.slot_tok[s0 + tid];
  __syncthreads();
  bool any = false;
  for (int s = 0; s < 16; ++s) any |= toks[s] >= 0;
  if (!any) return;
  for (int i = tid; i < 16 * 1024; i += 256) { const int s = i >> 10, d = i & 1023; xs[s][d] = toks[s] >= 0 ? bf2f(p.h2[(size_t)toks[s] * D + d]) : 0.f; }
  __syncthreads();
  {
    float ag[16], au[16];
    for (int s = 0; s < 16; ++s) { ag[s] = 0.f; au[s] = 0.f; }
    const float* wg = p.ew_gate + (size_t)e * D * EFF + tid;
    const float* wu = p.ew_up + (size_t)e * D * EFF + tid;
    for (int d = 0; d < D; ++d) {
      const float g = wg[(size_t)d * EFF], u = wu[(size_t)d * EFF];
      for (int s = 0; s < 16; ++s) { const float xv = xs[s][d]; ag[s] += xv * g; au[s] += xv * u; }
    }
    for (int s = 0; s < 16; ++s) hs[s][tid] = bf2f(f2bf(siluf_(ag[s]) * au[s]));
  }
  __syncthreads();
  for (int nb = 0; nb < 4; ++nb) {
    float acc[16];
    for (int s = 0; s < 16; ++s) acc[s] = 0.f;
    const float* wd = p.ew_down + (size_t)e * EFF * D + nb * 256 + tid;
    for (int j = 0; j < EFF; ++j) { const float w = wd[(size_t)j * D]; for (int s = 0; s < 16; ++s) acc[s] += hs[s][j] * w; }
    for (int s = 0; s < 16; ++s) if (toks[s] >= 0) p.Y[(size_t)(s0 + s) * D + nb * 256 + tid] = f2bf(acc[s]);
  }
}

#define SMEM_DECL __shared__ __attribute__((aligned(16))) unsigned char smem_raw[SMEM_BYTES]; const lds_ptr smem = (lds_ptr)smem_raw;


#define XB_TMO      128
#define XB_XCNT(j)  (256  + 64 * (j))
#define XB_XSUB(j)  (1280 + 64 * (j))
#define XB_XGEN(j)  (2304 + 64 * (j))
#define XB_TOP      3328
#define XB_TOPGEN   3392
#define XCD_BAR_WORDS 3456
#define XB_SPIN_CAP (1u << 18)
__device__ __forceinline__ unsigned xb_ld(unsigned* q)              { return __hip_atomic_load(q, __ATOMIC_RELAXED, __HIP_MEMORY_SCOPE_AGENT); }
__device__ __forceinline__ unsigned xb_add(unsigned* q, unsigned v) { return __hip_atomic_fetch_add(q, v, __ATOMIC_RELAXED, __HIP_MEMORY_SCOPE_AGENT); }
__device__ __forceinline__ unsigned xb_xcc_id() { return (unsigned)__builtin_amdgcn_s_getreg((3 << 11) | 20) & 0xFu; }
#define XB_SPIN(cond, bar) do { unsigned _sp = 0; while (cond) { __builtin_amdgcn_s_sleep(1); \
    if ((++_sp & 255u) == 0u) { if (xb_ld(&(bar)[XB_TMO])) break; if (_sp > XB_SPIN_CAP) { atomicAdd(&(bar)[XB_TMO], 1u); break; } } } } while (0)
struct XcdBarrier { unsigned* bar; unsigned x; volatile LAS unsigned* st; };
__device__ __forceinline__ XcdBarrier xcd_barrier_post(unsigned* bar, volatile LAS unsigned* st) {
  XcdBarrier b; b.bar = bar; b.x = xb_xcc_id(); b.st = st;
  if (threadIdx.x == 0) (void)xb_add(&bar[XB_XCNT(b.x)], 1u);
  return b;
}
__device__ __forceinline__ void xcd_barrier_complete(unsigned* bar, unsigned x, unsigned& nloc, unsigned& nx) {
  const unsigned G = gridDim.x * gridDim.y * gridDim.z;
  unsigned sum, cnt, mine, sp = 0u;
  for (;;) {
    sum = 0u; cnt = 0u; mine = 0u;
#pragma unroll
    for (unsigned j = 0; j < 16; ++j) { const unsigned c = xb_ld(&bar[XB_XCNT(j)]); sum += c; cnt += (c > 0u) ? 1u : 0u; mine = (j == x) ? c : mine; }
    if (sum == G) break;
    __builtin_amdgcn_s_sleep(1);
    if ((++sp & 255u) == 0u) { if (xb_ld(&bar[XB_TMO])) break; if (sp > XB_SPIN_CAP) { atomicAdd(&bar[XB_TMO], 1u); break; } }
  }
  nloc = mine > 0u ? mine : 1u; nx = cnt > 0u ? cnt : 1u;
}
__device__ __forceinline__ void xcd_barrier(const XcdBarrier& b) {
  asm volatile("s_waitcnt vmcnt(0)" ::: "memory");
  __syncthreads();
  if (threadIdx.x == 0) {
    unsigned* bar = b.bar;
    __builtin_amdgcn_s_waitcnt(0);
    unsigned nloc = b.st[0], nx = b.st[1];
    if (nloc == 0u) { xcd_barrier_complete(bar, b.x, nloc, nx); b.st[0] = nloc; b.st[1] = nx; }
    const unsigned old = xb_add(&bar[XB_XSUB(b.x)], 1u);
    const unsigned gen = old / nloc;
    if (old + 1u == (gen + 1u) * nloc) {
      __builtin_amdgcn_fence(__ATOMIC_RELEASE, "agent");
      asm volatile("s_waitcnt vmcnt(0)" ::: "memory");
      const unsigned og = xb_add(&bar[XB_TOP], 1u);
      const unsigned tg = og / nx;
      if (og + 1u == (tg + 1u) * nx) xb_add(&bar[XB_TOPGEN], 1u);
      else XB_SPIN(xb_ld(&bar[XB_TOPGEN]) == tg, bar);
      __builtin_amdgcn_fence(__ATOMIC_ACQUIRE, "agent");
      xb_add(&bar[XB_XGEN(b.x)], 1u);
      asm volatile("s_waitcnt vmcnt(0)" ::: "memory");
    } else {
      XB_SPIN(xb_ld(&bar[XB_XGEN(b.x)]) == gen, bar);
      __builtin_amdgcn_fence(__ATOMIC_ACQUIRE, "agent");
      asm volatile("s_waitcnt vmcnt(0)" ::: "memory");
    }
  }
  __syncthreads();
}

__device__ __forceinline__ const __attribute__((address_space(4))) P* kargs() { auto q = __builtin_amdgcn_kernarg_segment_ptr(); asm volatile("" : "+s"(q)); return (const __attribute__((address_space(4))) P*)q; }
#define PK (*kargs())
__global__ void __launch_bounds__(NTHR) k_fused(P p_unused) {
  SMEM_DECL
  const int bid = blockIdx.x, nb = gridDim.x;
  volatile LAS unsigned* xbw = (volatile LAS unsigned*)(smem + SMEM_BYTES - 16);
  if (threadIdx.x == 0) { xbw[0] = 0u; xbw[1] = 0u; }
  __syncthreads();
  const XcdBarrier xb = xcd_barrier_post(PK.bar, xbw);
#define GSYNC() xcd_barrier(xb)
#define RUN(k, ...) do { __VA_ARGS__; if (REP_PHASE == (k)) { _Pragma("unroll 1") for (int r_ = 0; r_ < REP_N; ++r_) { __builtin_amdgcn_sched_barrier(0); __VA_ARGS__; } } } while (0)
  RUN(0, phase_prep(PK, bid, nb, smem));                                                                   GSYNC();
  RUN(1, phase_norm<false>(PK, PK.x, PK.norm1_g, 0, D, PK.h1, bid, nb, smem));                                 GSYNC();
  RUN(2, phase_gemm_dense256_bf16(PK.h1, D, PK.wb_in, LDP, T, LDP, D, PK.proj, LDP, bid, nb, smem); gk_rows(PK, bid, nb));     GSYNC();
  RUN(3, phase_mix_local(PK, bid, nb, smem, 3));                                                           GSYNC();
  RUN(4, phase_mix_carry(PK, bid, nb, 3));                                                                 GSYNC();
  RUN(5, phase_mix_final(PK, bid, nb, smem, 3));                                                           GSYNC();
  RUN(6, phase_gemm_dense(PK.yA, S5W, PK.wb_glu, S5W, T, S5W, S5W, EpiGlu{PK.yA, PK.b_glu, PK.zA}, bid, nb, smem));   GSYNC();
  RUN(7, phase_gemm_mixed(PK, bid, nb, smem));                                                             GSYNC();
  RUN(8, phase_gemm_dense256(PK.mixed, D, PK.wb_out, D, T, D, D, EpiOut{PK.x, PK.mod, PK.x1}, bid, nb, smem));    GSYNC();
  RUN(9, phase_norm<false>(PK, PK.x1, PK.norm2_g, 3 * D, 4 * D, PK.h2, bid, nb, smem));                       GSYNC();
  RUN(10, phase_gemm_rs(PK, bid, nb, smem));                                                               GSYNC();
  phase_route(PK, bid, nb);                                                                                GSYNC();
  RUN(12, phase_scatter(PK, bid, nb, smem));                                                               GSYNC();
  phase_moe_pair<1>(PK, bid, nb, smem);                                                                    GSYNC();
  phase_moe_pair<2>(PK, bid, nb, smem);
  RUN(14, phase_gemm_dense256_bf16(PK.shH, SFF, PK.wb_sd, D, T, D, SFF, PK.S, D, bid, nb, smem));        GSYNC();
  RUN(15, phase_combine(PK, bid, nb));
}

static inline size_t al256(size_t v) { return (v + 255) & ~(size_t)255; }

extern "C" void kernel_launch(void* const* d_in, const int* in_sizes, int n_in, void* d_out, int out_size, void* d_ws, size_t ws_size, hipStream_t stream) {
  P p{};
  const float** pin = (const float**)&p;
  for (int i = 0; i < 32; ++i) pin[i] = (const float*)d_in[i];
  p.out = (float*)d_out;
  char* w = (char*)d_ws; size_t off = 0;
  auto take = [&](size_t bytes) { char* r = w + off; off = al256(off + bytes); return (void*)r; };
  p.mod = (float*)take(8 * 6144 * 4);
  p.wb_in = (bf16_t*)take((size_t)D * LDP * 2);
  p.wb_glu = (bf16_t*)take((size_t)S5W * S5W * 2);
  p.wb_pa = (bf16_t*)take((size_t)S5W * D * 2);
  p.wb_pb = (bf16_t*)take((size_t)GVAL * D * 2);
  p.wb_out = (bf16_t*)take((size_t)D * D * 2);
  p.wb_rs = (bf16_t*)take((size_t)D * 768 * 2);
  p.wb_sd = (bf16_t*)take((size_t)SFF * D * 2);
  p.h1 = (bf16_t*)take((size_t)T * D * 2);
  p.gkl = (float*)take((size_t)T * 16 * 4);
  p.proj = (bf16_t*)take((size_t)T * LDP * 2);
  p.abar = (float*)take(S5G * S5P * 2 * 4);
  p.bbar = (float*)take(S5G * S5P * S5H * 2 * 4);
  p.yA = (bf16_t*)take((size_t)T * S5W * 2);
  p.oraw = (float*)take((size_t)T * GVAL * 4);
  p.yB = (bf16_t*)take((size_t)T * GVAL * 2);
  p.zA = (bf16_t*)take((size_t)T * S5W * 2);
  p.mixed = (bf16_t*)take((size_t)T * D * 2);
  p.x1 = (float*)take((size_t)T * D * 4);
  p.h2 = (bf16_t*)take((size_t)T * D * 2);
  p.logits = (float*)take((size_t)T * NE * 4);
  p.tk_idx = (int*)take((size_t)T * 8 * 4);
  p.tk_w = (float*)take((size_t)T * 8 * 4);
  p.tk_rank = (int*)take((size_t)T * 8 * 4);
  p.slot_of = (int*)take((size_t)T * 8 * 4);
  p.counts = (int*)take(256 * 4);
  p.pad_start = (int*)take(257 * 4);
  p.blk_exp = (int*)take(NBLK128 * 4);
  p.slot_tok = (int*)take((size_t)NSLOT * 4);
  p.Y = (bf16_t*)take((size_t)NSLOT * D * 2);
  p.shH = (bf16_t*)take((size_t)T * SFF * 2);
  p.S = (bf16_t*)take((size_t)T * D * 2);
  p.bbarT = (bf16_t*)take((size_t)S5G * 128 * 16 * 2);
  p.cmT = (bf16_t*)take((size_t)S5G * 16 * 128 * 2);
  p.apow64 = (float*)take(S5G * S5P * 2 * 4);
  p.s5E = (float*)take((size_t)NB * 32 * S5G * 64 * 2 * 4);
  p.s5Sin = (float*)take((size_t)NB * 32 * S5G * 64 * 2 * 4);
  p.glaKV = (float*)take((size_t)1024 * 64 * 128 * 4);
  p.glaDec = (float*)take((size_t)1024 * 64 * 4);
  p.glaSin = (bf16_t*)take((size_t)1024 * 64 * 128 * 2);
  p.wgkT = (bf16_t*)take((size_t)16 * D * 2);
  p.moe_list = (int*)take((size_t)8 * NBLK128 * 4);
  p.moe_cnt = (int*)take(64);
  p.moe_ctr = (int*)take(64);
  p.Hbuf = (bf16_t*)take((size_t)NSLOT * EFF * 2);
  p.bar = (unsigned*)take(XCD_BAR_WORDS * 4);
  if (off > ws_size) { fprintf(stderr, "workspace too small: need %zu have %zu\n", off, ws_size); return; }

  static int grid_blocks = 0;
  if (!grid_blocks) {
    int dev = 0, cus = 0, per_cu = 0;
    (void)hipGetDevice(&dev);
    (void)hipDeviceGetAttribute(&cus, hipDeviceAttributeMultiprocessorCount, dev);
    (void)hipOccupancyMaxActiveBlocksPerMultiprocessor(&per_cu, k_fused, NTHR, 0);
    grid_blocks = (per_cu >= 1) ? cus : 0;
    grid_blocks &= ~7;
    if (grid_blocks <= 0) { fprintf(stderr, "occupancy query says the fused kernel does not fit (per_cu=%d cus=%d)\n", per_cu, cus); grid_blocks = 0; return; }
  }
  (void)hipMemsetAsync(p.bar, 0, XCD_BAR_WORDS * 4, stream);
  void* args[] = {&p};
  hipError_t e = hipLaunchCooperativeKernel((const void*)k_fused, dim3(grid_blocks), dim3(NTHR), args, 0, stream);
  if (e != hipSuccess) fprintf(stderr, "cooperative launch failed: %s (grid %d)\n", hipGetErrorString(e), grid_blocks);
}
```

```cpp
#include <hip/hip_runtime.h>
#include <hip/hip_cooperative_groups.h>
namespace cg = cooperative_groups;
#include <cstdint>
#include <cstdio>

typedef unsigned short bf16_t;
typedef short s16x8 __attribute__((ext_vector_type(8)));
typedef short s16x4 __attribute__((ext_vector_type(4)));
typedef float f32x4 __attribute__((ext_vector_type(4)));
typedef unsigned u32x4 __attribute__((ext_vector_type(4)));
typedef unsigned u32x2 __attribute__((ext_vector_type(2)));
#define LAS __attribute__((address_space(3)))
typedef LAS unsigned char* lds_ptr;

constexpr int D = 1024, NB = 8, SEQ = 2048, T = NB * SEQ;
constexpr int S5W = 512, S5G = 32, S5H = 16, S5P = 64;
constexpr int GH = 4, GDK = 64, GDV = 128, GKEY = 256, GVAL = 512, GRANK = 16;
constexpr int NE = 256, TOPK = 8, NGRP = 8, EFF = 256, SFF = 256;
constexpr int INW = 4112, LDP = 4096;
constexpr int OFF_U = 0, OFF_Q = 512, OFF_K = 768, OFF_V = 1024, OFF_R = 1536, OFF_GA = 2048, OFF_GB = 3072;
constexpr int WIN_GK = 1536;
constexpr int NSLOT = 163584, NBLK128 = NSLOT / 128;
constexpr int NTHR = 512;
constexpr int USE_MFMA = 127;
constexpr int USE_NEW = 7;
constexpr int REP_PHASE = -1, REP_N = 8;
constexpr int MOE_REP_GU = 1, MOE_REP_DN = 1;

__device__ __forceinline__ float bf2f(bf16_t v) { return __uint_as_float(((unsigned)v) << 16); }
__device__ __forceinline__ bf16_t f2bf(float f) { return __builtin_bit_cast(unsigned short, (__bf16)f); }
typedef float f32x2 __attribute__((ext_vector_type(2)));
typedef __bf16 bf16x2_t __attribute__((ext_vector_type(2)));
__device__ __forceinline__ unsigned cvtpk(float lo, float hi) { const f32x2 v = {lo, hi}; return __builtin_bit_cast(unsigned, __builtin_convertvector(v, bf16x2_t)); }
__device__ __forceinline__ float sigmoidf_(float x) { return __builtin_amdgcn_rcpf(1.f + __expf(-x)); }
__device__ __forceinline__ float siluf_(float x) { return x * __builtin_amdgcn_rcpf(1.f + __expf(-x)); }
__device__ __forceinline__ float geluf_(float x) { const float u = 0.7978845608028654f * (x + 0.044715f * x * x * x); return x * __builtin_amdgcn_rcpf(1.f + __expf(-2.f * u)); }
__device__ __forceinline__ float logsigmoidf_(float x) { return fminf(x, 0.f) - __logf(1.f + __expf(-fabsf(x))); }

struct P;
typedef const __attribute__((address_space(4))) P& PR;

__device__ __forceinline__ int ltid() { int t = threadIdx.x; asm volatile("" : "+v"(t)); return t; }

struct P {
  const float *x, *c, *ada_w, *ada_b, *norm1_g, *w_in, *lam_re, *lam_im, *log_dt, *b_re, *b_im, *c_re, *c_im, *s5_d, *w_glu, *b_glu, *w_proj_a,
      *w_gk2, *b_gk2, *gla_norm_g, *w_proj_b, *w_out, *norm2_g, *router_w, *router_bias, *ew_gate, *ew_up, *ew_down, *sw_gate, *sw_up, *sw_down, *final_g;
  float* out;
  float* mod;
  bf16_t* wb_in;
  bf16_t* wb_glu;
  bf16_t* wb_pa;
  bf16_t* wb_pb;
  bf16_t* wb_out;
  bf16_t* wb_rs;
  bf16_t* wb_sd;
  bf16_t* h1;
  float* gkl;
  bf16_t* proj;
  float* abar;
  float* bbar;
  bf16_t* yA;
  float* oraw;
  bf16_t* yB;
  bf16_t* zA;
  bf16_t* mixed;
  float* x1;
  bf16_t* h2;
  float* logits;
  int* tk_idx;
  float* tk_w;
  int* tk_rank;
  int* slot_of;
  int* counts;
  int* pad_start;
  int* blk_exp;
  int* slot_tok;
  bf16_t* Y;
  bf16_t* shH;
  bf16_t* S;
  bf16_t* bbarT;
  bf16_t* cmT;
  float* apow64;
  float* s5E;
  float* s5Sin;
  float* glaKV;
  float* glaDec;
  bf16_t* glaSin;
  bf16_t* wgkT;
  int* moe_list;
  int* moe_cnt;
  int* moe_ctr;
  bf16_t* Hbuf;
  unsigned* bar;
};

constexpr int G_ASZ = 128 * 64, G_BSZ = 32 * 512, G_STAGE = G_ASZ + G_BSZ;

__device__ __forceinline__ int a_off(int r, int c) { return r * 64 + ((c ^ ((0x78 >> (((r >> 2) & 3) * 2)) & 3)) << 4); }
__device__ __forceinline__ int b_off(int k, int ch) { return k * 512 + ((ch ^ ((k & 3) | (((k >> 3) & 1) << 2))) << 5); }
__device__ __forceinline__ s16x4 tr_read(lds_ptr p) { return __builtin_bit_cast(s16x4, __builtin_amdgcn_ds_read_tr16_b64_v4i16((LAS s16x4*)p)); }

struct ALoadDense { const bf16_t* A; long lda; __device__ __forceinline__ const bf16_t* rowptr(int r) const { return A + (size_t)r * lda; } };
struct ALoadGatherLds { const bf16_t* A; LAS int* tk; __device__ __forceinline__ const bf16_t* rowptr(int r) const { int t = tk[r]; t = t < 0 ? 0 : t; return A + (size_t)t * D; } };
struct BLoadBf { const bf16_t* Bm; long ldb;
  __device__ __forceinline__ u32x4 load(int kg, int c8) const { return *(const u32x4*)(Bm + (size_t)kg * ldb + c8 * 8); } };
struct BLoadF32 { const float* Bm; long ldb;
  __device__ __forceinline__ u32x4 load(int kg, int c8) const { const float* q = Bm + (size_t)kg * ldb + c8 * 8; const f32x4 a = *(const f32x4*)q, b = *(const f32x4*)(q + 4);
    u32x4 r; r.x = cvtpk(a[0], a[1]); r.y = cvtpk(a[2], a[3]); r.z = cvtpk(b[0], b[1]); r.w = cvtpk(b[2], b[3]); return r; } };
struct BLoadGU { const float* Wg; const float* Wu; long ldb; int h0;
  __device__ __forceinline__ u32x4 load(int kg, int c8) const { const int col = c8 * 8, w = col >> 6, xx = col & 63; const float* base = (xx < 32) ? Wg : Wu;
    const float* q = base + (size_t)kg * ldb + h0 + 32 * w + (xx & 31); const f32x4 a = *(const f32x4*)q, b = *(const f32x4*)(q + 4);
    u32x4 r; r.x = cvtpk(a[0], a[1]); r.y = cvtpk(a[2], a[3]); r.z = cvtpk(b[0], b[1]); r.w = cvtpk(b[2], b[3]); return r; } };

template <bool A_RES, class AL, class BL>
__device__ __forceinline__ void gemm_mainloop(f32x4 (&acc)[4][4], const AL& al, const BL& bl, int nk, lds_ptr stage, lds_ptr resA) {
  const int tid = ltid(), lane = tid & 63, wid = tid >> 6, wm = wid >> 2, wn = wid & 3, fr = lane & 15, fq = lane >> 4;
  const int ar = tid >> 2, ac = tid & 3;
  const int p0 = tid, p1 = tid + 512;
  const int bk0 = p0 >> 5, bc0 = p0 & 31, bk1 = p1 >> 5, bc1 = p1 & 31;
  const bf16_t* aptr = nullptr;
  if (!A_RES) aptr = al.rowptr(ar) + ac * 8;
  const int a_st = a_off(ar, ac);
  const int b_st0 = b_off(bk0, bc0 >> 1) + (bc0 & 1) * 16, b_st1 = b_off(bk1, bc1 >> 1) + (bc1 & 1) * 16;
  int a_rd[4];
#pragma unroll
  for (int mt = 0; mt < 4; ++mt) a_rd[mt] = a_off(wm * 64 + mt * 16 + fr, fq);
  int b_rd[4][2];
#pragma unroll
  for (int nt = 0; nt < 4; ++nt) {
    b_rd[nt][0] = b_off(8 * fq + (fr >> 2), wn * 4 + nt) + (fr & 3) * 8;
    b_rd[nt][1] = b_off(8 * fq + 4 + (fr >> 2), wn * 4 + nt) + (fr & 3) * 8;
  }
#pragma unroll
  for (int mt = 0; mt < 4; ++mt)
#pragma unroll
    for (int nt = 0; nt < 4; ++nt) acc[mt][nt] = (f32x4){0.f, 0.f, 0.f, 0.f};
  u32x4 areg = {0, 0, 0, 0}, breg0, breg1;
  if (!A_RES) areg = *(const u32x4*)aptr;
  breg0 = bl.load(bk0, bc0); breg1 = bl.load(bk1, bc1);
  __syncthreads();
  if (!A_RES) *(LAS u32x4*)(stage + a_st) = areg;
  *(LAS u32x4*)(stage + G_ASZ + b_st0) = breg0;
  *(LAS u32x4*)(stage + G_ASZ + b_st1) = breg1;
  __syncthreads();
  for (int kt = 0; kt < nk; ++kt) {
    const lds_ptr cur = stage + (kt & 1) * G_STAGE, nxt = stage + ((kt + 1) & 1) * G_STAGE;
    const bool more = kt + 1 < nk;
    if (more) {
      if (!A_RES) areg = *(const u32x4*)(aptr + (kt + 1) * 32);
      breg0 = bl.load((kt + 1) * 32 + bk0, bc0); breg1 = bl.load((kt + 1) * 32 + bk1, bc1);
    }
    s16x8 af[4], bfr[4];
    const lds_ptr abase = A_RES ? (resA + kt * G_ASZ) : cur;
#pragma unroll
    for (int mt = 0; mt < 4; ++mt) af[mt] = *(LAS s16x8*)(abase + a_rd[mt]);
#pragma unroll
    for (int nt = 0; nt < 4; ++nt) {
      const s16x4 lo = tr_read(cur + G_ASZ + b_rd[nt][0]), hi = tr_read(cur + G_ASZ + b_rd[nt][1]);
      bfr[nt] = __builtin_shufflevector(lo, hi, 0, 1, 2, 3, 4, 5, 6, 7);
    }
#pragma unroll
    for (int mt = 0; mt < 4; ++mt)
#pragma unroll
      for (int nt = 0; nt < 4; ++nt) acc[mt][nt] = __builtin_amdgcn_mfma_f32_16x16x32_bf16(bfr[nt], af[mt], acc[mt][nt], 0, 0, 0);
    if (more) {
      if (!A_RES) *(LAS u32x4*)(nxt + a_st) = areg;
      *(LAS u32x4*)(nxt + G_ASZ + b_st0) = breg0;
      *(LAS u32x4*)(nxt + G_ASZ + b_st1) = breg1;
    }
    __syncthreads();
  }
}


struct BRaw { f32x4 v[4]; };
struct BLoadF32R { const float* Bm; long ldb;
  __device__ __forceinline__ void load(BRaw& r, int kbase, int tid) const {
    const float* q = Bm + (size_t)(kbase + (tid >> 6)) * ldb + (tid & 63) * 4;
#pragma unroll
    for (int i = 0; i < 4; ++i) r.v[i] = *(const f32x4*)(q + (size_t)(8 * i) * ldb); } };
struct BLoadGUR { const float* Wg; long du; long ldb; int h0;
  __device__ __forceinline__ void load(BRaw& r, int kbase, int tid) const {
    const int col = (tid & 63) * 4, w = col >> 6, xx = col & 63;
    const float* q = Wg + ((xx < 32) ? 0l : du) + (size_t)(kbase + (tid >> 6)) * ldb + h0 + 32 * w + (xx & 31);
#pragma unroll
    for (int i = 0; i < 4; ++i) r.v[i] = *(const f32x4*)(q + (size_t)(8 * i) * ldb); } };
__device__ __forceinline__ u32x4 cvt8(const f32x4& a, const f32x4& b) { u32x4 r; r.x = cvtpk(a[0], a[1]); r.y = cvtpk(a[2], a[3]); r.z = cvtpk(b[0], b[1]); r.w = cvtpk(b[2], b[3]); return r; }

template <bool A_RES, class AL, class BL>
__device__ __forceinline__ void gemm_mainloop_r3(f32x4 (&acc)[4][4], const AL& al, const BL& bl, int nk, lds_ptr stage, lds_ptr resA) {
  const int tid = ltid(), lane = tid & 63, wid = tid >> 6, wm = wid >> 2, wn = wid & 3, fr = lane & 15, fq = lane >> 4;
  const int ar = tid >> 2, ac = tid & 3;
  const bf16_t* aptr = nullptr;
  if (!A_RES) aptr = al.rowptr(ar) + ac * 8;
  const int a_st = a_off(ar, ac);
  int b_st[4];
#pragma unroll
  for (int i = 0; i < 4; ++i) b_st[i] = G_ASZ + b_off((tid >> 6) + 8 * i, (tid & 63) >> 2) + (tid & 3) * 8;
  int a_rd[4];
#pragma unroll
  for (int mt = 0; mt < 4; ++mt) a_rd[mt] = a_off(wm * 64 + mt * 16 + fr, fq);
  int b_rd[4][2];
#pragma unroll
  for (int nt = 0; nt < 4; ++nt) {
    b_rd[nt][0] = G_ASZ + b_off(8 * fq + (fr >> 2), wn * 4 + nt) + (fr & 3) * 8;
    b_rd[nt][1] = G_ASZ + b_off(8 * fq + 4 + (fr >> 2), wn * 4 + nt) + (fr & 3) * 8;
  }
#pragma unroll
  for (int mt = 0; mt < 4; ++mt)
#pragma unroll
    for (int nt = 0; nt < 4; ++nt) acc[mt][nt] = (f32x4){0.f, 0.f, 0.f, 0.f};
  u32x4 ra0 = {0, 0, 0, 0}, ra1 = {0, 0, 0, 0}, ra2 = {0, 0, 0, 0};
  BRaw rb0, rb1, rb2;
#define R3_LOAD(RA, RB, kt_) do { if (!A_RES) RA = *(const u32x4*)(aptr + (size_t)(kt_) * 32); bl.load(RB, (kt_) * 32, tid); } while (0)
#define R3_STORE(RA, RB, st_) do { const lds_ptr s_ = stage + (st_) * G_STAGE; if (!A_RES) *(LAS u32x4*)(s_ + a_st) = RA; \
    _Pragma("unroll") for (int i_ = 0; i_ < 4; ++i_) { u32x2 o_; o_.x = cvtpk(RB.v[i_][0], RB.v[i_][1]); o_.y = cvtpk(RB.v[i_][2], RB.v[i_][3]); *(LAS u32x2*)(s_ + b_st[i_]) = o_; } } while (0)
#define R3_COMPUTE(kt_) do { const lds_ptr cur = stage + ((kt_) & 1) * G_STAGE; const lds_ptr abase = A_RES ? (resA + (kt_) * G_ASZ) : cur; \
    s16x8 af[4], bfr[4]; \
    _Pragma("unroll") for (int mt = 0; mt < 4; ++mt) af[mt] = *(LAS s16x8*)(abase + a_rd[mt]); \
    _Pragma("unroll") for (int nt = 0; nt < 4; ++nt) { const s16x4 lo = tr_read(cur + b_rd[nt][0]), hi = tr_read(cur + b_rd[nt][1]); bfr[nt] = __builtin_shufflevector(lo, hi, 0, 1, 2, 3, 4, 5, 6, 7); } \
    _Pragma("unroll") for (int mt = 0; mt < 4; ++mt) _Pragma("unroll") for (int nt = 0; nt < 4; ++nt) acc[mt][nt] = __builtin_amdgcn_mfma_f32_16x16x32_bf16(bfr[nt], af[mt], acc[mt][nt], 0, 0, 0); } while (0)
#define R3_BODY_U(kt_, RAN, RBN, RAW, RBW) do { const int kl_ = ((kt_) + 3 < nk) ? (kt_) + 3 : nk - 1; R3_LOAD(RAN, RBN, kl_); __builtin_amdgcn_sched_barrier(0); R3_COMPUTE(kt_); __builtin_amdgcn_sched_barrier(0); R3_STORE(RAW, RBW, ((kt_) + 1) & 1); __syncthreads(); } while (0)
#define R3_BODY_T(kt_, RAW, RBW) do { R3_COMPUTE(kt_); if ((kt_) + 1 < nk) R3_STORE(RAW, RBW, ((kt_) + 1) & 1); __syncthreads(); } while (0)
  R3_LOAD(ra0, rb0, 0);
  R3_LOAD(ra1, rb1, 1);
  R3_LOAD(ra2, rb2, 2);
  __syncthreads();
  R3_STORE(ra0, rb0, 0);
  __syncthreads();
  int kt = 0;
  for (; kt + 3 <= nk; kt += 3) {
    R3_BODY_U(kt, ra0, rb0, ra1, rb1);
    R3_BODY_U(kt + 1, ra1, rb1, ra2, rb2);
    R3_BODY_U(kt + 2, ra2, rb2, ra0, rb0);
  }
  if (kt < nk) { R3_BODY_T(kt, ra1, rb1); if (kt + 1 < nk) R3_BODY_T(kt + 1, ra2, rb2); }
#undef R3_BODY_U
#undef R3_BODY_T
#undef R3_LOAD
#undef R3_STORE
#undef R3_COMPUTE
}

constexpr int G_NST = 4;
#define WAIT_VM(n) asm volatile("s_waitcnt vmcnt(" #n ")" ::: "memory")
template <class AL>
__device__ __forceinline__ void gemm_mainloop_glds(f32x4 (&acc)[4][4], const AL& al, const bf16_t* __restrict__ Bm, long ldb, int nk, lds_ptr ring) {
  const int tid = ltid(), lane = tid & 63, wid = tid >> 6, wm = wid >> 2, wn = wid & 3, fr = lane & 15, fq = lane >> 4;
  const int ar = tid >> 2;
  const bf16_t* aptr = al.rowptr(ar) + (((tid & 3) ^ ((0x78 >> (((ar >> 2) & 3) * 2)) & 3)) << 3);
  const int bk = tid >> 5, pc = tid & 31;
  const int bcol = ((((pc >> 1) ^ ((bk & 3) | (((bk >> 3) & 1) << 2))) << 4) | ((pc & 1) << 3));
  const bf16_t* bptr0 = Bm + (size_t)bk * ldb + bcol;
  const bf16_t* bptr1 = bptr0 + (size_t)16 * ldb;
  const size_t bstep = (size_t)32 * ldb;
  int a_rd[4];
#pragma unroll
  for (int mt = 0; mt < 4; ++mt) a_rd[mt] = a_off(wm * 64 + mt * 16 + fr, fq);
  int b_rd[4][2];
#pragma unroll
  for (int nt = 0; nt < 4; ++nt) {
    b_rd[nt][0] = G_ASZ + b_off(8 * fq + (fr >> 2), wn * 4 + nt) + (fr & 3) * 8;
    b_rd[nt][1] = G_ASZ + b_off(8 * fq + 4 + (fr >> 2), wn * 4 + nt) + (fr & 3) * 8;
  }
#pragma unroll
  for (int mt = 0; mt < 4; ++mt)
#pragma unroll
    for (int nt = 0; nt < 4; ++nt) acc[mt][nt] = (f32x4){0.f, 0.f, 0.f, 0.f};
  const lds_ptr dstl = ring + tid * 16;
#define GLDS_ISSUE(kt_) do { const lds_ptr d_ = dstl + ((kt_) & (G_NST - 1)) * G_STAGE; \
    __builtin_amdgcn_global_load_lds((const unsigned*)(aptr + (size_t)(kt_) * 32), (LAS unsigned*)(d_), 16, 0, 0); \
    __builtin_amdgcn_global_load_lds((const unsigned*)(bptr0 + (size_t)(kt_) * bstep), (LAS unsigned*)(d_ + G_ASZ), 16, 0, 0); \
    __builtin_amdgcn_global_load_lds((const unsigned*)(bptr1 + (size_t)(kt_) * bstep), (LAS unsigned*)(d_ + G_ASZ + 8192), 16, 0, 0); } while (0)
  __syncthreads();
  GLDS_ISSUE(0);
  if (nk > 1) GLDS_ISSUE(1);
  if (nk > 2) GLDS_ISSUE(2);
  for (int kt = 0; kt < nk; ++kt) {
    if (kt + 2 < nk) WAIT_VM(6); else if (kt + 1 < nk) WAIT_VM(3); else WAIT_VM(0);
    __builtin_amdgcn_s_barrier();
    if (kt + 3 < nk) GLDS_ISSUE(kt + 3);
    const lds_ptr cur = ring + (kt & (G_NST - 1)) * G_STAGE;
    s16x8 af[4], bfr[4];
#pragma unroll
    for (int mt = 0; mt < 4; ++mt) af[mt] = *(LAS s16x8*)(cur + a_rd[mt]);
#pragma unroll
    for (int nt = 0; nt < 4; ++nt) {
      const s16x4 lo = tr_read(cur + b_rd[nt][0]), hi = tr_read(cur + b_rd[nt][1]);
      bfr[nt] = __builtin_shufflevector(lo, hi, 0, 1, 2, 3, 4, 5, 6, 7);
    }
#pragma unroll
    for (int mt = 0; mt < 4; ++mt)
#pragma unroll
      for (int nt = 0; nt < 4; ++nt) acc[mt][nt] = __builtin_amdgcn_mfma_f32_16x16x32_bf16(bfr[nt], af[mt], acc[mt][nt], 0, 0, 0);
  }
#undef GLDS_ISSUE
}


constexpr int G2_STAGE = 2 * G_ASZ + G_BSZ;
__device__ __forceinline__ void gemm_mainloop_glds256(f32x4 (&acc)[8][4], const bf16_t* __restrict__ A, long lda, const bf16_t* __restrict__ Bm, long ldb, int nk, lds_ptr ring) {
  const int tid = ltid(), lane = tid & 63, wid = tid >> 6, wm = wid >> 2, wn = wid & 3, fr = lane & 15, fq = lane >> 4;
  const int ar = tid >> 2;
  const bf16_t* aptr0 = A + (size_t)ar * lda + (((tid & 3) ^ ((0x78 >> (((ar >> 2) & 3) * 2)) & 3)) << 3);
  const bf16_t* aptr1 = aptr0 + (size_t)128 * lda;
  const int bk = tid >> 5, pc = tid & 31;
  const int bcol = ((((pc >> 1) ^ ((bk & 3) | (((bk >> 3) & 1) << 2))) << 4) | ((pc & 1) << 3));
  const bf16_t* bptr0 = Bm + (size_t)bk * ldb + bcol;
  const bf16_t* bptr1 = bptr0 + (size_t)16 * ldb;
  const size_t bstep = (size_t)32 * ldb;
  int a_rd[8];
#pragma unroll
  for (int mt = 0; mt < 8; ++mt) a_rd[mt] = wm * G_ASZ + a_off(mt * 16 + fr, fq);
  int b_rd[4][2];
#pragma unroll
  for (int nt = 0; nt < 4; ++nt) {
    b_rd[nt][0] = 2 * G_ASZ + b_off(8 * fq + (fr >> 2), wn * 4 + nt) + (fr & 3) * 8;
    b_rd[nt][1] = 2 * G_ASZ + b_off(8 * fq + 4 + (fr >> 2), wn * 4 + nt) + (fr & 3) * 8;
  }
#pragma unroll
  for (int mt = 0; mt < 8; ++mt)
#pragma unroll
    for (int nt = 0; nt < 4; ++nt) acc[mt][nt] = (f32x4){0.f, 0.f, 0.f, 0.f};
  const lds_ptr dstl = ring + tid * 16;
#define GLDS2_ISSUE(kt_) do { const lds_ptr d_ = dstl + ((kt_) & (G_NST - 1)) * G2_STAGE; \
    __builtin_amdgcn_global_load_lds((const unsigned*)(aptr0 + (size_t)(kt_) * 32), (LAS unsigned*)(d_), 16, 0, 0); \
    __builtin_amdgcn_global_load_lds((const unsigned*)(aptr1 + (size_t)(kt_) * 32), (LAS unsigned*)(d_ + G_ASZ), 16, 0, 0); \
    __builtin_amdgcn_global_load_lds((const unsigned*)(bptr0 + (size_t)(kt_) * bstep), (LAS unsigned*)(d_ + 2 * G_ASZ), 16, 0, 0); \
    __builtin_amdgcn_global_load_lds((const unsigned*)(bptr1 + (size_t)(kt_) * bstep), (LAS unsigned*)(d_ + 2 * G_ASZ + 8192), 16, 0, 0); } while (0)
  __syncthreads();
  GLDS2_ISSUE(0);
  if (nk > 1) GLDS2_ISSUE(1);
  if (nk > 2) GLDS2_ISSUE(2);
  for (int kt = 0; kt < nk; ++kt) {
    if (kt + 2 < nk) WAIT_VM(8); else if (kt + 1 < nk) WAIT_VM(4); else WAIT_VM(0);
    __builtin_amdgcn_s_barrier();
    if (kt + 3 < nk) GLDS2_ISSUE(kt + 3);
    const lds_ptr cur = ring + (kt & (G_NST - 1)) * G2_STAGE;
    s16x8 bfr[4];
#pragma unroll
    for (int nt = 0; nt < 4; ++nt) {
      const s16x4 lo = tr_read(cur + b_rd[nt][0]), hi = tr_read(cur + b_rd[nt][1]);
      bfr[nt] = __builtin_shufflevector(lo, hi, 0, 1, 2, 3, 4, 5, 6, 7);
    }
#pragma unroll
    for (int h = 0; h < 2; ++h) {
      s16x8 af[4];
#pragma unroll
      for (int mt = 0; mt < 4; ++mt) af[mt] = *(LAS s16x8*)(cur + a_rd[h * 4 + mt]);
#pragma unroll
      for (int mt = 0; mt < 4; ++mt)
#pragma unroll
        for (int nt = 0; nt < 4; ++nt) acc[h * 4 + mt][nt] = __builtin_amdgcn_mfma_f32_16x16x32_bf16(bfr[nt], af[mt], acc[h * 4 + mt][nt], 0, 0, 0);
    }
  }
#undef GLDS2_ISSUE
}

__device__ __forceinline__ void tile_map(int round, int bid, int nb, int nMt, int nNt, int& mt, int& nt, bool& valid) {
  if (nb == 256 && (nNt & 3) == 0 && (nMt & 7) == 0) {
    const int xcd = bid & 7, j = bid >> 3, q = round * 8 + xcd, rn = nNt >> 2;
    const int rect_m = q / rn, rect_n = q % rn;
    mt = rect_m * 8 + (j & 7); nt = rect_n * 4 + (j >> 3); valid = mt < nMt;
  } else {
    const int per = (nb + 7) / 8, xcd = bid & 7, j = bid >> 3;
    const int idx = round * nb + xcd * per + j;
    mt = idx / nNt; nt = idx % nNt; valid = (j < per) && (idx < nMt * nNt) && (xcd * per + j < nb);
  }
}

__device__ __forceinline__ void cvt_copy(const float* __restrict__ src, long lds_, bf16_t* __restrict__ dst, long ldd, int rows, int cols, int gtid, int gsz) {
  const int c4 = cols >> 2;
  for (long i = gtid; i < (long)rows * c4; i += gsz) {
    const int r = (int)(i / c4), c = (int)(i % c4) * 4;
    const f32x4 v = *(const f32x4*)(src + (size_t)r * lds_ + c);
    u32x2 o; o.x = cvtpk(v[0], v[1]); o.y = cvtpk(v[2], v[3]);
    *(u32x2*)(dst + (size_t)r * ldd + c) = o;
  }
}
__device__ __forceinline__ void phase_prep(PR p, int bid, int nb, lds_ptr smem) {
  const int gtid = bid * NTHR + ltid(), gsz = nb * NTHR;
  cvt_copy(p.w_in, INW, p.wb_in, LDP, D, WIN_GK, gtid, gsz);
  cvt_copy(p.w_in + WIN_GK + 16, INW, p.wb_in + WIN_GK, LDP, D, LDP - WIN_GK, gtid, gsz);
  cvt_copy(p.w_glu, S5W, p.wb_glu, S5W, S5W, S5W, gtid, gsz);
  cvt_copy(p.w_proj_a, D, p.wb_pa, D, S5W, D, gtid, gsz);
  cvt_copy(p.w_proj_b, D, p.wb_pb, D, GVAL, D, gtid, gsz);
  cvt_copy(p.w_out, D, p.wb_out, D, D, D, gtid, gsz);
  cvt_copy(p.router_w, NE, p.wb_rs, 768, D, NE, gtid, gsz);
  cvt_copy(p.sw_down, D, p.wb_sd, D, SFF, D, gtid, gsz);
  for (long i = gtid; i < (long)D * 512; i += gsz) {
    const int k = (int)(i >> 9), cc = (int)(i & 511), w = cc >> 6, xx = cc & 63;
    const int hcol = 32 * w + (xx & 31);
    const float v = (xx < 32) ? p.sw_gate[(size_t)k * SFF + hcol] : p.sw_up[(size_t)k * SFF + hcol];
    p.wb_rs[(size_t)k * 768 + 256 + cc] = f2bf(v);
  }
  for (int i = gtid; i < 16 * D; i += gsz) { const int n = i >> 10, k = i & 1023; p.wgkT[i] = f2bf(p.w_in[(size_t)k * INW + WIN_GK + n]); }
  for (int i = gtid; i < NSLOT; i += gsz) p.slot_tok[i] = -1;
  if (gtid < 256) p.counts[gtid] = 0;
  if (gtid < 16) p.moe_ctr[gtid] = 0;
  if (ltid() < 8 && bid * 8 + ltid() < S5G * S5P) {
    const int i = bid * 8 + ltid(), g = i / S5P;
    const double lr = p.lam_re[i], li = p.lam_im[i], dt = (double)__expf(p.log_dt[g]);
    const double TWO_PI = 6.283185307179586476925286766559;
    double ang = li * dt; ang -= TWO_PI * floor(ang / TWO_PI);
    const double mag = (double)__expf((float)(lr * dt));
    const double are = mag * (double)cosf((float)ang), aim = mag * (double)sinf((float)ang);
    const double den = lr * lr + li * li, nre = are - 1.0;
    const double cre = (nre * lr + aim * li) / den, cim = (aim * lr - nre * li) / den;
    p.abar[i * 2] = (float)are; p.abar[i * 2 + 1] = (float)aim;
    for (int h = 0; h < S5H; ++h) {
      const double br = p.b_re[i * S5H + h], bi = p.b_im[i * S5H + h];
      p.bbar[(i * S5H + h) * 2] = (float)(cre * br - cim * bi);
      p.bbar[(i * S5H + h) * 2 + 1] = (float)(cre * bi + cim * br);
      const int pq = i & 63;
      p.bbarT[(size_t)(g * 128 + 2 * pq) * 16 + h] = f2bf((float)(cre * br - cim * bi));
      p.bbarT[(size_t)(g * 128 + 2 * pq + 1) * 16 + h] = f2bf((float)(cre * bi + cim * br));
    }
    double a64 = 64.0 * li * dt; a64 -= TWO_PI * floor(a64 / TWO_PI);
    const double m64 = (double)__expf((float)(64.0 * lr * dt));
    p.apow64[i * 2] = (float)(m64 * (double)cosf((float)a64)); p.apow64[i * 2 + 1] = (float)(m64 * (double)sinf((float)a64));
  }
  for (int i = gtid; i < S5G * S5H * 128; i += gsz) {
    const int pp = i & 127, ho = (i >> 7) & 15, g = i >> 11;
    p.cmT[i] = f2bf((pp & 1) ? -p.c_im[(g * 16 + ho) * 64 + (pp >> 1)] : p.c_re[(g * 16 + ho) * 64 + (pp >> 1)]);
  }
  LAS float* red = (LAS float*)smem;
  LAS float* sc = (LAS float*)(smem + 16384);
  if (bid < 192) {
    __syncthreads();
    for (int i = ltid(); i < 8 * D; i += NTHR) sc[i] = siluf_(p.c[i]);
    __syncthreads();
  }
  for (int item = bid; item < 192; item += nb) {
    const int cl = ltid() & 31, kg = ltid() >> 5, col = item * 32 + cl;
    float acc[8];
#pragma unroll
    for (int b = 0; b < 8; ++b) acc[b] = 0.f;
    const float* wp = p.ada_w + (size_t)(kg * 64) * 6144 + col;
#pragma unroll 1
    for (int k0 = 0; k0 < 64; k0 += 16) {
      float w[16];
#pragma unroll
      for (int q = 0; q < 16; ++q) w[q] = wp[(size_t)(k0 + q) * 6144];
#pragma unroll
      for (int q = 0; q < 16; ++q)
#pragma unroll
        for (int b = 0; b < 8; ++b) acc[b] += sc[b * D + kg * 64 + k0 + q] * w[q];
    }
    __syncthreads();
#pragma unroll
    for (int b = 0; b < 8; ++b) red[(kg * 8 + b) * 32 + cl] = acc[b];
    __syncthreads();
    if (ltid() < 256) {
      const int b = ltid() >> 5, c2 = ltid() & 31;
      float sum = p.ada_b[item * 32 + c2];
      for (int q = 0; q < 16; ++q) sum += red[(q * 8 + b) * 32 + c2];
      p.mod[b * 6144 + item * 32 + c2] = sum;
    }
  }
}

template <bool WITH_GK>
__device__ __forceinline__ void phase_norm(PR p, const float* __restrict__ xin, const float* __restrict__ g, int sh_off, int sc_off, bf16_t* __restrict__ outp, int bid, int nb, lds_ptr smem) {
  const int lane = ltid() & 63, wid = ltid() >> 6;
  const int stride = nb * 8;
  int row = bid * 8 + wid;
  f32x4 nx[4];
  if (row < T) {
#pragma unroll
    for (int i = 0; i < 4; ++i) nx[i] = *(const f32x4*)(xin + (size_t)row * D + lane * 4 + 256 * i);
  }
  f32x4 gv[4];
#pragma unroll
  for (int i = 0; i < 4; ++i) gv[i] = *(const f32x4*)(g + lane * 4 + 256 * i);
  for (; row < T; row += stride) {
    const int b = row / SEQ;
    f32x4 v[4];
#pragma unroll
    for (int i = 0; i < 4; ++i) v[i] = nx[i];
    const int rn = row + stride;
    if (rn < T) {
#pragma unroll
      for (int i = 0; i < 4; ++i) nx[i] = *(const f32x4*)(xin + (size_t)rn * D + lane * 4 + 256 * i);
    }
    float ss = 0.f;
#pragma unroll
    for (int i = 0; i < 4; ++i) ss += v[i][0] * v[i][0] + v[i][1] * v[i][1] + v[i][2] * v[i][2] + v[i][3] * v[i][3];
#pragma unroll
    for (int o = 32; o > 0; o >>= 1) ss += __shfl_xor(ss, o);
    const float r = rsqrtf(ss * (1.f / D) + 1e-6f);
#pragma unroll
    for (int i = 0; i < 4; ++i) {
      const int c0 = lane * 4 + 256 * i;
      const f32x4 scv = *(const f32x4*)(p.mod + b * 6144 + sc_off + c0), shv = *(const f32x4*)(p.mod + b * 6144 + sh_off + c0);
      float y[4];
#pragma unroll
      for (int j = 0; j < 4; ++j) y[j] = (v[i][j] * r) * gv[i][j] * (1.f + scv[j]) + shv[j];
      u32x2 o; o.x = cvtpk(y[0], y[1]); o.y = cvtpk(y[2], y[3]);
      *(u32x2*)(outp + (size_t)row * D + c0) = o;
    }
  }
}

struct EpiStoreBf {
  bf16_t* O; long ld;
  template <int MT> __device__ __forceinline__ void operator()(const f32x4 (&acc)[MT][4], int mbase, int nbase, int fr, int fq) const {
    bf16_t* rowp = O + (size_t)(mbase + fr) * ld + nbase + fq * 4;
#pragma unroll
    for (int mt = 0; mt < MT; ++mt) {
#pragma unroll
      for (int nt = 0; nt < 4; ++nt) { const f32x4 v = acc[mt][nt]; u32x2 o; o.x = cvtpk(v[0], v[1]); o.y = cvtpk(v[2], v[3]);
        *(u32x2*)(rowp + nt * 16) = o; }
      rowp += 16 * ld;
      __builtin_amdgcn_sched_barrier(0); }
  }
};
__device__ __forceinline__ f32x4 ld_bf4(const bf16_t* q) { const u32x2 w = *(const u32x2*)q; f32x4 r; r[0] = __uint_as_float(w.x << 16); r[1] = __uint_as_float(w.x & 0xffff0000u); r[2] = __uint_as_float(w.y << 16); r[3] = __uint_as_float(w.y & 0xffff0000u); return r; }
struct EpiGlu {
  const bf16_t* yA; const float* b; bf16_t* z;
  template <int MT> __device__ __forceinline__ void operator()(const f32x4 (&acc)[MT][4], int mbase, int nbase, int fr, int fq) const {
#pragma unroll
    for (int mt = 0; mt < MT; ++mt) {
#pragma unroll
      for (int nt = 0; nt < 4; ++nt) { const int row = mbase + mt * 16 + fr, col = nbase + nt * 16 + fq * 4; const f32x4 v = acc[mt][nt];
        const f32x4 y = ld_bf4(yA + (size_t)row * S5W + col); const f32x4 bb = *(const f32x4*)(b + col);
        u32x2 o; o.x = cvtpk(y[0] * sigmoidf_(v[0] + bb[0]), y[1] * sigmoidf_(v[1] + bb[1])); o.y = cvtpk(y[2] * sigmoidf_(v[2] + bb[2]), y[3] * sigmoidf_(v[3] + bb[3]));
        *(u32x2*)(z + (size_t)row * S5W + col) = o; }
      __builtin_amdgcn_sched_barrier(0); }
  }
};
struct EpiOut {
  const float* x; const float* mod; float* x1;
  template <int MT> __device__ __forceinline__ void operator()(const f32x4 (&acc)[MT][4], int mbase, int nbase, int fr, int fq) const {
#pragma unroll
    for (int mt = 0; mt < MT; ++mt) {
#pragma unroll
      for (int nt = 0; nt < 4; ++nt) { const int row = mbase + mt * 16 + fr, col = nbase + nt * 16 + fq * 4, b = row / SEQ; const f32x4 v = acc[mt][nt];
        const f32x4 xv = *(const f32x4*)(x + (size_t)row * D + col), gg = *(const f32x4*)(mod + b * 6144 + 2 * D + col);
        f32x4 o; o[0] = xv[0] + gg[0] * v[0]; o[1] = xv[1] + gg[1] * v[1]; o[2] = xv[2] + gg[2] * v[2]; o[3] = xv[3] + gg[3] * v[3];
        *(f32x4*)(x1 + (size_t)row * D + col) = o; }
      __builtin_amdgcn_sched_barrier(0); }
  }
};

template <class Epi>
__device__ __forceinline__ void phase_gemm_dense(const bf16_t* A, long lda, const bf16_t* Bm, long ldb, int M, int N, int K, const Epi& epi, int bid, int nb, lds_ptr smem) {
  const int nMt = M / 128, nNt = N / 256, ntiles = nMt * nNt, rounds = (ntiles + nb - 1) / nb;
  const int lane = ltid() & 63, wid = ltid() >> 6, wm = wid >> 2, wn = wid & 3, fr = lane & 15, fq = lane >> 4;
  for (int r = 0; r < rounds; ++r) {
    int mt, nt; bool valid; tile_map(r, bid, nb, nMt, nNt, mt, nt, valid);
    if (!valid) continue;
    f32x4 acc[4][4];
    ALoadDense al{A + (size_t)mt * 128 * lda, lda};
    gemm_mainloop_glds(acc, al, Bm + nt * 256, ldb, K / 32, smem);
    epi.template operator()<4>(acc, mt * 128 + wm * 64, nt * 256 + wn * 64, fr, fq);
  }
}


template <class Epi>
__device__ __forceinline__ void phase_gemm_dense256(const bf16_t* A, long lda, const bf16_t* Bm, long ldb, int M, int N, int K, const Epi& epi, int bid, int nb, lds_ptr smem) {
  const int nMt = M / 256, nNt = N / 256, ntiles = nMt * nNt, rounds = (ntiles + nb - 1) / nb;
  const int lane = ltid() & 63, wid = ltid() >> 6, wm = wid >> 2, wn = wid & 3, fr = lane & 15, fq = lane >> 4;
  for (int r = 0; r < rounds; ++r) {
    int mt, nt; bool valid; tile_map(r, bid, nb, nMt, nNt, mt, nt, valid);
    if (!valid) continue;
    f32x4 acc[8][4];
    gemm_mainloop_glds256(acc, A + (size_t)mt * 256 * lda, lda, Bm + nt * 256, ldb, K / 32, smem);
    epi.template operator()<8>(acc, mt * 256 + wm * 128, nt * 256 + wn * 64, fr, fq);
  }
}


constexpr int ST_ROW = 528;
__device__ __forceinline__ void phase_gemm_dense256_bf16(const bf16_t* A, long lda, const bf16_t* Bm, long ldb, int M, int N, int K, bf16_t* O, long ldo, int bid, int nb, lds_ptr smem) {
  const int nMt = M / 256, nNt = N / 256, ntiles = nMt * nNt, rounds = (ntiles + nb - 1) / nb;
  for (int r = 0; r < rounds; ++r) {
    int mt, nt; bool valid; tile_map(r, bid, nb, nMt, nNt, mt, nt, valid);
    if (!valid) continue;
    f32x4 acc[8][4];
    gemm_mainloop_glds256(acc, A + (size_t)mt * 256 * lda, lda, Bm + nt * 256, ldb, K / 32, smem);
    const int t1 = ltid(), l1 = t1 & 63, w1 = t1 >> 6, wm = w1 >> 2;
    bf16_t* ob = O + (size_t)(mt * 256) * ldo + nt * 256 + (t1 & 31) * 8;
#pragma unroll
    for (int h = 0; h < 2; ++h) {
      __syncthreads();
      if (wm == h) {
#pragma unroll
        for (int i = 0; i < 8; ++i)
#pragma unroll
          for (int j = 0; j < 4; ++j) { const f32x4 v = acc[i][j]; u32x2 o; o.x = cvtpk(v[0], v[1]); o.y = cvtpk(v[2], v[3]);
            *(LAS u32x2*)(smem + (i * 16 + (l1 & 15)) * ST_ROW + ((w1 & 3) * 64 + j * 16 + (l1 >> 4) * 4) * 2) = o; }
      }
      __syncthreads();
#pragma unroll
      for (int ps = 0; ps < 8; ++ps) {
        const int row = ps * 16 + (t1 >> 5);
        *(u32x4*)(ob + (size_t)(h * 128 + row) * ldo) = *(LAS u32x4*)(smem + row * ST_ROW + (t1 & 31) * 16);
      }
    }
  }
}

__device__ __forceinline__ void gk_rows(PR p, int bid, int nb) {
  const int lane = ltid() & 63, wid = ltid() >> 6, fr = lane & 15, fq = lane >> 4;
  if (wid >= 4) return;
  for (int r0 = (bid * 4 + wid) * 16; r0 < T; r0 += nb * 64) {
    const bf16_t* ap = p.h1 + (size_t)(r0 + fr) * D + fq * 8;
    const bf16_t* bp = p.wgkT + (size_t)fr * D + fq * 8;
    f32x4 acc = {0.f, 0.f, 0.f, 0.f};
#pragma unroll 1
    for (int k0 = 0; k0 < 32; k0 += 8) {
      s16x8 a[8], b[8];
#pragma unroll
      for (int q = 0; q < 8; ++q) { a[q] = *(const s16x8*)(ap + (k0 + q) * 32); b[q] = *(const s16x8*)(bp + (k0 + q) * 32); }
#pragma unroll
      for (int q = 0; q < 8; ++q) acc = __builtin_amdgcn_mfma_f32_16x16x32_bf16(a[q], b[q], acc, 0, 0, 0);
    }
#pragma unroll
    for (int j = 0; j < 4; ++j) p.gkl[(size_t)(r0 + 4 * fq + j) * 16 + fr] = acc[j];
  }
}

__device__ __forceinline__ void phase_gemm_mixed(PR p, int bid, int nb, lds_ptr smem) {
  const int nMt = T / 128, nNt = D / 256, ntiles = nMt * nNt, rounds = (ntiles + nb - 1) / nb;
  const int lane = ltid() & 63, wid = ltid() >> 6, wm = wid >> 2, wn = wid & 3, fr = lane & 15, fq = lane >> 4;
  for (int r = 0; r < rounds; ++r) {
    int mt, nt; bool valid; tile_map(r, bid, nb, nMt, nNt, mt, nt, valid);
    if (!valid) continue;
    const int mbase = mt * 128 + wm * 64, nbase = nt * 256 + wn * 64;
    const bf16_t* gp = p.proj + (size_t)(mbase + fr) * LDP + nbase + fq * 4;
    u32x2 gte[4][4], pk[4][4];
#pragma unroll
    for (int i = 0; i < 4; ++i)
#pragma unroll
      for (int j = 0; j < 4; ++j) gte[i][j] = *(const u32x2*)(gp + (size_t)(i * 16) * LDP + OFF_GA + j * 16);
    f32x4 acc[4][4];
    { ALoadDense al{p.zA + (size_t)mt * 128 * S5W, S5W}; gemm_mainloop_glds(acc, al, p.wb_pa + nt * 256, D, S5W / 32, smem); }
#pragma unroll
    for (int i = 0; i < 4; ++i)
#pragma unroll
      for (int j = 0; j < 4; ++j) {
        const float g0 = __uint_as_float(gte[i][j].x << 16), g1 = __uint_as_float(gte[i][j].x & 0xffff0000u), g2 = __uint_as_float(gte[i][j].y << 16), g3 = __uint_as_float(gte[i][j].y & 0xffff0000u);
        pk[i][j].x = cvtpk(acc[i][j][0] * sigmoidf_(g0), acc[i][j][1] * sigmoidf_(g1)); pk[i][j].y = cvtpk(acc[i][j][2] * sigmoidf_(g2), acc[i][j][3] * sigmoidf_(g3)); }
#pragma unroll
    for (int i = 0; i < 4; ++i)
#pragma unroll
      for (int j = 0; j < 4; ++j) gte[i][j] = *(const u32x2*)(gp + (size_t)(i * 16) * LDP + OFF_GB + j * 16);
    { ALoadDense al{p.yB + (size_t)mt * 128 * GVAL, GVAL}; gemm_mainloop_glds(acc, al, p.wb_pb + nt * 256, D, GVAL / 32, smem); }
    bf16_t* op = p.mixed + (size_t)(mbase + fr) * D + nbase + fq * 4;
#pragma unroll
    for (int i = 0; i < 4; ++i)
#pragma unroll
      for (int j = 0; j < 4; ++j) {
        const float g0 = __uint_as_float(gte[i][j].x << 16), g1 = __uint_as_float(gte[i][j].x & 0xffff0000u), g2 = __uint_as_float(gte[i][j].y << 16), g3 = __uint_as_float(gte[i][j].y & 0xffff0000u);
        const float a0 = __uint_as_float(pk[i][j].x << 16), a1 = __uint_as_float(pk[i][j].x & 0xffff0000u), a2 = __uint_as_float(pk[i][j].y << 16), a3 = __uint_as_float(pk[i][j].y & 0xffff0000u);
        u32x2 o; o.x = cvtpk(a0 + sigmoidf_(g0) * acc[i][j][0], a1 + sigmoidf_(g1) * acc[i][j][1]); o.y = cvtpk(a2 + sigmoidf_(g2) * acc[i][j][2], a3 + sigmoidf_(g3) * acc[i][j][3]);
        *(u32x2*)(op + (size_t)(i * 16) * D + j * 16) = o; }
  }
}

__device__ __forceinline__ void phase_gemm_rs(PR p, int bid, int nb, lds_ptr smem) {
  const int nMt = T / 256, nNt = 3, ntiles = nMt * nNt, rounds = (ntiles + nb - 1) / nb;
  const int lane = ltid() & 63, wid = ltid() >> 6, wm = wid >> 2, wn = wid & 3, fr = lane & 15, fq = lane >> 4;
  for (int r = 0; r < rounds; ++r) {
    int mt, nt; bool valid; tile_map(r, bid, nb, nMt, nNt, mt, nt, valid);
    if (!valid) continue;
    f32x4 acc[8][4];
    gemm_mainloop_glds256(acc, p.h2 + (size_t)mt * 256 * D, D, p.wb_rs + nt * 256, 768, D / 32, smem);
    const int mbase = mt * 256 + wm * 128;
    if (nt == 0) {
#pragma unroll
      for (int i = 0; i < 8; ++i) {
#pragma unroll
        for (int j = 0; j < 4; ++j) *(f32x4*)(p.logits + (size_t)(mbase + i * 16 + fr) * NE + wn * 64 + j * 16 + fq * 4) = acc[i][j];
        __builtin_amdgcn_sched_barrier(0); }
    } else {
      const int h0 = (nt - 1) * 128 + wn * 32;
#pragma unroll
      for (int i = 0; i < 8; ++i) {
#pragma unroll
        for (int j = 0; j < 2; ++j) { const f32x4 gv = acc[i][j], uv = acc[i][j + 2];
          u32x2 o; o.x = cvtpk(siluf_(gv[0]) * uv[0], siluf_(gv[1]) * uv[1]); o.y = cvtpk(siluf_(gv[2]) * uv[2], siluf_(gv[3]) * uv[3]);
          *(u32x2*)(p.shH + (size_t)(mbase + i * 16 + fr) * SFF + h0 + j * 16 + fq * 4) = o; }
        __builtin_amdgcn_sched_barrier(0); }
    }
  }
}

constexpr int MOE_H_OFF = 2 * G_STAGE;
constexpr int MOE_TOK_OFF = MOE_H_OFF + 65536;
constexpr int SMEM_BYTES = 139264;
__device__ __forceinline__ void phase_moe(PR p, int bid, int nb, lds_ptr smem) {
  const int lane = ltid() & 63, wid = ltid() >> 6, wm = wid >> 2, wn = wid & 3, fr = lane & 15, fq = lane >> 4;
  LAS int* toks = (LAS int*)(smem + MOE_TOK_OFF);
  const lds_ptr Hs = smem + MOE_H_OFF;
  LAS int* qi = (LAS int*)(smem + MOE_TOK_OFF + 512);
  for (int sx = 0; sx < 8; ++sx) {
   const int x = (bid + sx) & 7;
   const int cnt = p.moe_cnt[x];
   for (;;) {
    __syncthreads();
    if (ltid() == 0) qi[0] = atomicAdd(&p.moe_ctr[x], 1);
    __syncthreads();
    const int qidx = qi[0];
    if (qidx >= cnt) break;
    const int blk = p.moe_list[x * NBLK128 + qidx];
    const int e = p.blk_exp[blk];
    if (ltid() < 128) toks[ltid()] = p.slot_tok[blk * 128 + ltid()];
    __syncthreads();
    const float* Wg = p.ew_gate + (size_t)e * D * EFF; const float* Wu = p.ew_up + (size_t)e * D * EFF; const float* Wd = p.ew_down + (size_t)e * EFF * D;
    for (int hp2 = 0; hp2 < 2 * MOE_REP_GU; ++hp2) { const int hp = hp2 & 1;
      f32x4 acc[4][4];
      ALoadGatherLds al2{p.h2, toks};
      BLoadGUR bl{Wg, (long)(Wu - Wg), EFF, hp * 128};
      gemm_mainloop_r3<false>(acc, al2, bl, D / 32, smem, smem);
#pragma unroll
      for (int i = 0; i < 4; ++i)
#pragma unroll
        for (int j = 0; j < 2; ++j) { const f32x4 gv = acc[i][j], uv = acc[i][j + 2]; const int row = wm * 64 + i * 16 + fr, hc = hp * 128 + wn * 32 + j * 16 + fq * 4;
          u32x2 o; o.x = cvtpk(siluf_(gv[0]) * uv[0], siluf_(gv[1]) * uv[1]); o.y = cvtpk(siluf_(gv[2]) * uv[2], siluf_(gv[3]) * uv[3]);
          *(LAS u32x2*)(Hs + (hc >> 5) * G_ASZ + a_off(row, (hc & 31) >> 3) + (hc & 7) * 2) = o; }
    }
    for (int np2 = 0; np2 < 4 * MOE_REP_DN; ++np2) { const int np = np2 & 3;
      f32x4 acc[4][4];
      ALoadDense al{nullptr, 0};
      BLoadF32R bl{Wd + np * 256, D};
      gemm_mainloop_r3<true>(acc, al, bl, EFF / 32, smem, Hs);
#pragma unroll
      for (int i = 0; i < 4; ++i) {
        const int rl = wm * 64 + i * 16 + fr;
        if (toks[rl] >= 0) {
#pragma unroll
          for (int j = 0; j < 4; ++j) { const f32x4 v = acc[i][j]; u32x2 o; o.x = cvtpk(v[0], v[1]); o.y = cvtpk(v[2], v[3]);
            *(u32x2*)(p.Y + (size_t)(blk * 128 + rl) * D + np * 256 + wn * 64 + j * 16 + fq * 4) = o; }
        }
      }
    }
   }
  }
}

struct BStreamGU { const float* Wg; long du; int hp0;
  __device__ __forceinline__ void load(BRaw& r, int s, int tid) const {
    const int hp = hp0 + (s >> 5), kbase = (s & 31) * 32;
    const int col = (tid & 63) * 4, w = col >> 6, xx = col & 63;
    const float* q = Wg + ((xx < 32) ? 0l : du) + (size_t)(kbase + (tid >> 6)) * EFF + hp * 128 + 32 * w + (xx & 31);
#pragma unroll
    for (int i = 0; i < 4; ++i) r.v[i] = *(const f32x4*)(q + (size_t)(8 * i) * EFF); } };
struct BStreamDown { const float* Wd; int np0;
  __device__ __forceinline__ void load(BRaw& r, int s, int tid) const {
    const int np = np0 + (s >> 3), kbase = (s & 7) * 32;
    const float* q = Wd + (size_t)(kbase + (tid >> 6)) * D + np * 256 + (tid & 63) * 4;
#pragma unroll
    for (int i = 0; i < 4; ++i) r.v[i] = *(const f32x4*)(q + (size_t)(8 * i) * D); } };
constexpr int PV_STAGE = 2 * G_ASZ + G_BSZ;
template <int SEG, int NSEG, class AL, class BL, class SE>
__device__ __forceinline__ void gemm_stream_pair(const AL& al, const BL& bl, lds_ptr stage, const SE& segend, bool has2) {
  constexpr int NS = SEG * NSEG;
  const int tid = ltid(), lane = tid & 63, wid = tid >> 6, wm = wid >> 2, wn = wid & 3, fr = lane & 15, fq = lane >> 4;
  const int ar = tid >> 2, ac = tid & 3;
  const bf16_t* aptr0 = al.rowptr(0, ar) + ac * 8;
  const bf16_t* aptr1 = al.rowptr(1, ar) + ac * 8;
  const int a_st = a_off(ar, ac);
  int b_st[4];
#pragma unroll
  for (int i = 0; i < 4; ++i) b_st[i] = 2 * G_ASZ + b_off((tid >> 6) + 8 * i, (tid & 63) >> 2) + (tid & 3) * 8;
  int a_rd[4];
#pragma unroll
  for (int mt = 0; mt < 4; ++mt) a_rd[mt] = a_off(wm * 64 + mt * 16 + fr, fq);
  int b_rd[4][2];
#pragma unroll
  for (int nt = 0; nt < 4; ++nt) {
    b_rd[nt][0] = 2 * G_ASZ + b_off(8 * fq + (fr >> 2), wn * 4 + nt) + (fr & 3) * 8;
    b_rd[nt][1] = 2 * G_ASZ + b_off(8 * fq + 4 + (fr >> 2), wn * 4 + nt) + (fr & 3) * 8;
  }
  f32x4 acc[2][4][4];
#pragma unroll
  for (int h = 0; h < 2; ++h)
#pragma unroll
    for (int mt = 0; mt < 4; ++mt)
#pragma unroll
      for (int nt = 0; nt < 4; ++nt) acc[h][mt][nt] = (f32x4){0.f, 0.f, 0.f, 0.f};
  u32x4 xa0, xb0, xa1, xb1;
  BRaw rb0, rb1;
#define P2_LOAD(XA, XB, RB, s_) do { XA = *(const u32x4*)(aptr0 + (size_t)((s_) % SEG) * 32); XB = *(const u32x4*)(aptr1 + (size_t)((s_) % SEG) * 32); bl.load(RB, (s_), tid); } while (0)
#define P2_STORE(XA, XB, RB, st_) do { const lds_ptr q_ = stage + (st_) * PV_STAGE; *(LAS u32x4*)(q_ + a_st) = XA; *(LAS u32x4*)(q_ + G_ASZ + a_st) = XB; \
    _Pragma("unroll") for (int i_ = 0; i_ < 4; ++i_) { u32x2 o_; o_.x = cvtpk(RB.v[i_][0], RB.v[i_][1]); o_.y = cvtpk(RB.v[i_][2], RB.v[i_][3]); *(LAS u32x2*)(q_ + b_st[i_]) = o_; } } while (0)
#define P2_COMPUTE(s_) do { const lds_ptr cur = stage + ((s_) & 1) * PV_STAGE; s16x8 bfr[4]; \
    _Pragma("unroll") for (int nt = 0; nt < 4; ++nt) { const s16x4 lo = tr_read(cur + b_rd[nt][0]), hi = tr_read(cur + b_rd[nt][1]); bfr[nt] = __builtin_shufflevector(lo, hi, 0, 1, 2, 3, 4, 5, 6, 7); } \
    _Pragma("unroll") for (int h = 0; h < 2; ++h) if (h == 0 || has2) { s16x8 af[4]; \
      _Pragma("unroll") for (int mt = 0; mt < 4; ++mt) af[mt] = *(LAS s16x8*)(cur + h * G_ASZ + a_rd[mt]); \
      _Pragma("unroll") for (int mt = 0; mt < 4; ++mt) _Pragma("unroll") for (int nt = 0; nt < 4; ++nt) acc[h][mt][nt] = __builtin_amdgcn_mfma_f32_16x16x32_bf16(bfr[nt], af[mt], acc[h][mt][nt], 0, 0, 0); } } while (0)
#define P2_SEGEND(s_) do { if (((s_) % SEG) == SEG - 1) { segend((s_) / SEG, acc); \
    _Pragma("unroll") for (int h = 0; h < 2; ++h) _Pragma("unroll") for (int mt = 0; mt < 4; ++mt) _Pragma("unroll") for (int nt = 0; nt < 4; ++nt) acc[h][mt][nt] = (f32x4){0.f, 0.f, 0.f, 0.f}; } } while (0)
#define P2_BODY(s_, XAN, XBN, RBN, XAW, XBW, RBW) do { const int sl_ = ((s_) + 2 < NS) ? (s_) + 2 : NS - 1; P2_LOAD(XAN, XBN, RBN, sl_); __builtin_amdgcn_sched_barrier(0); \
    P2_COMPUTE(s_); __builtin_amdgcn_sched_barrier(0); P2_SEGEND(s_); P2_STORE(XAW, XBW, RBW, ((s_) + 1) & 1); __syncthreads(); } while (0)
  P2_LOAD(xa0, xb0, rb0, 0);
  P2_LOAD(xa1, xb1, rb1, 1);
  __syncthreads();
  P2_STORE(xa0, xb0, rb0, 0);
  __syncthreads();
  for (int s = 0; s < NS; s += 2) {
    P2_BODY(s, xa0, xb0, rb0, xa1, xb1, rb1);
    P2_BODY(s + 1, xa1, xb1, rb1, xa0, xb0, rb0);
  }
#undef P2_LOAD
#undef P2_STORE
#undef P2_COMPUTE
#undef P2_SEGEND
#undef P2_BODY
}
struct APairGather { const bf16_t* A; LAS int* tk; __device__ __forceinline__ const bf16_t* rowptr(int h, int r) const { int t = tk[h * 128 + r]; t = t < 0 ? 0 : t; return A + (size_t)t * D; } };
struct APairDense { const bf16_t* A0; const bf16_t* A1; __device__ __forceinline__ const bf16_t* rowptr(int h, int r) const { return (h ? A1 : A0) + (size_t)r * EFF; } };

constexpr int PV_TOK = 2 * PV_STAGE;
constexpr int PV_Q = PV_TOK + 1024;
constexpr int PV_STG = 69632, PV_STG_ROW = 528;
template <int STG>
__device__ __forceinline__ void phase_moe_pair(PR p, int bid, int nb, lds_ptr smem) {
  LAS int* toks = (LAS int*)(smem + PV_TOK);
  LAS int* qi = (LAS int*)(smem + PV_Q);
  for (int sx = 0; sx < 8; ++sx) {
   const int x = ((int)((unsigned)__builtin_amdgcn_s_getreg((3 << 11) | 20) & 7u) + sx) & 7;
   const int cnt = 2 * p.moe_cnt[x];
   for (;;) {
    __syncthreads();
    if (ltid() == 0) qi[0] = atomicAdd(&p.moe_ctr[(STG - 1) * 8 + x], 1);
    __syncthreads();
    const int qidx = qi[0];
    if (qidx >= cnt) break;
    const int blk = p.moe_list[x * NBLK128 + (qidx >> 1)], sub = qidx & 1;
    const int e = p.blk_exp[blk];
    const bool has2 = (blk + 1 < NBLK128) && (p.blk_exp[blk + 1] == e);
    const int blk2 = has2 ? blk + 1 : blk;
    { const int t = ltid(); if (t < 256) toks[t] = (t < 128) ? p.slot_tok[blk * 128 + t] : (has2 ? p.slot_tok[blk2 * 128 + (t - 128)] : -1); }
    __syncthreads();
    const int lane = ltid() & 63, wid = ltid() >> 6, wm = wid >> 2, wn = wid & 3, fr = lane & 15, fq = lane >> 4;
    if (STG == 1) {
      const float* Wg = p.ew_gate + (size_t)e * D * EFF; const float* Wu = p.ew_up + (size_t)e * D * EFF;
      APairGather al{p.h2, toks};
      BStreamGU bl{Wg, (long)(Wu - Wg), sub};
      auto segH = [&](int hseg, const f32x4 (&acc)[2][4][4]) { const int hp = sub + hseg;
        const int t1 = ltid(), l1 = t1 & 63, w1 = t1 >> 6;
        const lds_ptr stg = smem + PV_STG;
#pragma unroll
        for (int h = 0; h < 2; ++h) {
          if (h == 1 && !has2) continue;
#pragma unroll
          for (int i = 0; i < 4; ++i)
#pragma unroll
            for (int j = 0; j < 2; ++j) { const f32x4 gv = acc[h][i][j], uv = acc[h][i][j + 2];
              u32x2 o; o.x = cvtpk(siluf_(gv[0]) * uv[0], siluf_(gv[1]) * uv[1]); o.y = cvtpk(siluf_(gv[2]) * uv[2], siluf_(gv[3]) * uv[3]);
              *(LAS u32x2*)(stg + ((w1 >> 2) * 64 + i * 16 + (l1 & 15)) * 272 + ((w1 & 3) * 32 + j * 16 + (l1 >> 4) * 4) * 2) = o; }
          __syncthreads();
          bf16_t* hb = p.Hbuf + (size_t)((h ? blk2 : blk) * 128) * EFF + hp * 128 + (t1 & 15) * 8;
#pragma unroll
          for (int ps = 0; ps < 4; ++ps) {
            const int row = ps * 32 + (t1 >> 4);
            *(u32x4*)(hb + (size_t)row * EFF) = *(LAS u32x4*)(stg + row * 272 + (t1 & 15) * 16);
          }
          __syncthreads();
        }
      };
      gemm_stream_pair<32, 1>(al, bl, smem, segH, has2);
    } else {
      const float* Wd = p.ew_down + (size_t)e * EFF * D;
      APairDense al{p.Hbuf + (size_t)blk * 128 * EFF, p.Hbuf + (size_t)blk2 * 128 * EFF};
      BStreamDown bl{Wd, 2 * sub};
      auto segY = [&](int nseg, const f32x4 (&acc)[2][4][4]) { const int np = 2 * sub + nseg;
        const int t1 = ltid(), l1 = t1 & 63, w1 = t1 >> 6;
        const lds_ptr stg = smem + PV_STG;
#pragma unroll
        for (int h = 0; h < 2; ++h) {
          if (h == 1 && !has2) continue;
#pragma unroll
          for (int i = 0; i < 4; ++i)
#pragma unroll
            for (int j = 0; j < 4; ++j) { const f32x4 v = acc[h][i][j]; u32x2 o; o.x = cvtpk(v[0], v[1]); o.y = cvtpk(v[2], v[3]);
              *(LAS u32x2*)(stg + ((w1 >> 2) * 64 + i * 16 + (l1 & 15)) * PV_STG_ROW + ((w1 & 3) * 64 + j * 16 + (l1 >> 4) * 4) * 2) = o; }
          __syncthreads();
          bf16_t* yb = p.Y + (size_t)((h ? blk2 : blk) * 128) * D + np * 256 + (t1 & 31) * 8;
#pragma unroll
          for (int ps = 0; ps < 8; ++ps) {
            const int row = ps * 16 + (t1 >> 5);
            const u32x4 v = *(LAS u32x4*)(stg + row * PV_STG_ROW + (t1 & 31) * 16);
            if (toks[h * 128 + row] >= 0) *(u32x4*)(yb + (size_t)row * D) = v;
          }
          __syncthreads();
        }
      };
      gemm_stream_pair<8, 2>(al, bl, smem, segY, has2);
    }
   }
  }
}

__device__ __forceinline__ void wave_sync() { asm volatile("s_waitcnt lgkmcnt(0)" ::: "memory"); }
constexpr int S5_BU_STRIDE = 132;
constexpr int S5_S_STRIDE = 272;
constexpr int S5_WAVE_LDS = 16 * S5_BU_STRIDE * 4 + 16 * S5_S_STRIDE;
template <bool FINAL>
__device__ __forceinline__ void s5_item(PR p, int b, int c, int g, lds_ptr wl) {
  const int lane = ltid() & 63, fr = lane & 15, fq = lane >> 4;
  LAS float* bu = (LAS float*)wl;
  const lds_ptr Sb = wl + 16 * S5_BU_STRIDE * 4;
  const size_t t0 = (size_t)b * SEQ + (size_t)c * 64;
  const s16x8 zero8 = {0, 0, 0, 0, 0, 0, 0, 0};
  s16x8 bfr[8];
#pragma unroll
  for (int nt = 0; nt < 8; ++nt) { const s16x8 x = *(const s16x8*)(p.bbarT + ((size_t)(g * 128 + nt * 16 + fr) * 16 + (fq & 1) * 8)); bfr[nt] = (fq < 2) ? x : zero8; }
  const float are = p.abar[(g * 64 + lane) * 2], aim = p.abar[(g * 64 + lane) * 2 + 1];
  const size_t sidx = (((size_t)b * 32 + c) * S5G + g) * 64 + lane;
  float sre = 0.f, sim = 0.f;
  s16x8 cfr[4];
  f32x4 dsk = {0.f, 0.f, 0.f, 0.f};
  if (FINAL) {
    sre = p.s5Sin[sidx * 2]; sim = p.s5Sin[sidx * 2 + 1];
#pragma unroll
    for (int ks = 0; ks < 4; ++ks) cfr[ks] = *(const s16x8*)(p.cmT + ((size_t)(g * 16 + fr) * 128 + ks * 32 + fq * 8));
    dsk = *(const f32x4*)(p.s5_d + g * 16 + fq * 4);
  }
  s16x8 uxs[4]; u32x2 u4s[4];
#pragma unroll
  for (int mt = 0; mt < 4; ++mt) {
    const bf16_t* urow = p.proj + (t0 + mt * 16 + fr) * LDP + OFF_U + g * 16;
    uxs[mt] = *(const s16x8*)(urow + (fq & 1) * 8);
    if (FINAL) u4s[mt] = *(const u32x2*)(urow + fq * 4);
  }
#pragma unroll
  for (int mt = 0; mt < 4; ++mt) {
    const s16x8 ufr = (fq < 2) ? uxs[mt] : zero8;
#pragma unroll
    for (int nt = 0; nt < 8; ++nt) {
      const f32x4 z = {0.f, 0.f, 0.f, 0.f};
      const f32x4 acc = __builtin_amdgcn_mfma_f32_16x16x32_bf16(bfr[nt], ufr, z, 0, 0, 0);
      *(LAS f32x4*)(bu + fr * S5_BU_STRIDE + nt * 16 + 4 * fq) = acc;
    }
    wave_sync();
    f32x2 bv[16];
#pragma unroll
    for (int l = 0; l < 16; ++l) bv[l] = *(LAS f32x2*)(bu + l * S5_BU_STRIDE + 2 * lane);
#pragma unroll
    for (int l = 0; l < 16; ++l) {
      const float nr = are * sre - aim * sim + bv[l].x, ni = are * sim + aim * sre + bv[l].y;
      sre = nr; sim = ni;
      if (FINAL) *(LAS unsigned*)(Sb + l * S5_S_STRIDE + lane * 4) = cvtpk(sre, sim);
    }
    if (FINAL) {
      wave_sync();
      f32x4 y = {0.f, 0.f, 0.f, 0.f};
#pragma unroll
      for (int ks = 0; ks < 4; ++ks) {
        const s16x8 sfr = *(LAS s16x8*)(Sb + fr * S5_S_STRIDE + (ks * 32 + fq * 8) * 2);
        y = __builtin_amdgcn_mfma_f32_16x16x32_bf16(cfr[ks], sfr, y, 0, 0, 0);
      }
      const f32x4 u4 = {__builtin_bit_cast(float, u4s[mt].x << 16), __builtin_bit_cast(float, u4s[mt].x & 0xffff0000u), __builtin_bit_cast(float, u4s[mt].y << 16), __builtin_bit_cast(float, u4s[mt].y & 0xffff0000u)};
      u32x2 o; o.x = cvtpk(geluf_(y[0] + dsk[0] * u4[0]), geluf_(y[1] + dsk[1] * u4[1])); o.y = cvtpk(geluf_(y[2] + dsk[2] * u4[2]), geluf_(y[3] + dsk[3] * u4[3]));
      *(u32x2*)(p.yA + (t0 + mt * 16 + fr) * S5W + g * 16 + fq * 4) = o;
    } else wave_sync();
  }
  if (!FINAL) { p.s5E[sidx * 2] = sre; p.s5E[sidx * 2 + 1] = sim; }
}
template <bool FINAL>
__device__ __forceinline__ void s5_block_item(PR p, int item, lds_ptr smem) {
  const int wid = ltid() >> 6;
  const int go = item & 3, c = (item >> 2) & 31, b = item >> 7;
  s5_item<FINAL>(p, b, c, go * 8 + wid, smem + wid * S5_WAVE_LDS);
}

template <bool FINAL>
__device__ __forceinline__ void s5_wave_phase(PR p, int bid, int nb, lds_ptr smem) {
  const int lane = ltid() & 63, fr = lane & 15, fq = lane >> 4, wid = ltid() >> 6;
  const int g = (bid & 3) * 8 + wid;
  const lds_ptr wl = smem + wid * S5_WAVE_LDS;
  LAS float* bu = (LAS float*)wl;
  const lds_ptr Sb = wl + 16 * S5_BU_STRIDE * 4;
  const s16x8 zero8 = {0, 0, 0, 0, 0, 0, 0, 0};
  s16x8 bfr[8];
#pragma unroll
  for (int nt = 0; nt < 8; ++nt) { const s16x8 x = *(const s16x8*)(p.bbarT + ((size_t)(g * 128 + nt * 16 + fr) * 16 + (fq & 1) * 8)); bfr[nt] = (fq < 2) ? x : zero8; }
  const float are = p.abar[(g * 64 + lane) * 2], aim = p.abar[(g * 64 + lane) * 2 + 1];
  s16x8 cfr[4];
  f32x4 dsk = {0.f, 0.f, 0.f, 0.f};
  if (FINAL) {
#pragma unroll
    for (int ks = 0; ks < 4; ++ks) cfr[ks] = *(const s16x8*)(p.cmT + ((size_t)(g * 16 + fr) * 128 + ks * 32 + fq * 8));
    dsk = *(const f32x4*)(p.s5_d + g * 16 + fq * 4);
  }
  s16x8 nux[4]; u32x2 nu4[4]; f32x2 nsin = {0.f, 0.f};
#define S5_ISSUE(IDX) do { const int c_ = ((IDX) >> 2) & 31, b_ = (IDX) >> 7; const size_t t0_ = (size_t)b_ * SEQ + (size_t)c_ * 64; \
    _Pragma("unroll") for (int mt = 0; mt < 4; ++mt) { const bf16_t* urow = p.proj + (t0_ + mt * 16 + fr) * LDP + OFF_U + g * 16; \
      nux[mt] = *(const s16x8*)(urow + (fq & 1) * 8); if (FINAL) nu4[mt] = *(const u32x2*)(urow + fq * 4); } \
    if (FINAL) nsin = *(const f32x2*)(p.s5Sin + ((((size_t)b_ * 32 + c_) * S5G + g) * 64 + lane) * 2); } while (0)
  S5_ISSUE(bid);
#pragma unroll 1
  for (int idx = bid; idx < 1024; idx += nb) {
    const int c = (idx >> 2) & 31, b = idx >> 7;
    const size_t t0 = (size_t)b * SEQ + (size_t)c * 64;
    s16x8 uxs[4]; u32x2 u4s[4];
#pragma unroll
    for (int mt = 0; mt < 4; ++mt) { uxs[mt] = nux[mt]; u4s[mt] = nu4[mt]; }
    float sre = nsin.x, sim = nsin.y;
    __builtin_amdgcn_sched_barrier(0);
    { const int nidx = (idx + nb < 1024) ? idx + nb : idx; S5_ISSUE(nidx); }
    __builtin_amdgcn_sched_barrier(0);
#pragma unroll
    for (int mt = 0; mt < 4; ++mt) {
      const s16x8 ufr = (fq < 2) ? uxs[mt] : zero8;
#pragma unroll
      for (int nt = 0; nt < 8; ++nt) {
        const f32x4 z = {0.f, 0.f, 0.f, 0.f};
        const f32x4 acc = __builtin_amdgcn_mfma_f32_16x16x32_bf16(bfr[nt], ufr, z, 0, 0, 0);
        *(LAS f32x4*)(bu + fr * S5_BU_STRIDE + nt * 16 + 4 * fq) = acc;
      }
      wave_sync();
      f32x2 bv[16];
#pragma unroll
      for (int l = 0; l < 16; ++l) bv[l] = *(LAS f32x2*)(bu + l * S5_BU_STRIDE + 2 * lane);
#pragma unroll
      for (int l = 0; l < 16; ++l) {
        const float nr = are * sre - aim * sim + bv[l].x, ni = are * sim + aim * sre + bv[l].y;
        sre = nr; sim = ni;
        if (FINAL) *(LAS unsigned*)(Sb + l * S5_S_STRIDE + lane * 4) = cvtpk(sre, sim);
      }
      if (FINAL) {
        wave_sync();
        f32x4 y = {0.f, 0.f, 0.f, 0.f};
#pragma unroll
        for (int ks = 0; ks < 4; ++ks) {
          const s16x8 sfr = *(LAS s16x8*)(Sb + fr * S5_S_STRIDE + (ks * 32 + fq * 8) * 2);
          y = __builtin_amdgcn_mfma_f32_16x16x32_bf16(cfr[ks], sfr, y, 0, 0, 0);
        }
        const f32x4 u4 = {__builtin_bit_cast(float, u4s[mt].x << 16), __builtin_bit_cast(float, u4s[mt].x & 0xffff0000u), __builtin_bit_cast(float, u4s[mt].y << 16), __builtin_bit_cast(float, u4s[mt].y & 0xffff0000u)};
        u32x2 o; o.x = cvtpk(geluf_(y[0] + dsk[0] * u4[0]), geluf_(y[1] + dsk[1] * u4[1])); o.y = cvtpk(geluf_(y[2] + dsk[2] * u4[2]), geluf_(y[3] + dsk[3] * u4[3]));
        *(u32x2*)(p.yA + (t0 + mt * 16 + fr) * S5W + g * 16 + fq * 4) = o;
      } else wave_sync();
    }
    if (!FINAL) { const size_t sidx = (((size_t)b * 32 + c) * S5G + g) * 64 + lane; *(f32x2*)(p.s5E + sidx * 2) = (f32x2){sre, sim}; }
  }
#undef S5_ISSUE
}

constexpr int GL_QD = 0, GL_KE = 8192, GL_V = 16384, GL_SIN = 32768, GL_GL = 49152, GL_W2 = 53248, GL_TOT = 57344, GL_B2 = 58368, GL_ITEM = 58624;
__device__ __forceinline__ int rowrd_off(int r, int c) { return r * 128 + ((c ^ ((r >> 1) & 7)) << 4); }
__device__ __forceinline__ int tr128_off(int r, int ch) { return r * 128 + ((ch ^ (((r >> 1) & 1) | (((r >> 3) & 1) << 1))) << 5); }
__device__ __forceinline__ int tr256_off(int r, int ch) { return r * 256 + ((ch ^ ((r & 3) | (((r >> 3) & 1) << 2))) << 5); }

__device__ __forceinline__ void gla_front(lds_ptr il, int t, const f32x4& gklv, const float (&wv)[16], float bias, float (&bl)[16], float& blast) {
  LAS float* gl = (LAS float*)(il + GL_GL); LAS float* tot = (LAS float*)(il + GL_TOT);
  __syncthreads();
  *(LAS f32x4*)(gl + t * 4) = gklv;
  __syncthreads();
  const int d = t & 63, part = t >> 6;
  float run = 0.f;
#pragma unroll
  for (int ii = 0; ii < 16; ++ii) {
    const int i = part * 16 + ii;
    float gk = bias;
#pragma unroll
    for (int q = 0; q < 4; ++q) { const f32x4 gv = *(LAS f32x4*)(gl + i * 16 + q * 4); gk += gv[0] * wv[q * 4] + gv[1] * wv[q * 4 + 1] + gv[2] * wv[q * 4 + 2] + gv[3] * wv[q * 4 + 3]; }
    run += logsigmoidf_(gk) * (1.f / 16.f);
    bl[ii] = run;
  }
  tot[part * 64 + d] = run;
  __syncthreads();
  float offs = 0.f, all = 0.f;
#pragma unroll
  for (int q = 0; q < 4; ++q) { const float v = tot[q * 64 + d]; all += v; offs += (q < part) ? v : 0.f; }
#pragma unroll
  for (int ii = 0; ii < 16; ++ii) bl[ii] += offs;
  blast = all;
}

__device__ __forceinline__ void gla_pass1(PR p, int item, lds_ptr smem, const float (&wv)[16], float bias) {
  const int half = ltid() >> 8, t = ltid() & 255, lane = t & 63, w = t >> 6, fr = lane & 15, fq = lane >> 4;
  const int it = item * 2 + half, c = it & 31, h = (it >> 5) & 3, b = it >> 7;
  const lds_ptr il = smem + half * GL_ITEM;
  const size_t t0 = (size_t)b * SEQ + (size_t)c * 64;
  float bl[16], blast;
  const f32x4 gklv = *(const f32x4*)(p.gkl + t0 * 16 + t * 4);
  bf16_t kraw[16]; u32x4 vraw[4];
#pragma unroll
  for (int ii = 0; ii < 16; ++ii) kraw[ii] = p.proj[(t0 + (t >> 6) * 16 + ii) * LDP + OFF_K + h * 64 + (t & 63)];
#pragma unroll
  for (int q = 0; q < 4; ++q) { const int pc = t + 256 * q, r = pc >> 4, c8 = pc & 15; vraw[q] = *(const u32x4*)(p.proj + (t0 + r) * LDP + OFF_V + h * 128 + c8 * 8); }
  gla_front(il, t, gklv, wv, bias, bl, blast);
  {
    const int d = t & 63, part = t >> 6;
#pragma unroll
    for (int ii = 0; ii < 16; ++ii) {
      const int i = part * 16 + ii;
      const float kv = bf2f(kraw[ii]);
      *(LAS bf16_t*)(il + GL_KE + tr128_off(i, d >> 4) + (d & 15) * 2) = f2bf(kv * __expf(blast - bl[ii]));
    }
    if (part == 0) p.glaDec[(size_t)it * 64 + d] = __expf(blast);
#pragma unroll
    for (int q = 0; q < 4; ++q) { const int pc = t + 256 * q, r = pc >> 4, c8 = pc & 15;
      *(LAS u32x4*)(il + GL_V + tr256_off(r, c8 >> 1) + (c8 & 1) * 16) = vraw[q]; }
  }
  __syncthreads();
  f32x4 acc[8];
#pragma unroll
  for (int et = 0; et < 8; ++et) acc[et] = (f32x4){0.f, 0.f, 0.f, 0.f};
#pragma unroll
  for (int ks = 0; ks < 2; ++ks) {
    const int r0 = 32 * ks + 8 * fq + (fr >> 2);
    const s16x4 klo = tr_read(il + GL_KE + tr128_off(r0, w) + (fr & 3) * 8), khi = tr_read(il + GL_KE + tr128_off(r0 + 4, w) + (fr & 3) * 8);
    const s16x8 kf = __builtin_shufflevector(klo, khi, 0, 1, 2, 3, 4, 5, 6, 7);
#pragma unroll
    for (int et = 0; et < 8; ++et) {
      const s16x4 vlo = tr_read(il + GL_V + tr256_off(r0, et) + (fr & 3) * 8), vhi = tr_read(il + GL_V + tr256_off(r0 + 4, et) + (fr & 3) * 8);
      const s16x8 vf = __builtin_shufflevector(vlo, vhi, 0, 1, 2, 3, 4, 5, 6, 7);
      acc[et] = __builtin_amdgcn_mfma_f32_16x16x32_bf16(vf, kf, acc[et], 0, 0, 0);
    }
  }
#pragma unroll
  for (int et = 0; et < 8; ++et) *(f32x4*)(p.glaKV + ((size_t)it * 64 + 16 * w + fr) * 128 + et * 16 + fq * 4) = acc[et];
}

__device__ __forceinline__ void gla_pass2(PR p, int item, lds_ptr smem, const float (&wv)[16], float bias) {
  const int half = ltid() >> 8, t = ltid() & 255, lane = t & 63, w = t >> 6, fr = lane & 15, fq = lane >> 4;
  const int it = item * 2 + half, c = it & 31, h = (it >> 5) & 3, b = it >> 7;
  const lds_ptr il = smem + half * GL_ITEM;
  const size_t t0 = (size_t)b * SEQ + (size_t)c * 64;
  float bl[16], blast;
  const f32x4 gklv = *(const f32x4*)(p.gkl + t0 * 16 + t * 4);
  bf16_t qraw[16], kraw[16]; u32x4 vraw[4], sraw[4]; u32x2 rgraw[8];
#pragma unroll
  for (int ii = 0; ii < 16; ++ii) { const bf16_t* pr = p.proj + (t0 + (t >> 6) * 16 + ii) * LDP + h * 64 + (t & 63); qraw[ii] = pr[OFF_Q]; kraw[ii] = pr[OFF_K]; }
#pragma unroll
  for (int q = 0; q < 4; ++q) { const int pc = t + 256 * q, r = pc >> 4, c8 = pc & 15;
    vraw[q] = *(const u32x4*)(p.proj + (t0 + r) * LDP + OFF_V + h * 128 + c8 * 8);
    sraw[q] = *(const u32x4*)(p.glaSin + ((size_t)it * 64 + r) * 128 + c8 * 8); }
  const size_t trow = t0 + 16 * w + fr;
#pragma unroll
  for (int et = 0; et < 8; ++et) rgraw[et] = *(const u32x2*)(p.proj + trow * LDP + OFF_R + h * 128 + et * 16 + fq * 4);
  gla_front(il, t, gklv, wv, bias, bl, blast);
  {
    const int d = t & 63, part = t >> 6;
#pragma unroll
    for (int ii = 0; ii < 16; ++ii) {
      const int i = part * 16 + ii;
      const float qv = bf2f(qraw[ii]) * 0.125f, kv = bf2f(kraw[ii]);
      const int o = rowrd_off(i, d >> 3) + (d & 7) * 2;
      *(LAS bf16_t*)(il + GL_QD + o) = f2bf(qv * __expf(bl[ii]));
      *(LAS bf16_t*)(il + GL_KE + o) = f2bf(kv * __expf(-bl[ii]));
    }
#pragma unroll
    for (int q = 0; q < 4; ++q) { const int pc = t + 256 * q, r = pc >> 4, c8 = pc & 15;
      *(LAS u32x4*)(il + GL_V + tr256_off(r, c8 >> 1) + (c8 & 1) * 16) = vraw[q];
      *(LAS u32x4*)(il + GL_SIN + tr256_off(r, c8 >> 1) + (c8 & 1) * 16) = sraw[q]; }
  }
  __syncthreads();
  s16x8 qf[2];
#pragma unroll
  for (int ks = 0; ks < 2; ++ks) qf[ks] = *(LAS s16x8*)(il + GL_QD + rowrd_off(16 * w + fr, ks * 4 + fq));
  f32x4 st[4];
#pragma unroll
  for (int jt = 0; jt < 4; ++jt) {
    st[jt] = (f32x4){0.f, 0.f, 0.f, 0.f};
    if (jt <= w) {
#pragma unroll
      for (int ks = 0; ks < 2; ++ks) {
        const s16x8 kf = *(LAS s16x8*)(il + GL_KE + rowrd_off(16 * jt + fr, ks * 4 + fq));
        st[jt] = __builtin_amdgcn_mfma_f32_16x16x32_bf16(kf, qf[ks], st[jt], 0, 0, 0);
      }
      if (jt == w) {
#pragma unroll
        for (int r = 0; r < 4; ++r) st[jt][r] = (4 * fq + r <= fr) ? st[jt][r] : 0.f;
      }
    }
  }
  f32x4 acc[8];
#pragma unroll
  for (int et = 0; et < 8; ++et) acc[et] = (f32x4){0.f, 0.f, 0.f, 0.f};
#pragma unroll
  for (int u = 0; u < 2; ++u) {
    if (2 * u <= w) {
      u32x4 pk; pk.x = cvtpk(st[2 * u][0], st[2 * u][1]); pk.y = cvtpk(st[2 * u][2], st[2 * u][3]); pk.z = cvtpk(st[2 * u + 1][0], st[2 * u + 1][1]); pk.w = cvtpk(st[2 * u + 1][2], st[2 * u + 1][3]);
      const s16x8 pf = __builtin_bit_cast(s16x8, pk);
      const int r0 = 32 * u + 4 * fq + (fr >> 2);
#pragma unroll
      for (int et = 0; et < 8; ++et) {
        const s16x4 vlo = tr_read(il + GL_V + tr256_off(r0, et) + (fr & 3) * 8), vhi = tr_read(il + GL_V + tr256_off(r0 + 16, et) + (fr & 3) * 8);
        const s16x8 vf = __builtin_shufflevector(vlo, vhi, 0, 1, 2, 3, 4, 5, 6, 7);
        acc[et] = __builtin_amdgcn_mfma_f32_16x16x32_bf16(vf, pf, acc[et], 0, 0, 0);
      }
    }
  }
#pragma unroll
  for (int ks = 0; ks < 2; ++ks) {
    const int r0 = 32 * ks + 8 * fq + (fr >> 2);
#pragma unroll
    for (int et = 0; et < 8; ++et) {
      const s16x4 slo = tr_read(il + GL_SIN + tr256_off(r0, et) + (fr & 3) * 8), shi = tr_read(il + GL_SIN + tr256_off(r0 + 4, et) + (fr & 3) * 8);
      const s16x8 sf = __builtin_shufflevector(slo, shi, 0, 1, 2, 3, 4, 5, 6, 7);
      acc[et] = __builtin_amdgcn_mfma_f32_16x16x32_bf16(sf, qf[ks], acc[et], 0, 0, 0);
    }
  }
  float ss = 0.f;
#pragma unroll
  for (int et = 0; et < 8; ++et) ss += acc[et][0] * acc[et][0] + acc[et][1] * acc[et][1] + acc[et][2] * acc[et][2] + acc[et][3] * acc[et][3];
  ss += __shfl_xor(ss, 16); ss += __shfl_xor(ss, 32);
  const float rn = rsqrtf(ss * (1.f / 128.f) + 1e-6f);
#pragma unroll
  for (int et = 0; et < 8; ++et) {
    const int e = et * 16 + fq * 4;
    const f32x4 ng = *(const f32x4*)(p.gla_norm_g + e);
    const f32x4 rg = {__builtin_bit_cast(float, rgraw[et].x << 16), __builtin_bit_cast(float, rgraw[et].x & 0xffff0000u), __builtin_bit_cast(float, rgraw[et].y << 16), __builtin_bit_cast(float, rgraw[et].y & 0xffff0000u)};
    u32x2 o; o.x = cvtpk(acc[et][0] * rn * ng[0] * siluf_(rg[0]), acc[et][1] * rn * ng[1] * siluf_(rg[1])); o.y = cvtpk(acc[et][2] * rn * ng[2] * siluf_(rg[2]), acc[et][3] * rn * ng[3] * siluf_(rg[3]));
    *(u32x2*)(p.yB + trow * GVAL + h * 128 + e) = o;
  }
}

#define GLA_LOAD_WV(H) do { const int d_ = ltid() & 63; _Pragma("unroll") for (int r_ = 0; r_ < 16; ++r_) wv[r_] = p.w_gk2[r_ * GKEY + (H) * 64 + d_]; bias = p.b_gk2[(H) * 64 + d_]; } while (0)
__device__ __forceinline__ void phase_mix_local(PR p, int bid, int nb, lds_ptr smem, int which) {
  if (which & 1) { __syncthreads(); s5_wave_phase<false>(p, bid, nb, smem); }
  if (which & 2) {
    float wv[16], bias = 0.f; int hprev = -1;
    for (int item = bid; item < 512; item += nb) {
      const int h = ((item * 2 + (ltid() >> 8)) >> 5) & 3;
      if (h != hprev) { GLA_LOAD_WV(h); hprev = h; }
      gla_pass1(p, item, smem, wv, bias);
    }
  }
}
__device__ __forceinline__ void phase_mix_carry(PR p, int bid, int nb, int which) {
  const int wave = __builtin_amdgcn_readfirstlane(ltid() >> 6), ln = ltid() & 63;
  if (which & 1) {
    for (int j = bid; j < NB * S5G; j += nb) if (wave == 7) {
      const int g = j & 31, b = j >> 5;
      const float2 a = *(const float2*)(p.apow64 + (g * 64 + ln) * 2);
      float2 e[32];
#pragma unroll
      for (int c = 0; c < 32; ++c) e[c] = *(const float2*)(p.s5E + ((((size_t)b * 32 + c) * S5G + g) * 64 + ln) * 2);
      float sre = 0.f, sim = 0.f;
#pragma unroll
      for (int c = 0; c < 32; ++c) {
        *(float2*)(p.s5Sin + ((((size_t)b * 32 + c) * S5G + g) * 64 + ln) * 2) = make_float2(sre, sim);
        const float nr = a.x * sre - a.y * sim + e[c].x, ni = a.x * sim + a.y * sre + e[c].y;
        sre = nr; sim = ni;
      }
    }
  }
  if (which & 2) {
    for (int r = bid * 8 + wave; r < NB * GH * 64; r += nb * 8) {
      const int d = r & 63, bh = r >> 6;
      float2 kv[32]; float dec[32];
#pragma unroll
      for (int c = 0; c < 32; ++c) {
        const size_t it = (size_t)bh * 32 + c;
        kv[c] = *(const float2*)(p.glaKV + (it * 64 + d) * 128 + 2 * ln);
        dec[c] = p.glaDec[it * 64 + d];
      }
      float S0 = 0.f, S1 = 0.f;
#pragma unroll
      for (int c = 0; c < 32; ++c) {
        const size_t it = (size_t)bh * 32 + c;
        *(uint32_t*)(p.glaSin + (it * 64 + d) * 128 + 2 * ln) = cvtpk(S0, S1);
        S0 = dec[c] * S0 + kv[c].x; S1 = dec[c] * S1 + kv[c].y;
      }
    }
  }
}
__device__ __forceinline__ void phase_mix_final(PR p, int bid, int nb, lds_ptr smem, int which) {
  if (which & 1) { __syncthreads(); s5_wave_phase<true>(p, bid, nb, smem); }
  if (which & 2) {
    float wv[16], bias = 0.f; int hprev = -1;
    for (int item = bid; item < 512; item += nb) {
      const int h = ((item * 2 + (ltid() >> 8)) >> 5) & 3;
      if (h != hprev) { GLA_LOAD_WV(h); hprev = h; }
      gla_pass2(p, item, smem, wv, bias);
    }
  }
}

template <int CTRL> __device__ __forceinline__ float dppf(float x) { return __builtin_bit_cast(float, __builtin_amdgcn_update_dpp(0, __builtin_bit_cast(int, x), CTRL, 0xF, 0xF, false)); }
__device__ __forceinline__ float rlf(float x, int l) { return __builtin_bit_cast(float, __builtin_amdgcn_readlane(__builtin_bit_cast(int, x), l)); }
__device__ __forceinline__ float wave_max(float x) {
  x = fmaxf(x, dppf<0xB1>(x)); x = fmaxf(x, dppf<0x4E>(x)); x = fmaxf(x, dppf<0x141>(x)); x = fmaxf(x, dppf<0x140>(x));
  return fmaxf(fmaxf(rlf(x, 0), rlf(x, 16)), fmaxf(rlf(x, 32), rlf(x, 48)));
}
__device__ __forceinline__ float wave_sum(float x) {
  x += dppf<0xB1>(x); x += dppf<0x4E>(x); x += dppf<0x141>(x); x += dppf<0x140>(x);
  return (rlf(x, 0) + rlf(x, 16)) + (rlf(x, 32) + rlf(x, 48));
}
__device__ __forceinline__ void phase_route(PR p, int bid, int nb, lds_ptr smem) {
  const int lane = ltid() & 63, wid = ltid() >> 6;
  const f32x4 bias = *(const f32x4*)(p.router_bias + lane * 4);
  const int stride = nb * 8;
  int t = bid * 8 + wid;
  f32x4 nlg = {0.f, 0.f, 0.f, 0.f};
  if (t < T) nlg = *(const f32x4*)(p.logits + (size_t)t * NE + lane * 4);
  LAS int* hist = (LAS int*)smem; LAS int* base = hist + 256; LAS int* stg = hist + 512;
  __syncthreads();
  if (ltid() < 256) hist[ltid()] = 0;
  __syncthreads();
  int itn = 0;
  for (; t < T; t += stride, ++itn) {
    const f32x4 lg = nlg;
    { const int tn = (t + stride < T) ? t + stride : t; nlg = *(const f32x4*)(p.logits + (size_t)tn * NE + lane * 4); }
    float sc[4], v[4];
#pragma unroll
    for (int j = 0; j < 4; ++j) { sc[j] = sigmoidf_(lg[j]); v[j] = sc[j] + bias[j]; }
    float m1 = fmaxf(v[0], v[1]), m2 = fminf(v[0], v[1]);
#pragma unroll
    for (int j = 2; j < 4; ++j) { const float nm1 = fmaxf(m1, v[j]); m2 = fmaxf(fminf(m1, v[j]), m2); m1 = nm1; }
    { const float o1 = dppf<0xB1>(m1), o2 = dppf<0xB1>(m2); const float nm1 = fmaxf(m1, o1); m2 = fmaxf(fminf(m1, o1), fmaxf(m2, o2)); m1 = nm1; }
    { const float o1 = dppf<0x4E>(m1), o2 = dppf<0x4E>(m2); const float nm1 = fmaxf(m1, o1); m2 = fmaxf(fminf(m1, o1), fmaxf(m2, o2)); m1 = nm1; }
    { const float o1 = dppf<0x141>(m1), o2 = dppf<0x141>(m2); const float nm1 = fmaxf(m1, o1); m2 = fmaxf(fminf(m1, o1), fmaxf(m2, o2)); m1 = nm1; }
    const float gs = m1 + m2;
    const int grp = lane >> 3;
    int rank = 0;
#pragma unroll
    for (int g2 = 0; g2 < 8; ++g2) { const float og = rlf(gs, g2 * 8); rank += (og > gs || (og == gs && g2 < grp)) ? 1 : 0; }
    const bool gsel = rank < 4;
#pragma unroll
    for (int j = 0; j < 4; ++j) v[j] = gsel ? v[j] : -INFINITY;
    int my_e = 0; float my_s = 0.f, wsum = 0.f;
#pragma unroll 1
    for (int r = 0; r < 8; ++r) {
      const float wm = wave_max(fmaxf(fmaxf(v[0], v[1]), fmaxf(v[2], v[3])));
      const int my_j = (v[0] == wm) ? 0 : (v[1] == wm) ? 1 : (v[2] == wm) ? 2 : (v[3] == wm) ? 3 : 4;
      const unsigned long long ball = __ballot(my_j < 4);
      const int ol = ball ? (int)__builtin_ctzll(ball) : 0;
      const int oj = __builtin_amdgcn_readlane(my_j, ol) & 3;
      const int be = ol * 4 + oj;
      float s_own = 0.f;
#pragma unroll
      for (int j = 0; j < 4; ++j) if (lane == ol && oj == j) { s_own = sc[j]; v[j] = -INFINITY; }
      const float s_w = rlf(s_own, ol);
      wsum += s_w;
      if (lane == r) { my_e = be; my_s = s_w; }
    }
    if (lane < 8) {
      p.tk_idx[t * 8 + lane] = my_e;
      p.tk_w[t * 8 + lane] = my_s / wsum * 2.5f;
      const int lr = __hip_atomic_fetch_add(hist + my_e, 1, __ATOMIC_RELAXED, __HIP_MEMORY_SCOPE_WORKGROUP);
      stg[(itn * 8 + wid) * 8 + lane] = my_e | (lr << 8);
    }
  }
  __syncthreads();
  if (ltid() < 256) { const int c = hist[ltid()]; base[ltid()] = c ? atomicAdd(&p.counts[ltid()], c) : 0; }
  __syncthreads();
  itn = 0;
  for (t = bid * 8 + wid; t < T; t += stride, ++itn) if (lane < 8) { const int v = stg[(itn * 8 + wid) * 8 + lane]; p.tk_rank[t * 8 + lane] = base[v & 255] + (v >> 8); }
}
__device__ __forceinline__ void phase_scatter(PR p, int bid, int nb, lds_ptr smem) {
  LAS int* st = (LAS int*)smem;
  __syncthreads();
  if (ltid() < 256) st[ltid() + 1] = (p.counts[ltid()] + 127) / 128 * 128;
  if (ltid() == 0) st[0] = 0;
  __syncthreads();
  if (ltid() < 64) {
    const int ln = ltid();
    const int c0 = st[4 * ln + 1], c1 = st[4 * ln + 2], c2 = st[4 * ln + 3], c3 = st[4 * ln + 4];
    const int tot = c0 + c1 + c2 + c3;
    int inc = tot;
    #pragma unroll
    for (int o = 1; o < 64; o <<= 1) { const int v = __shfl_up(inc, o, 64); if (ln >= o) inc += v; }
    const int b0 = inc - tot;
    st[4 * ln + 1] = b0 + c0; st[4 * ln + 2] = b0 + c0 + c1; st[4 * ln + 3] = b0 + c0 + c1 + c2; st[4 * ln + 4] = inc;
  }
  __syncthreads();
  if (bid == 0) {
    if (ltid() < 256) { const int e = ltid(); for (int b = st[e] / 128; b < st[e + 1] / 128; ++b) p.blk_exp[b] = e; }
    for (int b = st[256] / 128 + ltid(); b < NBLK128; b += NTHR) p.blk_exp[b] = -1;
  }
  if (bid >= 8 && bid < 16 && ltid() < 64) {
    const int x = bid - 8, ln = ltid() & 63, half = ln >> 5;
    const int e = x + 8 * (ln & 31);
    const int np = (st[e + 1] / 128 - st[e] / 128 + 1) >> 1;
    int inc = np;
    #pragma unroll
    for (int o = 1; o < 32; o <<= 1) { const int v = __shfl_up(inc, o, 32); if ((ln & 31) >= o) inc += v; }
    const int base = inc - np;
    if (half == 0) for (int j = 0; j < np; ++j) p.moe_list[x * NBLK128 + base + j] = st[e] / 128 + 2 * j;
    if (ln == 31) p.moe_cnt[x] = inc;
  }
  for (int i = bid * NTHR + ltid(); i < T * 8; i += nb * NTHR) {
    const int e = p.tk_idx[i], pos = st[e] + p.tk_rank[i];
    p.slot_tok[pos] = i >> 3;
    p.slot_of[i] = pos;
  }
}

__global__ void __launch_bounds__(64) k_s5_naive(P p) {
  __shared__ float sre[64], sim[64], cre[16][64], cim[16][64], us[16];
  const int b = blockIdx.x / S5G, g = blockIdx.x % S5G, lane = threadIdx.x;
  const float are = p.abar[(g * 64 + lane) * 2], aim = p.abar[(g * 64 + lane) * 2 + 1];
  float bre[16], bim[16];
  for (int h = 0; h < 16; ++h) { bre[h] = p.bbar[((g * 64 + lane) * 16 + h) * 2]; bim[h] = p.bbar[((g * 64 + lane) * 16 + h) * 2 + 1]; }
  for (int i = lane; i < 1024; i += 64) { cre[i >> 6][i & 63] = p.c_re[g * 1024 + i]; cim[i >> 6][i & 63] = p.c_im[g * 1024 + i]; }
  const float dsk = lane < 16 ? p.s5_d[g * 16 + lane] : 0.f;
  float s_re = 0.f, s_im = 0.f;
  __syncthreads();
  for (int l = 0; l < SEQ; ++l) {
    const size_t t = (size_t)b * SEQ + l;
    if (lane < 16) us[lane] = bf2f(p.proj[t * LDP + OFF_U + g * 16 + lane]);
    __syncthreads();
    float bur = 0.f, bui = 0.f;
    for (int h = 0; h < 16; ++h) { bur += us[h] * bre[h]; bui += us[h] * bim[h]; }
    const float nr = are * s_re - aim * s_im + bur, ni = are * s_im + aim * s_re + bui;
    s_re = nr; s_im = ni;
    sre[lane] = s_re; sim[lane] = s_im;
    __syncthreads();
    if (lane < 16) {
      float y = dsk * us[lane];
      for (int q = 0; q < 64; ++q) y += sre[q] * cre[lane][q] - sim[q] * cim[lane][q];
      p.yA[t * S5W + g * 16 + lane] = f2bf(geluf_(y));
    }
    __syncthreads();
  }
}

__global__ void __launch_bounds__(128) k_gla_naive(P p) {
  __shared__ float qs[32][64], ks[32][64], as[32][64], gl[32][16], w2[16][64], b2[64];
  const int b = blockIdx.x / GH, h = blockIdx.x % GH, tid = threadIdx.x;
  for (int i = tid; i < 16 * 64; i += 128) w2[i >> 6][i & 63] = p.w_gk2[(i >> 6) * GKEY + h * 64 + (i & 63)];
  if (tid < 64) b2[tid] = p.b_gk2[h * 64 + tid];
  float S[64];
  for (int d = 0; d < 64; ++d) S[d] = 0.f;
  for (int l0 = 0; l0 < SEQ; l0 += 32) {
    __syncthreads();
    for (int i = tid; i < 32 * 64; i += 128) {
      const size_t t = (size_t)b * SEQ + l0 + (i >> 6);
      qs[i >> 6][i & 63] = bf2f(p.proj[t * LDP + OFF_Q + h * 64 + (i & 63)]) * 0.125f;
      ks[i >> 6][i & 63] = bf2f(p.proj[t * LDP + OFF_K + h * 64 + (i & 63)]);
    }
    for (int i = tid; i < 32 * 16; i += 128) { const size_t t = (size_t)b * SEQ + l0 + (i >> 4); gl[i >> 4][i & 15] = p.gkl[t * 16 + (i & 15)]; }
    __syncthreads();
    for (int i = tid; i < 32 * 64; i += 128) {
      const int s = i >> 6, d = i & 63;
      float gk = b2[d];
      for (int r = 0; r < 16; ++r) gk += gl[s][r] * w2[r][d];
      as[s][d] = __expf(logsigmoidf_(gk) * (1.f / 16.f));
    }
    __syncthreads();
    for (int s = 0; s < 32; ++s) {
      const size_t t = (size_t)b * SEQ + l0 + s;
      const float v = bf2f(p.proj[t * LDP + OFF_V + h * 128 + tid]);
      float o = 0.f;
      for (int d = 0; d < 64; ++d) { S[d] = as[s][d] * S[d] + ks[s][d] * v; o += qs[s][d] * S[d]; }
      p.oraw[t * GVAL + h * 128 + tid] = o;
    }
  }
}
__global__ void __launch_bounds__(256) k_gla_post(P p) {
  const int idx = blockIdx.x * 4 + (threadIdx.x >> 6), lane = threadIdx.x & 63;
  const int t = idx / GH, h = idx % GH;
  const float o0 = p.oraw[(size_t)t * GVAL + h * 128 + lane], o1 = p.oraw[(size_t)t * GVAL + h * 128 + 64 + lane];
  float ss = o0 * o0 + o1 * o1;
  for (int o = 32; o > 0; o >>= 1) ss += __shfl_xor(ss, o);
  const float r = rsqrtf(ss * (1.f / 128.f) + 1e-6f);
  const float r0 = bf2f(p.proj[(size_t)t * LDP + OFF_R + h * 128 + lane]), r1 = bf2f(p.proj[(size_t)t * LDP + OFF_R + h * 128 + 64 + lane]);
  p.yB[(size_t)t * GVAL + h * 128 + lane] = f2bf(o0 * r * p.gla_norm_g[lane] * siluf_(r0));
  p.yB[(size_t)t * GVAL + h * 128 + 64 + lane] = f2bf(o1 * r * p.gla_norm_g[64 + lane] * siluf_(r1));
}

__global__ void __launch_bounds__(64) k_route(P p) {
  const int t = blockIdx.x * 64 + threadIdx.x;
  const float* lg = p.logits + (size_t)t * NE;
  float gs[8];
#pragma unroll
  for (int g = 0; g < 8; ++g) {
    float m1 = -INFINITY, m2 = -INFINITY;
    for (int j = 0; j < 32; ++j) { const float v = sigmoidf_(lg[g * 32 + j]) + p.router_bias[g * 32 + j]; if (v > m1) { m2 = m1; m1 = v; } else if (v > m2) m2 = v; }
    gs[g] = m1 + m2;
  }
  unsigned gmask = 0;
#pragma unroll
  for (int r = 0; r < 4; ++r) { int best = -1; float bv = -INFINITY;
#pragma unroll
    for (int g = 0; g < 8; ++g) if (!((gmask >> g) & 1u) && gs[g] > bv) { bv = gs[g]; best = g; }
    gmask |= 1u << best; }
  int sel[8]; float sw[8]; float wsum = 0.f;
#pragma unroll
  for (int r = 0; r < 8; ++r) {
    int best = -1; float bv = -INFINITY;
    for (int e = 0; e < NE; ++e) {
      if (!((gmask >> (e >> 5)) & 1u)) continue;
      bool taken = false;
#pragma unroll
      for (int q = 0; q < 8; ++q) taken |= (q < r) && (sel[q] == e);
      if (taken) continue;
      const float v = sigmoidf_(lg[e]) + p.router_bias[e];
      if (v > bv) { bv = v; best = e; }
    }
    best = best < 0 ? r : best;
    sel[r] = best; sw[r] = sigmoidf_(lg[best]); wsum += sw[r];
  }
#pragma unroll
  for (int r = 0; r < 8; ++r) {
    p.tk_idx[t * 8 + r] = sel[r];
    p.tk_w[t * 8 + r] = sw[r] / wsum * 2.5f;
    p.tk_rank[t * 8 + r] = atomicAdd(&p.counts[sel[r]], 1);
  }
}
__global__ void __launch_bounds__(256) k_offsets(P p) {
  __shared__ int pad[256], st[257];
  const int e = threadIdx.x;
  pad[e] = (p.counts[e] + 127) / 128 * 128;
  __syncthreads();
  if (e == 0) { int s = 0; for (int i = 0; i < 256; ++i) { st[i] = s; s += pad[i]; } st[256] = s; }
  __syncthreads();
  p.pad_start[e] = st[e];
  if (e == 0) p.pad_start[256] = st[256];
  for (int b = st[e] / 128; b < st[e + 1] / 128; ++b) p.blk_exp[b] = e;
  for (int b = st[256] / 128 + e; b < NBLK128; b += 256) p.blk_exp[b] = -1;
}
__global__ void __launch_bounds__(256) k_scatter(P p) {
  const int i = blockIdx.x * 256 + threadIdx.x;
  const int e = p.tk_idx[i], pos = p.pad_start[e] + p.tk_rank[i];
  p.slot_tok[pos] = i >> 3;
  p.slot_of[i] = pos;
}

__device__ __forceinline__ void phase_combine(PR p, int bid, int nb) {
  const int lane = ltid() & 63, wid = ltid() >> 6;
  for (int t = bid * 8 + wid; t < T; t += nb * 8) {
    const int b = t / SEQ;
    int so[8]; float w[8];
#pragma unroll
    for (int k = 0; k < 8; ++k) { so[k] = p.slot_of[t * 8 + k]; w[k] = p.tk_w[t * 8 + k]; }
    float v[16], ss = 0.f;
#pragma unroll
    for (int i = 0; i < 4; ++i) {
      const int c0 = lane * 4 + 256 * i;
      f32x4 m = ld_bf4(p.S + (size_t)t * D + c0);
#pragma unroll
      for (int k = 0; k < 8; ++k) { const f32x4 y = ld_bf4(p.Y + (size_t)so[k] * D + c0); m[0] += w[k] * y[0]; m[1] += w[k] * y[1]; m[2] += w[k] * y[2]; m[3] += w[k] * y[3]; }
      const f32x4 xv = *(const f32x4*)(p.x1 + (size_t)t * D + c0), gg = *(const f32x4*)(p.mod + b * 6144 + 5 * D + c0);
#pragma unroll
      for (int j = 0; j < 4; ++j) { v[i * 4 + j] = xv[j] + gg[j] * m[j]; ss += v[i * 4 + j] * v[i * 4 + j]; }
    }
#pragma unroll
    for (int o = 32; o > 0; o >>= 1) ss += __shfl_xor(ss, o);
    const float r = rsqrtf(ss * (1.f / D) + 1e-6f);
#pragma unroll
    for (int i = 0; i < 4; ++i) {
      const int c0 = lane * 4 + 256 * i; const f32x4 fg = *(const f32x4*)(p.final_g + c0);
      f32x4 o; o[0] = v[i * 4] * r * fg[0]; o[1] = v[i * 4 + 1] * r * fg[1]; o[2] = v[i * 4 + 2] * r * fg[2]; o[3] = v[i * 4 + 3] * r * fg[3];
      *(f32x4*)(p.out + (size_t)t * D + c0) = o;
    }
  }
}


template <class Epi>
__global__ void __launch_bounds__(256) k_gemm_naive(const bf16_t* __restrict__ A, int lda, const float* __restrict__ Bm, int ldb, int M, int N, int K, Epi epi) {
  __shared__ float As[16][68];
  __shared__ float Bs[16][68];
  const int tx = threadIdx.x & 15, ty = threadIdx.x >> 4;
  const int row0 = blockIdx.y * 64, col0 = blockIdx.x * 64;
  float acc[4][4];
  for (int i = 0; i < 4; ++i) for (int j = 0; j < 4; ++j) acc[i][j] = 0.f;
  for (int k0 = 0; k0 < K; k0 += 16) {
    { const int r = threadIdx.x >> 2, k4 = (threadIdx.x & 3) * 4;
      const bf16_t* ap = A + (size_t)(row0 + r) * lda + k0 + k4;
      for (int j = 0; j < 4; ++j) As[k4 + j][r] = bf2f(ap[j]); }
    { const int k = threadIdx.x >> 4, c4 = (threadIdx.x & 15) * 4;
      for (int j = 0; j < 4; ++j) { const int cc = col0 + c4 + j; Bs[k][c4 + j] = cc < N ? Bm[(size_t)(k0 + k) * ldb + cc] : 0.f; } }
    __syncthreads();
    for (int k = 0; k < 16; ++k) {
      float a[4], b[4];
      for (int i = 0; i < 4; ++i) a[i] = As[k][ty * 4 + i];
      for (int j = 0; j < 4; ++j) b[j] = Bs[k][tx * 4 + j];
      for (int i = 0; i < 4; ++i) for (int j = 0; j < 4; ++j) acc[i][j] += a[i] * b[j];
    }
    __syncthreads();
  }
  for (int i = 0; i < 4; ++i) for (int j = 0; j < 4; ++j) { const int r = row0 + ty * 4 + i, cc = col0 + tx * 4 + j; if (cc < N) epi(r, cc, acc[i][j]); }
}
struct NEpiProj { bf16_t* o; __device__ void operator()(int r, int c, float v) const { if (c >= WIN_GK && c < WIN_GK + 16) return; const int cc = c < WIN_GK ? c : c - 16; o[(size_t)r * LDP + cc] = f2bf(v); } };
struct NEpiGlu { const bf16_t* yA; const float* b; bf16_t* z; __device__ void operator()(int r, int c, float v) const { const float y = bf2f(yA[(size_t)r * S5W + c]); z[(size_t)r * S5W + c] = f2bf(y * sigmoidf_(v + b[c])); } };
struct NEpiPA { const bf16_t* proj; float* t; __device__ void operator()(int r, int c, float v) const { t[(size_t)r * D + c] = sigmoidf_(bf2f(proj[(size_t)r * LDP + OFF_GA + c])) * v; } };
struct NEpiPB { const bf16_t* proj; const float* t; bf16_t* m; __device__ void operator()(int r, int c, float v) const { m[(size_t)r * D + c] = f2bf(t[(size_t)r * D + c] + sigmoidf_(bf2f(proj[(size_t)r * LDP + OFF_GB + c])) * v); } };
struct NEpiOut { const float* x; const float* mod; float* x1; __device__ void operator()(int r, int c, float v) const { const int b = r / SEQ; x1[(size_t)r * D + c] = x[(size_t)r * D + c] + mod[b * 6144 + 2 * D + c] * v; } };
struct NEpiF32 { float* o; long ld; __device__ void operator()(int r, int c, float v) const { o[(size_t)r * ld + c] = v; } };
struct NEpiShUp { const float* g; bf16_t* h; __device__ void operator()(int r, int c, float v) const { h[(size_t)r * SFF + c] = f2bf(siluf_(g[(size_t)r * SFF + c]) * v); } };
struct NEpiBf { bf16_t* o; long ld; __device__ void operator()(int r, int c, float v) const { o[(size_t)r * ld + c] = f2bf(v); } };
__global__ void __launch_bounds__(256) k_moe_naive(P p) {
  __shared__ float xs[16][1024];
  __shared__ float hs[16][256];
  __shared__ int toks[16];
  const int s0 = blockIdx.x * 16, e = p.blk_exp[s0 / 128], tid = threadIdx.x;
  if (e < 0) return;
  if (tid < 16) toks[tid] = p.slot_tok[s0 + tid];
  __syncthreads();
  bool any = false;
  for (int s = 0; s < 16; ++s) any |= toks[s] >= 0;
  if (!any) return;
  for (int i = tid; i < 16 * 1024; i += 256) { const int s = i >> 10, d = i & 1023; xs[s][d] = toks[s] >= 0 ? bf2f(p.h2[(size_t)toks[s] * D + d]) : 0.f; }
  __syncthreads();
  {
    float ag[16], au[16];
    for (int s = 0; s < 16; ++s) { ag[s] = 0.f; au[s] = 0.f; }
    const float* wg = p.ew_gate + (size_t)e * D * EFF + tid;
    const float* wu = p.ew_up + (size_t)e * D * EFF + tid;
    for (int d = 0; d < D; ++d) {
      const float g = wg[(size_t)d * EFF], u = wu[(size_t)d * EFF];
      for (int s = 0; s < 16; ++s) { const float xv = xs[s][d]; ag[s] += xv * g; au[s] += xv * u; }
    }
    for (int s = 0; s < 16; ++s) hs[s][tid] = bf2f(f2bf(siluf_(ag[s]) * au[s]));
  }
  __syncthreads();
  for (int nb = 0; nb < 4; ++nb) {
    float acc[16];
    for (int s = 0; s < 16; ++s) acc[s] = 0.f;
    const float* wd = p.ew_down + (size_t)e * EFF * D + nb * 256 + tid;
    for (int j = 0; j < EFF; ++j) { const float w = wd[(size_t)j * D]; for (int s = 0; s < 16; ++s) acc[s] += hs[s][j] * w; }
    for (int s = 0; s < 16; ++s) if (toks[s] >= 0) p.Y[(size_t)(s0 + s) * D + nb * 256 + tid] = f2bf(acc[s]);
  }
}

#define SMEM_DECL __shared__ __attribute__((aligned(16))) unsigned char smem_raw[SMEM_BYTES]; const lds_ptr smem = (lds_ptr)smem_raw;


#define XB_TMO      128
#define XB_XCNT(j)  (256  + 64 * (j))
#define XB_XSUB(j)  (1280 + 64 * (j))
#define XB_XGEN(j)  (2304 + 64 * (j))
#define XB_TOP      3328
#define XB_TOPGEN   3392
#define XCD_BAR_WORDS 3456
#define XB_SPIN_CAP (1u << 18)
__device__ __forceinline__ unsigned xb_ld(unsigned* q)              { return __hip_atomic_load(q, __ATOMIC_RELAXED, __HIP_MEMORY_SCOPE_AGENT); }
__device__ __forceinline__ unsigned xb_add(unsigned* q, unsigned v) { return __hip_atomic_fetch_add(q, v, __ATOMIC_RELAXED, __HIP_MEMORY_SCOPE_AGENT); }
__device__ __forceinline__ unsigned xb_xcc_id() { return (unsigned)__builtin_amdgcn_s_getreg((3 << 11) | 20) & 0xFu; }
#define XB_SPIN(cond, bar) do { unsigned _sp = 0; while (cond) { __builtin_amdgcn_s_sleep(1); \
    if ((++_sp & 255u) == 0u) { if (xb_ld(&(bar)[XB_TMO])) break; if (_sp > XB_SPIN_CAP) { atomicAdd(&(bar)[XB_TMO], 1u); break; } } } } while (0)
struct XcdBarrier { unsigned* bar; unsigned x; volatile LAS unsigned* st; };
__device__ __forceinline__ XcdBarrier xcd_barrier_post(unsigned* bar, volatile LAS unsigned* st) {
  XcdBarrier b; b.bar = bar; b.x = xb_xcc_id(); b.st = st;
  if (threadIdx.x == 0) (void)xb_add(&bar[XB_XCNT(b.x)], 1u);
  return b;
}
__device__ __forceinline__ void xcd_barrier_complete(unsigned* bar, unsigned x, unsigned& nloc, unsigned& nx) {
  const unsigned G = gridDim.x * gridDim.y * gridDim.z;
  unsigned sum, cnt, mine, sp = 0u;
  for (;;) {
    sum = 0u; cnt = 0u; mine = 0u;
#pragma unroll
    for (unsigned j = 0; j < 16; ++j) { const unsigned c = xb_ld(&bar[XB_XCNT(j)]); sum += c; cnt += (c > 0u) ? 1u : 0u; mine = (j == x) ? c : mine; }
    if (sum == G) break;
    __builtin_amdgcn_s_sleep(1);
    if ((++sp & 255u) == 0u) { if (xb_ld(&bar[XB_TMO])) break; if (sp > XB_SPIN_CAP) { atomicAdd(&bar[XB_TMO], 1u); break; } }
  }
  nloc = mine > 0u ? mine : 1u; nx = cnt > 0u ? cnt : 1u;
}
__device__ __forceinline__ void xcd_barrier(const XcdBarrier& b) {
  asm volatile("s_waitcnt vmcnt(0)" ::: "memory");
  __syncthreads();
  if (threadIdx.x == 0) {
    unsigned* bar = b.bar;
    __builtin_amdgcn_s_waitcnt(0);
    unsigned nloc = b.st[0], nx = b.st[1];
    if (nloc == 0u) { xcd_barrier_complete(bar, b.x, nloc, nx); b.st[0] = nloc; b.st[1] = nx; }
    const unsigned old = xb_add(&bar[XB_XSUB(b.x)], 1u);
    const unsigned gen = old / nloc;
    if (old + 1u == (gen + 1u) * nloc) {
      __builtin_amdgcn_fence(__ATOMIC_RELEASE, "agent");
      asm volatile("s_waitcnt vmcnt(0)" ::: "memory");
      const unsigned og = xb_add(&bar[XB_TOP], 1u);
      const unsigned tg = og / nx;
      if (og + 1u == (tg + 1u) * nx) xb_add(&bar[XB_TOPGEN], 1u);
      else XB_SPIN(xb_ld(&bar[XB_TOPGEN]) == tg, bar);
      __builtin_amdgcn_fence(__ATOMIC_ACQUIRE, "agent");
      xb_add(&bar[XB_XGEN(b.x)], 1u);
      asm volatile("s_waitcnt vmcnt(0)" ::: "memory");
    } else {
      XB_SPIN(xb_ld(&bar[XB_XGEN(b.x)]) == gen, bar);
      __builtin_amdgcn_fence(__ATOMIC_ACQUIRE, "agent");
      asm volatile("s_waitcnt vmcnt(0)" ::: "memory");
    }
  }
  __syncthreads();
}

__device__ __forceinline__ const __attribute__((address_space(4))) P* kargs() { auto q = __builtin_amdgcn_kernarg_segment_ptr(); asm volatile("" : "+s"(q)); return (const __attribute__((address_space(4))) P*)q; }
#define PK (*kargs())
__global__ void __launch_bounds__(NTHR) k_fused(P p_unused) {
  SMEM_DECL
  const int bid = blockIdx.x, nb = gridDim.x;
  volatile LAS unsigned* xbw = (volatile LAS unsigned*)(smem + SMEM_BYTES - 16);
  if (threadIdx.x == 0) { xbw[0] = 0u; xbw[1] = 0u; }
  __syncthreads();
  const XcdBarrier xb = xcd_barrier_post(PK.bar, xbw);
#define GSYNC() xcd_barrier(xb)
#define RUN(k, ...) do { __VA_ARGS__; if (REP_PHASE == (k)) { _Pragma("unroll 1") for (int r_ = 0; r_ < REP_N; ++r_) { __builtin_amdgcn_sched_barrier(0); __VA_ARGS__; } } } while (0)
  RUN(0, phase_prep(PK, bid, nb, smem));                                                                   GSYNC();
  RUN(1, phase_norm<false>(PK, PK.x, PK.norm1_g, 0, D, PK.h1, bid, nb, smem));                                 GSYNC();
  RUN(2, phase_gemm_dense256_bf16(PK.h1, D, PK.wb_in, LDP, T, LDP, D, PK.proj, LDP, bid, nb, smem); gk_rows(PK, bid, nb));     GSYNC();
  RUN(3, phase_mix_local(PK, bid, nb, smem, 3));                                                           GSYNC();
  RUN(4, phase_mix_carry(PK, bid, nb, 3));                                                                 GSYNC();
  RUN(5, phase_mix_final(PK, bid, nb, smem, 3));                                                           GSYNC();
  RUN(6, phase_gemm_dense(PK.yA, S5W, PK.wb_glu, S5W, T, S5W, S5W, EpiGlu{PK.yA, PK.b_glu, PK.zA}, bid, nb, smem));   GSYNC();
  RUN(7, phase_gemm_mixed(PK, bid, nb, smem));                                                             GSYNC();
  RUN(8, phase_gemm_dense256(PK.mixed, D, PK.wb_out, D, T, D, D, EpiOut{PK.x, PK.mod, PK.x1}, bid, nb, smem));    GSYNC();
  RUN(9, phase_norm<false>(PK, PK.x1, PK.norm2_g, 3 * D, 4 * D, PK.h2, bid, nb, smem));                       GSYNC();
  RUN(10, phase_gemm_rs(PK, bid, nb, smem));                                                               GSYNC();
  phase_route(PK, bid, nb, smem);                                                                                GSYNC();
  RUN(12, phase_scatter(PK, bid, nb, smem));                                                               GSYNC();
  phase_moe_pair<1>(PK, bid, nb, smem);                                                                    GSYNC();
  phase_moe_pair<2>(PK, bid, nb, smem);
  RUN(14, phase_gemm_dense256_bf16(PK.shH, SFF, PK.wb_sd, D, T, D, SFF, PK.S, D, bid, nb, smem));        GSYNC();
  RUN(15, phase_combine(PK, bid, nb));
}

static inline size_t al256(size_t v) { return (v + 255) & ~(size_t)255; }

extern "C" void kernel_launch(void* const* d_in, const int* in_sizes, int n_in, void* d_out, int out_size, void* d_ws, size_t ws_size, hipStream_t stream) {
  P p{};
  const float** pin = (const float**)&p;
  for (int i = 0; i < 32; ++i) pin[i] = (const float*)d_in[i];
  p.out = (float*)d_out;
  char* w = (char*)d_ws; size_t off = 0;
  auto take = [&](size_t bytes) { char* r = w + off; off = al256(off + bytes); return (void*)r; };
  p.mod = (float*)take(8 * 6144 * 4);
  p.wb_in = (bf16_t*)take((size_t)D * LDP * 2);
  p.wb_glu = (bf16_t*)take((size_t)S5W * S5W * 2);
  p.wb_pa = (bf16_t*)take((size_t)S5W * D * 2);
  p.wb_pb = (bf16_t*)take((size_t)GVAL * D * 2);
  p.wb_out = (bf16_t*)take((size_t)D * D * 2);
  p.wb_rs = (bf16_t*)take((size_t)D * 768 * 2);
  p.wb_sd = (bf16_t*)take((size_t)SFF * D * 2);
  p.h1 = (bf16_t*)take((size_t)T * D * 2);
  p.gkl = (float*)take((size_t)T * 16 * 4);
  p.proj = (bf16_t*)take((size_t)T * LDP * 2);
  p.abar = (float*)take(S5G * S5P * 2 * 4);
  p.bbar = (float*)take(S5G * S5P * S5H * 2 * 4);
  p.yA = (bf16_t*)take((size_t)T * S5W * 2);
  p.oraw = (float*)take((size_t)T * GVAL * 4);
  p.yB = (bf16_t*)take((size_t)T * GVAL * 2);
  p.zA = (bf16_t*)take((size_t)T * S5W * 2);
  p.mixed = (bf16_t*)take((size_t)T * D * 2);
  p.x1 = (float*)take((size_t)T * D * 4);
  p.h2 = (bf16_t*)take((size_t)T * D * 2);
  p.logits = (float*)take((size_t)T * NE * 4);
  p.tk_idx = (int*)take((size_t)T * 8 * 4);
  p.tk_w = (float*)take((size_t)T * 8 * 4);
  p.tk_rank = (int*)take((size_t)T * 8 * 4);
  p.slot_of = (int*)take((size_t)T * 8 * 4);
  p.counts = (int*)take(256 * 4);
  p.pad_start = (int*)take(257 * 4);
  p.blk_exp = (int*)take(NBLK128 * 4);
  p.slot_tok = (int*)take((size_t)NSLOT * 4);
  p.Y = (bf16_t*)take((size_t)NSLOT * D * 2);
  p.shH = (bf16_t*)take((size_t)T * SFF * 2);
  p.S = (bf16_t*)take((size_t)T * D * 2);
  p.bbarT = (bf16_t*)take((size_t)S5G * 128 * 16 * 2);
  p.cmT = (bf16_t*)take((size_t)S5G * 16 * 128 * 2);
  p.apow64 = (float*)take(S5G * S5P * 2 * 4);
  p.s5E = (float*)take((size_t)NB * 32 * S5G * 64 * 2 * 4);
  p.s5Sin = (float*)take((size_t)NB * 32 * S5G * 64 * 2 * 4);
  p.glaKV = (float*)take((size_t)1024 * 64 * 128 * 4);
  p.glaDec = (float*)take((size_t)1024 * 64 * 4);
  p.glaSin = (bf16_t*)take((size_t)1024 * 64 * 128 * 2);
  p.wgkT = (bf16_t*)take((size_t)16 * D * 2);
  p.moe_list = (int*)take((size_t)8 * NBLK128 * 4);
  p.moe_cnt = (int*)take(64);
  p.moe_ctr = (int*)take(64);
  p.Hbuf = (bf16_t*)take((size_t)NSLOT * EFF * 2);
  p.bar = (unsigned*)take(XCD_BAR_WORDS * 4);
  if (off > ws_size) { fprintf(stderr, "workspace too small: need %zu have %zu\n", off, ws_size); return; }

  static int grid_blocks = 0;
  if (!grid_blocks) {
    int dev = 0, cus = 0, per_cu = 0;
    (void)hipGetDevice(&dev);
    (void)hipDeviceGetAttribute(&cus, hipDeviceAttributeMultiprocessorCount, dev);
    (void)hipOccupancyMaxActiveBlocksPerMultiprocessor(&per_cu, k_fused, NTHR, 0);
    grid_blocks = (per_cu >= 1) ? cus : 0;
    grid_blocks &= ~7;
    if (grid_blocks <= 0) { fprintf(stderr, "occupancy query says the fused kernel does not fit (per_cu=%d cus=%d)\n", per_cu, cus); grid_blocks = 0; return; }
  }
  (void)hipMemsetAsync(p.bar, 0, XCD_BAR_WORDS * 4, stream);
  void* args[] = {&p};
  hipError_t e = hipLaunchCooperativeKernel((const void*)k_fused, dim3(grid_blocks), dim3(NTHR), args, 0, stream);
  if (e != hipSuccess) fprintf(stderr, "cooperative launch failed: %s (grid %d)\n", hipGetErrorString(e), grid_blocks);
}
```

```cpp
#include <hip/hip_runtime.h>
#include <hip/hip_cooperative_groups.h>
namespace cg = cooperative_groups;
#include <cstdint>
#include <cstdio>

typedef unsigned short bf16_t;
typedef short s16x8 __attribute__((ext_vector_type(8)));
typedef short s16x4 __attribute__((ext_vector_type(4)));
typedef float f32x4 __attribute__((ext_vector_type(4)));
typedef unsigned u32x4 __attribute__((ext_vector_type(4)));
typedef unsigned u32x2 __attribute__((ext_vector_type(2)));
#define LAS __attribute__((address_space(3)))
typedef LAS unsigned char* lds_ptr;

constexpr int D = 1024, NB = 8, SEQ = 2048, T = NB * SEQ;
constexpr int S5W = 512, S5G = 32, S5H = 16, S5P = 64;
constexpr int GH = 4, GDK = 64, GDV = 128, GKEY = 256, GVAL = 512, GRANK = 16;
constexpr int NE = 256, TOPK = 8, NGRP = 8, EFF = 256, SFF = 256;
constexpr int INW = 4112, LDP = 4096;
constexpr int OFF_U = 0, OFF_Q = 512, OFF_K = 768, OFF_V = 1024, OFF_R = 1536, OFF_GA = 2048, OFF_GB = 3072;
constexpr int WIN_GK = 1536;
constexpr int NSLOT = 163584, NBLK128 = NSLOT / 128;
constexpr int NTHR = 512;
constexpr int USE_MFMA = 127;
constexpr int USE_NEW = 7;
constexpr int REP_PHASE = -1, REP_N = 8;
constexpr int MOE_REP_GU = 1, MOE_REP_DN = 1;

__device__ __forceinline__ float bf2f(bf16_t v) { return __uint_as_float(((unsigned)v) << 16); }
__device__ __forceinline__ bf16_t f2bf(float f) { return __builtin_bit_cast(unsigned short, (__bf16)f); }
typedef float f32x2 __attribute__((ext_vector_type(2)));
typedef __bf16 bf16x2_t __attribute__((ext_vector_type(2)));
__device__ __forceinline__ unsigned cvtpk(float lo, float hi) { const f32x2 v = {lo, hi}; return __builtin_bit_cast(unsigned, __builtin_convertvector(v, bf16x2_t)); }
__device__ __forceinline__ float sigmoidf_(float x) { return __builtin_amdgcn_rcpf(1.f + __expf(-x)); }
__device__ __forceinline__ float siluf_(float x) { return x * __builtin_amdgcn_rcpf(1.f + __expf(-x)); }
__device__ __forceinline__ float geluf_(float x) { const float u = 0.7978845608028654f * (x + 0.044715f * x * x * x); return x * __builtin_amdgcn_rcpf(1.f + __expf(-2.f * u)); }
__device__ __forceinline__ float logsigmoidf_(float x) { return fminf(x, 0.f) - __logf(1.f + __expf(-fabsf(x))); }

struct P;
typedef const __attribute__((address_space(4))) P& PR;

__device__ __forceinline__ int ltid() { int t = threadIdx.x; asm volatile("" : "+v"(t)); return t; }

struct P {
  const float *x, *c, *ada_w, *ada_b, *norm1_g, *w_in, *lam_re, *lam_im, *log_dt, *b_re, *b_im, *c_re, *c_im, *s5_d, *w_glu, *b_glu, *w_proj_a,
      *w_gk2, *b_gk2, *gla_norm_g, *w_proj_b, *w_out, *norm2_g, *router_w, *router_bias, *ew_gate, *ew_up, *ew_down, *sw_gate, *sw_up, *sw_down, *final_g;
  float* out;
  float* mod;
  bf16_t* wb_in;
  bf16_t* wb_glu;
  bf16_t* wb_pa;
  bf16_t* wb_pb;
  bf16_t* wb_out;
  bf16_t* wb_rs;
  bf16_t* wb_sd;
  bf16_t* h1;
  float* gkl;
  bf16_t* proj;
  float* abar;
  float* bbar;
  bf16_t* yA;
  float* oraw;
  bf16_t* yB;
  bf16_t* zA;
  bf16_t* mixed;
  float* x1;
  bf16_t* h2;
  float* logits;
  int* tk_idx;
  float* tk_w;
  int* tk_rank;
  int* slot_of;
  int* counts;
  int* pad_start;
  int* blk_exp;
  int* slot_tok;
  bf16_t* Y;
  bf16_t* shH;
  bf16_t* S;
  bf16_t* bbarT;
  bf16_t* cmT;
  float* apow64;
  float* s5E;
  float* s5Sin;
  float* glaKV;
  float* glaDec;
  bf16_t* glaSin;
  bf16_t* wgkT;
  int* moe_list;
  int* moe_cnt;
  int* moe_ctr;
  bf16_t* Hbuf;
  unsigned* bar;
};

constexpr int G_ASZ = 128 * 64, G_BSZ = 32 * 512, G_STAGE = G_ASZ + G_BSZ;

__device__ __forceinline__ int a_off(int r, int c) { return r * 64 + ((c ^ ((0x78 >> (((r >> 2) & 3) * 2)) & 3)) << 4); }
__device__ __forceinline__ int b_off(int k, int ch) { return k * 512 + ((ch ^ ((k & 3) | (((k >> 3) & 1) << 2))) << 5); }
__device__ __forceinline__ s16x4 tr_read(lds_ptr p) { return __builtin_bit_cast(s16x4, __builtin_amdgcn_ds_read_tr16_b64_v4i16((LAS s16x4*)p)); }

struct ALoadDense { const bf16_t* A; long lda; __device__ __forceinline__ const bf16_t* rowptr(int r) const { return A + (size_t)r * lda; } };
struct ALoadGatherLds { const bf16_t* A; LAS int* tk; __device__ __forceinline__ const bf16_t* rowptr(int r) const { int t = tk[r]; t = t < 0 ? 0 : t; return A + (size_t)t * D; } };
struct BLoadBf { const bf16_t* Bm; long ldb;
  __device__ __forceinline__ u32x4 load(int kg, int c8) const { return *(const u32x4*)(Bm + (size_t)kg * ldb + c8 * 8); } };
struct BLoadF32 { const float* Bm; long ldb;
  __device__ __forceinline__ u32x4 load(int kg, int c8) const { const float* q = Bm + (size_t)kg * ldb + c8 * 8; const f32x4 a = *(const f32x4*)q, b = *(const f32x4*)(q + 4);
    u32x4 r; r.x = cvtpk(a[0], a[1]); r.y = cvtpk(a[2], a[3]); r.z = cvtpk(b[0], b[1]); r.w = cvtpk(b[2], b[3]); return r; } };
struct BLoadGU { const float* Wg; const float* Wu; long ldb; int h0;
  __device__ __forceinline__ u32x4 load(int kg, int c8) const { const int col = c8 * 8, w = col >> 6, xx = col & 63; const float* base = (xx < 32) ? Wg : Wu;
    const float* q = base + (size_t)kg * ldb + h0 + 32 * w + (xx & 31); const f32x4 a = *(const f32x4*)q, b = *(const f32x4*)(q + 4);
    u32x4 r; r.x = cvtpk(a[0], a[1]); r.y = cvtpk(a[2], a[3]); r.z = cvtpk(b[0], b[1]); r.w = cvtpk(b[2], b[3]); return r; } };

template <bool A_RES, class AL, class BL>
__device__ __forceinline__ void gemm_mainloop(f32x4 (&acc)[4][4], const AL& al, const BL& bl, int nk, lds_ptr stage, lds_ptr resA) {
  const int tid = ltid(), lane = tid & 63, wid = tid >> 6, wm = wid >> 2, wn = wid & 3, fr = lane & 15, fq = lane >> 4;
  const int ar = tid >> 2, ac = tid & 3;
  const int p0 = tid, p1 = tid + 512;
  const int bk0 = p0 >> 5, bc0 = p0 & 31, bk1 = p1 >> 5, bc1 = p1 & 31;
  const bf16_t* aptr = nullptr;
  if (!A_RES) aptr = al.rowptr(ar) + ac * 8;
  const int a_st = a_off(ar, ac);
  const int b_st0 = b_off(bk0, bc0 >> 1) + (bc0 & 1) * 16, b_st1 = b_off(bk1, bc1 >> 1) + (bc1 & 1) * 16;
  int a_rd[4];
#pragma unroll
  for (int mt = 0; mt < 4; ++mt) a_rd[mt] = a_off(wm * 64 + mt * 16 + fr, fq);
  int b_rd[4][2];
#pragma unroll
  for (int nt = 0; nt < 4; ++nt) {
    b_rd[nt][0] = b_off(8 * fq + (fr >> 2), wn * 4 + nt) + (fr & 3) * 8;
    b_rd[nt][1] = b_off(8 * fq + 4 + (fr >> 2), wn * 4 + nt) + (fr & 3) * 8;
  }
#pragma unroll
  for (int mt = 0; mt < 4; ++mt)
#pragma unroll
    for (int nt = 0; nt < 4; ++nt) acc[mt][nt] = (f32x4){0.f, 0.f, 0.f, 0.f};
  u32x4 areg = {0, 0, 0, 0}, breg0, breg1;
  if (!A_RES) areg = *(const u32x4*)aptr;
  breg0 = bl.load(bk0, bc0); breg1 = bl.load(bk1, bc1);
  __syncthreads();
  if (!A_RES) *(LAS u32x4*)(stage + a_st) = areg;
  *(LAS u32x4*)(stage + G_ASZ + b_st0) = breg0;
  *(LAS u32x4*)(stage + G_ASZ + b_st1) = breg1;
  __syncthreads();
  for (int kt = 0; kt < nk; ++kt) {
    const lds_ptr cur = stage + (kt & 1) * G_STAGE, nxt = stage + ((kt + 1) & 1) * G_STAGE;
    const bool more = kt + 1 < nk;
    if (more) {
      if (!A_RES) areg = *(const u32x4*)(aptr + (kt + 1) * 32);
      breg0 = bl.load((kt + 1) * 32 + bk0, bc0); breg1 = bl.load((kt + 1) * 32 + bk1, bc1);
    }
    s16x8 af[4], bfr[4];
    const lds_ptr abase = A_RES ? (resA + kt * G_ASZ) : cur;
#pragma unroll
    for (int mt = 0; mt < 4; ++mt) af[mt] = *(LAS s16x8*)(abase + a_rd[mt]);
#pragma unroll
    for (int nt = 0; nt < 4; ++nt) {
      const s16x4 lo = tr_read(cur + G_ASZ + b_rd[nt][0]), hi = tr_read(cur + G_ASZ + b_rd[nt][1]);
      bfr[nt] = __builtin_shufflevector(lo, hi, 0, 1, 2, 3, 4, 5, 6, 7);
    }
#pragma unroll
    for (int mt = 0; mt < 4; ++mt)
#pragma unroll
      for (int nt = 0; nt < 4; ++nt) acc[mt][nt] = __builtin_amdgcn_mfma_f32_16x16x32_bf16(bfr[nt], af[mt], acc[mt][nt], 0, 0, 0);
    if (more) {
      if (!A_RES) *(LAS u32x4*)(nxt + a_st) = areg;
      *(LAS u32x4*)(nxt + G_ASZ + b_st0) = breg0;
      *(LAS u32x4*)(nxt + G_ASZ + b_st1) = breg1;
    }
    __syncthreads();
  }
}


struct BRaw { f32x4 v[4]; };
struct BLoadF32R { const float* Bm; long ldb;
  __device__ __forceinline__ void load(BRaw& r, int kbase, int tid) const {
    const float* q = Bm + (size_t)(kbase + (tid >> 6)) * ldb + (tid & 63) * 4;
#pragma unroll
    for (int i = 0; i < 4; ++i) r.v[i] = *(const f32x4*)(q + (size_t)(8 * i) * ldb); } };
struct BLoadGUR { const float* Wg; long du; long ldb; int h0;
  __device__ __forceinline__ void load(BRaw& r, int kbase, int tid) const {
    const int col = (tid & 63) * 4, w = col >> 6, xx = col & 63;
    const float* q = Wg + ((xx < 32) ? 0l : du) + (size_t)(kbase + (tid >> 6)) * ldb + h0 + 32 * w + (xx & 31);
#pragma unroll
    for (int i = 0; i < 4; ++i) r.v[i] = *(const f32x4*)(q + (size_t)(8 * i) * ldb); } };
__device__ __forceinline__ u32x4 cvt8(const f32x4& a, const f32x4& b) { u32x4 r; r.x = cvtpk(a[0], a[1]); r.y = cvtpk(a[2], a[3]); r.z = cvtpk(b[0], b[1]); r.w = cvtpk(b[2], b[3]); return r; }

template <bool A_RES, class AL, class BL>
__device__ __forceinline__ void gemm_mainloop_r3(f32x4 (&acc)[4][4], const AL& al, const BL& bl, int nk, lds_ptr stage, lds_ptr resA) {
  const int tid = ltid(), lane = tid & 63, wid = tid >> 6, wm = wid >> 2, wn = wid & 3, fr = lane & 15, fq = lane >> 4;
  const int ar = tid >> 2, ac = tid & 3;
  const bf16_t* aptr = nullptr;
  if (!A_RES) aptr = al.rowptr(ar) + ac * 8;
  const int a_st = a_off(ar, ac);
  int b_st[4];
#pragma unroll
  for (int i = 0; i < 4; ++i) b_st[i] = G_ASZ + b_off((tid >> 6) + 8 * i, (tid & 63) >> 2) + (tid & 3) * 8;
  int a_rd[4];
#pragma unroll
  for (int mt = 0; mt < 4; ++mt) a_rd[mt] = a_off(wm * 64 + mt * 16 + fr, fq);
  int b_rd[4][2];
#pragma unroll
  for (int nt = 0; nt < 4; ++nt) {
    b_rd[nt][0] = G_ASZ + b_off(8 * fq + (fr >> 2), wn * 4 + nt) + (fr & 3) * 8;
    b_rd[nt][1] = G_ASZ + b_off(8 * fq + 4 + (fr >> 2), wn * 4 + nt) + (fr & 3) * 8;
  }
#pragma unroll
  for (int mt = 0; mt < 4; ++mt)
#pragma unroll
    for (int nt = 0; nt < 4; ++nt) acc[mt][nt] = (f32x4){0.f, 0.f, 0.f, 0.f};
  u32x4 ra0 = {0, 0, 0, 0}, ra1 = {0, 0, 0, 0}, ra2 = {0, 0, 0, 0};
  BRaw rb0, rb1, rb2;
#define R3_LOAD(RA, RB, kt_) do { if (!A_RES) RA = *(const u32x4*)(aptr + (size_t)(kt_) * 32); bl.load(RB, (kt_) * 32, tid); } while (0)
#define R3_STORE(RA, RB, st_) do { const lds_ptr s_ = stage + (st_) * G_STAGE; if (!A_RES) *(LAS u32x4*)(s_ + a_st) = RA; \
    _Pragma("unroll") for (int i_ = 0; i_ < 4; ++i_) { u32x2 o_; o_.x = cvtpk(RB.v[i_][0], RB.v[i_][1]); o_.y = cvtpk(RB.v[i_][2], RB.v[i_][3]); *(LAS u32x2*)(s_ + b_st[i_]) = o_; } } while (0)
#define R3_COMPUTE(kt_) do { const lds_ptr cur = stage + ((kt_) & 1) * G_STAGE; const lds_ptr abase = A_RES ? (resA + (kt_) * G_ASZ) : cur; \
    s16x8 af[4], bfr[4]; \
    _Pragma("unroll") for (int mt = 0; mt < 4; ++mt) af[mt] = *(LAS s16x8*)(abase + a_rd[mt]); \
    _Pragma("unroll") for (int nt = 0; nt < 4; ++nt) { const s16x4 lo = tr_read(cur + b_rd[nt][0]), hi = tr_read(cur + b_rd[nt][1]); bfr[nt] = __builtin_shufflevector(lo, hi, 0, 1, 2, 3, 4, 5, 6, 7); } \
    _Pragma("unroll") for (int mt = 0; mt < 4; ++mt) _Pragma("unroll") for (int nt = 0; nt < 4; ++nt) acc[mt][nt] = __builtin_amdgcn_mfma_f32_16x16x32_bf16(bfr[nt], af[mt], acc[mt][nt], 0, 0, 0); } while (0)
#define R3_BODY_U(kt_, RAN, RBN, RAW, RBW) do { const int kl_ = ((kt_) + 3 < nk) ? (kt_) + 3 : nk - 1; R3_LOAD(RAN, RBN, kl_); __builtin_amdgcn_sched_barrier(0); R3_COMPUTE(kt_); __builtin_amdgcn_sched_barrier(0); R3_STORE(RAW, RBW, ((kt_) + 1) & 1); __syncthreads(); } while (0)
#define R3_BODY_T(kt_, RAW, RBW) do { R3_COMPUTE(kt_); if ((kt_) + 1 < nk) R3_STORE(RAW, RBW, ((kt_) + 1) & 1); __syncthreads(); } while (0)
  R3_LOAD(ra0, rb0, 0);
  R3_LOAD(ra1, rb1, 1);
  R3_LOAD(ra2, rb2, 2);
  __syncthreads();
  R3_STORE(ra0, rb0, 0);
  __syncthreads();
  int kt = 0;
  for (; kt + 3 <= nk; kt += 3) {
    R3_BODY_U(kt, ra0, rb0, ra1, rb1);
    R3_BODY_U(kt + 1, ra1, rb1, ra2, rb2);
    R3_BODY_U(kt + 2, ra2, rb2, ra0, rb0);
  }
  if (kt < nk) { R3_BODY_T(kt, ra1, rb1); if (kt + 1 < nk) R3_BODY_T(kt + 1, ra2, rb2); }
#undef R3_BODY_U
#undef R3_BODY_T
#undef R3_LOAD
#undef R3_STORE
#undef R3_COMPUTE
}

constexpr int G_NST = 4;
#define WAIT_VM(n) asm volatile("s_waitcnt vmcnt(" #n ")" ::: "memory")
template <class AL>
__device__ __forceinline__ void gemm_mainloop_glds(f32x4 (&acc)[4][4], const AL& al, const bf16_t* __restrict__ Bm, long ldb, int nk, lds_ptr ring) {
  const int tid = ltid(), lane = tid & 63, wid = tid >> 6, wm = wid >> 2, wn = wid & 3, fr = lane & 15, fq = lane >> 4;
  const int ar = tid >> 2;
  const bf16_t* aptr = al.rowptr(ar) + (((tid & 3) ^ ((0x78 >> (((ar >> 2) & 3) * 2)) & 3)) << 3);
  const int bk = tid >> 5, pc = tid & 31;
  const int bcol = ((((pc >> 1) ^ ((bk & 3) | (((bk >> 3) & 1) << 2))) << 4) | ((pc & 1) << 3));
  const bf16_t* bptr0 = Bm + (size_t)bk * ldb + bcol;
  const bf16_t* bptr1 = bptr0 + (size_t)16 * ldb;
  const size_t bstep = (size_t)32 * ldb;
  int a_rd[4];
#pragma unroll
  for (int mt = 0; mt < 4; ++mt) a_rd[mt] = a_off(wm * 64 + mt * 16 + fr, fq);
  int b_rd[4][2];
#pragma unroll
  for (int nt = 0; nt < 4; ++nt) {
    b_rd[nt][0] = G_ASZ + b_off(8 * fq + (fr >> 2), wn * 4 + nt) + (fr & 3) * 8;
    b_rd[nt][1] = G_ASZ + b_off(8 * fq + 4 + (fr >> 2), wn * 4 + nt) + (fr & 3) * 8;
  }
#pragma unroll
  for (int mt = 0; mt < 4; ++mt)
#pragma unroll
    for (int nt = 0; nt < 4; ++nt) acc[mt][nt] = (f32x4){0.f, 0.f, 0.f, 0.f};
  const lds_ptr dstl = ring + tid * 16;
#define GLDS_ISSUE(kt_) do { const lds_ptr d_ = dstl + ((kt_) & (G_NST - 1)) * G_STAGE; \
    __builtin_amdgcn_global_load_lds((const unsigned*)(aptr + (size_t)(kt_) * 32), (LAS unsigned*)(d_), 16, 0, 0); \
    __builtin_amdgcn_global_load_lds((const unsigned*)(bptr0 + (size_t)(kt_) * bstep), (LAS unsigned*)(d_ + G_ASZ), 16, 0, 0); \
    __builtin_amdgcn_global_load_lds((const unsigned*)(bptr1 + (size_t)(kt_) * bstep), (LAS unsigned*)(d_ + G_ASZ + 8192), 16, 0, 0); } while (0)
  __syncthreads();
  GLDS_ISSUE(0);
  if (nk > 1) GLDS_ISSUE(1);
  if (nk > 2) GLDS_ISSUE(2);
  for (int kt = 0; kt < nk; ++kt) {
    if (kt + 2 < nk) WAIT_VM(6); else if (kt + 1 < nk) WAIT_VM(3); else WAIT_VM(0);
    __builtin_amdgcn_s_barrier();
    if (kt + 3 < nk) GLDS_ISSUE(kt + 3);
    const lds_ptr cur = ring + (kt & (G_NST - 1)) * G_STAGE;
    s16x8 af[4], bfr[4];
#pragma unroll
    for (int mt = 0; mt < 4; ++mt) af[mt] = *(LAS s16x8*)(cur + a_rd[mt]);
#pragma unroll
    for (int nt = 0; nt < 4; ++nt) {
      const s16x4 lo = tr_read(cur + b_rd[nt][0]), hi = tr_read(cur + b_rd[nt][1]);
      bfr[nt] = __builtin_shufflevector(lo, hi, 0, 1, 2, 3, 4, 5, 6, 7);
    }
#pragma unroll
    for (int mt = 0; mt < 4; ++mt)
#pragma unroll
      for (int nt = 0; nt < 4; ++nt) acc[mt][nt] = __builtin_amdgcn_mfma_f32_16x16x32_bf16(bfr[nt], af[mt], acc[mt][nt], 0, 0, 0);
  }
#undef GLDS_ISSUE
}


constexpr int G2_STAGE = 2 * G_ASZ + G_BSZ;
__device__ __forceinline__ void gemm_mainloop_glds256(f32x4 (&acc)[8][4], const bf16_t* __restrict__ A, long lda, const bf16_t* __restrict__ Bm, long ldb, int nk, lds_ptr ring) {
  const int tid = ltid(), lane = tid & 63, wid = tid >> 6, wm = wid >> 2, wn = wid & 3, fr = lane & 15, fq = lane >> 4;
  const int ar = tid >> 2;
  const bf16_t* aptr0 = A + (size_t)ar * lda + (((tid & 3) ^ ((0x78 >> (((ar >> 2) & 3) * 2)) & 3)) << 3);
  const bf16_t* aptr1 = aptr0 + (size_t)128 * lda;
  const int bk = tid >> 5, pc = tid & 31;
  const int bcol = ((((pc >> 1) ^ ((bk & 3) | (((bk >> 3) & 1) << 2))) << 4) | ((pc & 1) << 3));
  const bf16_t* bptr0 = Bm + (size_t)bk * ldb + bcol;
  const bf16_t* bptr1 = bptr0 + (size_t)16 * ldb;
  const size_t bstep = (size_t)32 * ldb;
  int a_rd[8];
#pragma unroll
  for (int mt = 0; mt < 8; ++mt) a_rd[mt] = wm * G_ASZ + a_off(mt * 16 + fr, fq);
  int b_rd[4][2];
#pragma unroll
  for (int nt = 0; nt < 4; ++nt) {
    b_rd[nt][0] = 2 * G_ASZ + b_off(8 * fq + (fr >> 2), wn * 4 + nt) + (fr & 3) * 8;
    b_rd[nt][1] = 2 * G_ASZ + b_off(8 * fq + 4 + (fr >> 2), wn * 4 + nt) + (fr & 3) * 8;
  }
#pragma unroll
  for (int mt = 0; mt < 8; ++mt)
#pragma unroll
    for (int nt = 0; nt < 4; ++nt) acc[mt][nt] = (f32x4){0.f, 0.f, 0.f, 0.f};
  const lds_ptr dstl = ring + tid * 16;
#define GLDS2_ISSUE(kt_) do { const lds_ptr d_ = dstl + ((kt_) & (G_NST - 1)) * G2_STAGE; \
    __builtin_amdgcn_global_load_lds((const unsigned*)(aptr0 + (size_t)(kt_) * 32), (LAS unsigned*)(d_), 16, 0, 0); \
    __builtin_amdgcn_global_load_lds((const unsigned*)(aptr1 + (size_t)(kt_) * 32), (LAS unsigned*)(d_ + G_ASZ), 16, 0, 0); \
    __builtin_amdgcn_global_load_lds((const unsigned*)(bptr0 + (size_t)(kt_) * bstep), (LAS unsigned*)(d_ + 2 * G_ASZ), 16, 0, 0); \
    __builtin_amdgcn_global_load_lds((const unsigned*)(bptr1 + (size_t)(kt_) * bstep), (LAS unsigned*)(d_ + 2 * G_ASZ + 8192), 16, 0, 0); } while (0)
  __syncthreads();
  GLDS2_ISSUE(0);
  if (nk > 1) GLDS2_ISSUE(1);
  if (nk > 2) GLDS2_ISSUE(2);
  for (int kt = 0; kt < nk; ++kt) {
    if (kt + 2 < nk) WAIT_VM(8); else if (kt + 1 < nk) WAIT_VM(4); else WAIT_VM(0);
    __builtin_amdgcn_s_barrier();
    if (kt + 3 < nk) GLDS2_ISSUE(kt + 3);
    const lds_ptr cur = ring + (kt & (G_NST - 1)) * G2_STAGE;
    s16x8 bfr[4];
#pragma unroll
    for (int nt = 0; nt < 4; ++nt) {
      const s16x4 lo = tr_read(cur + b_rd[nt][0]), hi = tr_read(cur + b_rd[nt][1]);
      bfr[nt] = __builtin_shufflevector(lo, hi, 0, 1, 2, 3, 4, 5, 6, 7);
    }
#pragma unroll
    for (int h = 0; h < 2; ++h) {
      s16x8 af[4];
#pragma unroll
      for (int mt = 0; mt < 4; ++mt) af[mt] = *(LAS s16x8*)(cur + a_rd[h * 4 + mt]);
#pragma unroll
      for (int mt = 0; mt < 4; ++mt)
#pragma unroll
        for (int nt = 0; nt < 4; ++nt) acc[h * 4 + mt][nt] = __builtin_amdgcn_mfma_f32_16x16x32_bf16(bfr[nt], af[mt], acc[h * 4 + mt][nt], 0, 0, 0);
    }
  }
#undef GLDS2_ISSUE
}

__device__ __forceinline__ void tile_map(int round, int bid, int nb, int nMt, int nNt, int& mt, int& nt, bool& valid) {
  if (nb == 256 && (nNt & 3) == 0 && (nMt & 7) == 0) {
    const int xcd = bid & 7, j = bid >> 3, q = round * 8 + xcd, rn = nNt >> 2;
    const int rect_m = q / rn, rect_n = q % rn;
    mt = rect_m * 8 + (j & 7); nt = rect_n * 4 + (j >> 3); valid = mt < nMt;
  } else {
    const int per = (nb + 7) / 8, xcd = bid & 7, j = bid >> 3;
    const int idx = round * nb + xcd * per + j;
    mt = idx / nNt; nt = idx % nNt; valid = (j < per) && (idx < nMt * nNt) && (xcd * per + j < nb);
  }
}

__device__ __forceinline__ void cvt_copy(const float* __restrict__ src, long lds_, bf16_t* __restrict__ dst, long ldd, int rows, int cols, int gtid, int gsz) {
  const int c4 = cols >> 2;
  for (long i = gtid; i < (long)rows * c4; i += gsz) {
    const int r = (int)(i / c4), c = (int)(i % c4) * 4;
    const f32x4 v = *(const f32x4*)(src + (size_t)r * lds_ + c);
    u32x2 o; o.x = cvtpk(v[0], v[1]); o.y = cvtpk(v[2], v[3]);
    *(u32x2*)(dst + (size_t)r * ldd + c) = o;
  }
}
__device__ __forceinline__ void phase_prep(PR p, int bid, int nb, lds_ptr smem) {
  const int gtid = bid * NTHR + ltid(), gsz = nb * NTHR;
  cvt_copy(p.w_in, INW, p.wb_in, LDP, D, WIN_GK, gtid, gsz);
  cvt_copy(p.w_in + WIN_GK + 16, INW, p.wb_in + WIN_GK, LDP, D, LDP - WIN_GK, gtid, gsz);
  cvt_copy(p.w_glu, S5W, p.wb_glu, S5W, S5W, S5W, gtid, gsz);
  cvt_copy(p.w_proj_a, D, p.wb_pa, D, S5W, D, gtid, gsz);
  cvt_copy(p.w_proj_b, D, p.wb_pb, D, GVAL, D, gtid, gsz);
  cvt_copy(p.w_out, D, p.wb_out, D, D, D, gtid, gsz);
  cvt_copy(p.router_w, NE, p.wb_rs, 768, D, NE, gtid, gsz);
  cvt_copy(p.sw_down, D, p.wb_sd, D, SFF, D, gtid, gsz);
  for (long i = gtid; i < (long)D * 512; i += gsz) {
    const int k = (int)(i >> 9), cc = (int)(i & 511), w = cc >> 6, xx = cc & 63;
    const int hcol = 32 * w + (xx & 31);
    const float v = (xx < 32) ? p.sw_gate[(size_t)k * SFF + hcol] : p.sw_up[(size_t)k * SFF + hcol];
    p.wb_rs[(size_t)k * 768 + 256 + cc] = f2bf(v);
  }
  for (int i = gtid; i < 16 * D; i += gsz) { const int n = i >> 10, k = i & 1023; p.wgkT[i] = f2bf(p.w_in[(size_t)k * INW + WIN_GK + n]); }
  for (int i = gtid; i < NSLOT; i += gsz) p.slot_tok[i] = -1;
  if (gtid < 256) p.counts[gtid] = 0;
  if (gtid < 16) p.moe_ctr[gtid] = 0;
  if (ltid() < 8 && bid * 8 + ltid() < S5G * S5P) {
    const int i = bid * 8 + ltid(), g = i / S5P;
    const double lr = p.lam_re[i], li = p.lam_im[i], dt = (double)__expf(p.log_dt[g]);
    const double TWO_PI = 6.283185307179586476925286766559;
    double ang = li * dt; ang -= TWO_PI * floor(ang / TWO_PI);
    const double mag = (double)__expf((float)(lr * dt));
    const double are = mag * (double)cosf((float)ang), aim = mag * (double)sinf((float)ang);
    const double den = lr * lr + li * li, nre = are - 1.0;
    const double cre = (nre * lr + aim * li) / den, cim = (aim * lr - nre * li) / den;
    p.abar[i * 2] = (float)are; p.abar[i * 2 + 1] = (float)aim;
    for (int h = 0; h < S5H; ++h) {
      const double br = p.b_re[i * S5H + h], bi = p.b_im[i * S5H + h];
      p.bbar[(i * S5H + h) * 2] = (float)(cre * br - cim * bi);
      p.bbar[(i * S5H + h) * 2 + 1] = (float)(cre * bi + cim * br);
      const int pq = i & 63;
      p.bbarT[(size_t)(g * 128 + 2 * pq) * 16 + h] = f2bf((float)(cre * br - cim * bi));
      p.bbarT[(size_t)(g * 128 + 2 * pq + 1) * 16 + h] = f2bf((float)(cre * bi + cim * br));
    }
    double a64 = 64.0 * li * dt; a64 -= TWO_PI * floor(a64 / TWO_PI);
    const double m64 = (double)__expf((float)(64.0 * lr * dt));
    p.apow64[i * 2] = (float)(m64 * (double)cosf((float)a64)); p.apow64[i * 2 + 1] = (float)(m64 * (double)sinf((float)a64));
  }
  for (int i = gtid; i < S5G * S5H * 128; i += gsz) {
    const int pp = i & 127, ho = (i >> 7) & 15, g = i >> 11;
    p.cmT[i] = f2bf((pp & 1) ? -p.c_im[(g * 16 + ho) * 64 + (pp >> 1)] : p.c_re[(g * 16 + ho) * 64 + (pp >> 1)]);
  }
  LAS float* red = (LAS float*)smem;
  LAS float* sc = (LAS float*)(smem + 16384);
  if (bid < 192) {
    __syncthreads();
    for (int i = ltid(); i < 8 * D; i += NTHR) sc[i] = siluf_(p.c[i]);
    __syncthreads();
  }
  for (int item = bid; item < 192; item += nb) {
    const int cl = ltid() & 31, kg = ltid() >> 5, col = item * 32 + cl;
    float acc[8];
#pragma unroll
    for (int b = 0; b < 8; ++b) acc[b] = 0.f;
    const float* wp = p.ada_w + (size_t)(kg * 64) * 6144 + col;
#pragma unroll 1
    for (int k0 = 0; k0 < 64; k0 += 16) {
      float w[16];
#pragma unroll
      for (int q = 0; q < 16; ++q) w[q] = wp[(size_t)(k0 + q) * 6144];
#pragma unroll
      for (int q = 0; q < 16; ++q)
#pragma unroll
        for (int b = 0; b < 8; ++b) acc[b] += sc[b * D + kg * 64 + k0 + q] * w[q];
    }
    __syncthreads();
#pragma unroll
    for (int b = 0; b < 8; ++b) red[(kg * 8 + b) * 32 + cl] = acc[b];
    __syncthreads();
    if (ltid() < 256) {
      const int b = ltid() >> 5, c2 = ltid() & 31;
      float sum = p.ada_b[item * 32 + c2];
      for (int q = 0; q < 16; ++q) sum += red[(q * 8 + b) * 32 + c2];
      p.mod[b * 6144 + item * 32 + c2] = sum;
    }
  }
}

__device__ __forceinline__ void phase_gemm_out256_h(PR p, int bid, int nb, lds_ptr smem);
template <bool WITH_GK>
__device__ __forceinline__ void phase_norm(PR p, const float* __restrict__ xin, const float* __restrict__ g, int sh_off, int sc_off, bf16_t* __restrict__ outp, int bid, int nb, lds_ptr smem) {
  const int lane = ltid() & 63, wid = ltid() >> 6;
  const int stride = nb * 8;
  int row = bid * 8 + wid;
  f32x4 nx[4];
  if (row < T) {
#pragma unroll
    for (int i = 0; i < 4; ++i) nx[i] = *(const f32x4*)(xin + (size_t)row * D + lane * 4 + 256 * i);
  }
  f32x4 gv[4];
#pragma unroll
  for (int i = 0; i < 4; ++i) gv[i] = *(const f32x4*)(g + lane * 4 + 256 * i);
  for (; row < T; row += stride) {
    const int b = row / SEQ;
    f32x4 v[4];
#pragma unroll
    for (int i = 0; i < 4; ++i) v[i] = nx[i];
    const int rn = row + stride;
    if (rn < T) {
#pragma unroll
      for (int i = 0; i < 4; ++i) nx[i] = *(const f32x4*)(xin + (size_t)rn * D + lane * 4 + 256 * i);
    }
    float ss = 0.f;
#pragma unroll
    for (int i = 0; i < 4; ++i) ss += v[i][0] * v[i][0] + v[i][1] * v[i][1] + v[i][2] * v[i][2] + v[i][3] * v[i][3];
#pragma unroll
    for (int o = 32; o > 0; o >>= 1) ss += __shfl_xor(ss, o);
    const float r = rsqrtf(ss * (1.f / D) + 1e-6f);
#pragma unroll
    for (int i = 0; i < 4; ++i) {
      const int c0 = lane * 4 + 256 * i;
      const f32x4 scv = *(const f32x4*)(p.mod + b * 6144 + sc_off + c0), shv = *(const f32x4*)(p.mod + b * 6144 + sh_off + c0);
      float y[4];
#pragma unroll
      for (int j = 0; j < 4; ++j) y[j] = (v[i][j] * r) * gv[i][j] * (1.f + scv[j]) + shv[j];
      u32x2 o; o.x = cvtpk(y[0], y[1]); o.y = cvtpk(y[2], y[3]);
      *(u32x2*)(outp + (size_t)row * D + c0) = o;
    }
  }
}
__device__ __forceinline__ void phase_norm_h(PR p, const bf16_t* __restrict__ xin, const float* __restrict__ g, int sh_off, int sc_off, bf16_t* __restrict__ outp, int bid, int nb, lds_ptr smem) {
  const int lane = ltid() & 63, wid = ltid() >> 6;
  const int stride = nb * 8;
  int row = bid * 8 + wid;
  u32x2 nx[4];
  if (row < T) {
#pragma unroll
    for (int i = 0; i < 4; ++i) nx[i] = *(const u32x2*)(xin + (size_t)row * D + lane * 4 + 256 * i);
  }
  f32x4 gv[4];
#pragma unroll
  for (int i = 0; i < 4; ++i) gv[i] = *(const f32x4*)(g + lane * 4 + 256 * i);
  for (; row < T; row += stride) {
    const int b = row / SEQ;
    f32x4 v[4];
#pragma unroll
    for (int i = 0; i < 4; ++i) { v[i][0] = __uint_as_float(nx[i].x << 16); v[i][1] = __uint_as_float(nx[i].x & 0xffff0000u); v[i][2] = __uint_as_float(nx[i].y << 16); v[i][3] = __uint_as_float(nx[i].y & 0xffff0000u); }
    const int rn = row + stride;
    if (rn < T) {
#pragma unroll
      for (int i = 0; i < 4; ++i) nx[i] = *(const u32x2*)(xin + (size_t)rn * D + lane * 4 + 256 * i);
    }
    float ss = 0.f;
#pragma unroll
    for (int i = 0; i < 4; ++i) ss += v[i][0] * v[i][0] + v[i][1] * v[i][1] + v[i][2] * v[i][2] + v[i][3] * v[i][3];
#pragma unroll
    for (int o = 32; o > 0; o >>= 1) ss += __shfl_xor(ss, o);
    const float r = rsqrtf(ss * (1.f / D) + 1e-6f);
#pragma unroll
    for (int i = 0; i < 4; ++i) {
      const int c0 = lane * 4 + 256 * i;
      const f32x4 scv = *(const f32x4*)(p.mod + b * 6144 + sc_off + c0), shv = *(const f32x4*)(p.mod + b * 6144 + sh_off + c0);
      float y[4];
#pragma unroll
      for (int j = 0; j < 4; ++j) y[j] = (v[i][j] * r) * gv[i][j] * (1.f + scv[j]) + shv[j];
      u32x2 o; o.x = cvtpk(y[0], y[1]); o.y = cvtpk(y[2], y[3]);
      *(u32x2*)(outp + (size_t)row * D + c0) = o;
    }
  }
}

struct EpiStoreBf {
  bf16_t* O; long ld;
  template <int MT> __device__ __forceinline__ void operator()(const f32x4 (&acc)[MT][4], int mbase, int nbase, int fr, int fq) const {
    bf16_t* rowp = O + (size_t)(mbase + fr) * ld + nbase + fq * 4;
#pragma unroll
    for (int mt = 0; mt < MT; ++mt) {
#pragma unroll
      for (int nt = 0; nt < 4; ++nt) { const f32x4 v = acc[mt][nt]; u32x2 o; o.x = cvtpk(v[0], v[1]); o.y = cvtpk(v[2], v[3]);
        *(u32x2*)(rowp + nt * 16) = o; }
      rowp += 16 * ld;
      __builtin_amdgcn_sched_barrier(0); }
  }
};
__device__ __forceinline__ f32x4 ld_bf4(const bf16_t* q) { const u32x2 w = *(const u32x2*)q; f32x4 r; r[0] = __uint_as_float(w.x << 16); r[1] = __uint_as_float(w.x & 0xffff0000u); r[2] = __uint_as_float(w.y << 16); r[3] = __uint_as_float(w.y & 0xffff0000u); return r; }
struct EpiGlu {
  const bf16_t* yA; const float* b; bf16_t* z;
  template <int MT> __device__ __forceinline__ void operator()(const f32x4 (&acc)[MT][4], int mbase, int nbase, int fr, int fq) const {
#pragma unroll
    for (int mt = 0; mt < MT; ++mt) {
#pragma unroll
      for (int nt = 0; nt < 4; ++nt) { const int row = mbase + mt * 16 + fr, col = nbase + nt * 16 + fq * 4; const f32x4 v = acc[mt][nt];
        const f32x4 y = ld_bf4(yA + (size_t)row * S5W + col); const f32x4 bb = *(const f32x4*)(b + col);
        u32x2 o; o.x = cvtpk(y[0] * sigmoidf_(v[0] + bb[0]), y[1] * sigmoidf_(v[1] + bb[1])); o.y = cvtpk(y[2] * sigmoidf_(v[2] + bb[2]), y[3] * sigmoidf_(v[3] + bb[3]));
        *(u32x2*)(z + (size_t)row * S5W + col) = o; }
      __builtin_amdgcn_sched_barrier(0); }
  }
};
struct EpiOut {
  const float* x; const float* mod; float* x1;
  template <int MT> __device__ __forceinline__ void operator()(const f32x4 (&acc)[MT][4], int mbase, int nbase, int fr, int fq) const {
#pragma unroll
    for (int mt = 0; mt < MT; ++mt) {
#pragma unroll
      for (int nt = 0; nt < 4; ++nt) { const int row = mbase + mt * 16 + fr, col = nbase + nt * 16 + fq * 4, b = row / SEQ; const f32x4 v = acc[mt][nt];
        const f32x4 xv = *(const f32x4*)(x + (size_t)row * D + col), gg = *(const f32x4*)(mod + b * 6144 + 2 * D + col);
        f32x4 o; o[0] = xv[0] + gg[0] * v[0]; o[1] = xv[1] + gg[1] * v[1]; o[2] = xv[2] + gg[2] * v[2]; o[3] = xv[3] + gg[3] * v[3];
        *(f32x4*)(x1 + (size_t)row * D + col) = o; }
      __builtin_amdgcn_sched_barrier(0); }
  }
};

template <class Epi>
__device__ __forceinline__ void phase_gemm_dense(const bf16_t* A, long lda, const bf16_t* Bm, long ldb, int M, int N, int K, const Epi& epi, int bid, int nb, lds_ptr smem) {
  const int nMt = M / 128, nNt = N / 256, ntiles = nMt * nNt, rounds = (ntiles + nb - 1) / nb;
  const int lane = ltid() & 63, wid = ltid() >> 6, wm = wid >> 2, wn = wid & 3, fr = lane & 15, fq = lane >> 4;
  for (int r = 0; r < rounds; ++r) {
    int mt, nt; bool valid; tile_map(r, bid, nb, nMt, nNt, mt, nt, valid);
    if (!valid) continue;
    f32x4 acc[4][4];
    ALoadDense al{A + (size_t)mt * 128 * lda, lda};
    gemm_mainloop_glds(acc, al, Bm + nt * 256, ldb, K / 32, smem);
    epi.template operator()<4>(acc, mt * 128 + wm * 64, nt * 256 + wn * 64, fr, fq);
  }
}


template <class Epi>
__device__ __forceinline__ void phase_gemm_dense256(const bf16_t* A, long lda, const bf16_t* Bm, long ldb, int M, int N, int K, const Epi& epi, int bid, int nb, lds_ptr smem) {
  const int nMt = M / 256, nNt = N / 256, ntiles = nMt * nNt, rounds = (ntiles + nb - 1) / nb;
  const int lane = ltid() & 63, wid = ltid() >> 6, wm = wid >> 2, wn = wid & 3, fr = lane & 15, fq = lane >> 4;
  for (int r = 0; r < rounds; ++r) {
    int mt, nt; bool valid; tile_map(r, bid, nb, nMt, nNt, mt, nt, valid);
    if (!valid) continue;
    f32x4 acc[8][4];
    gemm_mainloop_glds256(acc, A + (size_t)mt * 256 * lda, lda, Bm + nt * 256, ldb, K / 32, smem);
    epi.template operator()<8>(acc, mt * 256 + wm * 128, nt * 256 + wn * 64, fr, fq);
  }
}


constexpr int ST_ROW = 528;
__device__ __forceinline__ void phase_gemm_dense256_bf16(const bf16_t* A, long lda, const bf16_t* Bm, long ldb, int M, int N, int K, bf16_t* O, long ldo, int bid, int nb, lds_ptr smem) {
  const int nMt = M / 256, nNt = N / 256, ntiles = nMt * nNt, rounds = (ntiles + nb - 1) / nb;
  for (int r = 0; r < rounds; ++r) {
    int mt, nt; bool valid; tile_map(r, bid, nb, nMt, nNt, mt, nt, valid);
    if (!valid) continue;
    f32x4 acc[8][4];
    gemm_mainloop_glds256(acc, A + (size_t)mt * 256 * lda, lda, Bm + nt * 256, ldb, K / 32, smem);
    const int t1 = ltid(), l1 = t1 & 63, w1 = t1 >> 6, wm = w1 >> 2;
    bf16_t* ob = O + (size_t)(mt * 256) * ldo + nt * 256 + (t1 & 31) * 8;
#pragma unroll
    for (int h = 0; h < 2; ++h) {
      __syncthreads();
      if (wm == h) {
#pragma unroll
        for (int i = 0; i < 8; ++i)
#pragma unroll
          for (int j = 0; j < 4; ++j) { const f32x4 v = acc[i][j]; u32x2 o; o.x = cvtpk(v[0], v[1]); o.y = cvtpk(v[2], v[3]);
            *(LAS u32x2*)(smem + (i * 16 + (l1 & 15)) * ST_ROW + ((w1 & 3) * 64 + j * 16 + (l1 >> 4) * 4) * 2) = o; }
      }
      __syncthreads();
#pragma unroll
      for (int ps = 0; ps < 8; ++ps) {
        const int row = ps * 16 + (t1 >> 5);
        *(u32x4*)(ob + (size_t)(h * 128 + row) * ldo) = *(LAS u32x4*)(smem + row * ST_ROW + (t1 & 31) * 16);
      }
    }
  }
}
__device__ __forceinline__ void phase_gemm_out256_h(PR p, int bid, int nb, lds_ptr smem) {
  const int nMt = T / 256, nNt = D / 256, ntiles = nMt * nNt, rounds = (ntiles + nb - 1) / nb;
  bf16_t* O = (bf16_t*)p.x1;
  for (int r = 0; r < rounds; ++r) {
    int mt, nt; bool valid; tile_map(r, bid, nb, nMt, nNt, mt, nt, valid);
    if (!valid) continue;
    f32x4 acc[8][4];
    gemm_mainloop_glds256(acc, p.mixed + (size_t)mt * 256 * D, D, p.wb_out + nt * 256, D, D / 32, smem);
    const int t1 = ltid(), l1 = t1 & 63, w1 = t1 >> 6, wm = w1 >> 2;
    const int b = (mt * 256) / SEQ;
    bf16_t* ob = O + (size_t)(mt * 256) * D + nt * 256 + (t1 & 31) * 8;
#pragma unroll
    for (int h = 0; h < 2; ++h) {
      __syncthreads();
      if (wm == h) {
#pragma unroll
        for (int i = 0; i < 8; ++i)
#pragma unroll
          for (int j = 0; j < 4; ++j) {
            const int row = mt * 256 + h * 128 + i * 16 + (l1 & 15), col = nt * 256 + (w1 & 3) * 64 + j * 16 + (l1 >> 4) * 4;
            const f32x4 v = acc[i][j], xv = *(const f32x4*)(p.x + (size_t)row * D + col), gg = *(const f32x4*)(p.mod + b * 6144 + 2 * D + col);
            u32x2 o; o.x = cvtpk(xv[0] + gg[0] * v[0], xv[1] + gg[1] * v[1]); o.y = cvtpk(xv[2] + gg[2] * v[2], xv[3] + gg[3] * v[3]);
            *(LAS u32x2*)(smem + (i * 16 + (l1 & 15)) * ST_ROW + ((w1 & 3) * 64 + j * 16 + (l1 >> 4) * 4) * 2) = o; }
      }
      __syncthreads();
#pragma unroll
      for (int ps = 0; ps < 8; ++ps) {
        const int row = ps * 16 + (t1 >> 5);
        *(u32x4*)(ob + (size_t)(h * 128 + row) * D) = *(LAS u32x4*)(smem + row * ST_ROW + (t1 & 31) * 16);
      }
    }
  }
}

__device__ __forceinline__ void gk_rows(PR p, int bid, int nb) {
  const int lane = ltid() & 63, wid = ltid() >> 6, fr = lane & 15, fq = lane >> 4;
  if (wid >= 4) return;
  for (int r0 = (bid * 4 + wid) * 16; r0 < T; r0 += nb * 64) {
    const bf16_t* ap = p.h1 + (size_t)(r0 + fr) * D + fq * 8;
    const bf16_t* bp = p.wgkT + (size_t)fr * D + fq * 8;
    f32x4 acc = {0.f, 0.f, 0.f, 0.f};
#pragma unroll 1
    for (int k0 = 0; k0 < 32; k0 += 8) {
      s16x8 a[8], b[8];
#pragma unroll
      for (int q = 0; q < 8; ++q) { a[q] = *(const s16x8*)(ap + (k0 + q) * 32); b[q] = *(const s16x8*)(bp + (k0 + q) * 32); }
#pragma unroll
      for (int q = 0; q < 8; ++q) acc = __builtin_amdgcn_mfma_f32_16x16x32_bf16(a[q], b[q], acc, 0, 0, 0);
    }
#pragma unroll
    for (int j = 0; j < 4; ++j) p.gkl[(size_t)(r0 + 4 * fq + j) * 16 + fr] = acc[j];
  }
}

__device__ __forceinline__ void phase_gemm_mixed(PR p, int bid, int nb, lds_ptr smem) {
  const int nMt = T / 128, nNt = D / 256, ntiles = nMt * nNt, rounds = (ntiles + nb - 1) / nb;
  const int lane = ltid() & 63, wid = ltid() >> 6, wm = wid >> 2, wn = wid & 3, fr = lane & 15, fq = lane >> 4;
  for (int r = 0; r < rounds; ++r) {
    int mt, nt; bool valid; tile_map(r, bid, nb, nMt, nNt, mt, nt, valid);
    if (!valid) continue;
    const int mbase = mt * 128 + wm * 64, nbase = nt * 256 + wn * 64;
    const bf16_t* gp = p.proj + (size_t)(mbase + fr) * LDP + nbase + fq * 4;
    u32x2 gte[4][4], pk[4][4];
#pragma unroll
    for (int i = 0; i < 4; ++i)
#pragma unroll
      for (int j = 0; j < 4; ++j) gte[i][j] = *(const u32x2*)(gp + (size_t)(i * 16) * LDP + OFF_GA + j * 16);
    f32x4 acc[4][4];
    { ALoadDense al{p.zA + (size_t)mt * 128 * S5W, S5W}; gemm_mainloop_glds(acc, al, p.wb_pa + nt * 256, D, S5W / 32, smem); }
#pragma unroll
    for (int i = 0; i < 4; ++i)
#pragma unroll
      for (int j = 0; j < 4; ++j) {
        const float g0 = __uint_as_float(gte[i][j].x << 16), g1 = __uint_as_float(gte[i][j].x & 0xffff0000u), g2 = __uint_as_float(gte[i][j].y << 16), g3 = __uint_as_float(gte[i][j].y & 0xffff0000u);
        pk[i][j].x = cvtpk(acc[i][j][0] * sigmoidf_(g0), acc[i][j][1] * sigmoidf_(g1)); pk[i][j].y = cvtpk(acc[i][j][2] * sigmoidf_(g2), acc[i][j][3] * sigmoidf_(g3)); }
#pragma unroll
    for (int i = 0; i < 4; ++i)
#pragma unroll
      for (int j = 0; j < 4; ++j) gte[i][j] = *(const u32x2*)(gp + (size_t)(i * 16) * LDP + OFF_GB + j * 16);
    { ALoadDense al{p.yB + (size_t)mt * 128 * GVAL, GVAL}; gemm_mainloop_glds(acc, al, p.wb_pb + nt * 256, D, GVAL / 32, smem); }
    bf16_t* op = p.mixed + (size_t)(mbase + fr) * D + nbase + fq * 4;
#pragma unroll
    for (int i = 0; i < 4; ++i)
#pragma unroll
      for (int j = 0; j < 4; ++j) {
        const float g0 = __uint_as_float(gte[i][j].x << 16), g1 = __uint_as_float(gte[i][j].x & 0xffff0000u), g2 = __uint_as_float(gte[i][j].y << 16), g3 = __uint_as_float(gte[i][j].y & 0xffff0000u);
        const float a0 = __uint_as_float(pk[i][j].x << 16), a1 = __uint_as_float(pk[i][j].x & 0xffff0000u), a2 = __uint_as_float(pk[i][j].y << 16), a3 = __uint_as_float(pk[i][j].y & 0xffff0000u);
        u32x2 o; o.x = cvtpk(a0 + sigmoidf_(g0) * acc[i][j][0], a1 + sigmoidf_(g1) * acc[i][j][1]); o.y = cvtpk(a2 + sigmoidf_(g2) * acc[i][j][2], a3 + sigmoidf_(g3) * acc[i][j][3]);
        *(u32x2*)(op + (size_t)(i * 16) * D + j * 16) = o; }
  }
}

__device__ __forceinline__ void phase_gemm_rs(PR p, int bid, int nb, lds_ptr smem) {
  const int nMt = T / 256, nNt = 3, ntiles = nMt * nNt, rounds = (ntiles + nb - 1) / nb;
  const int lane = ltid() & 63, wid = ltid() >> 6, wm = wid >> 2, wn = wid & 3, fr = lane & 15, fq = lane >> 4;
  for (int r = 0; r < rounds; ++r) {
    int mt, nt; bool valid; tile_map(r, bid, nb, nMt, nNt, mt, nt, valid);
    if (!valid) continue;
    f32x4 acc[8][4];
    gemm_mainloop_glds256(acc, p.h2 + (size_t)mt * 256 * D, D, p.wb_rs + nt * 256, 768, D / 32, smem);
    const int mbase = mt * 256 + wm * 128;
    if (nt == 0) {
#pragma unroll
      for (int i = 0; i < 8; ++i) {
#pragma unroll
        for (int j = 0; j < 4; ++j) *(f32x4*)(p.logits + (size_t)(mbase + i * 16 + fr) * NE + wn * 64 + j * 16 + fq * 4) = acc[i][j];
        __builtin_amdgcn_sched_barrier(0); }
    } else {
      const int h0 = (nt - 1) * 128 + wn * 32;
#pragma unroll
      for (int i = 0; i < 8; ++i) {
#pragma unroll
        for (int j = 0; j < 2; ++j) { const f32x4 gv = acc[i][j], uv = acc[i][j + 2];
          u32x2 o; o.x = cvtpk(siluf_(gv[0]) * uv[0], siluf_(gv[1]) * uv[1]); o.y = cvtpk(siluf_(gv[2]) * uv[2], siluf_(gv[3]) * uv[3]);
          *(u32x2*)(p.shH + (size_t)(mbase + i * 16 + fr) * SFF + h0 + j * 16 + fq * 4) = o; }
        __builtin_amdgcn_sched_barrier(0); }
    }
  }
}

constexpr int MOE_H_OFF = 2 * G_STAGE;
constexpr int MOE_TOK_OFF = MOE_H_OFF + 65536;
constexpr int SMEM_BYTES = 139264;
__device__ __forceinline__ void phase_moe(PR p, int bid, int nb, lds_ptr smem) {
  const int lane = ltid() & 63, wid = ltid() >> 6, wm = wid >> 2, wn = wid & 3, fr = lane & 15, fq = lane >> 4;
  LAS int* toks = (LAS int*)(smem + MOE_TOK_OFF);
  const lds_ptr Hs = smem + MOE_H_OFF;
  LAS int* qi = (LAS int*)(smem + MOE_TOK_OFF + 512);
  for (int sx = 0; sx < 8; ++sx) {
   const int x = (bid + sx) & 7;
   const int cnt = p.moe_cnt[x];
   for (;;) {
    __syncthreads();
    if (ltid() == 0) qi[0] = atomicAdd(&p.moe_ctr[x], 1);
    __syncthreads();
    const int qidx = qi[0];
    if (qidx >= cnt) break;
    const int blk = p.moe_list[x * NBLK128 + qidx];
    const int e = p.blk_exp[blk];
    if (ltid() < 128) toks[ltid()] = p.slot_tok[blk * 128 + ltid()];
    __syncthreads();
    const float* Wg = p.ew_gate + (size_t)e * D * EFF; const float* Wu = p.ew_up + (size_t)e * D * EFF; const float* Wd = p.ew_down + (size_t)e * EFF * D;
    for (int hp2 = 0; hp2 < 2 * MOE_REP_GU; ++hp2) { const int hp = hp2 & 1;
      f32x4 acc[4][4];
      ALoadGatherLds al2{p.h2, toks};
      BLoadGUR bl{Wg, (long)(Wu - Wg), EFF, hp * 128};
      gemm_mainloop_r3<false>(acc, al2, bl, D / 32, smem, smem);
#pragma unroll
      for (int i = 0; i < 4; ++i)
#pragma unroll
        for (int j = 0; j < 2; ++j) { const f32x4 gv = acc[i][j], uv = acc[i][j + 2]; const int row = wm * 64 + i * 16 + fr, hc = hp * 128 + wn * 32 + j * 16 + fq * 4;
          u32x2 o; o.x = cvtpk(siluf_(gv[0]) * uv[0], siluf_(gv[1]) * uv[1]); o.y = cvtpk(siluf_(gv[2]) * uv[2], siluf_(gv[3]) * uv[3]);
          *(LAS u32x2*)(Hs + (hc >> 5) * G_ASZ + a_off(row, (hc & 31) >> 3) + (hc & 7) * 2) = o; }
    }
    for (int np2 = 0; np2 < 4 * MOE_REP_DN; ++np2) { const int np = np2 & 3;
      f32x4 acc[4][4];
      ALoadDense al{nullptr, 0};
      BLoadF32R bl{Wd + np * 256, D};
      gemm_mainloop_r3<true>(acc, al, bl, EFF / 32, smem, Hs);
#pragma unroll
      for (int i = 0; i < 4; ++i) {
        const int rl = wm * 64 + i * 16 + fr;
        if (toks[rl] >= 0) {
#pragma unroll
          for (int j = 0; j < 4; ++j) { const f32x4 v = acc[i][j]; u32x2 o; o.x = cvtpk(v[0], v[1]); o.y = cvtpk(v[2], v[3]);
            *(u32x2*)(p.Y + (size_t)(blk * 128 + rl) * D + np * 256 + wn * 64 + j * 16 + fq * 4) = o; }
        }
      }
    }
   }
  }
}

struct BStreamGU { const float* Wg; long du; int hp0;
  __device__ __forceinline__ void load(BRaw& r, int s, int tid) const {
    const int hp = hp0 + (s >> 5), kbase = (s & 31) * 32;
    const int col = (tid & 63) * 4, w = col >> 6, xx = col & 63;
    const float* q = Wg + ((xx < 32) ? 0l : du) + (size_t)(kbase + (tid >> 6)) * EFF + hp * 128 + 32 * w + (xx & 31);
#pragma unroll
    for (int i = 0; i < 4; ++i) r.v[i] = *(const f32x4*)(q + (size_t)(8 * i) * EFF); } };
struct BStreamDown { const float* Wd; int np0;
  __device__ __forceinline__ void load(BRaw& r, int s, int tid) const {
    const int np = np0 + (s >> 3), kbase = (s & 7) * 32;
    const float* q = Wd + (size_t)(kbase + (tid >> 6)) * D + np * 256 + (tid & 63) * 4;
#pragma unroll
    for (int i = 0; i < 4; ++i) r.v[i] = *(const f32x4*)(q + (size_t)(8 * i) * D); } };
constexpr int PV_STAGE = 2 * G_ASZ + G_BSZ;
template <int SEG, int NSEG, class AL, class BL, class SE>
__device__ __forceinline__ void gemm_stream_pair(const AL& al, const BL& bl, lds_ptr stage, const SE& segend, bool has2) {
  constexpr int NS = SEG * NSEG;
  const int tid = ltid(), lane = tid & 63, wid = tid >> 6, wm = wid >> 2, wn = wid & 3, fr = lane & 15, fq = lane >> 4;
  const int ar = tid >> 2, ac = tid & 3;
  const bf16_t* aptr0 = al.rowptr(0, ar) + ac * 8;
  const bf16_t* aptr1 = al.rowptr(1, ar) + ac * 8;
  const int a_st = a_off(ar, ac);
  int b_st[4];
#pragma unroll
  for (int i = 0; i < 4; ++i) b_st[i] = 2 * G_ASZ + b_off((tid >> 6) + 8 * i, (tid & 63) >> 2) + (tid & 3) * 8;
  int a_rd[4];
#pragma unroll
  for (int mt = 0; mt < 4; ++mt) a_rd[mt] = a_off(wm * 64 + mt * 16 + fr, fq);
  int b_rd[4][2];
#pragma unroll
  for (int nt = 0; nt < 4; ++nt) {
    b_rd[nt][0] = 2 * G_ASZ + b_off(8 * fq + (fr >> 2), wn * 4 + nt) + (fr & 3) * 8;
    b_rd[nt][1] = 2 * G_ASZ + b_off(8 * fq + 4 + (fr >> 2), wn * 4 + nt) + (fr & 3) * 8;
  }
  f32x4 acc[2][4][4];
#pragma unroll
  for (int h = 0; h < 2; ++h)
#pragma unroll
    for (int mt = 0; mt < 4; ++mt)
#pragma unroll
      for (int nt = 0; nt < 4; ++nt) acc[h][mt][nt] = (f32x4){0.f, 0.f, 0.f, 0.f};
  u32x4 xa0, xb0, xa1, xb1;
  BRaw rb0, rb1;
#define P2_LOAD(XA, XB, RB, s_) do { XA = *(const u32x4*)(aptr0 + (size_t)((s_) % SEG) * 32); XB = *(const u32x4*)(aptr1 + (size_t)((s_) % SEG) * 32); bl.load(RB, (s_), tid); } while (0)
#define P2_STORE(XA, XB, RB, st_) do { const lds_ptr q_ = stage + (st_) * PV_STAGE; *(LAS u32x4*)(q_ + a_st) = XA; *(LAS u32x4*)(q_ + G_ASZ + a_st) = XB; \
    _Pragma("unroll") for (int i_ = 0; i_ < 4; ++i_) { u32x2 o_; o_.x = cvtpk(RB.v[i_][0], RB.v[i_][1]); o_.y = cvtpk(RB.v[i_][2], RB.v[i_][3]); *(LAS u32x2*)(q_ + b_st[i_]) = o_; } } while (0)
#define P2_COMPUTE(s_) do { const lds_ptr cur = stage + ((s_) & 1) * PV_STAGE; s16x8 bfr[4]; \
    _Pragma("unroll") for (int nt = 0; nt < 4; ++nt) { const s16x4 lo = tr_read(cur + b_rd[nt][0]), hi = tr_read(cur + b_rd[nt][1]); bfr[nt] = __builtin_shufflevector(lo, hi, 0, 1, 2, 3, 4, 5, 6, 7); } \
    _Pragma("unroll") for (int h = 0; h < 2; ++h) if (h == 0 || has2) { s16x8 af[4]; \
      _Pragma("unroll") for (int mt = 0; mt < 4; ++mt) af[mt] = *(LAS s16x8*)(cur + h * G_ASZ + a_rd[mt]); \
      _Pragma("unroll") for (int mt = 0; mt < 4; ++mt) _Pragma("unroll") for (int nt = 0; nt < 4; ++nt) acc[h][mt][nt] = __builtin_amdgcn_mfma_f32_16x16x32_bf16(bfr[nt], af[mt], acc[h][mt][nt], 0, 0, 0); } } while (0)
#define P2_SEGEND(s_) do { if (((s_) % SEG) == SEG - 1) { segend((s_) / SEG, acc); \
    _Pragma("unroll") for (int h = 0; h < 2; ++h) _Pragma("unroll") for (int mt = 0; mt < 4; ++mt) _Pragma("unroll") for (int nt = 0; nt < 4; ++nt) acc[h][mt][nt] = (f32x4){0.f, 0.f, 0.f, 0.f}; } } while (0)
#define P2_BODY(s_, XAN, XBN, RBN, XAW, XBW, RBW) do { const int sl_ = ((s_) + 2 < NS) ? (s_) + 2 : NS - 1; P2_LOAD(XAN, XBN, RBN, sl_); __builtin_amdgcn_sched_barrier(0); \
    P2_COMPUTE(s_); __builtin_amdgcn_sched_barrier(0); P2_SEGEND(s_); P2_STORE(XAW, XBW, RBW, ((s_) + 1) & 1); __syncthreads(); } while (0)
  P2_LOAD(xa0, xb0, rb0, 0);
  P2_LOAD(xa1, xb1, rb1, 1);
  __syncthreads();
  P2_STORE(xa0, xb0, rb0, 0);
  __syncthreads();
  for (int s = 0; s < NS; s += 2) {
    P2_BODY(s, xa0, xb0, rb0, xa1, xb1, rb1);
    P2_BODY(s + 1, xa1, xb1, rb1, xa0, xb0, rb0);
  }
#undef P2_LOAD
#undef P2_STORE
#undef P2_COMPUTE
#undef P2_SEGEND
#undef P2_BODY
}
struct APairGather { const bf16_t* A; LAS int* tk; __device__ __forceinline__ const bf16_t* rowptr(int h, int r) const { int t = tk[h * 128 + r]; t = t < 0 ? 0 : t; return A + (size_t)t * D; } };
struct APairDense { const bf16_t* A0; const bf16_t* A1; __device__ __forceinline__ const bf16_t* rowptr(int h, int r) const { return (h ? A1 : A0) + (size_t)r * EFF; } };

constexpr int PV_TOK = 2 * PV_STAGE;
constexpr int PV_Q = PV_TOK + 1024;
constexpr int PV_STG = 69632, PV_STG_ROW = 528;
template <int STG>
__device__ __forceinline__ void phase_moe_pair(PR p, int bid, int nb, lds_ptr smem) {
  LAS int* toks = (LAS int*)(smem + PV_TOK);
  LAS int* qi = (LAS int*)(smem + PV_Q);
  for (int sx = 0; sx < 8; ++sx) {
   const int x = ((int)((unsigned)__builtin_amdgcn_s_getreg((3 << 11) | 20) & 7u) + sx) & 7;
   const int cnt = 2 * p.moe_cnt[x];
   for (;;) {
    __syncthreads();
    if (ltid() == 0) qi[0] = atomicAdd(&p.moe_ctr[(STG - 1) * 8 + x], 1);
    __syncthreads();
    const int qidx = qi[0];
    if (qidx >= cnt) break;
    const int blk = p.moe_list[x * NBLK128 + (qidx >> 1)], sub = qidx & 1;
    const int e = p.blk_exp[blk];
    const bool has2 = (blk + 1 < NBLK128) && (p.blk_exp[blk + 1] == e);
    const int blk2 = has2 ? blk + 1 : blk;
    { const int t = ltid(); if (t < 256) toks[t] = (t < 128) ? p.slot_tok[blk * 128 + t] : (has2 ? p.slot_tok[blk2 * 128 + (t - 128)] : -1); }
    __syncthreads();
    const int lane = ltid() & 63, wid = ltid() >> 6, wm = wid >> 2, wn = wid & 3, fr = lane & 15, fq = lane >> 4;
    if (STG == 1) {
      const float* Wg = p.ew_gate + (size_t)e * D * EFF; const float* Wu = p.ew_up + (size_t)e * D * EFF;
      APairGather al{p.h2, toks};
      BStreamGU bl{Wg, (long)(Wu - Wg), sub};
      auto segH = [&](int hseg, const f32x4 (&acc)[2][4][4]) { const int hp = sub + hseg;
        const int t1 = ltid(), l1 = t1 & 63, w1 = t1 >> 6;
        const lds_ptr stg = smem + PV_STG;
#pragma unroll
        for (int h = 0; h < 2; ++h) {
          if (h == 1 && !has2) continue;
#pragma unroll
          for (int i = 0; i < 4; ++i)
#pragma unroll
            for (int j = 0; j < 2; ++j) { const f32x4 gv = acc[h][i][j], uv = acc[h][i][j + 2];
              u32x2 o; o.x = cvtpk(siluf_(gv[0]) * uv[0], siluf_(gv[1]) * uv[1]); o.y = cvtpk(siluf_(gv[2]) * uv[2], siluf_(gv[3]) * uv[3]);
              *(LAS u32x2*)(stg + ((w1 >> 2) * 64 + i * 16 + (l1 & 15)) * 272 + ((w1 & 3) * 32 + j * 16 + (l1 >> 4) * 4) * 2) = o; }
          __syncthreads();
          bf16_t* hb = p.Hbuf + (size_t)((h ? blk2 : blk) * 128) * EFF + hp * 128 + (t1 & 15) * 8;
#pragma unroll
          for (int ps = 0; ps < 4; ++ps) {
            const int row = ps * 32 + (t1 >> 4);
            *(u32x4*)(hb + (size_t)row * EFF) = *(LAS u32x4*)(stg + row * 272 + (t1 & 15) * 16);
          }
          __syncthreads();
        }
      };
      gemm_stream_pair<32, 1>(al, bl, smem, segH, has2);
    } else {
      const float* Wd = p.ew_down + (size_t)e * EFF * D;
      APairDense al{p.Hbuf + (size_t)blk * 128 * EFF, p.Hbuf + (size_t)blk2 * 128 * EFF};
      BStreamDown bl{Wd, 2 * sub};
      auto segY = [&](int nseg, const f32x4 (&acc)[2][4][4]) { const int np = 2 * sub + nseg;
        const int t1 = ltid(), l1 = t1 & 63, w1 = t1 >> 6;
        const lds_ptr stg = smem + PV_STG;
#pragma unroll
        for (int h = 0; h < 2; ++h) {
          if (h == 1 && !has2) continue;
#pragma unroll
          for (int i = 0; i < 4; ++i)
#pragma unroll
            for (int j = 0; j < 4; ++j) { const f32x4 v = acc[h][i][j]; u32x2 o; o.x = cvtpk(v[0], v[1]); o.y = cvtpk(v[2], v[3]);
              *(LAS u32x2*)(stg + ((w1 >> 2) * 64 + i * 16 + (l1 & 15)) * PV_STG_ROW + ((w1 & 3) * 64 + j * 16 + (l1 >> 4) * 4) * 2) = o; }
          __syncthreads();
          bf16_t* yb = p.Y + (size_t)((h ? blk2 : blk) * 128) * D + np * 256 + (t1 & 31) * 8;
#pragma unroll
          for (int ps = 0; ps < 8; ++ps) {
            const int row = ps * 16 + (t1 >> 5);
            const u32x4 v = *(LAS u32x4*)(stg + row * PV_STG_ROW + (t1 & 31) * 16);
            if (toks[h * 128 + row] >= 0) *(u32x4*)(yb + (size_t)row * D) = v;
          }
          __syncthreads();
        }
      };
      gemm_stream_pair<8, 2>(al, bl, smem, segY, has2);
    }
   }
  }
}

__device__ __forceinline__ void wave_sync() { asm volatile("s_waitcnt lgkmcnt(0)" ::: "memory"); }
constexpr int S5_BU_STRIDE = 132;
constexpr int S5_S_STRIDE = 272;
constexpr int S5_WAVE_LDS = 16 * S5_BU_STRIDE * 4 + 16 * S5_S_STRIDE;
template <bool FINAL>
__device__ __forceinline__ void s5_item(PR p, int b, int c, int g, lds_ptr wl) {
  const int lane = ltid() & 63, fr = lane & 15, fq = lane >> 4;
  LAS float* bu = (LAS float*)wl;
  const lds_ptr Sb = wl + 16 * S5_BU_STRIDE * 4;
  const size_t t0 = (size_t)b * SEQ + (size_t)c * 64;
  const s16x8 zero8 = {0, 0, 0, 0, 0, 0, 0, 0};
  s16x8 bfr[8];
#pragma unroll
  for (int nt = 0; nt < 8; ++nt) { const s16x8 x = *(const s16x8*)(p.bbarT + ((size_t)(g * 128 + nt * 16 + fr) * 16 + (fq & 1) * 8)); bfr[nt] = (fq < 2) ? x : zero8; }
  const float are = p.abar[(g * 64 + lane) * 2], aim = p.abar[(g * 64 + lane) * 2 + 1];
  const size_t sidx = (((size_t)b * 32 + c) * S5G + g) * 64 + lane;
  float sre = 0.f, sim = 0.f;
  s16x8 cfr[4];
  f32x4 dsk = {0.f, 0.f, 0.f, 0.f};
  if (FINAL) {
    sre = p.s5Sin[sidx * 2]; sim = p.s5Sin[sidx * 2 + 1];
#pragma unroll
    for (int ks = 0; ks < 4; ++ks) cfr[ks] = *(const s16x8*)(p.cmT + ((size_t)(g * 16 + fr) * 128 + ks * 32 + fq * 8));
    dsk = *(const f32x4*)(p.s5_d + g * 16 + fq * 4);
  }
  s16x8 uxs[4]; u32x2 u4s[4];
#pragma unroll
  for (int mt = 0; mt < 4; ++mt) {
    const bf16_t* urow = p.proj + (t0 + mt * 16 + fr) * LDP + OFF_U + g * 16;
    uxs[mt] = *(const s16x8*)(urow + (fq & 1) * 8);
    if (FINAL) u4s[mt] = *(const u32x2*)(urow + fq * 4);
  }
#pragma unroll
  for (int mt = 0; mt < 4; ++mt) {
    const s16x8 ufr = (fq < 2) ? uxs[mt] : zero8;
#pragma unroll
    for (int nt = 0; nt < 8; ++nt) {
      const f32x4 z = {0.f, 0.f, 0.f, 0.f};
      const f32x4 acc = __builtin_amdgcn_mfma_f32_16x16x32_bf16(bfr[nt], ufr, z, 0, 0, 0);
      *(LAS f32x4*)(bu + fr * S5_BU_STRIDE + nt * 16 + 4 * fq) = acc;
    }
    wave_sync();
    f32x2 bv[16];
#pragma unroll
    for (int l = 0; l < 16; ++l) bv[l] = *(LAS f32x2*)(bu + l * S5_BU_STRIDE + 2 * lane);
#pragma unroll
    for (int l = 0; l < 16; ++l) {
      const float nr = are * sre - aim * sim + bv[l].x, ni = are * sim + aim * sre + bv[l].y;
      sre = nr; sim = ni;
      if (FINAL) *(LAS unsigned*)(Sb + l * S5_S_STRIDE + lane * 4) = cvtpk(sre, sim);
    }
    if (FINAL) {
      wave_sync();
      f32x4 y = {0.f, 0.f, 0.f, 0.f};
#pragma unroll
      for (int ks = 0; ks < 4; ++ks) {
        const s16x8 sfr = *(LAS s16x8*)(Sb + fr * S5_S_STRIDE + (ks * 32 + fq * 8) * 2);
        y = __builtin_amdgcn_mfma_f32_16x16x32_bf16(cfr[ks], sfr, y, 0, 0, 0);
      }
      const f32x4 u4 = {__builtin_bit_cast(float, u4s[mt].x << 16), __builtin_bit_cast(float, u4s[mt].x & 0xffff0000u), __builtin_bit_cast(float, u4s[mt].y << 16), __builtin_bit_cast(float, u4s[mt].y & 0xffff0000u)};
      u32x2 o; o.x = cvtpk(geluf_(y[0] + dsk[0] * u4[0]), geluf_(y[1] + dsk[1] * u4[1])); o.y = cvtpk(geluf_(y[2] + dsk[2] * u4[2]), geluf_(y[3] + dsk[3] * u4[3]));
      *(u32x2*)(p.yA + (t0 + mt * 16 + fr) * S5W + g * 16 + fq * 4) = o;
    } else wave_sync();
  }
  if (!FINAL) { p.s5E[sidx * 2] = sre; p.s5E[sidx * 2 + 1] = sim; }
}
template <bool FINAL>
__device__ __forceinline__ void s5_block_item(PR p, int item, lds_ptr smem) {
  const int wid = ltid() >> 6;
  const int go = item & 3, c = (item >> 2) & 31, b = item >> 7;
  s5_item<FINAL>(p, b, c, go * 8 + wid, smem + wid * S5_WAVE_LDS);
}

template <bool FINAL>
__device__ __forceinline__ void s5_wave_phase(PR p, int bid, int nb, lds_ptr smem) {
  const int lane = ltid() & 63, fr = lane & 15, fq = lane >> 4, wid = ltid() >> 6;
  const int g = (bid & 3) * 8 + wid;
  const lds_ptr wl = smem + wid * S5_WAVE_LDS;
  LAS float* bu = (LAS float*)wl;
  const lds_ptr Sb = wl + 16 * S5_BU_STRIDE * 4;
  const s16x8 zero8 = {0, 0, 0, 0, 0, 0, 0, 0};
  s16x8 bfr[8];
#pragma unroll
  for (int nt = 0; nt < 8; ++nt) { const s16x8 x = *(const s16x8*)(p.bbarT + ((size_t)(g * 128 + nt * 16 + fr) * 16 + (fq & 1) * 8)); bfr[nt] = (fq < 2) ? x : zero8; }
  const float are = p.abar[(g * 64 + lane) * 2], aim = p.abar[(g * 64 + lane) * 2 + 1];
  s16x8 cfr[4];
  f32x4 dsk = {0.f, 0.f, 0.f, 0.f};
  if (FINAL) {
#pragma unroll
    for (int ks = 0; ks < 4; ++ks) cfr[ks] = *(const s16x8*)(p.cmT + ((size_t)(g * 16 + fr) * 128 + ks * 32 + fq * 8));
    dsk = *(const f32x4*)(p.s5_d + g * 16 + fq * 4);
  }
  s16x8 nux[4]; u32x2 nu4[4]; f32x2 nsin = {0.f, 0.f};
#define S5_ISSUE(IDX) do { const int c_ = ((IDX) >> 2) & 31, b_ = (IDX) >> 7; const size_t t0_ = (size_t)b_ * SEQ + (size_t)c_ * 64; \
    _Pragma("unroll") for (int mt = 0; mt < 4; ++mt) { const bf16_t* urow = p.proj + (t0_ + mt * 16 + fr) * LDP + OFF_U + g * 16; \
      nux[mt] = *(const s16x8*)(urow + (fq & 1) * 8); if (FINAL) nu4[mt] = *(const u32x2*)(urow + fq * 4); } \
    if (FINAL) nsin = *(const f32x2*)(p.s5Sin + ((((size_t)b_ * 32 + c_) * S5G + g) * 64 + lane) * 2); } while (0)
  S5_ISSUE(bid);
#pragma unroll 1
  for (int idx = bid; idx < 1024; idx += nb) {
    const int c = (idx >> 2) & 31, b = idx >> 7;
    const size_t t0 = (size_t)b * SEQ + (size_t)c * 64;
    s16x8 uxs[4]; u32x2 u4s[4];
#pragma unroll
    for (int mt = 0; mt < 4; ++mt) { uxs[mt] = nux[mt]; u4s[mt] = nu4[mt]; }
    float sre = nsin.x, sim = nsin.y;
    __builtin_amdgcn_sched_barrier(0);
    { const int nidx = (idx + nb < 1024) ? idx + nb : idx; S5_ISSUE(nidx); }
    __builtin_amdgcn_sched_barrier(0);
#pragma unroll
    for (int mt = 0; mt < 4; ++mt) {
      const s16x8 ufr = (fq < 2) ? uxs[mt] : zero8;
#pragma unroll
      for (int nt = 0; nt < 8; ++nt) {
        const f32x4 z = {0.f, 0.f, 0.f, 0.f};
        const f32x4 acc = __builtin_amdgcn_mfma_f32_16x16x32_bf16(bfr[nt], ufr, z, 0, 0, 0);
        *(LAS f32x4*)(bu + fr * S5_BU_STRIDE + nt * 16 + 4 * fq) = acc;
      }
      wave_sync();
      f32x2 bv[16];
#pragma unroll
      for (int l = 0; l < 16; ++l) bv[l] = *(LAS f32x2*)(bu + l * S5_BU_STRIDE + 2 * lane);
#pragma unroll
      for (int l = 0; l < 16; ++l) {
        const float nr = are * sre - aim * sim + bv[l].x, ni = are * sim + aim * sre + bv[l].y;
        sre = nr; sim = ni;
        if (FINAL) *(LAS unsigned*)(Sb + l * S5_S_STRIDE + lane * 4) = cvtpk(sre, sim);
      }
      if (FINAL) {
        wave_sync();
        f32x4 y = {0.f, 0.f, 0.f, 0.f};
#pragma unroll
        for (int ks = 0; ks < 4; ++ks) {
          const s16x8 sfr = *(LAS s16x8*)(Sb + fr * S5_S_STRIDE + (ks * 32 + fq * 8) * 2);
          y = __builtin_amdgcn_mfma_f32_16x16x32_bf16(cfr[ks], sfr, y, 0, 0, 0);
        }
        const f32x4 u4 = {__builtin_bit_cast(float, u4s[mt].x << 16), __builtin_bit_cast(float, u4s[mt].x & 0xffff0000u), __builtin_bit_cast(float, u4s[mt].y << 16), __builtin_bit_cast(float, u4s[mt].y & 0xffff0000u)};
        u32x2 o; o.x = cvtpk(geluf_(y[0] + dsk[0] * u4[0]), geluf_(y[1] + dsk[1] * u4[1])); o.y = cvtpk(geluf_(y[2] + dsk[2] * u4[2]), geluf_(y[3] + dsk[3] * u4[3]));
        *(u32x2*)(p.yA + (t0 + mt * 16 + fr) * S5W + g * 16 + fq * 4) = o;
      } else wave_sync();
    }
    if (!FINAL) { const size_t sidx = (((size_t)b * 32 + c) * S5G + g) * 64 + lane; *(f32x2*)(p.s5E + sidx * 2) = (f32x2){sre, sim}; }
  }
#undef S5_ISSUE
}

constexpr int GL_QD = 0, GL_KE = 8192, GL_V = 16384, GL_SIN = 32768, GL_GL = 49152, GL_W2 = 53248, GL_TOT = 57344, GL_B2 = 58368, GL_ITEM = 58624;
__device__ __forceinline__ int rowrd_off(int r, int c) { return r * 128 + ((c ^ ((r >> 1) & 7)) << 4); }
__device__ __forceinline__ int tr128_off(int r, int ch) { return r * 128 + ((ch ^ (((r >> 1) & 1) | (((r >> 3) & 1) << 1))) << 5); }
__device__ __forceinline__ int tr256_off(int r, int ch) { return r * 256 + ((ch ^ ((r & 3) | (((r >> 3) & 1) << 2))) << 5); }

__device__ __forceinline__ void gla_front(lds_ptr il, int t, const f32x4& gklv, const float (&wv)[16], float bias, float (&bl)[16], float& blast) {
  LAS float* gl = (LAS float*)(il + GL_GL); LAS float* tot = (LAS float*)(il + GL_TOT);
  __syncthreads();
  *(LAS f32x4*)(gl + t * 4) = gklv;
  __syncthreads();
  const int d = t & 63, part = t >> 6;
  float run = 0.f;
#pragma unroll
  for (int ii = 0; ii < 16; ++ii) {
    const int i = part * 16 + ii;
    float gk = bias;
#pragma unroll
    for (int q = 0; q < 4; ++q) { const f32x4 gv = *(LAS f32x4*)(gl + i * 16 + q * 4); gk += gv[0] * wv[q * 4] + gv[1] * wv[q * 4 + 1] + gv[2] * wv[q * 4 + 2] + gv[3] * wv[q * 4 + 3]; }
    run += logsigmoidf_(gk) * (1.f / 16.f);
    bl[ii] = run;
  }
  tot[part * 64 + d] = run;
  __syncthreads();
  float offs = 0.f, all = 0.f;
#pragma unroll
  for (int q = 0; q < 4; ++q) { const float v = tot[q * 64 + d]; all += v; offs += (q < part) ? v : 0.f; }
#pragma unroll
  for (int ii = 0; ii < 16; ++ii) bl[ii] += offs;
  blast = all;
}

__device__ __forceinline__ void gla_pass1(PR p, int item, lds_ptr smem, const float (&wv)[16], float bias) {
  const int half = ltid() >> 8, t = ltid() & 255, lane = t & 63, w = t >> 6, fr = lane & 15, fq = lane >> 4;
  const int it = item * 2 + half, c = it & 31, h = (it >> 5) & 3, b = it >> 7;
  const lds_ptr il = smem + half * GL_ITEM;
  const size_t t0 = (size_t)b * SEQ + (size_t)c * 64;
  float bl[16], blast;
  const f32x4 gklv = *(const f32x4*)(p.gkl + t0 * 16 + t * 4);
  bf16_t kraw[16]; u32x4 vraw[4];
#pragma unroll
  for (int ii = 0; ii < 16; ++ii) kraw[ii] = p.proj[(t0 + (t >> 6) * 16 + ii) * LDP + OFF_K + h * 64 + (t & 63)];
#pragma unroll
  for (int q = 0; q < 4; ++q) { const int pc = t + 256 * q, r = pc >> 4, c8 = pc & 15; vraw[q] = *(const u32x4*)(p.proj + (t0 + r) * LDP + OFF_V + h * 128 + c8 * 8); }
  gla_front(il, t, gklv, wv, bias, bl, blast);
  {
    const int d = t & 63, part = t >> 6;
#pragma unroll
    for (int ii = 0; ii < 16; ++ii) {
      const int i = part * 16 + ii;
      const float kv = bf2f(kraw[ii]);
      *(LAS bf16_t*)(il + GL_KE + tr128_off(i, d >> 4) + (d & 15) * 2) = f2bf(kv * __expf(blast - bl[ii]));
    }
    if (part == 0) p.glaDec[(size_t)it * 64 + d] = __expf(blast);
#pragma unroll
    for (int q = 0; q < 4; ++q) { const int pc = t + 256 * q, r = pc >> 4, c8 = pc & 15;
      *(LAS u32x4*)(il + GL_V + tr256_off(r, c8 >> 1) + (c8 & 1) * 16) = vraw[q]; }
  }
  __syncthreads();
  f32x4 acc[8];
#pragma unroll
  for (int et = 0; et < 8; ++et) acc[et] = (f32x4){0.f, 0.f, 0.f, 0.f};
#pragma unroll
  for (int ks = 0; ks < 2; ++ks) {
    const int r0 = 32 * ks + 8 * fq + (fr >> 2);
    const s16x4 klo = tr_read(il + GL_KE + tr128_off(r0, w) + (fr & 3) * 8), khi = tr_read(il + GL_KE + tr128_off(r0 + 4, w) + (fr & 3) * 8);
    const s16x8 kf = __builtin_shufflevector(klo, khi, 0, 1, 2, 3, 4, 5, 6, 7);
#pragma unroll
    for (int et = 0; et < 8; ++et) {
      const s16x4 vlo = tr_read(il + GL_V + tr256_off(r0, et) + (fr & 3) * 8), vhi = tr_read(il + GL_V + tr256_off(r0 + 4, et) + (fr & 3) * 8);
      const s16x8 vf = __builtin_shufflevector(vlo, vhi, 0, 1, 2, 3, 4, 5, 6, 7);
      acc[et] = __builtin_amdgcn_mfma_f32_16x16x32_bf16(vf, kf, acc[et], 0, 0, 0);
    }
  }
#pragma unroll
  for (int et = 0; et < 8; ++et) { u32x2 o; o.x = cvtpk(acc[et][0], acc[et][1]); o.y = cvtpk(acc[et][2], acc[et][3]);
    *(u32x2*)((bf16_t*)p.glaKV + ((size_t)it * 64 + 16 * w + fr) * 128 + et * 16 + fq * 4) = o; }
}

__device__ __forceinline__ void gla_pass2(PR p, int item, lds_ptr smem, const float (&wv)[16], float bias) {
  const int half = ltid() >> 8, t = ltid() & 255, lane = t & 63, w = t >> 6, fr = lane & 15, fq = lane >> 4;
  const int it = item * 2 + half, c = it & 31, h = (it >> 5) & 3, b = it >> 7;
  const lds_ptr il = smem + half * GL_ITEM;
  const size_t t0 = (size_t)b * SEQ + (size_t)c * 64;
  float bl[16], blast;
  const f32x4 gklv = *(const f32x4*)(p.gkl + t0 * 16 + t * 4);
  bf16_t qraw[16], kraw[16]; u32x4 vraw[4], sraw[4]; u32x2 rgraw[8];
#pragma unroll
  for (int ii = 0; ii < 16; ++ii) { const bf16_t* pr = p.proj + (t0 + (t >> 6) * 16 + ii) * LDP + h * 64 + (t & 63); qraw[ii] = pr[OFF_Q]; kraw[ii] = pr[OFF_K]; }
#pragma unroll
  for (int q = 0; q < 4; ++q) { const int pc = t + 256 * q, r = pc >> 4, c8 = pc & 15;
    vraw[q] = *(const u32x4*)(p.proj + (t0 + r) * LDP + OFF_V + h * 128 + c8 * 8);
    sraw[q] = *(const u32x4*)(p.glaSin + ((size_t)it * 64 + r) * 128 + c8 * 8); }
  const size_t trow = t0 + 16 * w + fr;
#pragma unroll
  for (int et = 0; et < 8; ++et) rgraw[et] = *(const u32x2*)(p.proj + trow * LDP + OFF_R + h * 128 + et * 16 + fq * 4);
  gla_front(il, t, gklv, wv, bias, bl, blast);
  {
    const int d = t & 63, part = t >> 6;
#pragma unroll
    for (int ii = 0; ii < 16; ++ii) {
      const int i = part * 16 + ii;
      const float qv = bf2f(qraw[ii]) * 0.125f, kv = bf2f(kraw[ii]);
      const int o = rowrd_off(i, d >> 3) + (d & 7) * 2;
      *(LAS bf16_t*)(il + GL_QD + o) = f2bf(qv * __expf(bl[ii]));
      *(LAS bf16_t*)(il + GL_KE + o) = f2bf(kv * __expf(-bl[ii]));
    }
#pragma unroll
    for (int q = 0; q < 4; ++q) { const int pc = t + 256 * q, r = pc >> 4, c8 = pc & 15;
      *(LAS u32x4*)(il + GL_V + tr256_off(r, c8 >> 1) + (c8 & 1) * 16) = vraw[q];
      *(LAS u32x4*)(il + GL_SIN + tr256_off(r, c8 >> 1) + (c8 & 1) * 16) = sraw[q]; }
  }
  __syncthreads();
  s16x8 qf[2];
#pragma unroll
  for (int ks = 0; ks < 2; ++ks) qf[ks] = *(LAS s16x8*)(il + GL_QD + rowrd_off(16 * w + fr, ks * 4 + fq));
  f32x4 st[4];
#pragma unroll
  for (int jt = 0; jt < 4; ++jt) {
    st[jt] = (f32x4){0.f, 0.f, 0.f, 0.f};
    if (jt <= w) {
#pragma unroll
      for (int ks = 0; ks < 2; ++ks) {
        const s16x8 kf = *(LAS s16x8*)(il + GL_KE + rowrd_off(16 * jt + fr, ks * 4 + fq));
        st[jt] = __builtin_amdgcn_mfma_f32_16x16x32_bf16(kf, qf[ks], st[jt], 0, 0, 0);
      }
      if (jt == w) {
#pragma unroll
        for (int r = 0; r < 4; ++r) st[jt][r] = (4 * fq + r <= fr) ? st[jt][r] : 0.f;
      }
    }
  }
  f32x4 acc[8];
#pragma unroll
  for (int et = 0; et < 8; ++et) acc[et] = (f32x4){0.f, 0.f, 0.f, 0.f};
#pragma unroll
  for (int u = 0; u < 2; ++u) {
    if (2 * u <= w) {
      u32x4 pk; pk.x = cvtpk(st[2 * u][0], st[2 * u][1]); pk.y = cvtpk(st[2 * u][2], st[2 * u][3]); pk.z = cvtpk(st[2 * u + 1][0], st[2 * u + 1][1]); pk.w = cvtpk(st[2 * u + 1][2], st[2 * u + 1][3]);
      const s16x8 pf = __builtin_bit_cast(s16x8, pk);
      const int r0 = 32 * u + 4 * fq + (fr >> 2);
#pragma unroll
      for (int et = 0; et < 8; ++et) {
        const s16x4 vlo = tr_read(il + GL_V + tr256_off(r0, et) + (fr & 3) * 8), vhi = tr_read(il + GL_V + tr256_off(r0 + 16, et) + (fr & 3) * 8);
        const s16x8 vf = __builtin_shufflevector(vlo, vhi, 0, 1, 2, 3, 4, 5, 6, 7);
        acc[et] = __builtin_amdgcn_mfma_f32_16x16x32_bf16(vf, pf, acc[et], 0, 0, 0);
      }
    }
  }
#pragma unroll
  for (int ks = 0; ks < 2; ++ks) {
    const int r0 = 32 * ks + 8 * fq + (fr >> 2);
#pragma unroll
    for (int et = 0; et < 8; ++et) {
      const s16x4 slo = tr_read(il + GL_SIN + tr256_off(r0, et) + (fr & 3) * 8), shi = tr_read(il + GL_SIN + tr256_off(r0 + 4, et) + (fr & 3) * 8);
      const s16x8 sf = __builtin_shufflevector(slo, shi, 0, 1, 2, 3, 4, 5, 6, 7);
      acc[et] = __builtin_amdgcn_mfma_f32_16x16x32_bf16(sf, qf[ks], acc[et], 0, 0, 0);
    }
  }
  float ss = 0.f;
#pragma unroll
  for (int et = 0; et < 8; ++et) ss += acc[et][0] * acc[et][0] + acc[et][1] * acc[et][1] + acc[et][2] * acc[et][2] + acc[et][3] * acc[et][3];
  ss += __shfl_xor(ss, 16); ss += __shfl_xor(ss, 32);
  const float rn = rsqrtf(ss * (1.f / 128.f) + 1e-6f);
#pragma unroll
  for (int et = 0; et < 8; ++et) {
    const int e = et * 16 + fq * 4;
    const f32x4 ng = *(const f32x4*)(p.gla_norm_g + e);
    const f32x4 rg = {__builtin_bit_cast(float, rgraw[et].x << 16), __builtin_bit_cast(float, rgraw[et].x & 0xffff0000u), __builtin_bit_cast(float, rgraw[et].y << 16), __builtin_bit_cast(float, rgraw[et].y & 0xffff0000u)};
    u32x2 o; o.x = cvtpk(acc[et][0] * rn * ng[0] * siluf_(rg[0]), acc[et][1] * rn * ng[1] * siluf_(rg[1])); o.y = cvtpk(acc[et][2] * rn * ng[2] * siluf_(rg[2]), acc[et][3] * rn * ng[3] * siluf_(rg[3]));
    *(u32x2*)(p.yB + trow * GVAL + h * 128 + e) = o;
  }
}

#define GLA_LOAD_WV(H) do { const int d_ = ltid() & 63; _Pragma("unroll") for (int r_ = 0; r_ < 16; ++r_) wv[r_] = p.w_gk2[r_ * GKEY + (H) * 64 + d_]; bias = p.b_gk2[(H) * 64 + d_]; } while (0)
__device__ __forceinline__ void phase_mix_local(PR p, int bid, int nb, lds_ptr smem, int which) {
  if (which & 1) { __syncthreads(); s5_wave_phase<false>(p, bid, nb, smem); }
  if (which & 2) {
    float wv[16], bias = 0.f; int hprev = -1;
    for (int item = bid; item < 512; item += nb) {
      const int h = ((item * 2 + (ltid() >> 8)) >> 5) & 3;
      if (h != hprev) { GLA_LOAD_WV(h); hprev = h; }
      gla_pass1(p, item, smem, wv, bias);
    }
  }
}
__device__ __forceinline__ void phase_mix_carry(PR p, int bid, int nb, int which) {
  const int wave = __builtin_amdgcn_readfirstlane(ltid() >> 6), ln = ltid() & 63;
  if (which & 1) {
    for (int j = bid; j < NB * S5G; j += nb) if (wave == 7) {
      const int g = j & 31, b = j >> 5;
      const float2 a = *(const float2*)(p.apow64 + (g * 64 + ln) * 2);
      float2 e[32];
#pragma unroll
      for (int c = 0; c < 32; ++c) e[c] = *(const float2*)(p.s5E + ((((size_t)b * 32 + c) * S5G + g) * 64 + ln) * 2);
      float sre = 0.f, sim = 0.f;
#pragma unroll
      for (int c = 0; c < 32; ++c) {
        *(float2*)(p.s5Sin + ((((size_t)b * 32 + c) * S5G + g) * 64 + ln) * 2) = make_float2(sre, sim);
        const float nr = a.x * sre - a.y * sim + e[c].x, ni = a.x * sim + a.y * sre + e[c].y;
        sre = nr; sim = ni;
      }
    }
  }
  if (which & 2) {
    for (int r = bid * 8 + wave; r < NB * GH * 64; r += nb * 8) {
      const int d = r & 63, bh = r >> 6;
      unsigned kv[32]; float dec[32];
#pragma unroll
      for (int c = 0; c < 32; ++c) {
        const size_t it = (size_t)bh * 32 + c;
        kv[c] = *(const unsigned*)((const bf16_t*)p.glaKV + (it * 64 + d) * 128 + 2 * ln);
        dec[c] = p.glaDec[it * 64 + d];
      }
      float S0 = 0.f, S1 = 0.f;
#pragma unroll
      for (int c = 0; c < 32; ++c) {
        const size_t it = (size_t)bh * 32 + c;
        *(uint32_t*)(p.glaSin + (it * 64 + d) * 128 + 2 * ln) = cvtpk(S0, S1);
        S0 = dec[c] * S0 + __uint_as_float(kv[c] << 16); S1 = dec[c] * S1 + __uint_as_float(kv[c] & 0xffff0000u);
      }
    }
  }
}
__device__ __forceinline__ void phase_mix_final(PR p, int bid, int nb, lds_ptr smem, int which) {
  if (which & 1) { __syncthreads(); s5_wave_phase<true>(p, bid, nb, smem); }
  if (which & 2) {
    float wv[16], bias = 0.f; int hprev = -1;
    for (int item = bid; item < 512; item += nb) {
      const int h = ((item * 2 + (ltid() >> 8)) >> 5) & 3;
      if (h != hprev) { GLA_LOAD_WV(h); hprev = h; }
      gla_pass2(p, item, smem, wv, bias);
    }
  }
}

template <int CTRL> __device__ __forceinline__ float dppf(float x) { return __builtin_bit_cast(float, __builtin_amdgcn_update_dpp(0, __builtin_bit_cast(int, x), CTRL, 0xF, 0xF, false)); }
__device__ __forceinline__ float rlf(float x, int l) { return __builtin_bit_cast(float, __builtin_amdgcn_readlane(__builtin_bit_cast(int, x), l)); }
__device__ __forceinline__ float wave_max(float x) {
  x = fmaxf(x, dppf<0xB1>(x)); x = fmaxf(x, dppf<0x4E>(x)); x = fmaxf(x, dppf<0x141>(x)); x = fmaxf(x, dppf<0x140>(x));
  return fmaxf(fmaxf(rlf(x, 0), rlf(x, 16)), fmaxf(rlf(x, 32), rlf(x, 48)));
}
__device__ __forceinline__ float wave_sum(float x) {
  x += dppf<0xB1>(x); x += dppf<0x4E>(x); x += dppf<0x141>(x); x += dppf<0x140>(x);
  return (rlf(x, 0) + rlf(x, 16)) + (rlf(x, 32) + rlf(x, 48));
}
__device__ __forceinline__ void phase_route(PR p, int bid, int nb, lds_ptr smem) {
  const int lane = ltid() & 63, wid = ltid() >> 6;
  const f32x4 bias = *(const f32x4*)(p.router_bias + lane * 4);
  const int stride = nb * 8;
  LAS int* hist = (LAS int*)smem; LAS int* base = hist + 256; LAS int* stg = hist + 512;
  __syncthreads();
  if (ltid() < 256) hist[ltid()] = 0;
  __syncthreads();
  int itn = 0;
  for (int t = bid * 8 + wid; t < T; t += 2 * stride, itn += 2) {
    const int tt[2] = {t, (t + stride < T) ? t + stride : t};
    const bool two = t + stride < T;
    float sc[2][4], v[2][4];
#pragma unroll
    for (int u = 0; u < 2; ++u) {
      const f32x4 lg = *(const f32x4*)(p.logits + (size_t)tt[u] * NE + lane * 4);
#pragma unroll
      for (int j = 0; j < 4; ++j) { sc[u][j] = sigmoidf_(lg[j]); v[u][j] = sc[u][j] + bias[j]; }
    }
    float m1[2], m2[2];
#pragma unroll
    for (int u = 0; u < 2; ++u) {
      m1[u] = fmaxf(v[u][0], v[u][1]); m2[u] = fminf(v[u][0], v[u][1]);
#pragma unroll
      for (int j = 2; j < 4; ++j) { const float nm1 = fmaxf(m1[u], v[u][j]); m2[u] = fmaxf(fminf(m1[u], v[u][j]), m2[u]); m1[u] = nm1; }
    }
#pragma unroll
    for (int u = 0; u < 2; ++u) { const float o1 = dppf<0xB1>(m1[u]), o2 = dppf<0xB1>(m2[u]); const float nm1 = fmaxf(m1[u], o1); m2[u] = fmaxf(fminf(m1[u], o1), fmaxf(m2[u], o2)); m1[u] = nm1; }
#pragma unroll
    for (int u = 0; u < 2; ++u) { const float o1 = dppf<0x4E>(m1[u]), o2 = dppf<0x4E>(m2[u]); const float nm1 = fmaxf(m1[u], o1); m2[u] = fmaxf(fminf(m1[u], o1), fmaxf(m2[u], o2)); m1[u] = nm1; }
#pragma unroll
    for (int u = 0; u < 2; ++u) { const float o1 = dppf<0x141>(m1[u]), o2 = dppf<0x141>(m2[u]); const float nm1 = fmaxf(m1[u], o1); m2[u] = fmaxf(fminf(m1[u], o1), fmaxf(m2[u], o2)); m1[u] = nm1; }
    const int grp = lane >> 3;
#pragma unroll
    for (int u = 0; u < 2; ++u) {
      const float gs = m1[u] + m2[u];
      int rank = 0;
#pragma unroll
      for (int g2 = 0; g2 < 8; ++g2) { const float og = rlf(gs, g2 * 8); rank += (og > gs || (og == gs && g2 < grp)) ? 1 : 0; }
      const bool gsel = rank < 4;
#pragma unroll
      for (int j = 0; j < 4; ++j) v[u][j] = gsel ? v[u][j] : -INFINITY;
    }
    int my_e[2] = {0, 0}; float my_s[2] = {0.f, 0.f}, wsum[2] = {0.f, 0.f};
#pragma unroll 2
    for (int r = 0; r < 8; ++r) {
#pragma unroll
      for (int u = 0; u < 2; ++u) {
        const float wm = wave_max(fmaxf(fmaxf(v[u][0], v[u][1]), fmaxf(v[u][2], v[u][3])));
        const int my_j = (v[u][0] == wm) ? 0 : (v[u][1] == wm) ? 1 : (v[u][2] == wm) ? 2 : (v[u][3] == wm) ? 3 : 4;
        const unsigned long long ball = __ballot(my_j < 4);
        const int ol = ball ? (int)__builtin_ctzll(ball) : 0;
        const int oj = __builtin_amdgcn_readlane(my_j, ol) & 3;
        const int be = ol * 4 + oj;
        float s_own = 0.f;
#pragma unroll
        for (int j = 0; j < 4; ++j) if (lane == ol && oj == j) { s_own = sc[u][j]; v[u][j] = -INFINITY; }
        const float s_w = rlf(s_own, ol);
        wsum[u] += s_w;
        if (lane == r) { my_e[u] = be; my_s[u] = s_w; }
      }
    }
#pragma unroll
    for (int u = 0; u < 2; ++u) {
      if (lane < 8 && (u == 0 || two)) {
        p.tk_idx[tt[u] * 8 + lane] = my_e[u];
        p.tk_w[tt[u] * 8 + lane] = my_s[u] / wsum[u] * 2.5f;
        const int lr = __hip_atomic_fetch_add(hist + my_e[u], 1, __ATOMIC_RELAXED, __HIP_MEMORY_SCOPE_WORKGROUP);
        stg[((itn + u) * 8 + wid) * 8 + lane] = my_e[u] | (lr << 8);
      }
    }
  }
  __syncthreads();
  if (ltid() < 256) { const int c = hist[ltid()]; base[ltid()] = c ? atomicAdd(&p.counts[ltid()], c) : 0; }
  __syncthreads();
  itn = 0;
  for (int t = bid * 8 + wid; t < T; t += stride, ++itn) if (lane < 8) { const int v = stg[(itn * 8 + wid) * 8 + lane]; p.tk_rank[t * 8 + lane] = base[v & 255] + (v >> 8); }
}
__device__ __forceinline__ void phase_scatter(PR p, int bid, int nb, lds_ptr smem) {
  LAS int* st = (LAS int*)smem;
  __syncthreads();
  if (ltid() < 256) st[ltid() + 1] = (p.counts[ltid()] + 127) / 128 * 128;
  if (ltid() == 0) st[0] = 0;
  __syncthreads();
  if (ltid() < 64) {
    const int ln = ltid();
    const int c0 = st[4 * ln + 1], c1 = st[4 * ln + 2], c2 = st[4 * ln + 3], c3 = st[4 * ln + 4];
    const int tot = c0 + c1 + c2 + c3;
    int inc = tot;
    #pragma unroll
    for (int o = 1; o < 64; o <<= 1) { const int v = __shfl_up(inc, o, 64); if (ln >= o) inc += v; }
    const int b0 = inc - tot;
    st[4 * ln + 1] = b0 + c0; st[4 * ln + 2] = b0 + c0 + c1; st[4 * ln + 3] = b0 + c0 + c1 + c2; st[4 * ln + 4] = inc;
  }
  __syncthreads();
  if (bid == 0) {
    if (ltid() < 256) { const int e = ltid(); for (int b = st[e] / 128; b < st[e + 1] / 128; ++b) p.blk_exp[b] = e; }
    for (int b = st[256] / 128 + ltid(); b < NBLK128; b += NTHR) p.blk_exp[b] = -1;
  }
  if (bid >= 8 && bid < 16 && ltid() < 64) {
    const int x = bid - 8, ln = ltid() & 63, half = ln >> 5;
    const int e = x + 8 * (ln & 31);
    const int np = (st[e + 1] / 128 - st[e] / 128 + 1) >> 1;
    int inc = np;
    #pragma unroll
    for (int o = 1; o < 32; o <<= 1) { const int v = __shfl_up(inc, o, 32); if ((ln & 31) >= o) inc += v; }
    const int base = inc - np;
    if (half == 0) for (int j = 0; j < np; ++j) p.moe_list[x * NBLK128 + base + j] = st[e] / 128 + 2 * j;
    if (ln == 31) p.moe_cnt[x] = inc;
  }
  for (int i = bid * NTHR + ltid(); i < T * 8; i += nb * NTHR) {
    const int e = p.tk_idx[i], pos = st[e] + p.tk_rank[i];
    p.slot_tok[pos] = i >> 3;
    p.slot_of[i] = pos;
  }
}

__global__ void __launch_bounds__(64) k_s5_naive(P p) {
  __shared__ float sre[64], sim[64], cre[16][64], cim[16][64], us[16];
  const int b = blockIdx.x / S5G, g = blockIdx.x % S5G, lane = threadIdx.x;
  const float are = p.abar[(g * 64 + lane) * 2], aim = p.abar[(g * 64 + lane) * 2 + 1];
  float bre[16], bim[16];
  for (int h = 0; h < 16; ++h) { bre[h] = p.bbar[((g * 64 + lane) * 16 + h) * 2]; bim[h] = p.bbar[((g * 64 + lane) * 16 + h) * 2 + 1]; }
  for (int i = lane; i < 1024; i += 64) { cre[i >> 6][i & 63] = p.c_re[g * 1024 + i]; cim[i >> 6][i & 63] = p.c_im[g * 1024 + i]; }
  const float dsk = lane < 16 ? p.s5_d[g * 16 + lane] : 0.f;
  float s_re = 0.f, s_im = 0.f;
  __syncthreads();
  for (int l = 0; l < SEQ; ++l) {
    const size_t t = (size_t)b * SEQ + l;
    if (lane < 16) us[lane] = bf2f(p.proj[t * LDP + OFF_U + g * 16 + lane]);
    __syncthreads();
    float bur = 0.f, bui = 0.f;
    for (int h = 0; h < 16; ++h) { bur += us[h] * bre[h]; bui += us[h] * bim[h]; }
    const float nr = are * s_re - aim * s_im + bur, ni = are * s_im + aim * s_re + bui;
    s_re = nr; s_im = ni;
    sre[lane] = s_re; sim[lane] = s_im;
    __syncthreads();
    if (lane < 16) {
      float y = dsk * us[lane];
      for (int q = 0; q < 64; ++q) y += sre[q] * cre[lane][q] - sim[q] * cim[lane][q];
      p.yA[t * S5W + g * 16 + lane] = f2bf(geluf_(y));
    }
    __syncthreads();
  }
}

__global__ void __launch_bounds__(128) k_gla_naive(P p) {
  __shared__ float qs[32][64], ks[32][64], as[32][64], gl[32][16], w2[16][64], b2[64];
  const int b = blockIdx.x / GH, h = blockIdx.x % GH, tid = threadIdx.x;
  for (int i = tid; i < 16 * 64; i += 128) w2[i >> 6][i & 63] = p.w_gk2[(i >> 6) * GKEY + h * 64 + (i & 63)];
  if (tid < 64) b2[tid] = p.b_gk2[h * 64 + tid];
  float S[64];
  for (int d = 0; d < 64; ++d) S[d] = 0.f;
  for (int l0 = 0; l0 < SEQ; l0 += 32) {
    __syncthreads();
    for (int i = tid; i < 32 * 64; i += 128) {
      const size_t t = (size_t)b * SEQ + l0 + (i >> 6);
      qs[i >> 6][i & 63] = bf2f(p.proj[t * LDP + OFF_Q + h * 64 + (i & 63)]) * 0.125f;
      ks[i >> 6][i & 63] = bf2f(p.proj[t * LDP + OFF_K + h * 64 + (i & 63)]);
    }
    for (int i = tid; i < 32 * 16; i += 128) { const size_t t = (size_t)b * SEQ + l0 + (i >> 4); gl[i >> 4][i & 15] = p.gkl[t * 16 + (i & 15)]; }
    __syncthreads();
    for (int i = tid; i < 32 * 64; i += 128) {
      const int s = i >> 6, d = i & 63;
      float gk = b2[d];
      for (int r = 0; r < 16; ++r) gk += gl[s][r] * w2[r][d];
      as[s][d] = __expf(logsigmoidf_(gk) * (1.f / 16.f));
    }
    __syncthreads();
    for (int s = 0; s < 32; ++s) {
      const size_t t = (size_t)b * SEQ + l0 + s;
      const float v = bf2f(p.proj[t * LDP + OFF_V + h * 128 + tid]);
      float o = 0.f;
      for (int d = 0; d < 64; ++d) { S[d] = as[s][d] * S[d] + ks[s][d] * v; o += qs[s][d] * S[d]; }
      p.oraw[t * GVAL + h * 128 + tid] = o;
    }
  }
}
__global__ void __launch_bounds__(256) k_gla_post(P p) {
  const int idx = blockIdx.x * 4 + (threadIdx.x >> 6), lane = threadIdx.x & 63;
  const int t = idx / GH, h = idx % GH;
  const float o0 = p.oraw[(size_t)t * GVAL + h * 128 + lane], o1 = p.oraw[(size_t)t * GVAL + h * 128 + 64 + lane];
  float ss = o0 * o0 + o1 * o1;
  for (int o = 32; o > 0; o >>= 1) ss += __shfl_xor(ss, o);
  const float r = rsqrtf(ss * (1.f / 128.f) + 1e-6f);
  const float r0 = bf2f(p.proj[(size_t)t * LDP + OFF_R + h * 128 + lane]), r1 = bf2f(p.proj[(size_t)t * LDP + OFF_R + h * 128 + 64 + lane]);
  p.yB[(size_t)t * GVAL + h * 128 + lane] = f2bf(o0 * r * p.gla_norm_g[lane] * siluf_(r0));
  p.yB[(size_t)t * GVAL + h * 128 + 64 + lane] = f2bf(o1 * r * p.gla_norm_g[64 + lane] * siluf_(r1));
}

__global__ void __launch_bounds__(64) k_route(P p) {
  const int t = blockIdx.x * 64 + threadIdx.x;
  const float* lg = p.logits + (size_t)t * NE;
  float gs[8];
#pragma unroll
  for (int g = 0; g < 8; ++g) {
    float m1 = -INFINITY, m2 = -INFINITY;
    for (int j = 0; j < 32; ++j) { const float v = sigmoidf_(lg[g * 32 + j]) + p.router_bias[g * 32 + j]; if (v > m1) { m2 = m1; m1 = v; } else if (v > m2) m2 = v; }
    gs[g] = m1 + m2;
  }
  unsigned gmask = 0;
#pragma unroll
  for (int r = 0; r < 4; ++r) { int best = -1; float bv = -INFINITY;
#pragma unroll
    for (int g = 0; g < 8; ++g) if (!((gmask >> g) & 1u) && gs[g] > bv) { bv = gs[g]; best = g; }
    gmask |= 1u << best; }
  int sel[8]; float sw[8]; float wsum = 0.f;
#pragma unroll
  for (int r = 0; r < 8; ++r) {
    int best = -1; float bv = -INFINITY;
    for (int e = 0; e < NE; ++e) {
      if (!((gmask >> (e >> 5)) & 1u)) continue;
      bool taken = false;
#pragma unroll
      for (int q = 0; q < 8; ++q) taken |= (q < r) && (sel[q] == e);
      if (taken) continue;
      const float v = sigmoidf_(lg[e]) + p.router_bias[e];
      if (v > bv) { bv = v; best = e; }
    }
    best = best < 0 ? r : best;
    sel[r] = best; sw[r] = sigmoidf_(lg[best]); wsum += sw[r];
  }
#pragma unroll
  for (int r = 0; r < 8; ++r) {
    p.tk_idx[t * 8 + r] = sel[r];
    p.tk_w[t * 8 + r] = sw[r] / wsum * 2.5f;
    p.tk_rank[t * 8 + r] = atomicAdd(&p.counts[sel[r]], 1);
  }
}
__global__ void __launch_bounds__(256) k_offsets(P p) {
  __shared__ int pad[256], st[257];
  const int e = threadIdx.x;
  pad[e] = (p.counts[e] + 127) / 128 * 128;
  __syncthreads();
  if (e == 0) { int s = 0; for (int i = 0; i < 256; ++i) { st[i] = s; s += pad[i]; } st[256] = s; }
  __syncthreads();
  p.pad_start[e] = st[e];
  if (e == 0) p.pad_start[256] = st[256];
  for (int b = st[e] / 128; b < st[e + 1] / 128; ++b) p.blk_exp[b] = e;
  for (int b = st[256] / 128 + e; b < NBLK128; b += 256) p.blk_exp[b] = -1;
}
__global__ void __launch_bounds__(256) k_scatter(P p) {
  const int i = blockIdx.x * 256 + threadIdx.x;
  const int e = p.tk_idx[i], pos = p.pad_start[e] + p.tk_rank[i];
  p.slot_tok[pos] = i >> 3;
  p.slot_of[i] = pos;
}

__device__ __forceinline__ void phase_combine(PR p, int bid, int nb) {
  const int lane = ltid() & 63, wid = ltid() >> 6;
  for (int t = bid * 8 + wid; t < T; t += nb * 8) {
    const int b = t / SEQ;
    int so[8]; float w[8];
#pragma unroll
    for (int k = 0; k < 8; ++k) { so[k] = p.slot_of[t * 8 + k]; w[k] = p.tk_w[t * 8 + k]; }
    float v[16], ss = 0.f;
#pragma unroll
    for (int i = 0; i < 4; ++i) {
      const int c0 = lane * 4 + 256 * i;
      f32x4 m = ld_bf4(p.S + (size_t)t * D + c0);
#pragma unroll
      for (int k = 0; k < 8; ++k) { const f32x4 y = ld_bf4(p.Y + (size_t)so[k] * D + c0); m[0] += w[k] * y[0]; m[1] += w[k] * y[1]; m[2] += w[k] * y[2]; m[3] += w[k] * y[3]; }
      const f32x4 xv = ld_bf4((const bf16_t*)p.x1 + (size_t)t * D + c0), gg = *(const f32x4*)(p.mod + b * 6144 + 5 * D + c0);
#pragma unroll
      for (int j = 0; j < 4; ++j) { v[i * 4 + j] = xv[j] + gg[j] * m[j]; ss += v[i * 4 + j] * v[i * 4 + j]; }
    }
#pragma unroll
    for (int o = 32; o > 0; o >>= 1) ss += __shfl_xor(ss, o);
    const float r = rsqrtf(ss * (1.f / D) + 1e-6f);
#pragma unroll
    for (int i = 0; i < 4; ++i) {
      const int c0 = lane * 4 + 256 * i; const f32x4 fg = *(const f32x4*)(p.final_g + c0);
      f32x4 o; o[0] = v[i * 4] * r * fg[0]; o[1] = v[i * 4 + 1] * r * fg[1]; o[2] = v[i * 4 + 2] * r * fg[2]; o[3] = v[i * 4 + 3] * r * fg[3];
      *(f32x4*)(p.out + (size_t)t * D + c0) = o;
    }
  }
}


template <class Epi>
__global__ void __launch_bounds__(256) k_gemm_naive(const bf16_t* __restrict__ A, int lda, const float* __restrict__ Bm, int ldb, int M, int N, int K, Epi epi) {
  __shared__ float As[16][68];
  __shared__ float Bs[16][68];
  const int tx = threadIdx.x & 15, ty = threadIdx.x >> 4;
  const int row0 = blockIdx.y * 64, col0 = blockIdx.x * 64;
  float acc[4][4];
  for (int i = 0; i < 4; ++i) for (int j = 0; j < 4; ++j) acc[i][j] = 0.f;
  for (int k0 = 0; k0 < K; k0 += 16) {
    { const int r = threadIdx.x >> 2, k4 = (threadIdx.x & 3) * 4;
      const bf16_t* ap = A + (size_t)(row0 + r) * lda + k0 + k4;
      for (int j = 0; j < 4; ++j) As[k4 + j][r] = bf2f(ap[j]); }
    { const int k = threadIdx.x >> 4, c4 = (threadIdx.x & 15) * 4;
      for (int j = 0; j < 4; ++j) { const int cc = col0 + c4 + j; Bs[k][c4 + j] = cc < N ? Bm[(size_t)(k0 + k) * ldb + cc] : 0.f; } }
    __syncthreads();
    for (int k = 0; k < 16; ++k) {
      float a[4], b[4];
      for (int i = 0; i < 4; ++i) a[i] = As[k][ty * 4 + i];
      for (int j = 0; j < 4; ++j) b[j] = Bs[k][tx * 4 + j];
      for (int i = 0; i < 4; ++i) for (int j = 0; j < 4; ++j) acc[i][j] += a[i] * b[j];
    }
    __syncthreads();
  }
  for (int i = 0; i < 4; ++i) for (int j = 0; j < 4; ++j) { const int r = row0 + ty * 4 + i, cc = col0 + tx * 4 + j; if (cc < N) epi(r, cc, acc[i][j]); }
}
struct NEpiProj { bf16_t* o; __device__ void operator()(int r, int c, float v) const { if (c >= WIN_GK && c < WIN_GK + 16) return; const int cc = c < WIN_GK ? c : c - 16; o[(size_t)r * LDP + cc] = f2bf(v); } };
struct NEpiGlu { const bf16_t* yA; const float* b; bf16_t* z; __device__ void operator()(int r, int c, float v) const { const float y = bf2f(yA[(size_t)r * S5W + c]); z[(size_t)r * S5W + c] = f2bf(y * sigmoidf_(v + b[c])); } };
struct NEpiPA { const bf16_t* proj; float* t; __device__ void operator()(int r, int c, float v) const { t[(size_t)r * D + c] = sigmoidf_(bf2f(proj[(size_t)r * LDP + OFF_GA + c])) * v; } };
struct NEpiPB { const bf16_t* proj; const float* t; bf16_t* m; __device__ void operator()(int r, int c, float v) const { m[(size_t)r * D + c] = f2bf(t[(size_t)r * D + c] + sigmoidf_(bf2f(proj[(size_t)r * LDP + OFF_GB + c])) * v); } };
struct NEpiOut { const float* x; const float* mod; float* x1; __device__ void operator()(int r, int c, float v) const { const int b = r / SEQ; x1[(size_t)r * D + c] = x[(size_t)r * D + c] + mod[b * 6144 + 2 * D + c] * v; } };
struct NEpiF32 { float* o; long ld; __device__ void operator()(int r, int c, float v) const { o[(size_t)r * ld + c] = v; } };
struct NEpiShUp { const float* g; bf16_t* h; __device__ void operator()(int r, int c, float v) const { h[(size_t)r * SFF + c] = f2bf(siluf_(g[(size_t)r * SFF + c]) * v); } };
struct NEpiBf { bf16_t* o; long ld; __device__ void operator()(int r, int c, float v) const { o[(size_t)r * ld + c] = f2bf(v); } };
__global__ void __launch_bounds__(256) k_moe_naive(P p) {
  __shared__ float xs[16][1024];
  __shared__ float hs[16][256];
  __shared__ int toks[16];
  const int s0 = blockIdx.x * 16, e = p.blk_exp[s0 / 128], tid = threadIdx.x;
  if (e < 0) return;
  if (tid < 16) toks[tid] = p.slot_tok[s0 + tid];
  __syncthreads();
  bool any = false;
  for (int s = 0; s < 16; ++s) any |= toks[s] >= 0;
  if (!any) return;
  for (int i = tid; i < 16 * 1024; i += 256) { const int s = i >> 10, d = i & 1023; xs[s][d] = toks[s] >= 0 ? bf2f(p.h2[(size_t)toks[s] * D + d]) : 0.f; }
  __syncthreads();
  {
    float ag[16], au[16];
    for (int s = 0; s < 16; ++s) { ag[s] = 0.f; au[s] = 0.f; }
    const float* wg = p.ew_gate + (size_t)e * D * EFF + tid;
    const float* wu = p.ew_up + (size_t)e * D * EFF + tid;
    for (int d = 0; d < D; ++d) {
      const float g = wg[(size_t)d * EFF], u = wu[(size_t)d * EFF];
      for (int s = 0; s < 16; ++s) { const float xv = xs[s][d]; ag[s] += xv * g; au[s] += xv * u; }
    }
    for (int s = 0; s < 16; ++s) hs[s][tid] = bf2f(f2bf(siluf_(ag[s]) * au[s]));
  }
  __syncthreads();
  for (int nb = 0; nb < 4; ++nb) {
    float acc[16];
    for (int s = 0; s < 16; ++s) acc[s] = 0.f;
    const float* wd = p.ew_down + (size_t)e * EFF * D + nb * 256 + tid;
    for (int j = 0; j < EFF; ++j) { const float w = wd[(size_t)j * D]; for (int s = 0; s < 16; ++s) acc[s] += hs[s][j] * w; }
    for (int s = 0; s < 16; ++s) if (toks[s] >= 0) p.Y[(size_t)(s0 + s) * D + nb * 256 + tid] = f2bf(acc[s]);
  }
}

#define SMEM_DECL __shared__ __attribute__((aligned(16))) unsigned char smem_raw[SMEM_BYTES]; const lds_ptr smem = (lds_ptr)smem_raw;


#define XB_TMO      128
#define XB_XCNT(j)  (256  + 64 * (j))
#define XB_XSUB(j)  (1280 + 64 * (j))
#define XB_XGEN(j)  (2304 + 64 * (j))
#define XB_TOP      3328
#define XB_TOPGEN   3392
#define XCD_BAR_WORDS 3456
#define XB_SPIN_CAP (1u << 18)
__device__ __forceinline__ unsigned xb_ld(unsigned* q)              { return __hip_atomic_load(q, __ATOMIC_RELAXED, __HIP_MEMORY_SCOPE_AGENT); }
__device__ __forceinline__ unsigned xb_add(unsigned* q, unsigned v) { return __hip_atomic_fetch_add(q, v, __ATOMIC_RELAXED, __HIP_MEMORY_SCOPE_AGENT); }
__device__ __forceinline__ unsigned xb_xcc_id() { return (unsigned)__builtin_amdgcn_s_getreg((3 << 11) | 20) & 0xFu; }
#define XB_SPIN(cond, bar) do { unsigned _sp = 0; while (cond) { __builtin_amdgcn_s_sleep(1); \
    if ((++_sp & 255u) == 0u) { if (xb_ld(&(bar)[XB_TMO])) break; if (_sp > XB_SPIN_CAP) { atomicAdd(&(bar)[XB_TMO], 1u); break; } } } } while (0)
struct XcdBarrier { unsigned* bar; unsigned x; volatile LAS unsigned* st; };
__device__ __forceinline__ XcdBarrier xcd_barrier_post(unsigned* bar, volatile LAS unsigned* st) {
  XcdBarrier b; b.bar = bar; b.x = xb_xcc_id(); b.st = st;
  if (threadIdx.x == 0) (void)xb_add(&bar[XB_XCNT(b.x)], 1u);
  return b;
}
__device__ __forceinline__ void xcd_barrier_complete(unsigned* bar, unsigned x, unsigned& nloc, unsigned& nx) {
  const unsigned G = gridDim.x * gridDim.y * gridDim.z;
  unsigned sum, cnt, mine, sp = 0u;
  for (;;) {
    sum = 0u; cnt = 0u; mine = 0u;
#pragma unroll
    for (unsigned j = 0; j < 16; ++j) { const unsigned c = xb_ld(&bar[XB_XCNT(j)]); sum += c; cnt += (c > 0u) ? 1u : 0u; mine = (j == x) ? c : mine; }
    if (sum == G) break;
    __builtin_amdgcn_s_sleep(1);
    if ((++sp & 255u) == 0u) { if (xb_ld(&bar[XB_TMO])) break; if (sp > XB_SPIN_CAP) { atomicAdd(&bar[XB_TMO], 1u); break; } }
  }
  nloc = mine > 0u ? mine : 1u; nx = cnt > 0u ? cnt : 1u;
}
__device__ __forceinline__ void xcd_barrier(const XcdBarrier& b) {
  asm volatile("s_waitcnt vmcnt(0)" ::: "memory");
  __syncthreads();
  if (threadIdx.x == 0) {
    unsigned* bar = b.bar;
    __builtin_amdgcn_s_waitcnt(0);
    unsigned nloc = b.st[0], nx = b.st[1];
    if (nloc == 0u) { xcd_barrier_complete(bar, b.x, nloc, nx); b.st[0] = nloc; b.st[1] = nx; }
    const unsigned old = xb_add(&bar[XB_XSUB(b.x)], 1u);
    const unsigned gen = old / nloc;
    if (old + 1u == (gen + 1u) * nloc) {
      __builtin_amdgcn_fence(__ATOMIC_RELEASE, "agent");
      asm volatile("s_waitcnt vmcnt(0)" ::: "memory");
      const unsigned og = xb_add(&bar[XB_TOP], 1u);
      const unsigned tg = og / nx;
      if (og + 1u == (tg + 1u) * nx) xb_add(&bar[XB_TOPGEN], 1u);
      else XB_SPIN(xb_ld(&bar[XB_TOPGEN]) == tg, bar);
      __builtin_amdgcn_fence(__ATOMIC_ACQUIRE, "agent");
      xb_add(&bar[XB_XGEN(b.x)], 1u);
      asm volatile("s_waitcnt vmcnt(0)" ::: "memory");
    } else {
      XB_SPIN(xb_ld(&bar[XB_XGEN(b.x)]) == gen, bar);
      __builtin_amdgcn_fence(__ATOMIC_ACQUIRE, "agent");
      asm volatile("s_waitcnt vmcnt(0)" ::: "memory");
    }
  }
  __syncthreads();
}

__device__ __forceinline__ const __attribute__((address_space(4))) P* kargs() { auto q = __builtin_amdgcn_kernarg_segment_ptr(); asm volatile("" : "+s"(q)); return (const __attribute__((address_space(4))) P*)q; }
#define PK (*kargs())
__global__ void __launch_bounds__(NTHR) k_fused(P p_unused) {
  SMEM_DECL
  const int bid = blockIdx.x, nb = gridDim.x;
  volatile LAS unsigned* xbw = (volatile LAS unsigned*)(smem + SMEM_BYTES - 16);
  if (threadIdx.x == 0) { xbw[0] = 0u; xbw[1] = 0u; }
  __syncthreads();
  const XcdBarrier xb = xcd_barrier_post(PK.bar, xbw);
#define GSYNC() xcd_barrier(xb)
#define RUN(k, ...) do { __VA_ARGS__; if (REP_PHASE == (k)) { _Pragma("unroll 1") for (int r_ = 0; r_ < REP_N; ++r_) { __builtin_amdgcn_sched_barrier(0); __VA_ARGS__; } } } while (0)
  RUN(0, phase_prep(PK, bid, nb, smem));                                                                   GSYNC();
  RUN(1, phase_norm<false>(PK, PK.x, PK.norm1_g, 0, D, PK.h1, bid, nb, smem));                                 GSYNC();
  RUN(2, phase_gemm_dense256_bf16(PK.h1, D, PK.wb_in, LDP, T, LDP, D, PK.proj, LDP, bid, nb, smem); gk_rows(PK, bid, nb));     GSYNC();
  RUN(3, phase_mix_local(PK, bid, nb, smem, 3));                                                           GSYNC();
  RUN(4, phase_mix_carry(PK, bid, nb, 3));                                                                 GSYNC();
  RUN(5, phase_mix_final(PK, bid, nb, smem, 3));                                                           GSYNC();
  RUN(6, phase_gemm_dense(PK.yA, S5W, PK.wb_glu, S5W, T, S5W, S5W, EpiGlu{PK.yA, PK.b_glu, PK.zA}, bid, nb, smem));   GSYNC();
  RUN(7, phase_gemm_mixed(PK, bid, nb, smem));                                                             GSYNC();
  RUN(8, phase_gemm_out256_h(PK, bid, nb, smem));    GSYNC();
  RUN(9, phase_norm_h(PK, (const bf16_t*)PK.x1, PK.norm2_g, 3 * D, 4 * D, PK.h2, bid, nb, smem));                       GSYNC();
  RUN(10, phase_gemm_rs(PK, bid, nb, smem));                                                               GSYNC();
  phase_route(PK, bid, nb, smem);                                                                                GSYNC();
  RUN(12, phase_scatter(PK, bid, nb, smem));                                                               GSYNC();
  phase_moe_pair<1>(PK, bid, nb, smem);                                                                    GSYNC();
  phase_moe_pair<2>(PK, bid, nb, smem);
  RUN(14, phase_gemm_dense256_bf16(PK.shH, SFF, PK.wb_sd, D, T, D, SFF, PK.S, D, bid, nb, smem));        GSYNC();
  RUN(15, phase_combine(PK, bid, nb));
}

static inline size_t al256(size_t v) { return (v + 255) & ~(size_t)255; }

extern "C" void kernel_launch(void* const* d_in, const int* in_sizes, int n_in, void* d_out, int out_size, void* d_ws, size_t ws_size, hipStream_t stream) {
  P p{};
  const float** pin = (const float**)&p;
  for (int i = 0; i < 32; ++i) pin[i] = (const float*)d_in[i];
  p.out = (float*)d_out;
  char* w = (char*)d_ws; size_t off = 0;
  auto take = [&](size_t bytes) { char* r = w + off; off = al256(off + bytes); return (void*)r; };
  p.mod = (float*)take(8 * 6144 * 4);
  p.wb_in = (bf16_t*)take((size_t)D * LDP * 2);
  p.wb_glu = (bf16_t*)take((size_t)S5W * S5W * 2);
  p.wb_pa = (bf16_t*)take((size_t)S5W * D * 2);
  p.wb_pb = (bf16_t*)take((size_t)GVAL * D * 2);
  p.wb_out = (bf16_t*)take((size_t)D * D * 2);
  p.wb_rs = (bf16_t*)take((size_t)D * 768 * 2);
  p.wb_sd = (bf16_t*)take((size_t)SFF * D * 2);
  p.h1 = (bf16_t*)take((size_t)T * D * 2);
  p.gkl = (float*)take((size_t)T * 16 * 4);
  p.proj = (bf16_t*)take((size_t)T * LDP * 2);
  p.abar = (float*)take(S5G * S5P * 2 * 4);
  p.bbar = (float*)take(S5G * S5P * S5H * 2 * 4);
  p.yA = (bf16_t*)take((size_t)T * S5W * 2);
  p.oraw = (float*)take((size_t)T * GVAL * 4);
  p.yB = (bf16_t*)take((size_t)T * GVAL * 2);
  p.zA = (bf16_t*)take((size_t)T * S5W * 2);
  p.mixed = (bf16_t*)take((size_t)T * D * 2);
  p.x1 = (float*)take((size_t)T * D * 4);
  p.h2 = (bf16_t*)take((size_t)T * D * 2);
  p.logits = (float*)take((size_t)T * NE * 4);
  p.tk_idx = (int*)take((size_t)T * 8 * 4);
  p.tk_w = (float*)take((size_t)T * 8 * 4);
  p.tk_rank = (int*)take((size_t)T * 8 * 4);
  p.slot_of = (int*)take((size_t)T * 8 * 4);
  p.counts = (int*)take(256 * 4);
  p.pad_start = (int*)take(257 * 4);
  p.blk_exp = (int*)take(NBLK128 * 4);
  p.slot_tok = (int*)take((size_t)NSLOT * 4);
  p.Y = (bf16_t*)take((size_t)NSLOT * D * 2);
  p.shH = (bf16_t*)take((size_t)T * SFF * 2);
  p.S = (bf16_t*)take((size_t)T * D * 2);
  p.bbarT = (bf16_t*)take((size_t)S5G * 128 * 16 * 2);
  p.cmT = (bf16_t*)take((size_t)S5G * 16 * 128 * 2);
  p.apow64 = (float*)take(S5G * S5P * 2 * 4);
  p.s5E = (float*)take((size_t)NB * 32 * S5G * 64 * 2 * 4);
  p.s5Sin = (float*)take((size_t)NB * 32 * S5G * 64 * 2 * 4);
  p.glaKV = (float*)take((size_t)1024 * 64 * 128 * 4);
  p.glaDec = (float*)take((size_t)1024 * 64 * 4);
  p.glaSin = (bf16_t*)take((size_t)1024 * 64 * 128 * 2);
  p.wgkT = (bf16_t*)take((size_t)16 * D * 2);
  p.moe_list = (int*)take((size_t)8 * NBLK128 * 4);
  p.moe_cnt = (int*)take(64);
  p.moe_ctr = (int*)take(64);
  p.Hbuf = (bf16_t*)take((size_t)NSLOT * EFF * 2);
  p.bar = (unsigned*)take(XCD_BAR_WORDS * 4);
  if (off > ws_size) { fprintf(stderr, "workspace too small: need %zu have %zu\n", off, ws_size); return; }

  static int grid_blocks = 0;
  if (!grid_blocks) {
    int dev = 0, cus = 0, per_cu = 0;
    (void)hipGetDevice(&dev);
    (void)hipDeviceGetAttribute(&cus, hipDeviceAttributeMultiprocessorCount, dev);
    (void)hipOccupancyMaxActiveBlocksPerMultiprocessor(&per_cu, k_fused, NTHR, 0);
    grid_blocks = (per_cu >= 1) ? cus : 0;
    grid_blocks &= ~7;
    if (grid_blocks <= 0) { fprintf(stderr, "occupancy query says the fused kernel does not fit (per_cu=%d cus=%d)\n", per_cu, cus); grid_blocks = 0; return; }
  }
  (void)hipMemsetAsync(p.bar, 0, XCD_BAR_WORDS * 4, stream);
  void* args[] = {&p};
  hipError_t e = hipLaunchCooperativeKernel((const void*)k_fused, dim3(grid_blocks), dim3(NTHR), args, 0, stream);
  if (e != hipSuccess) fprintf(stderr, "cooperative launch failed: %s (grid %d)\n", hipGetErrorString(e), grid_blocks);
}
```
